# Optimizing an MI355X kernel written in HIP

```python
import math
import jax
import jax.numpy as jnp
from jax import lax
import numpy as np

D_MODEL = 1024
BATCH = 8
SEQ = 4096
DEPTH = 1

GRID_W = 64
CTX_LEN = 256
NH_M = 4
DQK_M = D_MODEL // 8
DV_M = D_MODEL // 4
MLSTM_CHUNK = 128
NH_D = 8
DH_D = D_MODEL // 16
Q_BLOCK = 128
ROPE_BASE = 10000.0
N_EXPERTS = 32
TOP_K = 4
D_FF = D_MODEL
SWIGLU_LIMIT = 7.0
SWIGLU_ALPHA = 1.702
EXPERT_BLOCK = 128
NORM_EPS = 1e-6
SPLIT_SIZES = (NH_M * DQK_M, NH_M * DQK_M, NH_M * DV_M, 4 * NH_M, NH_M * DV_M,
               NH_D * 2 * DH_D, NH_D * 2 * DH_D, NH_D * 2 * DH_D, D_MODEL, D_MODEL)
IN_COLS = sum(SPLIT_SIZES)

kernel_name = 'hybrid_mlstm_diffattn_moe_dit'


def rmsnorm(x, g):
    xf = x.astype(jnp.float32)
    y = xf * lax.rsqrt(jnp.mean(xf * xf, axis=-1, keepdims=True) + NORM_EPS)
    return (y * g.astype(jnp.float32)).astype(x.dtype)


def modulate(u, shift, scale):
    return u * (1 + scale) + shift


def split_proj(u, w_in):
    return jnp.split(u @ w_in, np.cumsum(SPLIT_SIZES)[:-1].tolist(), axis=-1)


def axial_rope_tables(n_tok):
    rows = n_tok // GRID_W
    row = jnp.repeat(jnp.arange(rows, dtype=jnp.float32), GRID_W)
    col = jnp.tile(jnp.arange(GRID_W, dtype=jnp.float32), rows)
    n_freq = DH_D // 4
    inv_freq = ROPE_BASE ** (-jnp.arange(n_freq, dtype=jnp.float32) / n_freq)
    ang_r = (row[:, None] * inv_freq)[:, None, None, :]
    ang_c = (col[:, None] * inv_freq)[:, None, None, :]
    return (jnp.cos(ang_r), jnp.sin(ang_r), jnp.cos(ang_c), jnp.sin(ang_c))


def rotate_pairs(x, cos, sin):
    x1, x2 = jnp.split(x, 2, axis=-1)
    cos = cos.astype(x.dtype)
    sin = sin.astype(x.dtype)
    return jnp.concatenate([x1 * cos - x2 * sin, x2 * cos + x1 * sin], axis=-1)


def apply_axial_rope(x, tables):
    cos_r, sin_r, cos_c, sin_c = tables
    half = DH_D // 2
    return jnp.concatenate([rotate_pairs(x[..., :half], cos_r, sin_r),
                            rotate_pairs(x[..., half:], cos_c, sin_c)], axis=-1)


def mlstm_chunkwise(q, k, v, i_pre, logf, state):
    b_, h_, t_, _ = q.shape
    L = MLSTM_CHUNK
    nc = t_ // L

    def chunks(a):
        return jnp.moveaxis(a.reshape(a.shape[:2] + (nc, L) + a.shape[3:]), 2, 0)

    causal = jnp.tril(jnp.ones((L, L), dtype=bool))

    def step(carry, xs):
        C, n, m = carry
        qc, kc, vc, ic, fc = xs
        bcum = jnp.cumsum(fc, axis=-1)
        log_d = jnp.where(causal, bcum[..., :, None] - bcum[..., None, :] + ic[..., None, :], -jnp.inf)
        inter = bcum + m[..., None]
        m_t = jnp.maximum(inter, jnp.max(log_d, axis=-1))
        s = jnp.einsum('bhtk,bhsk->bhts', qc, kc) * jnp.exp(log_d - m_t[..., None])
        w_inter = jnp.exp(inter - m_t)
        num = w_inter[..., None] * jnp.einsum('bhtk,bhkv->bhtv', qc, C) + jnp.einsum('bhts,bhsv->bhtv', s, vc)
        den = w_inter * jnp.einsum('bhtk,bhk->bht', qc, n) + jnp.sum(s, axis=-1)
        h = num / jnp.maximum(jnp.abs(den), jnp.exp(-m_t))[..., None]
        b_last = bcum[..., -1]
        log_w = b_last[..., None] - bcum + ic
        m_new = jnp.maximum(b_last + m, jnp.max(log_w, axis=-1))
        w = jnp.exp(log_w - m_new[..., None])
        decay = jnp.exp(b_last + m - m_new)
        C_new = decay[..., None, None] * C + jnp.einsum('bhsk,bhsv->bhkv', kc * w[..., None], vc)
        n_new = decay[..., None] * n + jnp.einsum('bhs,bhsk->bhk', w, kc)
        return (C_new, n_new, m_new), h

    state, h = lax.scan(step, state, (chunks(q), chunks(k), chunks(v), chunks(i_pre), chunks(logf)))
    return jnp.moveaxis(h, 0, 2).reshape(b_, h_, t_, v.shape[-1]), state


def mlstm_zero_state(batch):
    return (jnp.zeros((batch, NH_M, DQK_M, DV_M), jnp.float32),
            jnp.zeros((batch, NH_M, DQK_M), jnp.float32),
            jnp.zeros((batch, NH_M), jnp.float32))


def mlstm_prepare(p, gate_b):
    b, t = p[0].shape[:2]

    def heads(a, d):
        return a.reshape(b, t, NH_M, d).transpose(0, 2, 1, 3).astype(jnp.float32)

    q = heads(p[0], DQK_M) * DQK_M ** -0.5
    k = heads(p[1], DQK_M)
    v = heads(p[2], DV_M)
    g = (p[3] + gate_b).astype(jnp.float32).reshape(b, t, 4, NH_M).transpose(2, 0, 3, 1)
    return q, k, v, g


def mlstm_direction(q, k, v, i_pre, f_pre, state, reverse):
    logf = jax.nn.log_sigmoid(f_pre)
    if reverse:
        q, k, v, i_pre, logf = (jnp.flip(a, axis=2) for a in (q, k, v, i_pre, logf))
    h, state = mlstm_chunkwise(q, k, v, i_pre, logf, state)
    if reverse:
        h = jnp.flip(h, axis=2)
    return h, state


def mlstm_output(h, o_raw, g):
    b, t = o_raw.shape[:2]
    hn = rmsnorm(h.transpose(0, 2, 1, 3), g)
    o = jax.nn.sigmoid(o_raw.astype(jnp.float32)).reshape(b, t, NH_M, DV_M)
    return (hn * o).reshape(b, t, NH_M * DV_M).astype(o_raw.dtype)


def diff_prepare(p, tables):
    b, t = p[5].shape[:2]
    q = p[5].reshape(b, t, NH_D, 2, DH_D)
    k = p[6].reshape(b, t, NH_D, 2, DH_D)
    if tables is not None:
        q = apply_axial_rope(q, tables)
        k = apply_axial_rope(k, tables)
    v = p[7].reshape(b, t, NH_D, 2 * DH_D)
    return q.transpose(0, 2, 3, 1, 4), k.transpose(0, 2, 3, 1, 4), v.transpose(0, 2, 1, 3)


def diff_attend(q, k, v, lam):
    s = jnp.einsum('bhmqd,bhmkd->bhmqk', q, k).astype(jnp.float32) * DH_D ** -0.5
    p = jax.nn.softmax(s, axis=-1)
    a = p[:, :, 0] - lam * p[:, :, 1]
    return jnp.einsum('bhqk,bhkd->bhqd', a.astype(v.dtype), v)


def diff_output(o, g, lam_init):
    b, h, t, d = o.shape
    on = rmsnorm(o.transpose(0, 2, 1, 3), g) * (1.0 - lam_init)
    return on.reshape(b, t, h * d)


def merge_branches(p, a_out, b_out, w_a, w_b, w_o):
    y = jax.nn.sigmoid(p[8]) * (a_out @ w_a) + jax.nn.sigmoid(p[9]) * (b_out @ w_b)
    return y @ w_o


def token_mixer(u, uc, tables, w_in, gate_b, m_norm_g, lam_p, d_norm_g, w_a, w_b, w_o, lam_init, need_ctx):
    pl = split_proj(u, w_in)
    pc = split_proj(uc, w_in)
    ql, kl, vl, gl = mlstm_prepare(pl, gate_b)
    qc, kc, vc, gc = mlstm_prepare(pc, gate_b)
    st0 = mlstm_zero_state(uc.shape[0])
    h_cf, st_f = mlstm_direction(qc, kc, vc, gc[0], gc[1], st0, False)
    h_cb, st_b = mlstm_direction(qc, kc, vc, gc[2], gc[3], st0, True)
    h_lf, _ = mlstm_direction(ql, kl, vl, gl[0], gl[1], st_f, False)
    h_lb, _ = mlstm_direction(ql, kl, vl, gl[2], gl[3], st_b, True)
    a_lat = mlstm_output(h_lf + h_lb, pl[4], m_norm_g)
    lp = lam_p.astype(jnp.float32)
    lam = jnp.exp(jnp.sum(lp[0] * lp[1])) - jnp.exp(jnp.sum(lp[2] * lp[3])) + lam_init
    qdl, kdl, vdl = diff_prepare(pl, tables)
    qdc, kdc, vdc = diff_prepare(pc, None)
    k_all = jnp.concatenate([kdc, kdl], axis=3)
    v_all = jnp.concatenate([vdc, vdl], axis=2)
    b, h, _, t, dh = qdl.shape
    n_blk = t // Q_BLOCK
    q_blocks = jnp.moveaxis(qdl.reshape(b, h, 2, n_blk, Q_BLOCK, dh), 3, 0)
    o_blocks = lax.map(lambda qb: diff_attend(qb, k_all, v_all, lam), q_blocks)
    o_lat = jnp.moveaxis(o_blocks, 0, 2).reshape(b, h, t, 2 * dh)
    b_lat = diff_output(o_lat, d_norm_g, lam_init)
    y = merge_branches(pl, a_lat, b_lat, w_a, w_b, w_o)
    if not need_ctx:
        return y, None
    a_ctx = mlstm_output(h_cf + h_cb, pc[4], m_norm_g)
    b_ctx = diff_output(diff_attend(qdc, kdc, vdc, lam), d_norm_g, lam_init)
    return y, merge_branches(pc, a_ctx, b_ctx, w_a, w_b, w_o)


def moe_ffn(u, router_w, router_b, w1, b1, w2, b2):
    b, t, d = u.shape
    n_tok = b * t
    xf = u.reshape(n_tok, d)
    logits = (xf @ router_w + router_b).astype(jnp.float32)
    top_val, top_idx = lax.top_k(logits, TOP_K)
    gate = jax.nn.softmax(top_val, axis=-1).astype(u.dtype)
    n_asg = n_tok * TOP_K
    flat_e = top_idx.reshape(n_asg)
    flat_tok = jnp.arange(n_asg, dtype=jnp.int32) // TOP_K
    order = jnp.argsort(flat_e)
    sorted_e = flat_e[order]
    counts = jnp.bincount(flat_e, length=N_EXPERTS)
    padded = (counts + EXPERT_BLOCK - 1) // EXPERT_BLOCK * EXPERT_BLOCK
    pad_end = jnp.cumsum(padded)
    pad_start = pad_end - padded
    sorted_start = jnp.cumsum(counts) - counts
    dest = pad_start[sorted_e] + jnp.arange(n_asg) - sorted_start[sorted_e]
    n_buf = -(-n_asg // EXPERT_BLOCK) * EXPERT_BLOCK + N_EXPERTS * EXPERT_BLOCK
    buf_tok = jnp.zeros((n_buf,), jnp.int32).at[dest].set(flat_tok[order])
    buf_w = jnp.zeros((n_buf,), u.dtype).at[dest].set(gate.reshape(n_asg)[order])
    n_blk = n_buf // EXPERT_BLOCK
    blk_e = jnp.minimum(jnp.searchsorted(pad_end, jnp.arange(n_blk) * EXPERT_BLOCK, side='right'), N_EXPERTS - 1)

    def expert_block(args):
        tok, e = args
        hcat = xf[tok] @ w1[e] + b1[e]
        h_glu = jnp.minimum(hcat[:, :D_FF], SWIGLU_LIMIT)
        h_lin = jnp.clip(hcat[:, D_FF:], -SWIGLU_LIMIT, SWIGLU_LIMIT)
        act = h_glu * jax.nn.sigmoid(SWIGLU_ALPHA * h_glu) * (h_lin + 1)
        return act @ w2[e] + b2[e]

    y_buf = lax.map(expert_block, (buf_tok.reshape(n_blk, EXPERT_BLOCK), blk_e))
    y = jax.ops.segment_sum(y_buf.reshape(n_buf, d) * buf_w[:, None], buf_tok, num_segments=n_tok)
    return y.reshape(b, t, d)


def setup_inputs(seed: int = 0) -> dict:
    key = jax.random.key(seed)
    ks = jax.random.split(key, 24)

    def nrm(k, shape, scale):
        return jax.random.normal(k, shape, jnp.float32) * scale

    L = DEPTH
    gate_base = jnp.array([0.0, 3.0, 0.0, 3.0], jnp.float32)[None, :, None]
    return {
        'x': nrm(ks[0], (BATCH, SEQ, D_MODEL), 1.0),
        'c': nrm(ks[1], (BATCH, D_MODEL), 1.0),
        'ctx': nrm(ks[2], (BATCH, CTX_LEN, D_MODEL), 1.0),
        'c_ctx': nrm(ks[3], (D_MODEL,), 1.0),
        'ada_w': nrm(ks[4], (L, D_MODEL, 6 * D_MODEL), 0.5 * D_MODEL ** -0.5),
        'ada_b': nrm(ks[5], (L, 6 * D_MODEL), 0.02),
        'norm1_g': 1.0 + nrm(ks[6], (L, D_MODEL), 0.02),
        'norm2_g': 1.0 + nrm(ks[7], (L, D_MODEL), 0.02),
        'w_in': nrm(ks[8], (L, D_MODEL, IN_COLS), D_MODEL ** -0.5),
        'mlstm_gate_b': (gate_base + nrm(ks[9], (L, 4, NH_M), 0.1)).reshape(L, 4 * NH_M),
        'mlstm_norm_g': 1.0 + nrm(ks[10], (L, NH_M, DV_M), 0.02),
        'diff_lambda': nrm(ks[11], (L, 4, DH_D), 0.1),
        'diff_norm_g': 1.0 + nrm(ks[12], (L, NH_D, 2 * DH_D), 0.02),
        'w_branch_a': nrm(ks[13], (L, NH_M * DV_M, D_MODEL), (NH_M * DV_M) ** -0.5),
        'w_branch_b': nrm(ks[14], (L, NH_D * 2 * DH_D, D_MODEL), (NH_D * 2 * DH_D) ** -0.5),
        'w_out': nrm(ks[15], (L, D_MODEL, D_MODEL), D_MODEL ** -0.5),
        'router_w': nrm(ks[16], (L, D_MODEL, N_EXPERTS), D_MODEL ** -0.5),
        'router_b': nrm(ks[17], (L, N_EXPERTS), 0.01),
        'exp_w1': nrm(ks[18], (L, N_EXPERTS, D_MODEL, 2 * D_FF), D_MODEL ** -0.5),
        'exp_b1': nrm(ks[19], (L, N_EXPERTS, 2 * D_FF), 0.01),
        'exp_w2': nrm(ks[20], (L, N_EXPERTS, D_FF, D_MODEL), D_FF ** -0.5),
        'exp_b2': nrm(ks[21], (L, N_EXPERTS, D_MODEL), 0.01),
        'final_norm_g': 1.0 + nrm(ks[22], (D_MODEL,), 0.02),
    }


def reference(x, c, ctx, c_ctx, ada_w, ada_b, norm1_g, norm2_g, w_in, mlstm_gate_b, mlstm_norm_g,
              diff_lambda, diff_norm_g, w_branch_a, w_branch_b, w_out, router_w, router_b,
              exp_w1, exp_b1, exp_w2, exp_b2, final_norm_g):
    tables = axial_rope_tables(x.shape[1])
    xc = ctx
    for l in range(DEPTH):
        need_ctx = l < DEPTH - 1
        lam_init = 0.8 - 0.6 * math.exp(-0.3 * l)
        mod = jax.nn.silu(c) @ ada_w[l] + ada_b[l]
        sh1, sc1, g1, sh2, sc2, g2 = jnp.split(mod[:, None, :], 6, axis=-1)
        modc = jax.nn.silu(c_ctx) @ ada_w[l] + ada_b[l]
        sh1c, sc1c, g1c, sh2c, sc2c, g2c = jnp.split(modc, 6, axis=-1)
        u = modulate(rmsnorm(x, norm1_g[l]), sh1, sc1)
        uc = modulate(rmsnorm(xc, norm1_g[l]), sh1c, sc1c)
        y, yc = token_mixer(u, uc, tables, w_in[l], mlstm_gate_b[l], mlstm_norm_g[l], diff_lambda[l],
                            diff_norm_g[l], w_branch_a[l], w_branch_b[l], w_out[l], lam_init, need_ctx)
        x = x + g1 * y
        x = x + g2 * moe_ffn(modulate(rmsnorm(x, norm2_g[l]), sh2, sc2), router_w[l], router_b[l],
                             exp_w1[l], exp_b1[l], exp_w2[l], exp_b2[l])
        if need_ctx:
            xc = xc + g1c * yc
            xc = xc + g2c * moe_ffn(modulate(rmsnorm(xc, norm2_g[l]), sh2c, sc2c), router_w[l], router_b[l],
                                    exp_w1[l], exp_b1[l], exp_w2[l], exp_b2[l])
    return rmsnorm(x, final_norm_g)
```

```cpp
#include <hip/hip_runtime.h>
#include <hip/hip_cooperative_groups.h>
#include <cstdio>
#include <cstdint>
namespace cg = cooperative_groups;

#define LAS __attribute__((address_space(3)))
typedef unsigned short bf16_t;
typedef short bf16x8 __attribute__((ext_vector_type(8)));
typedef short s16x4 __attribute__((ext_vector_type(4)));
typedef float f32x4 __attribute__((ext_vector_type(4)));
typedef float f32x8 __attribute__((ext_vector_type(8)));
typedef float f32x16 __attribute__((ext_vector_type(16)));
typedef unsigned u32x4 __attribute__((ext_vector_type(4)));
typedef unsigned u32x2 __attribute__((ext_vector_type(2)));

constexpr int D = 1024, BATCH = 8, SEQ = 4096, CTX = 256;
constexpr int TL = BATCH * SEQ, TC = BATCH * CTX, TT = TL + TC;
constexpr int KVLEN = CTX + SEQ;
constexpr int NEXP = 32, CAP = 32768, ACT_ROWS = 139264;
constexpr int INCOLS = 8208;
constexpr float EPS = 1e-6f;
constexpr float LAM_INIT = 0.2f;

constexpr size_t MiB = 1u << 20;
constexpr size_t WS_CTL = 0;
constexpr size_t WS_MOD = 1 * MiB;
constexpr size_t WS_ROPE = 1 * MiB + 256 * 1024;
constexpr size_t WS_LAM = 1 * MiB + 300 * 1024;
constexpr size_t WS_GT = 2 * MiB;
constexpr size_t WS_ASG = 5 * MiB;
constexpr size_t WS_LIST = 6 * MiB;
constexpr size_t WS_LGATE = 10 * MiB;
constexpr size_t WS_WIN = 16 * MiB;
constexpr size_t WS_WA = 32 * MiB, WS_WB = 34 * MiB, WS_WO = 36 * MiB;
constexpr size_t WS_W1 = 40 * MiB;
constexpr size_t WS_W2 = 168 * MiB;
constexpr size_t WS_U = 232 * MiB;
constexpr size_t WS_MQ = 300 * MiB;
constexpr size_t WS_MK = 332 * MiB;
constexpr size_t WS_MV = 366 * MiB;
constexpr size_t WS_MO = 434 * MiB;
constexpr size_t WS_HB = 498 * MiB;
constexpr size_t WS_DQ = 562 * MiB;
constexpr size_t WS_DK = 626 * MiB;
constexpr size_t WS_DV = 694 * MiB;
constexpr size_t WS_GA = 762 * MiB;
constexpr size_t WS_GB = 826 * MiB;
constexpr size_t WS_END = 890 * MiB;
constexpr size_t WS_HF = WS_U, WS_AO = WS_U, WS_BO = WS_DQ, WS_T = WS_MV, WS_Y = WS_MO, WS_U2 = WS_MQ, WS_ACT = WS_DQ, WS_YS = WS_U;
static_assert(WS_ACT + (size_t)ACT_ROWS * 2048 <= WS_END, "ACT fits");
static_assert(WS_YS + (size_t)ACT_ROWS * 2048 <= WS_DQ, "YS fits");

constexpr int CW_CNT = 0, CW_ATT = 64;
constexpr int LDS_BYTES = 147456;
constexpr int NTHREADS = 512;

struct Params {
    const float *x, *c, *ctx, *c_ctx, *ada_w, *ada_b, *norm1_g, *norm2_g, *w_in, *gate_b, *mnorm_g, *dlam, *dnorm_g, *w_a, *w_b, *w_o, *router_w, *router_b,
        *exp_w1, *exp_b1, *exp_w2, *exp_b2, *final_g;
    float* out;
    unsigned char* ws;
};

#define LDS_WAIT() asm volatile("s_waitcnt lgkmcnt(0)" ::: "memory")
#define VM_WAIT() asm volatile("s_waitcnt vmcnt(0)" ::: "memory")
__device__ __forceinline__ unsigned cvt_pk_bf16(float lo, float hi) { unsigned r; asm volatile("v_cvt_pk_bf16_f32 %0, %1, %2" : "=v"(r) : "v"(lo), "v"(hi)); return r; }
__device__ __forceinline__ float bf_lo(unsigned w) { return __uint_as_float(w << 16); }
__device__ __forceinline__ float bf_hi(unsigned w) { return __uint_as_float(w & 0xffff0000u); }
__device__ __forceinline__ float bf2f(bf16_t b) { return __uint_as_float(((unsigned)b) << 16); }
__device__ __forceinline__ float wave_sum(float v) {
#pragma unroll
    for (int o = 1; o < 64; o <<= 1) v += __shfl_xor(v, o);
    return v;
}
__device__ __forceinline__ float sigmoidf_(float x) { return 1.0f / (1.0f + __expf(-x)); }
__device__ __forceinline__ int otid() { int t = threadIdx.x; asm volatile("" : "+v"(t)); return t; }

namespace pg8 {
constexpr int BM = 256, BK = 64, HALF = 128, HTB = HALF * BK * 2, STAGE_BYTES = 8 * HTB, KD = 1024;
__host__ __device__ __forceinline__ int lds_byte(int r, int c) { const int st = (r >> 4) * 2 + (c >> 5), rr = r & 15, cc = c & 31, ob = rr * 64 + cc * 2; return st * 1024 + (ob ^ (((ob >> 9) & 1) << 5)); }
__host__ __device__ __forceinline__ void stage_rc(int b, int& R, int& C) { const int st = b / 1024, sb = b % 1024, swz = sb ^ (((sb >> 9) & 1) << 5); R = (st >> 1) * 16 + swz / 64; C = (st & 1) * 32 + (swz % 64) / 2; }

struct Unit { const char* A; const char* B; int row0; int pn; int aux; int aux2; };

__device__ __forceinline__ void tile_map(int L, int nM, int nN, int& pm, int& pn) {
    const int nwg = nM * nN; int wgid = L; { const int q = nwg / 8, r = nwg % 8, xcd = wgid % 8, off = wgid / 8; wgid = (xcd < r ? xcd * (q + 1) : r * (q + 1) + (xcd - r) * q) + off; }
    const int nig = 8 * nN, gid = wgid / nig, fm = gid * 8, gsz = (nM - fm) < 8 ? (nM - fm) : 8;
    pm = fm + ((wgid % nig) % gsz); pn = (wgid % nig) / gsz;
}

template <class Epi, class Sched, bool GATHER>
__device__ __forceinline__ void gemm_phase(LAS unsigned char* lds, const Sched& S, const Epi& E) {
    const int tid = otid(), wid = __builtin_amdgcn_readfirstlane(tid >> 6), lane = tid & 63, wr = wid >> 2, wc = wid & 3, fr = lane & 15, fq = lane >> 4;
    constexpr int K = KD, nt = K / BK;
    unsigned voffB[2], voffA0[2], voffA1[2], nvA0[2], nvA1[2];
    int sR[2], sC[2];
#pragma unroll
    for (int i = 0; i < 2; ++i) { int R, C; stage_rc(tid * 16 + i * 8192, R, C); sR[i] = R; sC[i] = C;
        voffB[i] = (unsigned)(R * K + C) * 2u; voffA0[i] = voffB[i]; voffA1[i] = voffB[i] + (unsigned)HALF * K * 2u; nvA0[i] = voffA0[i]; nvA1[i] = voffA1[i]; }
    const size_t kstep = (size_t)(BK * 2);
    const size_t hstep = (size_t)HALF * K * 2;
    const unsigned ldsw = (unsigned)wid * 1024u;
    const int aoff = lds_byte(wr * 64 + fr, fq * 8), boff = lds_byte(wc * 32 + fr, fq * 8);
#define PG8_SA(b, h) (((b) * 2 + (h)) * HTB)
#define PG8_SB(b, h) ((4 + (b) * 2 + (h)) * HTB)
#define PG8_STAGE(bufoff, gbase, voff) do { _Pragma("unroll") for (int _i = 0; _i < 2; ++_i) \
        __builtin_amdgcn_global_load_lds((const unsigned*)((const char*)(gbase) + (voff)[_i]), (LAS unsigned*)(lds + (bufoff) + ldsw + _i * 8192), 16, 0, 0); } while (0)
#define PG8_LDA(dst, b, h) do { _Pragma("unroll") for (int m = 0; m < 4; ++m) _Pragma("unroll") for (int k = 0; k < 2; ++k) dst[m][k] = *(const LAS bf16x8*)(lds + PG8_SA(b, h) + aoff + m * 2048 + k * 1024); } while (0)
#define PG8_LDB(dst, b, h) do { _Pragma("unroll") for (int n = 0; n < 2; ++n) _Pragma("unroll") for (int k = 0; k < 2; ++k) dst[n][k] = *(const LAS bf16x8*)(lds + PG8_SB(b, h) + boff + n * 2048 + k * 1024); } while (0)
#define PG8_MMA(ai, bj, At, Bt) do { __builtin_amdgcn_s_setprio(1); _Pragma("unroll") for (int m = 0; m < 4; ++m) _Pragma("unroll") for (int n = 0; n < 2; ++n) _Pragma("unroll") for (int k = 0; k < 2; ++k) \
        acc[ai][bj][m][n] = __builtin_amdgcn_mfma_f32_16x16x32_bf16(Bt[n][k], At[m][k], acc[ai][bj][m][n], 0, 0, 0); __builtin_amdgcn_s_setprio(0); } while (0)
#define PG8_WAIT_V(n) asm volatile("s_waitcnt vmcnt(" #n ")" ::: "memory")
#define PG8_WAIT_L(n) asm volatile("s_waitcnt lgkmcnt(" #n ")" ::: "memory")
#define PG8_BAR __builtin_amdgcn_s_barrier()
#define PG8_SCHED __builtin_amdgcn_sched_barrier(0)
    Unit cur, nxt; int ui = 0;
    if (!S.next(0, cur)) return;
    if constexpr (GATHER) { S.offsets(cur, sR, sC, voffA0, voffA1); }
    f32x4 acc[2][2][4][2];
#pragma unroll
    for (int a = 0; a < 2; ++a)
#pragma unroll
        for (int b = 0; b < 2; ++b)
#pragma unroll
            for (int m = 0; m < 4; ++m)
#pragma unroll
                for (int n = 0; n < 2; ++n) acc[a][b][m][n] = (f32x4){0.f, 0.f, 0.f, 0.f};
    bf16x8 At[4][2], B0[2][2], B1[2][2];
    const char* cA = cur.A; const char* cB = cur.B;
    PG8_STAGE(PG8_SB(0, 0), cB, voffB); PG8_STAGE(PG8_SB(0, 1), cB + hstep, voffB); PG8_STAGE(PG8_SA(0, 0), cA, voffA0); PG8_STAGE(PG8_SA(0, 1), cA, voffA1);
    if (wr == 1) PG8_BAR;
    PG8_WAIT_V(2); PG8_BAR;
    PG8_STAGE(PG8_SB(1, 0), cB + kstep, voffB); PG8_STAGE(PG8_SA(1, 0), cA + kstep, voffA0); PG8_STAGE(PG8_SB(1, 1), cB + hstep + kstep, voffB);
    PG8_WAIT_V(6); PG8_BAR;
    for (;;) {
        const bool has_next = S.next(ui + 1, nxt);
        if constexpr (GATHER) { if (has_next) S.offsets(nxt, sR, sC, nvA0, nvA1); }
        const char* nA = has_next ? nxt.A : cA; const char* nB = has_next ? nxt.B : cB;
        for (int t = 0; t < nt; t += 2) {
            const bool last = (t == nt - 2);
            const char* a1 = cA + (size_t)(t + 1) * kstep;
            const char* a2 = last ? nA : cA + (size_t)(t + 2) * kstep; const char* b2 = last ? nB : cB + (size_t)(t + 2) * kstep;
            const char* a3 = a2 + kstep; const char* b3 = b2 + kstep;
            unsigned w0[2], w1[2];
            if constexpr (GATHER) { const bool sw = last && has_next; w0[0] = sw ? nvA0[0] : voffA0[0]; w0[1] = sw ? nvA0[1] : voffA0[1]; w1[0] = sw ? nvA1[0] : voffA1[0]; w1[1] = sw ? nvA1[1] : voffA1[1]; }
            else { w0[0] = voffA0[0]; w0[1] = voffA0[1]; w1[0] = voffA1[0]; w1[1] = voffA1[1]; }
            PG8_LDB(B0, 0, 0); PG8_LDB(B1, 0, 1); PG8_SCHED; PG8_LDA(At, 0, 0); PG8_STAGE(PG8_SA(1, 1), a1, voffA1);
            PG8_WAIT_V(8); PG8_WAIT_L(0); PG8_BAR; PG8_MMA(0, 0, At, B0); PG8_MMA(0, 1, At, B1); PG8_BAR; PG8_SCHED;
            PG8_LDA(At, 0, 1); PG8_STAGE(PG8_SB(0, 0), b2, voffB); PG8_STAGE(PG8_SB(0, 1), b2 + hstep, voffB); PG8_STAGE(PG8_SA(0, 0), a2, w0);
            PG8_WAIT_V(8); PG8_WAIT_L(0); PG8_BAR; PG8_MMA(1, 0, At, B0); PG8_MMA(1, 1, At, B1); PG8_BAR; PG8_SCHED;
            PG8_LDB(B0, 1, 0); PG8_LDB(B1, 1, 1); PG8_SCHED; PG8_LDA(At, 1, 0); PG8_STAGE(PG8_SA(0, 1), a2, w1);
            PG8_WAIT_V(8); PG8_WAIT_L(0); PG8_BAR; PG8_MMA(0, 0, At, B0); PG8_MMA(0, 1, At, B1); PG8_BAR; PG8_SCHED;
            PG8_LDA(At, 1, 1); PG8_STAGE(PG8_SB(1, 0), b3, voffB); PG8_STAGE(PG8_SB(1, 1), b3 + hstep, voffB); PG8_STAGE(PG8_SA(1, 0), a3, w0);
            PG8_WAIT_V(8); PG8_WAIT_L(0); PG8_BAR; PG8_MMA(1, 0, At, B0); PG8_MMA(1, 1, At, B1); PG8_BAR; PG8_SCHED;
        }
        if (wr == 0) PG8_BAR;
        E(acc, cur, wr, wc, fr, fq);
        if (!has_next) break;
#pragma unroll
        for (int a = 0; a < 2; ++a)
#pragma unroll
            for (int b = 0; b < 2; ++b)
#pragma unroll
                for (int m = 0; m < 4; ++m)
#pragma unroll
                    for (int n = 0; n < 2; ++n) acc[a][b][m][n] = (f32x4){0.f, 0.f, 0.f, 0.f};
        cur = nxt; cA = nA; cB = nB; ++ui;
        if constexpr (GATHER) { voffA0[0] = nvA0[0]; voffA0[1] = nvA0[1]; voffA1[0] = nvA1[0]; voffA1[1] = nvA1[1]; }
        if (wr == 1) PG8_BAR;
    }
    PG8_WAIT_V(0);
    PG8_BAR;
#undef PG8_SA
#undef PG8_SB
#undef PG8_STAGE
#undef PG8_LDA
#undef PG8_LDB
#undef PG8_MMA
#undef PG8_WAIT_V
#undef PG8_WAIT_L
#undef PG8_BAR
#undef PG8_SCHED
}
}

using pg8::Unit;
constexpr size_t TSTEP = (size_t)256 * 1024 * 2;

struct SchedIn {
    const char* A; const char* B; int G, c;
    __device__ __forceinline__ bool next(int i, Unit& u) const {
        const int L = i * G + c; int pm, pn;
        if (L < 4096) { pg8::tile_map(L, 128, 32, pm, pn); }
        else { const int j = L - 4096; if (j >= 112) return false; pm = 128 + (j & 7); const int cj = j >> 3; pn = cj < 2 ? 2 + cj : (cj < 6 ? 4 + (cj - 2) : 16 + (cj - 6)); }
        u.A = A + (size_t)pm * TSTEP; u.B = B + (size_t)pn * TSTEP; u.row0 = pm * 256; u.pn = pn; u.aux = 0; u.aux2 = 0; return true;
    }
};
struct EpiIn {
    unsigned char* ws; const float* ropec; const float* ropes;
    __device__ __forceinline__ void operator()(const f32x4 (&acc)[2][2][4][2], const Unit& u, int wr, int wc, int fr, int fq) const {
        const int pn = u.pn, row0 = u.row0; const bool latent = row0 < TL;
        bf16_t* base; int ldc, col0, mode = 0; float sc = 1.f; int drow0 = row0;
        int kvrow0; if (latent) { const int b = row0 >> 12, t = row0 & 4095; kvrow0 = b * KVLEN + CTX + t; } else { const int cc = row0 - TL; kvrow0 = (cc >> 8) * KVLEN + (cc & 255); }
        if (pn < 2)       { base = (bf16_t*)(ws + WS_MQ); ldc = 512;  col0 = pn * 256;        sc = 0.08838834764831845f; }
        else if (pn < 4)  { base = (bf16_t*)(ws + WS_MK); ldc = 512;  col0 = (pn - 2) * 256; }
        else if (pn < 8)  { base = (bf16_t*)(ws + WS_MV); ldc = 1024; col0 = (pn - 4) * 256; }
        else if (pn < 12) { base = (bf16_t*)(ws + WS_MO); ldc = 1024; col0 = (pn - 8) * 256; }
        else if (pn < 16) { base = (bf16_t*)(ws + WS_DQ); ldc = 1024; col0 = (pn - 12) * 256; mode = 1; }
        else if (pn < 20) { base = (bf16_t*)(ws + WS_DK); ldc = 1024; col0 = (pn - 16) * 256; mode = latent ? 1 : 0; drow0 = kvrow0; }
        else if (pn < 24) { base = (bf16_t*)(ws + WS_DV); ldc = 1024; col0 = (pn - 20) * 256; drow0 = kvrow0; }
        else if (pn < 28) { base = (bf16_t*)(ws + WS_GA); ldc = 1024; col0 = (pn - 24) * 256; mode = 2; }
        else              { base = (bf16_t*)(ws + WS_GB); ldc = 1024; col0 = (pn - 28) * 256; mode = 2; }
        const int cl = col0 + wc * 32 + 4 * fq;
#pragma unroll
        for (int ai = 0; ai < 2; ++ai)
#pragma unroll
            for (int m = 0; m < 4; ++m) {
                const int rl = ai * 128 + wr * 64 + m * 16 + fr;
                bf16_t* rowp = base + (size_t)(drow0 + rl) * ldc + cl;
                f32x4 cs = {1.f, 1.f, 1.f, 1.f}, sn = {0.f, 0.f, 0.f, 0.f};
                if (mode == 1) { const int t = (row0 + rl) & 4095; const int pos = (wc & 1) ? (t & 63) : (t >> 6); cs = *(const f32x4*)(ropec + pos * 16 + 4 * fq); sn = *(const f32x4*)(ropes + pos * 16 + 4 * fq); }
#pragma unroll
                for (int bj = 0; bj < 2; ++bj) {
                    f32x4 v0 = acc[ai][bj][m][0], v1 = acc[ai][bj][m][1];
                    if (mode == 1) { const f32x4 a = v0 * cs - v1 * sn, b = v1 * cs + v0 * sn; v0 = a; v1 = b; }
                    else if (mode == 2) {
#pragma unroll
                        for (int i = 0; i < 4; ++i) { v0[i] = sigmoidf_(v0[i]); v1[i] = sigmoidf_(v1[i]); }
                    } else { v0 = v0 * sc; v1 = v1 * sc; }
                    u32x2 w0, w1; w0.x = cvt_pk_bf16(v0[0], v0[1]); w0.y = cvt_pk_bf16(v0[2], v0[3]); w1.x = cvt_pk_bf16(v1[0], v1[1]); w1.y = cvt_pk_bf16(v1[2], v1[3]);
                    *(u32x2*)(rowp + bj * 128) = w0; *(u32x2*)(rowp + bj * 128 + 16) = w1;
                }
            }
    }
};

struct SchedStatic {
    const char* A; const char* B; int nM, nN, G, c;
    __device__ __forceinline__ bool next(int i, Unit& u) const {
        const int L = i * G + c; if (L >= nM * nN) return false; int pm, pn; pg8::tile_map(L, nM, nN, pm, pn);
        u.A = A + (size_t)pm * TSTEP; u.B = B + (size_t)pn * TSTEP; u.row0 = pm * 256; u.pn = pn; u.aux = 0; u.aux2 = 0; return true;
    }
};
template <int MODE> struct EpiMerge {
    const bf16_t* gate; const bf16_t* tin; bf16_t* outp;
    __device__ __forceinline__ void operator()(const f32x4 (&acc)[2][2][4][2], const Unit& u, int wr, int wc, int fr, int fq) const {
        const int cl = u.pn * 256 + wc * 32 + 4 * fq;
#pragma unroll
        for (int ai = 0; ai < 2; ++ai)
#pragma unroll
            for (int m = 0; m < 4; ++m) {
                const size_t ro = (size_t)(u.row0 + ai * 128 + wr * 64 + m * 16 + fr) * 1024 + cl;
#pragma unroll
                for (int bj = 0; bj < 2; ++bj)
#pragma unroll
                    for (int n = 0; n < 2; ++n) {
                        const size_t o = ro + bj * 128 + n * 16;
                        const u32x2 g = *(const u32x2*)(gate + o);
                        f32x4 v = acc[ai][bj][m][n];
                        v[0] *= bf_lo(g.x); v[1] *= bf_hi(g.x); v[2] *= bf_lo(g.y); v[3] *= bf_hi(g.y);
                        if (MODE == 1) { const u32x2 t = *(const u32x2*)(tin + o); v[0] += bf_lo(t.x); v[1] += bf_hi(t.x); v[2] += bf_lo(t.y); v[3] += bf_hi(t.y); }
                        u32x2 w; w.x = cvt_pk_bf16(v[0], v[1]); w.y = cvt_pk_bf16(v[2], v[3]);
                        *(u32x2*)(outp + o) = w;
                    }
            }
    }
};
struct EpiOut {
    const float* x; const float* mod; float* x1;
    __device__ __forceinline__ void operator()(const f32x4 (&acc)[2][2][4][2], const Unit& u, int wr, int wc, int fr, int fq) const {
        const int cl = u.pn * 256 + wc * 32 + 4 * fq; const float* g1 = mod + (size_t)(u.row0 >> 12) * 6144 + 2048;
#pragma unroll
        for (int bj = 0; bj < 2; ++bj)
#pragma unroll
            for (int n = 0; n < 2; ++n) {
                const f32x4 g = *(const f32x4*)(g1 + cl + bj * 128 + n * 16);
#pragma unroll
                for (int ai = 0; ai < 2; ++ai)
#pragma unroll
                    for (int m = 0; m < 4; ++m) {
                        const size_t o = (size_t)(u.row0 + ai * 128 + wr * 64 + m * 16 + fr) * 1024 + cl + bj * 128 + n * 16;
                        const f32x4 xv = *(const f32x4*)(x + o);
                        *(f32x4*)(x1 + o) = xv + g * acc[ai][bj][m][n];
                    }
            }
    }
};

struct SchedMoe1 {
    const char* U2; const char* W1; const int* list; const LAS int* tb; const LAS int* cnt; int G, c;
    __device__ __forceinline__ bool next(int i, Unit& u) const {
        const int L = i * G + c; const int xcd = L & 7, j = L >> 3; const int pn = j & 7, rt = (j >> 3) * 8 + xcd;
        const int NRT = tb[32];
        if (rt >= NRT) return false;
        int e = 0;
#pragma unroll 1
        for (int k = 1; k < 32; ++k) e = (tb[k] <= rt) ? k : e;
        u.A = U2; u.B = W1 + ((size_t)e * 2048 + (size_t)pn * 256) * 2048; u.row0 = rt * 256; u.pn = pn; u.aux = e; u.aux2 = (rt - tb[e]) * 256; return true;
    }
    __device__ __forceinline__ void offsets(const Unit& u, const int (&sR)[2], const int (&sC)[2], unsigned (&o0)[2], unsigned (&o1)[2]) const {
        const int e = u.aux < 0 ? 0 : u.aux; const int n = u.aux < 0 ? 0 : cnt[e] - u.aux2; const int* lp = list + (size_t)e * CAP + u.aux2;
#pragma unroll
        for (int i = 0; i < 2; ++i) {
            const int r0 = sR[i], r1 = 128 + sR[i];
            const int t0 = r0 < n ? lp[r0] : 0, t1 = r1 < n ? lp[r1] : 0;
            o0[i] = (unsigned)t0 * 2048u + (unsigned)sC[i] * 2u; o1[i] = (unsigned)t1 * 2048u + (unsigned)sC[i] * 2u;
        }
    }
};
struct EpiMoe1 {
    bf16_t* act; const float* b1;
    __device__ __forceinline__ void operator()(const f32x4 (&acc)[2][2][4][2], const Unit& u, int wr, int wc, int fr, int fq) const {
        if (u.aux < 0) return;
        const int cl = u.pn * 128 + wc * 32 + 4 * fq; const float* bb = b1 + (size_t)u.aux * 2048;
#pragma unroll
        for (int n = 0; n < 2; ++n) {
            const f32x4 bg = *(const f32x4*)(bb + cl + n * 16), bl = *(const f32x4*)(bb + 1024 + cl + n * 16);
#pragma unroll
            for (int ai = 0; ai < 2; ++ai)
#pragma unroll
                for (int m = 0; m < 4; ++m) {
                    f32x4 g = acc[ai][0][m][n] + bg, l = acc[ai][1][m][n] + bl, a;
#pragma unroll
                    for (int i = 0; i < 4; ++i) { const float gg = fminf(g[i], 7.0f), ll = fminf(fmaxf(l[i], -7.0f), 7.0f); a[i] = gg * sigmoidf_(1.702f * gg) * (ll + 1.0f); }
                    u32x2 w; w.x = cvt_pk_bf16(a[0], a[1]); w.y = cvt_pk_bf16(a[2], a[3]);
                    *(u32x2*)(act + (size_t)(u.row0 + ai * 128 + wr * 64 + m * 16 + fr) * 1024 + cl + n * 16) = w;
                }
        }
    }
};
struct SchedMoe2 {
    const char* ACT; const char* W2; const LAS int* tb; int G, c;
    __device__ __forceinline__ bool next(int i, Unit& u) const {
        const int L = i * G + c; const int xcd = L & 7, j = L >> 3; const int pn = j & 3, rt = (j >> 2) * 8 + xcd;
        const int NRT = tb[32];
        if (rt >= NRT) return false;
        int e = 0;
#pragma unroll 1
        for (int k = 1; k < 32; ++k) e = (tb[k] <= rt) ? k : e;
        u.A = ACT + (size_t)rt * TSTEP; u.B = W2 + ((size_t)e * 1024 + (size_t)pn * 256) * 2048; u.row0 = rt * 256; u.pn = pn; u.aux = e; u.aux2 = (rt - tb[e]) * 256; return true;
    }
};
struct EpiMoe2 {
    bf16_t* ys; const float* b2; const float* lgate; const LAS int* cnt;
    __device__ __forceinline__ void operator()(const f32x4 (&acc)[2][2][4][2], const Unit& u, int wr, int wc, int fr, int fq) const {
        if (u.aux < 0) return;
        const int cl = u.pn * 256 + wc * 32 + 4 * fq; const float* bb = b2 + (size_t)u.aux * 1024; const int n = cnt[u.aux] - u.aux2; const float* gp = lgate + (size_t)u.aux * CAP + u.aux2;
        f32x4 bv[2][2];
#pragma unroll
        for (int bj = 0; bj < 2; ++bj)
#pragma unroll
            for (int nn = 0; nn < 2; ++nn) bv[bj][nn] = *(const f32x4*)(bb + cl + bj * 128 + nn * 16);
#pragma unroll
        for (int ai = 0; ai < 2; ++ai)
#pragma unroll
            for (int m = 0; m < 4; ++m) {
                const int rl = ai * 128 + wr * 64 + m * 16 + fr; const float gw = rl < n ? gp[rl] : 0.f;
#pragma unroll
                for (int bj = 0; bj < 2; ++bj)
#pragma unroll
                    for (int nn = 0; nn < 2; ++nn) {
                        const f32x4 v = (acc[ai][bj][m][nn] + bv[bj][nn]) * gw;
                        u32x2 w; w.x = cvt_pk_bf16(v[0], v[1]); w.y = cvt_pk_bf16(v[2], v[3]);
                        *(u32x2*)(ys + (size_t)(u.row0 + rl) * 1024 + cl + bj * 128 + nn * 16) = w;
                    }
            }
    }
};

namespace att {
constexpr int NW = 8, QBLK = 32, KVBLK = 64, LD = 1024;
constexpr float SCALE = 0.125f;
constexpr float THR = 8.f;
constexpr int SHM_V = KVBLK * 128 * 2, SHM_K = KVBLK * 128 * 2, SHM_ATTN = 2 * SHM_V + 2 * SHM_K + NW * 64 * 4;
#define KSWZ(row, colB) ((row) * 256 + ((colB) ^ (((row) & 7) << 4)))
#define SBAR() __builtin_amdgcn_sched_barrier(0)
__device__ __forceinline__ int crow(int r, int hi) { return (r & 3) + 8 * (r >> 2) + 4 * hi; }
__device__ __forceinline__ unsigned cvtpk(float lo, float hi) { unsigned r; asm volatile("v_cvt_pk_bf16_f32 %0, %1, %2" : "=v"(r) : "v"(lo), "v"(hi)); return r; }

__device__ __forceinline__ void partialSM(f32x16& p0, f32x16& p1, float& m_reg, float& mn, float& alpha) {
  constexpr float C = SCALE * 1.4426950408889634f;
  float pmax = p0[0];
#pragma unroll
  for (int r = 1; r < 16; ++r) pmax = fmaxf(pmax, p0[r]);
#pragma unroll
  for (int r = 0; r < 16; ++r) pmax = fmaxf(pmax, p1[r]);
  { auto rr = __builtin_amdgcn_permlane32_swap(__float_as_uint(pmax), __float_as_uint(pmax), false, false);
    pmax = fmaxf(__uint_as_float(rr[0]), __uint_as_float(rr[1])); }
  if (__builtin_expect(__all(pmax - m_reg <= THR / SCALE), 1)) { mn = m_reg; alpha = 1.f; }
  else { mn = fmaxf(m_reg, pmax); alpha = __builtin_amdgcn_exp2f((m_reg - mn) * C); m_reg = mn; }
  float mnC = -mn * C;
#pragma unroll
  for (int r = 0; r < 16; ++r) p0[r] = fmaf(p0[r], C, mnC);
#pragma unroll
  for (int r = 0; r < 16; ++r) p1[r] = fmaf(p1[r], C, mnC);
#pragma unroll
  for (int r = 0; r < 16; ++r) p0[r] = __builtin_amdgcn_exp2f(p0[r]);
}
__device__ __forceinline__ void finishSM(f32x16& p0, f32x16& p1, float alpha, float& l_reg, bf16x8& pa0, bf16x8& pa1, bf16x8& pa2, bf16x8& pa3) {
#pragma unroll
  for (int r = 0; r < 16; ++r) p1[r] = __builtin_amdgcn_exp2f(p1[r]);
  float ps = 0;
#pragma unroll
  for (int r = 0; r < 16; ++r) ps += p0[r];
#pragma unroll
  for (int r = 0; r < 16; ++r) ps += p1[r];
  { auto rr = __builtin_amdgcn_permlane32_swap(__float_as_uint(ps), __float_as_uint(ps), false, false);
    ps = __uint_as_float(rr[0]) + __uint_as_float(rr[1]); }
  l_reg = l_reg * alpha + ps;
#define PK4(P, BASE, OUT) do { unsigned a0 = cvtpk(P[BASE + 0], P[BASE + 1]), a1 = cvtpk(P[BASE + 2], P[BASE + 3]);   \
    unsigned b0 = cvtpk(P[BASE + 4], P[BASE + 5]), b1 = cvtpk(P[BASE + 6], P[BASE + 7]);                              \
    auto r0 = __builtin_amdgcn_permlane32_swap(a0, b0, false, false); auto r1 = __builtin_amdgcn_permlane32_swap(a1, b1, false, false); \
    u32x4 w = {r0[0], r1[0], r0[1], r1[1]}; OUT = *reinterpret_cast<bf16x8*>(&w); } while (0)
  PK4(p0, 0, pa0); PK4(p0, 8, pa1); PK4(p1, 0, pa2); PK4(p1, 8, pa3);
#undef PK4
}
__device__ __forceinline__ void qkt(f32x16& p0, f32x16& p1, const bf16_t* Ks, const bf16x8* qr, int r32, int hi, int mp) {
  p0 = f32x16{}; p1 = f32x16{};
#pragma unroll
  for (int d0 = 0; d0 < 4; ++d0) { int cb = (mp * 64 + d0 * 16 + hi * 8) * 2;
    bf16x8 b0 = *reinterpret_cast<const bf16x8*>((const char*)Ks + KSWZ(r32, cb));
    bf16x8 b1 = *reinterpret_cast<const bf16x8*>((const char*)Ks + KSWZ(32 + r32, cb));
    p0 = __builtin_amdgcn_mfma_f32_32x32x16_bf16(b0, qr[d0], p0, 0, 0, 0);
    p1 = __builtin_amdgcn_mfma_f32_32x32x16_bf16(b1, qr[d0], p1, 0, 0, 0); }
}
__device__ __forceinline__ int v_st(int k, int c) { const int kk = (k & ~0xC) | ((k & 4) << 1) | ((k & 8) >> 1); return ((kk >> 3) * 4 + (c >> 5)) * 512 + ((kk & 7) * 32 + (c & 31)) * 2; }
__device__ __forceinline__ int v_rd_base(int lane) { return ((lane & 3) << 3) | (((lane >> 2) & 3) << 6) | (((lane >> 4) & 1) << 5) | (((lane >> 5) & 1) << 8); }
constexpr int v_rd_off(int d0, int ks, int half) { return d0 * 512 + ks * 4096 + half * 2048; }
template <int OFF> __device__ __forceinline__ s16x4 tr_read(int vb) {
  s16x4 r; asm volatile("ds_read_b64_tr_b16 %0, %1 offset:%2" : "=&v"(r) : "v"(vb), "i"(OFF) : "memory"); return r;
}
template <int D0> __device__ __forceinline__ void pv_one(f32x16& od, int vb, bf16x8 pa0, bf16x8 pa1, bf16x8 pa2, bf16x8 pa3) {
  const s16x4 l0 = tr_read<v_rd_off(D0, 0, 0)>(vb), h0 = tr_read<v_rd_off(D0, 0, 1)>(vb), l1 = tr_read<v_rd_off(D0, 1, 0)>(vb), h1 = tr_read<v_rd_off(D0, 1, 1)>(vb);
  const s16x4 l2 = tr_read<v_rd_off(D0, 2, 0)>(vb), h2 = tr_read<v_rd_off(D0, 2, 1)>(vb), l3 = tr_read<v_rd_off(D0, 3, 0)>(vb), h3 = tr_read<v_rd_off(D0, 3, 1)>(vb);
  asm volatile("s_waitcnt lgkmcnt(0)" ::: "memory"); SBAR();
#define PK(L, H) (bf16x8){L[0], L[1], L[2], L[3], H[0], H[1], H[2], H[3]}
  od = __builtin_amdgcn_mfma_f32_32x32x16_bf16(pa0, PK(l0, h0), od, 0, 0, 0);
  od = __builtin_amdgcn_mfma_f32_32x32x16_bf16(pa1, PK(l1, h1), od, 0, 0, 0);
  od = __builtin_amdgcn_mfma_f32_32x32x16_bf16(pa2, PK(l2, h2), od, 0, 0, 0);
  od = __builtin_amdgcn_mfma_f32_32x32x16_bf16(pa3, PK(l3, h3), od, 0, 0, 0);
#undef PK
}
__device__ __forceinline__ void pv_d0(f32x16* o, int vb, bf16x8 pa0, bf16x8 pa1, bf16x8 pa2, bf16x8 pa3) {
  pv_one<0>(o[0], vb, pa0, pa1, pa2, pa3); pv_one<1>(o[1], vb, pa0, pa1, pa2, pa3); pv_one<2>(o[2], vb, pa0, pa1, pa2, pa3); pv_one<3>(o[3], vb, pa0, pa1, pa2, pa3);
}

__device__ __forceinline__ void attn_unit(const bf16_t* __restrict__ Qb, const bf16_t* __restrict__ Kh, const bf16_t* __restrict__ Vh, bf16_t* __restrict__ Ob,
                                          const float* __restrict__ gd, float lam, int seq, char* lds) {
  const int tid = otid(), wid = tid >> 6, lane = tid & 63, r32 = lane & 31, hi = lane >> 5;
  const int qw = wid & 3, mp = wid >> 2;
  bf16_t* V_lds = (bf16_t*)lds; bf16_t* K_lds = (bf16_t*)(lds + 2 * SHM_V);
  float* wsf = (float*)(lds + 2 * SHM_V + 2 * SHM_K) + wid * 64; float* li_l = wsf; float* al_l = wsf + 32;
  float m_reg = -1e30f, l_reg = 0; f32x16 o[4] = {}; bf16x8 qr[4];
  const bf16_t* Qw = Qb + (long)(qw * QBLK + r32) * LD + mp * 64 + hi * 8;
#pragma unroll
  for (int d0 = 0; d0 < 4; ++d0) qr[d0] = *reinterpret_cast<const bf16x8*>(Qw + d0 * 16);
  const int sr = tid >> 4, sc = (tid & 15) * 8, vst0 = v_st(sr, sc), vst1 = v_st(32 + sr, sc);
  const int vb0 = (int)(uintptr_t)V_lds + v_rd_base(lane);
  struct { bf16x8 vs0, vs1, ks0, ks1; } sr_[2];
#define SLOAD(i, k0) do { sr_[i].vs0 = *reinterpret_cast<const bf16x8*>(&Vh[(long)((k0) + sr) * LD + sc]); sr_[i].vs1 = *reinterpret_cast<const bf16x8*>(&Vh[(long)((k0) + 32 + sr) * LD + sc]); \
    sr_[i].ks0 = *reinterpret_cast<const bf16x8*>(&Kh[(long)((k0) + sr) * LD + sc]); sr_[i].ks1 = *reinterpret_cast<const bf16x8*>(&Kh[(long)((k0) + 32 + sr) * LD + sc]); } while (0)
#define SWRITE(b, i) do { *(bf16x8*)((char*)V_lds + (b) * SHM_V + vst0) = sr_[i].vs0;          \
    *(bf16x8*)((char*)V_lds + (b) * SHM_V + vst1) = sr_[i].vs1; int kc = sc * 2;               \
    *(bf16x8*)((char*)K_lds + (b) * SHM_K + KSWZ(sr, kc)) = sr_[i].ks0;                       \
    *(bf16x8*)((char*)K_lds + (b) * SHM_K + KSWZ(32 + sr, kc)) = sr_[i].ks1; } while (0)
#define SWAIT() asm volatile("s_waitcnt vmcnt(4)" ::: "memory")
#define RESC(a) do { if (__any((a) < 1.f)) { if (hi == 0) al_l[r32] = (a); asm volatile("s_waitcnt lgkmcnt(0)" ::: "memory"); \
    _Pragma("unroll") for (int d = 0; d < 4; ++d) _Pragma("unroll") for (int r = 0; r < 16; ++r) o[d][r] *= al_l[crow(r, hi)]; } } while (0)
  f32x16 pA0, pA1, pB0, pB1; float mnA, mnB, alA, alB; bf16x8 pa0, pa1, pa2, pa3; const int NT = seq / KVBLK;
  constexpr int SE = 0, SO = 1;
  SLOAD(SE, 0); asm volatile("s_waitcnt vmcnt(0)" ::: "memory"); SWRITE(0, SE); __syncthreads();
  qkt(pA0, pA1, K_lds, qr, r32, hi, mp); partialSM(pA0, pA1, m_reg, mnA, alA);
  SLOAD(SO, KVBLK); if (2 < NT) SLOAD(SE, 2 * KVBLK);
  SWAIT(); SWRITE(1, SO); __syncthreads();
  for (int j = 1; j + 1 < NT; j += 2) {
    SBAR(); qkt(pB0, pB1, (bf16_t*)((char*)K_lds + SHM_K), qr, r32, hi, mp);
    finishSM(pA0, pA1, alA, l_reg, pa0, pa1, pa2, pa3); SBAR();
    SLOAD(SO, (j + 2) * KVBLK); SBAR();
    pv_d0(o, vb0, pa0, pa1, pa2, pa3); partialSM(pB0, pB1, m_reg, mnB, alB);
    __syncthreads(); SWAIT(); SWRITE(0, SE);
    RESC(alB); __syncthreads();
    SBAR(); qkt(pA0, pA1, K_lds, qr, r32, hi, mp);
    finishSM(pB0, pB1, alB, l_reg, pa0, pa1, pa2, pa3); SBAR();
    if (j + 3 < NT) SLOAD(SE, (j + 3) * KVBLK); SBAR();
    pv_d0(o, vb0 + (int)SHM_V, pa0, pa1, pa2, pa3); partialSM(pA0, pA1, m_reg, mnA, alA);
    __syncthreads(); SWAIT(); SWRITE(1, SO);
    RESC(alA); __syncthreads();
  }
  SBAR(); qkt(pB0, pB1, (bf16_t*)((char*)K_lds + SHM_K), qr, r32, hi, mp);
  finishSM(pA0, pA1, alA, l_reg, pa0, pa1, pa2, pa3); SBAR();
  pv_d0(o, vb0, pa0, pa1, pa2, pa3); partialSM(pB0, pB1, m_reg, mnB, alB);
  __syncthreads(); RESC(alB);
  finishSM(pB0, pB1, alB, l_reg, pa0, pa1, pa2, pa3); SBAR();
  pv_d0(o, vb0 + (int)SHM_V, pa0, pa1, pa2, pa3);
  if (hi == 0) li_l[r32] = l_reg; asm volatile("s_waitcnt lgkmcnt(0)" ::: "memory");
  float rli[16];
#pragma unroll
  for (int r = 0; r < 16; ++r) rli[r] = __builtin_amdgcn_rcpf(li_l[crow(r, hi)]);
  __syncthreads();
  float* xch = (float*)lds + qw * 4096 + lane;
  if (mp == 1) {
#pragma unroll
    for (int r = 0; r < 16; ++r)
#pragma unroll
      for (int d0 = 0; d0 < 4; ++d0) xch[(r * 4 + d0) * 64] = o[d0][r] * rli[r] * lam;
  }
  __syncthreads();
  if (mp == 0) {
    float gv[4];
#pragma unroll
    for (int d0 = 0; d0 < 4; ++d0) gv[d0] = gd[d0 * 32 + r32] * (1.0f - LAM_INIT);
#pragma unroll
    for (int r = 0; r < 16; ++r) {
      float dv[4]; float ss = 0.f;
#pragma unroll
      for (int d0 = 0; d0 < 4; ++d0) { dv[d0] = o[d0][r] * rli[r] - xch[(r * 4 + d0) * 64]; ss += dv[d0] * dv[d0]; }
      ss += __shfl_xor(ss, 1); ss += __shfl_xor(ss, 2); ss += __shfl_xor(ss, 4); ss += __shfl_xor(ss, 8); ss += __shfl_xor(ss, 16);
      const float rstd = rsqrtf(ss * (1.0f / 128.0f) + EPS);
      bf16_t* orow = Ob + (long)(qw * QBLK + crow(r, hi)) * LD + r32;
#pragma unroll
      for (int d0 = 0; d0 < 4; ++d0) orow[d0 * 32] = (bf16_t)(cvtpk(dv[d0] * rstd * gv[d0], 0.f) & 0xffffu);
    }
  }
  __syncthreads();
#undef SLOAD
#undef SWRITE
#undef SWAIT
#undef RESC
}
#undef KSWZ
#undef SBAR
}

__device__ __forceinline__ float log_sigmoidf_(float x) { return x >= 0.f ? -log1pf(__expf(-x)) : x - log1pf(__expf(x)); }

__device__ __forceinline__ void transpose_item(const float* __restrict__ W, int ldw, int scol0, bf16_t* WTrow0, int k0, LAS float* scr, int lane) {
#pragma unroll 8
    for (int i = 0; i < 32; ++i) { const int kk = 2 * i + (lane >> 5); scr[kk * 33 + (lane & 31)] = W[(size_t)(k0 + kk) * ldw + scol0 + (lane & 31)]; }
    LDS_WAIT(); asm volatile("" ::: "memory");
    const int c = lane & 7;
#pragma unroll
    for (int j = 0; j < 4; ++j) { const int n = (lane >> 3) + 8 * j; const LAS float* s = scr + (8 * c) * 33 + n;
        u32x4 o; o.x = cvt_pk_bf16(s[0 * 33], s[1 * 33]); o.y = cvt_pk_bf16(s[2 * 33], s[3 * 33]); o.z = cvt_pk_bf16(s[4 * 33], s[5 * 33]); o.w = cvt_pk_bf16(s[6 * 33], s[7 * 33]);
        *(u32x4*)(WTrow0 + (size_t)n * 1024 + k0 + 8 * c) = o; }
    LDS_WAIT(); asm volatile("" ::: "memory");
}

__device__ __forceinline__ void phase_prep(const Params& p, LAS unsigned char* lds, int G) {
    const int tid = otid(), lane = tid & 63, wave = __builtin_amdgcn_readfirstlane(tid >> 6);
    const int gw = blockIdx.x * 8 + wave, NGW = G * 8;
    LAS float* sl = (LAS float*)(lds + 73728);
    for (int i = tid; i < 9 * 1024; i += NTHREADS) { const float v = i < 8192 ? p.c[i] : p.c_ctx[i - 8192]; sl[i] = v / (1.0f + __expf(-v)); }
    __syncthreads();
    float* mod = (float*)(p.ws + WS_MOD);
    if (gw < 384) {
        const int c0 = gw * 16, col = lane & 15, kq = lane >> 4;
        float acc[9];
#pragma unroll
        for (int v = 0; v < 9; ++v) acc[v] = 0.f;
        const float* wp = p.ada_w + (size_t)(kq * 256) * 6144 + c0 + col;
#pragma unroll 8
        for (int i = 0; i < 256; ++i) { const float w = wp[(size_t)i * 6144];
#pragma unroll
            for (int v = 0; v < 9; ++v) acc[v] += sl[v * 1024 + kq * 256 + i] * w; }
#pragma unroll
        for (int v = 0; v < 9; ++v) { acc[v] += __shfl_xor(acc[v], 16); acc[v] += __shfl_xor(acc[v], 32); }
        if (lane < 16) { const float b = p.ada_b[c0 + col];
#pragma unroll
            for (int v = 0; v < 9; ++v) mod[v * 6144 + c0 + col] = acc[v] + b; }
    }
    if (blockIdx.x == 0 && wave == 0) {
        const float s01 = wave_sum(p.dlam[lane] * p.dlam[64 + lane]), s23 = wave_sum(p.dlam[128 + lane] * p.dlam[192 + lane]);
        if (lane == 0) *(float*)(p.ws + WS_LAM) = expf(s01) - expf(s23) + LAM_INIT;
    }
    if (blockIdx.x == 1 && wave == 0 && lane < 16) {
        double th = 1.0; for (int j = 0; j < lane; ++j) th *= 0.5623413251903491;
        double ct = 1.0, st = th, term_c = 1.0, term_s = th; const double t2 = th * th;
        for (int n = 1; n < 14; ++n) { term_c *= -t2 / ((2.0 * n - 1.0) * (2.0 * n)); term_s *= -t2 / ((2.0 * n) * (2.0 * n + 1.0)); ct += term_c; st += term_s; }
        float* rc = (float*)(p.ws + WS_ROPE); float* rs = rc + 1024;
        double cc = 1.0, ss = 0.0;
        for (int pos = 0; pos < 64; ++pos) { rc[pos * 16 + lane] = (float)cc; rs[pos * 16 + lane] = (float)ss; const double c2 = cc * ct - ss * st, s2 = ss * ct + cc * st; cc = c2; ss = s2; }
    }
    LAS float* scr = (LAS float*)(lds + wave * 8448);
    bf16_t* WIN = (bf16_t*)(p.ws + WS_WIN);
    constexpr int I_IN = 16 * 256, I_SQ = 16 * 32, I_W1 = 32 * 16 * 64, I_W2 = 32 * 16 * 32, NITEMS = I_IN + 3 * I_SQ + I_W1 + I_W2;
    for (int it = gw; it < NITEMS; it += NGW) {
        int r = it;
        if (r < I_IN) { const int kb = r >> 8, nb = r & 255, n0 = nb * 32; transpose_item(p.w_in, INCOLS, n0 < 2048 ? n0 : n0 + 16, WIN + (size_t)n0 * 1024, kb * 64, scr, lane); continue; } r -= I_IN;
        if (r < 3 * I_SQ) { const int w = r / I_SQ, r2 = r % I_SQ, kb = r2 >> 5, nb = r2 & 31; const float* W = w == 0 ? p.w_a : (w == 1 ? p.w_b : p.w_o);
            bf16_t* WT = (bf16_t*)(p.ws + (w == 0 ? WS_WA : (w == 1 ? WS_WB : WS_WO))); transpose_item(W, 1024, nb * 32, WT + (size_t)nb * 32 * 1024, kb * 64, scr, lane); continue; } r -= 3 * I_SQ;
        if (r < I_W1) { const int e = r >> 10, r2 = r & 1023, kb = r2 >> 6, g = r2 & 63, pn = g >> 3, bj = (g >> 2) & 1, q = g & 3;
            transpose_item(p.exp_w1 + (size_t)e * 1024 * 2048, 2048, bj * 1024 + 128 * pn + 32 * q, (bf16_t*)(p.ws + WS_W1) + ((size_t)e * 2048 + 32 * g) * 1024, kb * 64, scr, lane); continue; } r -= I_W1;
        { const int e = r >> 9, r2 = r & 511, kb = r2 >> 5, nb = r2 & 31;
            transpose_item(p.exp_w2 + (size_t)e * 1024 * 1024, 1024, nb * 32, (bf16_t*)(p.ws + WS_W2) + ((size_t)e * 1024 + 32 * nb) * 1024, kb * 64, scr, lane); }
    }
}

__device__ __forceinline__ void phase_rows1(const Params& p, LAS unsigned char* lds, int G) {
    const int tid = otid(), lane = tid & 63, wave = __builtin_amdgcn_readfirstlane(tid >> 6);
    const int gw = blockIdx.x * 8 + wave, NGW = G * 8;
    LAS float* wg = (LAS float*)lds;
    for (int i = tid; i < 16 * 1024; i += NTHREADS) { const int k = i >> 4, g = i & 15; wg[g * 1024 + k] = p.w_in[(size_t)k * INCOLS + 2048 + g]; }
    __syncthreads();
    const float* mod = (const float*)(p.ws + WS_MOD); bf16_t* U = (bf16_t*)(p.ws + WS_U); float* GT = (float*)(p.ws + WS_GT);
    f32x4 gn[4];
#pragma unroll
    for (int j = 0; j < 4; ++j) gn[j] = *(const f32x4*)(p.norm1_g + 4 * lane + 256 * j);
    for (int m = gw; m < TT; m += NGW) {
        const float* xr = m < TL ? p.x + (size_t)m * 1024 : p.ctx + (size_t)(m - TL) * 1024;
        const float* md = mod + (size_t)(m < TL ? (m >> 12) : 8) * 6144;
        f32x4 v[4]; float ss = 0.f;
#pragma unroll
        for (int j = 0; j < 4; ++j) { v[j] = *(const f32x4*)(xr + 4 * lane + 256 * j); ss += (v[j][0] * v[j][0] + v[j][1] * v[j][1]) + (v[j][2] * v[j][2] + v[j][3] * v[j][3]); }
        const float rstd = rsqrtf(wave_sum(ss) * (1.0f / 1024.0f) + EPS);
#pragma unroll
        for (int j = 0; j < 4; ++j) { const f32x4 sh = *(const f32x4*)(md + 4 * lane + 256 * j), sc = *(const f32x4*)(md + 1024 + 4 * lane + 256 * j);
            v[j] = (v[j] * rstd * gn[j]) * (sc + 1.0f) + sh;
            u32x2 w; w.x = cvt_pk_bf16(v[j][0], v[j][1]); w.y = cvt_pk_bf16(v[j][2], v[j][3]); *(u32x2*)(U + (size_t)m * 1024 + 4 * lane + 256 * j) = w; }
        float gacc[16];
#pragma unroll
        for (int g = 0; g < 16; ++g) { float a = 0.f;
#pragma unroll
            for (int j = 0; j < 4; ++j) { const f32x4 w = *(const LAS f32x4*)(wg + g * 1024 + 4 * lane + 256 * j); a += (v[j][0] * w[0] + v[j][1] * w[1]) + (v[j][2] * w[2] + v[j][3] * w[3]); }
            gacc[g] = wave_sum(a); }
        if (lane < 16) { float val = 0.f;
#pragma unroll
            for (int g = 0; g < 16; ++g) val = (lane == g) ? gacc[g] : val;
            val += p.gate_b[lane]; const int type = lane >> 2; if (type & 1) val = log_sigmoidf_(val);
            GT[(size_t)m * 16 + lane] = val; }
    }
}

__device__ __forceinline__ void phase_mlstm_naive(const Params& p, LAS unsigned char* lds_, int item) {
    const int tid = otid(); float* lds = (float*)(unsigned char*)lds_;
    const int dvh = item & 1, dir = (item >> 1) & 1, h = (item >> 2) & 3, b = item >> 4;
    const int dvl = tid >> 2, kq = tid & 3;
    float* Ks = lds; float* Qs = lds + 4096; float* Vs = lds + 8192; float* gi = lds + 12288; float* gf = gi + 32;
    const bf16_t* MQ = (const bf16_t*)(p.ws + WS_MQ); const bf16_t* MK = (const bf16_t*)(p.ws + WS_MK); const bf16_t* MV = (const bf16_t*)(p.ws + WS_MV);
    const float* GT = (const float*)(p.ws + WS_GT); bf16_t* H = (bf16_t*)(p.ws + (dir ? WS_HB : WS_HF));
    float C[32], nn[32];
#pragma unroll
    for (int r = 0; r < 32; ++r) { C[r] = 0.f; nn[r] = 0.f; }
    for (int s0 = 0; s0 < KVLEN; s0 += 32) {
        const bool latent = s0 >= CTX;
        __syncthreads();
        {
            const int j = tid >> 4, c8 = (tid & 15) * 8; const int s = s0 + j;
            const int m = latent ? b * SEQ + (dir ? SEQ - 1 - (s - CTX) : s - CTX) : TL + b * CTX + (dir ? CTX - 1 - s : s);
            const bf16x8 kv = *(const bf16x8*)(MK + (size_t)m * 512 + h * 128 + c8);
            const bf16x8 vv = *(const bf16x8*)(MV + (size_t)m * 1024 + h * 256 + dvh * 128 + c8);
#pragma unroll
            for (int i = 0; i < 8; ++i) { Ks[j * 128 + c8 + i] = bf2f((bf16_t)kv[i]); Vs[j * 128 + c8 + i] = bf2f((bf16_t)vv[i]); }
            if (latent) { const bf16x8 qv = *(const bf16x8*)(MQ + (size_t)m * 512 + h * 128 + c8);
#pragma unroll
                for (int i = 0; i < 8; ++i) Qs[j * 128 + c8 + i] = bf2f((bf16_t)qv[i]); }
            if ((tid & 15) == 0) { gi[j] = GT[(size_t)m * 16 + dir * 8 + h]; gf[j] = GT[(size_t)m * 16 + dir * 8 + 4 + h]; }
        }
        __syncthreads();
        for (int j = 0; j < 32; ++j) {
            const float f = __expf(gf[j]), ig = __expf(gi[j]); const float v = Vs[j * 128 + dvl];
            float num = 0.f, den = 0.f;
            const f32x4* kp = (const f32x4*)(Ks + j * 128 + kq * 32); const f32x4* qp = (const f32x4*)(Qs + j * 128 + kq * 32);
#pragma unroll
            for (int r4 = 0; r4 < 8; ++r4) { const f32x4 k4 = kp[r4]; f32x4 q4 = {0.f, 0.f, 0.f, 0.f}; if (latent) q4 = qp[r4];
#pragma unroll
                for (int i = 0; i < 4; ++i) { const int r = r4 * 4 + i; const float ik = ig * k4[i]; C[r] = f * C[r] + ik * v; nn[r] = f * nn[r] + ik; num += q4[i] * C[r]; den += q4[i] * nn[r]; } }
            if (latent) {
                num += __shfl_xor(num, 1); num += __shfl_xor(num, 2); den += __shfl_xor(den, 1); den += __shfl_xor(den, 2);
                if (kq == 0) { const int s = s0 + j; const int m = b * SEQ + (dir ? SEQ - 1 - (s - CTX) : s - CTX);
                    const float hv = num / fmaxf(fabsf(den), 1.0f);
                    H[(size_t)m * 1024 + h * 256 + dvh * 128 + dvl] = (bf16_t)(cvt_pk_bf16(hv, 0.f) & 0xffffu); }
            }
        }
    }
    __syncthreads();
}

__device__ __forceinline__ void phase_mfinal(const Params& p, int G) {
    const int tid = otid(), lane = tid & 63, wave = __builtin_amdgcn_readfirstlane(tid >> 6);
    const int gw = blockIdx.x * 8 + wave, NGW = G * 8;
    bf16_t* HF = (bf16_t*)(p.ws + WS_HF); const bf16_t* HB = (const bf16_t*)(p.ws + WS_HB); const bf16_t* MO = (const bf16_t*)(p.ws + WS_MO);
    for (int m = gw; m < TL; m += NGW) {
#pragma unroll
        for (int j = 0; j < 4; ++j) {
            const size_t o = (size_t)m * 1024 + 256 * j + 4 * lane;
            const u32x2 a = *(const u32x2*)(HF + o), bq = *(const u32x2*)(HB + o), og = *(const u32x2*)(MO + o);
            f32x4 hs = {bf_lo(a.x) + bf_lo(bq.x), bf_hi(a.x) + bf_hi(bq.x), bf_lo(a.y) + bf_lo(bq.y), bf_hi(a.y) + bf_hi(bq.y)};
            const float rstd = rsqrtf(wave_sum((hs[0] * hs[0] + hs[1] * hs[1]) + (hs[2] * hs[2] + hs[3] * hs[3])) * (1.0f / 256.0f) + EPS);
            const f32x4 g = *(const f32x4*)(p.mnorm_g + 256 * j + 4 * lane);
            const f32x4 ov = {sigmoidf_(bf_lo(og.x)), sigmoidf_(bf_hi(og.x)), sigmoidf_(bf_lo(og.y)), sigmoidf_(bf_hi(og.y))};
            const f32x4 r = hs * rstd * g * ov;
            u32x2 w; w.x = cvt_pk_bf16(r[0], r[1]); w.y = cvt_pk_bf16(r[2], r[3]); *(u32x2*)(HF + o) = w;
        }
    }
}

__device__ __forceinline__ void phase_rows2(const Params& p, LAS unsigned char* lds, int grp) {
    const int tid = otid(), lane = tid & 63, wave = __builtin_amdgcn_readfirstlane(tid >> 6);
    LAS float* rw = (LAS float*)lds;
    LAS int* hist = (LAS int*)(lds + 131072);
    LAS int* basee = hist + 32;
    LAS int* a_e = basee + 32;
    LAS int* a_p = a_e + 512;
    LAS float* a_g = (LAS float*)(a_p + 512);
    for (int i = tid; i < 32 * 1024; i += NTHREADS) { const int k = i >> 5, e = i & 31; rw[e * 1024 + k] = p.router_w[i]; }
    if (tid < 32) hist[tid] = 0;
    __syncthreads();
    const float* mod = (const float*)(p.ws + WS_MOD); bf16_t* U2 = (bf16_t*)(p.ws + WS_U2);
    unsigned* cnt = (unsigned*)(p.ws + WS_CTL) + CW_CNT; int* asg = (int*)(p.ws + WS_ASG); int* list = (int*)(p.ws + WS_LIST); float* lgate = (float*)(p.ws + WS_LGATE);
    f32x4 gn[4];
#pragma unroll
    for (int j = 0; j < 4; ++j) gn[j] = *(const f32x4*)(p.norm2_g + 4 * lane + 256 * j);
    const int tok0 = grp * 128 + wave * 16;
    for (int it = 0; it < 16; ++it) {
        const int m = tok0 + it; const float* xr = p.out + (size_t)m * 1024; const float* md = mod + (size_t)(m >> 12) * 6144;
        f32x4 v[4]; float ss = 0.f;
#pragma unroll
        for (int j = 0; j < 4; ++j) { v[j] = *(const f32x4*)(xr + 4 * lane + 256 * j); ss += (v[j][0] * v[j][0] + v[j][1] * v[j][1]) + (v[j][2] * v[j][2] + v[j][3] * v[j][3]); }
        const float rstd = rsqrtf(wave_sum(ss) * (1.0f / 1024.0f) + EPS);
#pragma unroll
        for (int j = 0; j < 4; ++j) { const f32x4 sh = *(const f32x4*)(md + 3072 + 4 * lane + 256 * j), sc = *(const f32x4*)(md + 4096 + 4 * lane + 256 * j);
            v[j] = (v[j] * rstd * gn[j]) * (sc + 1.0f) + sh;
            u32x2 w; w.x = cvt_pk_bf16(v[j][0], v[j][1]); w.y = cvt_pk_bf16(v[j][2], v[j][3]); *(u32x2*)(U2 + (size_t)m * 1024 + 4 * lane + 256 * j) = w; }
        float mine = 0.f;
#pragma unroll 4
        for (int e = 0; e < 32; ++e) { float a = 0.f;
#pragma unroll
            for (int j = 0; j < 4; ++j) { const f32x4 w = *(const LAS f32x4*)(rw + e * 1024 + 4 * lane + 256 * j); a += (v[j][0] * w[0] + v[j][1] * w[1]) + (v[j][2] * w[2] + v[j][3] * w[3]); }
            a = wave_sum(a); mine = (lane == e) ? a : mine; }
        if (lane < 32) mine += p.router_b[lane];
        float val = lane < 32 ? mine : -INFINITY; int sel_e[4]; float sel_v[4];
#pragma unroll
        for (int k = 0; k < 4; ++k) {
            float bv = val; int bi = lane;
#pragma unroll
            for (int o = 1; o < 64; o <<= 1) { const float ov = __shfl_xor(bv, o); const int oi = __shfl_xor(bi, o); if (ov > bv || (ov == bv && oi < bi)) { bv = ov; bi = oi; } }
            sel_e[k] = bi; sel_v[k] = bv; if (lane == bi) val = -INFINITY;
        }
        if (lane == 0) {
            const float e1 = __expf(sel_v[1] - sel_v[0]), e2 = __expf(sel_v[2] - sel_v[0]), e3 = __expf(sel_v[3] - sel_v[0]); const float inv = 1.0f / (1.0f + e1 + e2 + e3);
            const float gk[4] = {inv, e1 * inv, e2 * inv, e3 * inv};
#pragma unroll
            for (int k = 0; k < 4; ++k) { const int a = (wave * 16 + it) * 4 + k; a_e[a] = sel_e[k]; a_p[a] = atomicAdd((int*)&hist[sel_e[k]], 1); a_g[a] = gk[k]; }
        }
    }
    __syncthreads();
    if (tid < 32) basee[tid] = (int)atomicAdd(cnt + tid, (unsigned)hist[tid]);
    __syncthreads();
    {
        const int a = tid; const int e = a_e[a]; const int pos = basee[e] + a_p[a]; const int tok = grp * 128 + (a >> 2);
        list[(size_t)e * CAP + pos] = tok; lgate[(size_t)e * CAP + pos] = a_g[a]; asg[tok * 4 + (a & 3)] = e * CAP + pos;
    }
    __syncthreads();
}

__device__ __forceinline__ void moe_tables(const Params& p, LAS int* tb, LAS int* cn) {
    if (threadIdx.x == 0) { const unsigned* cnt = (const unsigned*)(p.ws + WS_CTL) + CW_CNT; int acc = 0;
        for (int e = 0; e < 32; ++e) { const int c = (int)__hip_atomic_load(cnt + e, __ATOMIC_RELAXED, __HIP_MEMORY_SCOPE_AGENT); cn[e] = c; tb[e] = acc; acc += (c + 255) >> 8; } tb[32] = acc; }
    __syncthreads();
}

__device__ __forceinline__ void phase_final(const Params& p, const LAS int* tb, int G) {
    const int tid = otid(), lane = tid & 63, wave = __builtin_amdgcn_readfirstlane(tid >> 6);
    const int gw = blockIdx.x * 8 + wave, NGW = G * 8;
    const float* mod = (const float*)(p.ws + WS_MOD); const bf16_t* YS = (const bf16_t*)(p.ws + WS_YS); const int* asg = (const int*)(p.ws + WS_ASG);
    f32x4 gn[4];
#pragma unroll
    for (int j = 0; j < 4; ++j) gn[j] = *(const f32x4*)(p.final_g + 4 * lane + 256 * j);
    for (int m = gw; m < TL; m += NGW) {
        float* xr = p.out + (size_t)m * 1024; const float* g2 = mod + (size_t)(m >> 12) * 6144 + 5120;
        size_t rows[4];
#pragma unroll
        for (int k = 0; k < 4; ++k) { const int a = asg[m * 4 + k]; const int e = a >> 15, pos = a & (CAP - 1); rows[k] = (size_t)(tb[e] * 256 + pos) * 1024; }
        f32x4 v[4]; float ss = 0.f;
#pragma unroll
        for (int j = 0; j < 4; ++j) {
            f32x4 y = {0.f, 0.f, 0.f, 0.f};
#pragma unroll
            for (int k = 0; k < 4; ++k) { const u32x2 w = *(const u32x2*)(YS + rows[k] + 4 * lane + 256 * j); y[0] += bf_lo(w.x); y[1] += bf_hi(w.x); y[2] += bf_lo(w.y); y[3] += bf_hi(w.y); }
            v[j] = *(const f32x4*)(xr + 4 * lane + 256 * j) + *(const f32x4*)(g2 + 4 * lane + 256 * j) * y;
            ss += (v[j][0] * v[j][0] + v[j][1] * v[j][1]) + (v[j][2] * v[j][2] + v[j][3] * v[j][3]);
        }
        const float rstd = rsqrtf(wave_sum(ss) * (1.0f / 1024.0f) + EPS);
#pragma unroll
        for (int j = 0; j < 4; ++j) *(f32x4*)(xr + 4 * lane + 256 * j) = v[j] * rstd * gn[j];
    }
}

__device__ __forceinline__ void phase_attn(const Params& p, LAS unsigned char* lds_, int G) {
    char* lds = (char*)(unsigned char*)lds_;
    volatile int* uslot = (volatile int*)(lds + att::SHM_ATTN);
    unsigned* ctr = (unsigned*)(p.ws + WS_CTL) + CW_ATT;
    const float lam = *(const float*)(p.ws + WS_LAM);
    const bf16_t* DQ = (const bf16_t*)(p.ws + WS_DQ); const bf16_t* DK = (const bf16_t*)(p.ws + WS_DK); const bf16_t* DV = (const bf16_t*)(p.ws + WS_DV); bf16_t* BO = (bf16_t*)(p.ws + WS_BO);
    for (;;) {
        __syncthreads();
        if (threadIdx.x == 0) uslot[0] = (int)atomicAdd(ctr, 1u);
        __syncthreads();
        const int u = uslot[0];
        if (u >= 2048) break;
        const int bh = u >> 5, qb = u & 31, b = bh >> 3, h = bh & 7;
        const size_t qoff = ((size_t)b * SEQ + qb * 128) * 1024 + h * 128, koff = (size_t)b * KVLEN * 1024 + h * 128;
        att::attn_unit(DQ + qoff, DK + koff, DV + koff, BO + qoff, p.dnorm_g + h * 128, lam, KVLEN, lds);
    }
}

__global__ void __launch_bounds__(NTHREADS, 2) fwd_megakernel(Params p) {
    extern __shared__ __attribute__((aligned(16))) unsigned char smem[];
    LAS unsigned char* lds = (LAS unsigned char*)smem;
    cg::grid_group grid = cg::this_grid();
    const int G = gridDim.x, c = blockIdx.x;
    unsigned char* ws = p.ws;

#ifndef PH_MASK
#define PH_MASK 0xFFFF
#endif
#define PH(k) if constexpr (((PH_MASK) >> (k)) & 1)
    PH(0) phase_prep(p, lds, G);
    grid.sync();
    PH(1) phase_rows1(p, lds, G);
    grid.sync();
    PH(2) {
        SchedIn S{(const char*)(ws + WS_U), (const char*)(ws + WS_WIN), G, c};
        EpiIn E{ws, (const float*)(ws + WS_ROPE), (const float*)(ws + WS_ROPE) + 1024};
        pg8::gemm_phase<EpiIn, SchedIn, false>(lds, S, E);
    }
    grid.sync();
    PH(3) for (int item = c; item < 128; item += G) phase_mlstm_naive(p, lds, item);
    PH(4) phase_attn(p, lds, G);
    grid.sync();
    PH(5) phase_mfinal(p, G);
    grid.sync();
    PH(6) {
        SchedStatic S{(const char*)(ws + WS_AO), (const char*)(ws + WS_WA), 128, 4, G, c};
        EpiMerge<0> E{(const bf16_t*)(ws + WS_GA), nullptr, (bf16_t*)(ws + WS_T)};
        pg8::gemm_phase<EpiMerge<0>, SchedStatic, false>(lds, S, E);
    }
    grid.sync();
    PH(7) {
        SchedStatic S{(const char*)(ws + WS_BO), (const char*)(ws + WS_WB), 128, 4, G, c};
        EpiMerge<1> E{(const bf16_t*)(ws + WS_GB), (const bf16_t*)(ws + WS_T), (bf16_t*)(ws + WS_Y)};
        pg8::gemm_phase<EpiMerge<1>, SchedStatic, false>(lds, S, E);
    }
    grid.sync();
    PH(8) {
        SchedStatic S{(const char*)(ws + WS_Y), (const char*)(ws + WS_WO), 128, 4, G, c};
        EpiOut E{p.x, (const float*)(ws + WS_MOD), p.out};
        pg8::gemm_phase<EpiOut, SchedStatic, false>(lds, S, E);
    }
    grid.sync();
    PH(9) for (int grp = c; grp < 256; grp += G) phase_rows2(p, lds, grp);
    grid.sync();
    LAS int* tb = (LAS int*)(lds + 131072); LAS int* cn = tb + 64;
    moe_tables(p, tb, cn);
    PH(10) {
        SchedMoe1 S{(const char*)(ws + WS_U2), (const char*)(ws + WS_W1), (const int*)(ws + WS_LIST), tb, cn, G, c};
        EpiMoe1 E{(bf16_t*)(ws + WS_ACT), p.exp_b1};
        pg8::gemm_phase<EpiMoe1, SchedMoe1, true>(lds, S, E);
    }
    grid.sync();
    PH(11) {
        SchedMoe2 S{(const char*)(ws + WS_ACT), (const char*)(ws + WS_W2), tb, G, c};
        EpiMoe2 E{(bf16_t*)(ws + WS_YS), p.exp_b2, (const float*)(ws + WS_LGATE), cn};
        pg8::gemm_phase<EpiMoe2, SchedMoe2, false>(lds, S, E);
    }
    grid.sync();
    PH(12) phase_final(p, tb, G);
}

extern "C" void kernel_launch(void* const* d_in, const int* in_sizes, int n_in, void* d_out, int out_size, void* d_ws, size_t ws_size, hipStream_t stream) {
    static int grid = 0;
    if (grid == 0) {
        if (n_in != 23 || out_size != TL * D || ws_size < WS_END) { fprintf(stderr, "kernel_launch: unexpected shapes: n_in %d out %d ws %zu (need %zu)\n", n_in, out_size, ws_size, (size_t)WS_END); grid = -1; return; }
        int dev = 0, cus = 0, per_cu = 0;
        hipGetDevice(&dev); hipDeviceGetAttribute(&cus, hipDeviceAttributeMultiprocessorCount, dev);
        if (hipFuncSetAttribute((const void*)fwd_megakernel, hipFuncAttributeMaxDynamicSharedMemorySize, LDS_BYTES) != hipSuccess) { fprintf(stderr, "kernel_launch: hipFuncSetAttribute failed\n"); grid = -1; return; }
        if (hipOccupancyMaxActiveBlocksPerMultiprocessor(&per_cu, (const void*)fwd_megakernel, NTHREADS, LDS_BYTES) != hipSuccess || per_cu < 1) { fprintf(stderr, "kernel_launch: occupancy query says %d\n", per_cu); per_cu = 1; }
        (void)hipGetLastError();
        grid = cus;
        if (grid > 256) grid = 256;
    }
    if (grid < 0) return;
    hipMemsetAsync((char*)d_ws + WS_CTL, 0, 4096, stream);
    Params p{};
    const float** pp = (const float**)&p;
    for (int i = 0; i < 23; ++i) pp[i] = (const float*)d_in[i];
    p.out = (float*)d_out; p.ws = (unsigned char*)d_ws;
    void* args[] = {&p};
    hipError_t e = hipLaunchCooperativeKernel((const void*)fwd_megakernel, dim3(grid), dim3(NTHREADS), args, LDS_BYTES, stream);
    if (e != hipSuccess) fprintf(stderr, "cooperative launch failed: %s (grid %d)\n", hipGetErrorString(e), grid);
}
```

```cpp
#include <hip/hip_runtime.h>
#include <hip/hip_cooperative_groups.h>
#include <cstdio>
#include <cstdint>
namespace cg = cooperative_groups;

#define LAS __attribute__((address_space(3)))
typedef unsigned short bf16_t;
typedef short bf16x8 __attribute__((ext_vector_type(8)));
typedef short s16x4 __attribute__((ext_vector_type(4)));
typedef float f32x4 __attribute__((ext_vector_type(4)));
typedef float f32x8 __attribute__((ext_vector_type(8)));
typedef float f32x16 __attribute__((ext_vector_type(16)));
typedef unsigned u32x4 __attribute__((ext_vector_type(4)));
typedef unsigned u32x2 __attribute__((ext_vector_type(2)));

constexpr int D = 1024, BATCH = 8, SEQ = 4096, CTX = 256;
constexpr int TL = BATCH * SEQ, TC = BATCH * CTX, TT = TL + TC;
constexpr int KVLEN = CTX + SEQ;
constexpr int NEXP = 32, CAP = 32768, ACT_ROWS = 139264;
constexpr int INCOLS = 8208;
constexpr float EPS = 1e-6f;
constexpr float LAM_INIT = 0.2f;

constexpr size_t MiB = 1u << 20;
constexpr size_t WS_CTL = 0;
constexpr size_t WS_MOD = 1 * MiB;
constexpr size_t WS_ROPE = 1 * MiB + 256 * 1024;
constexpr size_t WS_LAM = 1 * MiB + 300 * 1024;
constexpr size_t WS_GT = 2 * MiB;
constexpr size_t WS_ASG = 5 * MiB;
constexpr size_t WS_LIST = 6 * MiB;
constexpr size_t WS_LGATE = 10 * MiB;
constexpr size_t WS_WIN = 16 * MiB;
constexpr size_t WS_WA = 32 * MiB, WS_WB = 34 * MiB, WS_WO = 36 * MiB;
constexpr size_t WS_W1 = 40 * MiB;
constexpr size_t WS_W2 = 168 * MiB;
constexpr size_t WS_U = 232 * MiB;
constexpr size_t WS_MQ = 300 * MiB;
constexpr size_t WS_MK = 332 * MiB;
constexpr size_t WS_MV = 366 * MiB;
constexpr size_t WS_MO = 434 * MiB;
constexpr size_t WS_HB = 498 * MiB;
constexpr size_t WS_DQ = 562 * MiB;
constexpr size_t WS_DK = 626 * MiB;
constexpr size_t WS_DV = 694 * MiB;
constexpr size_t WS_GA = 762 * MiB;
constexpr size_t WS_GB = 826 * MiB;
constexpr size_t WS_END = 890 * MiB;
constexpr size_t WS_HF = WS_U, WS_AO = WS_U, WS_BO = WS_DQ, WS_T = WS_MV, WS_Y = WS_MO, WS_U2 = WS_MQ, WS_ACT = WS_DQ, WS_YS = WS_U;
static_assert(WS_ACT + (size_t)ACT_ROWS * 2048 <= WS_END, "ACT fits");
static_assert(WS_YS + (size_t)ACT_ROWS * 2048 <= WS_DQ, "YS fits");

constexpr int CW_CNT = 0, CW_ATT = 64;
constexpr int LDS_BYTES = 147456;
constexpr int NTHREADS = 512;

struct Params {
    const float *x, *c, *ctx, *c_ctx, *ada_w, *ada_b, *norm1_g, *norm2_g, *w_in, *gate_b, *mnorm_g, *dlam, *dnorm_g, *w_a, *w_b, *w_o, *router_w, *router_b,
        *exp_w1, *exp_b1, *exp_w2, *exp_b2, *final_g;
    float* out;
    unsigned char* ws;
};

#define LDS_WAIT() asm volatile("s_waitcnt lgkmcnt(0)" ::: "memory")
#define VM_WAIT() asm volatile("s_waitcnt vmcnt(0)" ::: "memory")
typedef float f32x2_t __attribute__((ext_vector_type(2))); typedef __bf16 bf16x2_t __attribute__((ext_vector_type(2)));
__device__ __forceinline__ unsigned cvt_pk_bf16(float lo, float hi) { f32x2_t v = {lo, hi}; bf16x2_t b = __builtin_convertvector(v, bf16x2_t); return __builtin_bit_cast(unsigned, b); }
__device__ __forceinline__ float bf_lo(unsigned w) { return __uint_as_float(w << 16); }
__device__ __forceinline__ float bf_hi(unsigned w) { return __uint_as_float(w & 0xffff0000u); }
__device__ __forceinline__ float bf2f(bf16_t b) { return __uint_as_float(((unsigned)b) << 16); }
__device__ __forceinline__ float wave_sum(float v) {
#pragma unroll
    for (int o = 1; o < 64; o <<= 1) v += __shfl_xor(v, o);
    return v;
}
__device__ __forceinline__ float sigmoidf_(float x) { return 1.0f / (1.0f + __expf(-x)); }
__device__ __forceinline__ int otid() { int t = threadIdx.x; asm volatile("" : "+v"(t)); return t; }

namespace pg8 {
constexpr int BM = 256, BK = 64, HALF = 128, HTB = HALF * BK * 2, STAGE_BYTES = 8 * HTB, KD = 1024;
__host__ __device__ __forceinline__ int lds_byte(int r, int c) { const int st = (r >> 4) * 2 + (c >> 5), rr = r & 15, cc = c & 31, ob = rr * 64 + cc * 2; return st * 1024 + (ob ^ (((ob >> 9) & 1) << 5)); }
__host__ __device__ __forceinline__ void stage_rc(int b, int& R, int& C) { const int st = b / 1024, sb = b % 1024, swz = sb ^ (((sb >> 9) & 1) << 5); R = (st >> 1) * 16 + swz / 64; C = (st & 1) * 32 + (swz % 64) / 2; }

struct Unit { const char* A; const char* B; int row0; int pn; int aux; int aux2; };

__device__ __forceinline__ void tile_map(int L, int nM, int nN, int& pm, int& pn) {
    const int nwg = nM * nN; int wgid = L; { const int q = nwg / 8, r = nwg % 8, xcd = wgid % 8, off = wgid / 8; wgid = (xcd < r ? xcd * (q + 1) : r * (q + 1) + (xcd - r) * q) + off; }
    const int nig = 8 * nN, gid = wgid / nig, fm = gid * 8, gsz = (nM - fm) < 8 ? (nM - fm) : 8;
    pm = fm + ((wgid % nig) % gsz); pn = (wgid % nig) / gsz;
}

template <class Epi, class Sched, bool GATHER>
__device__ __forceinline__ void gemm_phase(LAS unsigned char* lds, const Sched& S, const Epi& E) {
    const int tid = otid(), wid = __builtin_amdgcn_readfirstlane(tid >> 6), lane = tid & 63, wr = wid >> 2, wc = wid & 3, fr = lane & 15, fq = lane >> 4;
    constexpr int K = KD, nt = K / BK;
    unsigned voffB[2], voffA0[2], voffA1[2], nvA0[2], nvA1[2];
    int sR[2], sC[2];
#pragma unroll
    for (int i = 0; i < 2; ++i) { int R, C; stage_rc(tid * 16 + i * 8192, R, C); sR[i] = R; sC[i] = C;
        voffB[i] = (unsigned)(R * K + C) * 2u; voffA0[i] = voffB[i]; voffA1[i] = voffB[i] + (unsigned)HALF * K * 2u; nvA0[i] = voffA0[i]; nvA1[i] = voffA1[i]; }
    const size_t kstep = (size_t)(BK * 2);
    const size_t hstep = (size_t)HALF * K * 2;
    const unsigned ldsw = (unsigned)wid * 1024u;
    const int aoff = lds_byte(wr * 64 + fr, fq * 8), boff = lds_byte(wc * 32 + fr, fq * 8);
#define PG8_SA(b, h) (((b) * 2 + (h)) * HTB)
#define PG8_SB(b, h) ((4 + (b) * 2 + (h)) * HTB)
#define PG8_STAGE(bufoff, gbase, voff) do { _Pragma("unroll") for (int _i = 0; _i < 2; ++_i) \
        __builtin_amdgcn_global_load_lds((const unsigned*)((const char*)(gbase) + (voff)[_i]), (LAS unsigned*)(lds + (bufoff) + ldsw + _i * 8192), 16, 0, 0); } while (0)
#define PG8_LDA(dst, b, h) do { _Pragma("unroll") for (int m = 0; m < 4; ++m) _Pragma("unroll") for (int k = 0; k < 2; ++k) dst[m][k] = *(const LAS bf16x8*)(lds + PG8_SA(b, h) + aoff + m * 2048 + k * 1024); } while (0)
#define PG8_LDB(dst, b, h) do { _Pragma("unroll") for (int n = 0; n < 2; ++n) _Pragma("unroll") for (int k = 0; k < 2; ++k) dst[n][k] = *(const LAS bf16x8*)(lds + PG8_SB(b, h) + boff + n * 2048 + k * 1024); } while (0)
#define PG8_MMA(ai, bj, At, Bt) do { __builtin_amdgcn_s_setprio(1); _Pragma("unroll") for (int m = 0; m < 4; ++m) _Pragma("unroll") for (int n = 0; n < 2; ++n) _Pragma("unroll") for (int k = 0; k < 2; ++k) \
        acc[ai][bj][m][n] = __builtin_amdgcn_mfma_f32_16x16x32_bf16(Bt[n][k], At[m][k], acc[ai][bj][m][n], 0, 0, 0); __builtin_amdgcn_s_setprio(0); } while (0)
#define PG8_WAIT_V(n) asm volatile("s_waitcnt vmcnt(" #n ")" ::: "memory")
#define PG8_WAIT_L(n) asm volatile("s_waitcnt lgkmcnt(" #n ")" ::: "memory")
#define PG8_BAR __builtin_amdgcn_s_barrier()
#define PG8_SCHED __builtin_amdgcn_sched_barrier(0)
    Unit cur, nxt; int ui = 0;
    if (!S.next(0, cur)) return;
    if constexpr (GATHER) { S.offsets(cur, sR, sC, voffA0, voffA1); }
    f32x4 acc[2][2][4][2];
#pragma unroll
    for (int a = 0; a < 2; ++a)
#pragma unroll
        for (int b = 0; b < 2; ++b)
#pragma unroll
            for (int m = 0; m < 4; ++m)
#pragma unroll
                for (int n = 0; n < 2; ++n) acc[a][b][m][n] = (f32x4){0.f, 0.f, 0.f, 0.f};
    bf16x8 At[4][2], B0[2][2], B1[2][2];
    const char* cA = cur.A; const char* cB = cur.B;
    PG8_STAGE(PG8_SB(0, 0), cB, voffB); PG8_STAGE(PG8_SB(0, 1), cB + hstep, voffB); PG8_STAGE(PG8_SA(0, 0), cA, voffA0); PG8_STAGE(PG8_SA(0, 1), cA, voffA1);
    if (wr == 1) PG8_BAR;
    PG8_WAIT_V(2); PG8_BAR;
    PG8_STAGE(PG8_SB(1, 0), cB + kstep, voffB); PG8_STAGE(PG8_SA(1, 0), cA + kstep, voffA0); PG8_STAGE(PG8_SB(1, 1), cB + hstep + kstep, voffB);
    PG8_WAIT_V(6); PG8_BAR;
    for (;;) {
        const bool has_next = S.next(ui + 1, nxt);
        if constexpr (GATHER) { if (has_next) S.offsets(nxt, sR, sC, nvA0, nvA1); }
        const char* nA = has_next ? nxt.A : cA; const char* nB = has_next ? nxt.B : cB;
        for (int t = 0; t < nt; t += 2) {
            const bool last = (t == nt - 2);
            const char* a1 = cA + (size_t)(t + 1) * kstep;
            const char* a2 = last ? nA : cA + (size_t)(t + 2) * kstep; const char* b2 = last ? nB : cB + (size_t)(t + 2) * kstep;
            const char* a3 = a2 + kstep; const char* b3 = b2 + kstep;
            unsigned w0[2], w1[2];
            if constexpr (GATHER) { const bool sw = last && has_next; w0[0] = sw ? nvA0[0] : voffA0[0]; w0[1] = sw ? nvA0[1] : voffA0[1]; w1[0] = sw ? nvA1[0] : voffA1[0]; w1[1] = sw ? nvA1[1] : voffA1[1]; }
            else { w0[0] = voffA0[0]; w0[1] = voffA0[1]; w1[0] = voffA1[0]; w1[1] = voffA1[1]; }
            PG8_LDB(B0, 0, 0); PG8_LDB(B1, 0, 1); PG8_SCHED; PG8_LDA(At, 0, 0); PG8_STAGE(PG8_SA(1, 1), a1, voffA1);
            PG8_WAIT_V(8); PG8_WAIT_L(0); PG8_BAR; PG8_MMA(0, 0, At, B0); PG8_MMA(0, 1, At, B1); PG8_BAR; PG8_SCHED;
            PG8_LDA(At, 0, 1); PG8_STAGE(PG8_SB(0, 0), b2, voffB); PG8_STAGE(PG8_SB(0, 1), b2 + hstep, voffB); PG8_STAGE(PG8_SA(0, 0), a2, w0);
            PG8_WAIT_V(8); PG8_WAIT_L(0); PG8_BAR; PG8_MMA(1, 0, At, B0); PG8_MMA(1, 1, At, B1); PG8_BAR; PG8_SCHED;
            PG8_LDB(B0, 1, 0); PG8_LDB(B1, 1, 1); PG8_SCHED; PG8_LDA(At, 1, 0); PG8_STAGE(PG8_SA(0, 1), a2, w1);
            PG8_WAIT_V(8); PG8_WAIT_L(0); PG8_BAR; PG8_MMA(0, 0, At, B0); PG8_MMA(0, 1, At, B1); PG8_BAR; PG8_SCHED;
            PG8_LDA(At, 1, 1); PG8_STAGE(PG8_SB(1, 0), b3, voffB); PG8_STAGE(PG8_SB(1, 1), b3 + hstep, voffB); PG8_STAGE(PG8_SA(1, 0), a3, w0);
            PG8_WAIT_V(8); PG8_WAIT_L(0); PG8_BAR; PG8_MMA(1, 0, At, B0); PG8_MMA(1, 1, At, B1); PG8_BAR; PG8_SCHED;
        }
        if (wr == 0) PG8_BAR;
        E(acc, cur, wr, wc, fr, fq);
        if (!has_next) break;
#pragma unroll
        for (int a = 0; a < 2; ++a)
#pragma unroll
            for (int b = 0; b < 2; ++b)
#pragma unroll
                for (int m = 0; m < 4; ++m)
#pragma unroll
                    for (int n = 0; n < 2; ++n) acc[a][b][m][n] = (f32x4){0.f, 0.f, 0.f, 0.f};
        cur = nxt; cA = nA; cB = nB; ++ui;
        if constexpr (GATHER) { voffA0[0] = nvA0[0]; voffA0[1] = nvA0[1]; voffA1[0] = nvA1[0]; voffA1[1] = nvA1[1]; }
        if (wr == 1) PG8_BAR;
    }
    PG8_WAIT_V(0);
    PG8_BAR;
#undef PG8_SA
#undef PG8_SB
#undef PG8_STAGE
#undef PG8_LDA
#undef PG8_LDB
#undef PG8_MMA
#undef PG8_WAIT_V
#undef PG8_WAIT_L
#undef PG8_BAR
#undef PG8_SCHED
}
}

using pg8::Unit;
constexpr size_t TSTEP = (size_t)256 * 1024 * 2;

struct SchedIn {
    const char* A; const char* B; int G, c;
    __device__ __forceinline__ bool next(int i, Unit& u) const {
        const int L = i * G + c; int pm, pn;
        if (L < 4096) { pg8::tile_map(L, 128, 32, pm, pn); }
        else { const int j = L - 4096; if (j >= 112) return false; pm = 128 + (j & 7); const int cj = j >> 3; pn = cj < 2 ? 2 + cj : (cj < 6 ? 4 + (cj - 2) : 16 + (cj - 6)); }
        u.A = A + (size_t)pm * TSTEP; u.B = B + (size_t)pn * TSTEP; u.row0 = pm * 256; u.pn = pn; u.aux = 0; u.aux2 = 0; return true;
    }
};
struct EpiIn {
    unsigned char* ws; const float* ropec; const float* ropes;
    __device__ __forceinline__ void operator()(const f32x4 (&acc)[2][2][4][2], const Unit& u, int wr, int wc, int fr, int fq) const {
        const int pn = u.pn, row0 = u.row0; const bool latent = row0 < TL;
        bf16_t* base; int ldc, col0, mode = 0; float sc = 1.f; int drow0 = row0;
        int kvrow0; if (latent) { const int b = row0 >> 12, t = row0 & 4095; kvrow0 = b * KVLEN + CTX + t; } else { const int cc = row0 - TL; kvrow0 = (cc >> 8) * KVLEN + (cc & 255); }
        if (pn < 2)       { base = (bf16_t*)(ws + WS_MQ); ldc = 512;  col0 = pn * 256;        sc = 0.08838834764831845f; }
        else if (pn < 4)  { base = (bf16_t*)(ws + WS_MK); ldc = 512;  col0 = (pn - 2) * 256; }
        else if (pn < 8)  { base = (bf16_t*)(ws + WS_MV); ldc = 1024; col0 = (pn - 4) * 256; }
        else if (pn < 12) { base = (bf16_t*)(ws + WS_MO); ldc = 1024; col0 = (pn - 8) * 256; }
        else if (pn < 16) { base = (bf16_t*)(ws + WS_DQ); ldc = 1024; col0 = (pn - 12) * 256; mode = 1; }
        else if (pn < 20) { base = (bf16_t*)(ws + WS_DK); ldc = 1024; col0 = (pn - 16) * 256; mode = latent ? 1 : 0; drow0 = kvrow0; }
        else if (pn < 24) { base = (bf16_t*)(ws + WS_DV); ldc = 1024; col0 = (pn - 20) * 256; drow0 = kvrow0; }
        else if (pn < 28) { base = (bf16_t*)(ws + WS_GA); ldc = 1024; col0 = (pn - 24) * 256; mode = 2; }
        else              { base = (bf16_t*)(ws + WS_GB); ldc = 1024; col0 = (pn - 28) * 256; mode = 2; }
        const int cl = col0 + wc * 32 + 4 * fq;
#pragma unroll
        for (int ai = 0; ai < 2; ++ai)
#pragma unroll
            for (int m = 0; m < 4; ++m) {
                const int rl = ai * 128 + wr * 64 + m * 16 + fr;
                bf16_t* rowp = base + (size_t)(drow0 + rl) * ldc + cl;
                f32x4 cs = {1.f, 1.f, 1.f, 1.f}, sn = {0.f, 0.f, 0.f, 0.f};
                if (mode == 1) { const int t = (row0 + rl) & 4095; const int pos = (wc & 1) ? (t & 63) : (t >> 6); cs = *(const f32x4*)(ropec + pos * 16 + 4 * fq); sn = *(const f32x4*)(ropes + pos * 16 + 4 * fq); }
#pragma unroll
                for (int bj = 0; bj < 2; ++bj) {
                    f32x4 v0 = acc[ai][bj][m][0], v1 = acc[ai][bj][m][1];
                    if (mode == 1) { const f32x4 a = v0 * cs - v1 * sn, b = v1 * cs + v0 * sn; v0 = a; v1 = b; }
                    else if (mode == 2) {
#pragma unroll
                        for (int i = 0; i < 4; ++i) { v0[i] = sigmoidf_(v0[i]); v1[i] = sigmoidf_(v1[i]); }
                    } else { v0 = v0 * sc; v1 = v1 * sc; }
                    u32x2 w0, w1; w0.x = cvt_pk_bf16(v0[0], v0[1]); w0.y = cvt_pk_bf16(v0[2], v0[3]); w1.x = cvt_pk_bf16(v1[0], v1[1]); w1.y = cvt_pk_bf16(v1[2], v1[3]);
                    *(u32x2*)(rowp + bj * 128) = w0; *(u32x2*)(rowp + bj * 128 + 16) = w1;
                }
            }
    }
};

struct SchedStatic {
    const char* A; const char* B; int nM, nN, G, c;
    __device__ __forceinline__ bool next(int i, Unit& u) const {
        const int L = i * G + c; if (L >= nM * nN) return false; int pm, pn; pg8::tile_map(L, nM, nN, pm, pn);
        u.A = A + (size_t)pm * TSTEP; u.B = B + (size_t)pn * TSTEP; u.row0 = pm * 256; u.pn = pn; u.aux = 0; u.aux2 = 0; return true;
    }
};
template <int MODE> struct EpiMerge {
    const bf16_t* gate; const bf16_t* tin; bf16_t* outp;
    __device__ __forceinline__ void operator()(const f32x4 (&acc)[2][2][4][2], const Unit& u, int wr, int wc, int fr, int fq) const {
        const int cl = u.pn * 256 + wc * 32 + 4 * fq;
#pragma unroll
        for (int ai = 0; ai < 2; ++ai)
#pragma unroll
            for (int m = 0; m < 4; ++m) {
                const size_t ro = (size_t)(u.row0 + ai * 128 + wr * 64 + m * 16 + fr) * 1024 + cl;
#pragma unroll
                for (int bj = 0; bj < 2; ++bj)
#pragma unroll
                    for (int n = 0; n < 2; ++n) {
                        const size_t o = ro + bj * 128 + n * 16;
                        const u32x2 g = *(const u32x2*)(gate + o);
                        f32x4 v = acc[ai][bj][m][n];
                        v[0] *= bf_lo(g.x); v[1] *= bf_hi(g.x); v[2] *= bf_lo(g.y); v[3] *= bf_hi(g.y);
                        if (MODE == 1) { const u32x2 t = *(const u32x2*)(tin + o); v[0] += bf_lo(t.x); v[1] += bf_hi(t.x); v[2] += bf_lo(t.y); v[3] += bf_hi(t.y); }
                        u32x2 w; w.x = cvt_pk_bf16(v[0], v[1]); w.y = cvt_pk_bf16(v[2], v[3]);
                        *(u32x2*)(outp + o) = w;
                    }
            }
    }
};
struct EpiOut {
    const float* x; const float* mod; float* x1;
    __device__ __forceinline__ void operator()(const f32x4 (&acc)[2][2][4][2], const Unit& u, int wr, int wc, int fr, int fq) const {
        const int cl = u.pn * 256 + wc * 32 + 4 * fq; const float* g1 = mod + (size_t)(u.row0 >> 12) * 6144 + 2048;
#pragma unroll
        for (int bj = 0; bj < 2; ++bj)
#pragma unroll
            for (int n = 0; n < 2; ++n) {
                const f32x4 g = *(const f32x4*)(g1 + cl + bj * 128 + n * 16);
#pragma unroll
                for (int ai = 0; ai < 2; ++ai)
#pragma unroll
                    for (int m = 0; m < 4; ++m) {
                        const size_t o = (size_t)(u.row0 + ai * 128 + wr * 64 + m * 16 + fr) * 1024 + cl + bj * 128 + n * 16;
                        const f32x4 xv = *(const f32x4*)(x + o);
                        *(f32x4*)(x1 + o) = xv + g * acc[ai][bj][m][n];
                    }
            }
    }
};

struct SchedMoe1 {
    const char* U2; const char* W1; const int* list; const LAS int* tb; const LAS int* cnt; int G, c;
    __device__ __forceinline__ bool next(int i, Unit& u) const {
        const int L = i * G + c; const int xcd = L & 7, j = L >> 3; const int pn = j & 7, rt = (j >> 3) * 8 + xcd;
        const int NRT = tb[32];
        if (rt >= NRT) return false;
        int e = 0;
#pragma unroll 1
        for (int k = 1; k < 32; ++k) e = (tb[k] <= rt) ? k : e;
        u.A = U2; u.B = W1 + ((size_t)e * 2048 + (size_t)pn * 256) * 2048; u.row0 = rt * 256; u.pn = pn; u.aux = e; u.aux2 = (rt - tb[e]) * 256; return true;
    }
    __device__ __forceinline__ void offsets(const Unit& u, const int (&sR)[2], const int (&sC)[2], unsigned (&o0)[2], unsigned (&o1)[2]) const {
        const int e = u.aux < 0 ? 0 : u.aux; const int n = u.aux < 0 ? 0 : cnt[e] - u.aux2; const int* lp = list + (size_t)e * CAP + u.aux2;
#pragma unroll
        for (int i = 0; i < 2; ++i) {
            const int r0 = sR[i], r1 = 128 + sR[i];
            const int t0 = r0 < n ? lp[r0] : 0, t1 = r1 < n ? lp[r1] : 0;
            o0[i] = (unsigned)t0 * 2048u + (unsigned)sC[i] * 2u; o1[i] = (unsigned)t1 * 2048u + (unsigned)sC[i] * 2u;
        }
    }
};
struct EpiMoe1 {
    bf16_t* act; const float* b1;
    __device__ __forceinline__ void operator()(const f32x4 (&acc)[2][2][4][2], const Unit& u, int wr, int wc, int fr, int fq) const {
        if (u.aux < 0) return;
        const int cl = u.pn * 128 + wc * 32 + 4 * fq; const float* bb = b1 + (size_t)u.aux * 2048;
#pragma unroll
        for (int n = 0; n < 2; ++n) {
            const f32x4 bg = *(const f32x4*)(bb + cl + n * 16), bl = *(const f32x4*)(bb + 1024 + cl + n * 16);
#pragma unroll
            for (int ai = 0; ai < 2; ++ai)
#pragma unroll
                for (int m = 0; m < 4; ++m) {
                    f32x4 g = acc[ai][0][m][n] + bg, l = acc[ai][1][m][n] + bl, a;
#pragma unroll
                    for (int i = 0; i < 4; ++i) { const float gg = fminf(g[i], 7.0f), ll = fminf(fmaxf(l[i], -7.0f), 7.0f); a[i] = gg * sigmoidf_(1.702f * gg) * (ll + 1.0f); }
                    u32x2 w; w.x = cvt_pk_bf16(a[0], a[1]); w.y = cvt_pk_bf16(a[2], a[3]);
                    *(u32x2*)(act + (size_t)(u.row0 + ai * 128 + wr * 64 + m * 16 + fr) * 1024 + cl + n * 16) = w;
                }
        }
    }
};
struct SchedMoe2 {
    const char* ACT; const char* W2; const LAS int* tb; int G, c;
    __device__ __forceinline__ bool next(int i, Unit& u) const {
        const int L = i * G + c; const int xcd = L & 7, j = L >> 3; const int pn = j & 3, rt = (j >> 2) * 8 + xcd;
        const int NRT = tb[32];
        if (rt >= NRT) return false;
        int e = 0;
#pragma unroll 1
        for (int k = 1; k < 32; ++k) e = (tb[k] <= rt) ? k : e;
        u.A = ACT + (size_t)rt * TSTEP; u.B = W2 + ((size_t)e * 1024 + (size_t)pn * 256) * 2048; u.row0 = rt * 256; u.pn = pn; u.aux = e; u.aux2 = (rt - tb[e]) * 256; return true;
    }
};
struct EpiMoe2 {
    bf16_t* ys; const float* b2; const float* lgate; const LAS int* cnt;
    __device__ __forceinline__ void operator()(const f32x4 (&acc)[2][2][4][2], const Unit& u, int wr, int wc, int fr, int fq) const {
        if (u.aux < 0) return;
        const int cl = u.pn * 256 + wc * 32 + 4 * fq; const float* bb = b2 + (size_t)u.aux * 1024; const int n = cnt[u.aux] - u.aux2; const float* gp = lgate + (size_t)u.aux * CAP + u.aux2;
        f32x4 bv[2][2];
#pragma unroll
        for (int bj = 0; bj < 2; ++bj)
#pragma unroll
            for (int nn = 0; nn < 2; ++nn) bv[bj][nn] = *(const f32x4*)(bb + cl + bj * 128 + nn * 16);
#pragma unroll
        for (int ai = 0; ai < 2; ++ai)
#pragma unroll
            for (int m = 0; m < 4; ++m) {
                const int rl = ai * 128 + wr * 64 + m * 16 + fr; const float gw = rl < n ? gp[rl] : 0.f;
#pragma unroll
                for (int bj = 0; bj < 2; ++bj)
#pragma unroll
                    for (int nn = 0; nn < 2; ++nn) {
                        const f32x4 v = (acc[ai][bj][m][nn] + bv[bj][nn]) * gw;
                        u32x2 w; w.x = cvt_pk_bf16(v[0], v[1]); w.y = cvt_pk_bf16(v[2], v[3]);
                        *(u32x2*)(ys + (size_t)(u.row0 + rl) * 1024 + cl + bj * 128 + nn * 16) = w;
                    }
            }
    }
};

namespace att {
constexpr int NW = 8, QBLK = 32, KVBLK = 64, LD = 1024;
constexpr float SCALE = 0.125f;
constexpr float THR = 8.f;
constexpr int SHM_V = KVBLK * 128 * 2, SHM_K = KVBLK * 128 * 2, SHM_ATTN = 2 * SHM_V + 2 * SHM_K + NW * 64 * 4;
#define KSWZ(row, colB) ((row) * 256 + ((colB) ^ (((row) & 7) << 4)))
#define SBAR() __builtin_amdgcn_sched_barrier(0)
__device__ __forceinline__ int crow(int r, int hi) { return (r & 3) + 8 * (r >> 2) + 4 * hi; }
__device__ __forceinline__ unsigned cvtpk(float lo, float hi) { return cvt_pk_bf16(lo, hi); }

__device__ __forceinline__ void partialSM(f32x16& p0, f32x16& p1, float& m_reg, float& mn, float& alpha) {
  constexpr float C = SCALE * 1.4426950408889634f;
  float pmax = p0[0];
#pragma unroll
  for (int r = 1; r < 16; ++r) pmax = fmaxf(pmax, p0[r]);
#pragma unroll
  for (int r = 0; r < 16; ++r) pmax = fmaxf(pmax, p1[r]);
  { auto rr = __builtin_amdgcn_permlane32_swap(__float_as_uint(pmax), __float_as_uint(pmax), false, false);
    pmax = fmaxf(__uint_as_float(rr[0]), __uint_as_float(rr[1])); }
  if (__builtin_expect(__all(pmax - m_reg <= THR / SCALE), 1)) { mn = m_reg; alpha = 1.f; }
  else { mn = fmaxf(m_reg, pmax); alpha = __builtin_amdgcn_exp2f((m_reg - mn) * C); m_reg = mn; }
  float mnC = -mn * C;
#pragma unroll
  for (int r = 0; r < 16; ++r) p0[r] = fmaf(p0[r], C, mnC);
#pragma unroll
  for (int r = 0; r < 16; ++r) p1[r] = fmaf(p1[r], C, mnC);
#pragma unroll
  for (int r = 0; r < 16; ++r) p0[r] = __builtin_amdgcn_exp2f(p0[r]);
}
__device__ __forceinline__ void finishSM(f32x16& p0, f32x16& p1, float alpha, float& l_reg, bf16x8& pa0, bf16x8& pa1, bf16x8& pa2, bf16x8& pa3) {
#pragma unroll
  for (int r = 0; r < 16; ++r) p1[r] = __builtin_amdgcn_exp2f(p1[r]);
  float ps = 0;
#pragma unroll
  for (int r = 0; r < 16; ++r) ps += p0[r];
#pragma unroll
  for (int r = 0; r < 16; ++r) ps += p1[r];
  { auto rr = __builtin_amdgcn_permlane32_swap(__float_as_uint(ps), __float_as_uint(ps), false, false);
    ps = __uint_as_float(rr[0]) + __uint_as_float(rr[1]); }
  l_reg = l_reg * alpha + ps;
#define PK4(P, BASE, OUT) do { unsigned a0 = cvtpk(P[BASE + 0], P[BASE + 1]), a1 = cvtpk(P[BASE + 2], P[BASE + 3]);   \
    unsigned b0 = cvtpk(P[BASE + 4], P[BASE + 5]), b1 = cvtpk(P[BASE + 6], P[BASE + 7]);                              \
    auto r0 = __builtin_amdgcn_permlane32_swap(a0, b0, false, false); auto r1 = __builtin_amdgcn_permlane32_swap(a1, b1, false, false); \
    u32x4 w = {r0[0], r1[0], r0[1], r1[1]}; OUT = *reinterpret_cast<bf16x8*>(&w); } while (0)
  PK4(p0, 0, pa0); PK4(p0, 8, pa1); PK4(p1, 0, pa2); PK4(p1, 8, pa3);
#undef PK4
}
__device__ __forceinline__ void qkt(f32x16& p0, f32x16& p1, const bf16_t* Ks, const bf16x8* qr, int r32, int hi, int mp) {
  p0 = f32x16{}; p1 = f32x16{};
#pragma unroll
  for (int d0 = 0; d0 < 4; ++d0) { int cb = (mp * 64 + d0 * 16 + hi * 8) * 2;
    bf16x8 b0 = *reinterpret_cast<const bf16x8*>((const char*)Ks + KSWZ(r32, cb));
    bf16x8 b1 = *reinterpret_cast<const bf16x8*>((const char*)Ks + KSWZ(32 + r32, cb));
    p0 = __builtin_amdgcn_mfma_f32_32x32x16_bf16(b0, qr[d0], p0, 0, 0, 0);
    p1 = __builtin_amdgcn_mfma_f32_32x32x16_bf16(b1, qr[d0], p1, 0, 0, 0); }
}
__device__ __forceinline__ int v_st(int k, int c) { const int kk = (k & ~0xC) | ((k & 4) << 1) | ((k & 8) >> 1); return ((kk >> 3) * 4 + (c >> 5)) * 512 + ((kk & 7) * 32 + (c & 31)) * 2; }
__device__ __forceinline__ int v_rd_base(int lane) { return ((lane & 3) << 3) | (((lane >> 2) & 3) << 6) | (((lane >> 4) & 1) << 5) | (((lane >> 5) & 1) << 8); }
constexpr int v_rd_off(int d0, int ks, int half) { return d0 * 512 + ks * 4096 + half * 2048; }
template <int OFF> __device__ __forceinline__ s16x4 tr_read(int vb) {
  s16x4 r; asm volatile("ds_read_b64_tr_b16 %0, %1 offset:%2" : "=&v"(r) : "v"(vb), "i"(OFF) : "memory"); return r;
}
template <int D0> __device__ __forceinline__ void pv_one(f32x16& od, int vb, bf16x8 pa0, bf16x8 pa1, bf16x8 pa2, bf16x8 pa3) {
  const s16x4 l0 = tr_read<v_rd_off(D0, 0, 0)>(vb), h0 = tr_read<v_rd_off(D0, 0, 1)>(vb), l1 = tr_read<v_rd_off(D0, 1, 0)>(vb), h1 = tr_read<v_rd_off(D0, 1, 1)>(vb);
  const s16x4 l2 = tr_read<v_rd_off(D0, 2, 0)>(vb), h2 = tr_read<v_rd_off(D0, 2, 1)>(vb), l3 = tr_read<v_rd_off(D0, 3, 0)>(vb), h3 = tr_read<v_rd_off(D0, 3, 1)>(vb);
  asm volatile("s_waitcnt lgkmcnt(0)" ::: "memory"); SBAR();
#define PK(L, H) (bf16x8){L[0], L[1], L[2], L[3], H[0], H[1], H[2], H[3]}
  od = __builtin_amdgcn_mfma_f32_32x32x16_bf16(pa0, PK(l0, h0), od, 0, 0, 0);
  od = __builtin_amdgcn_mfma_f32_32x32x16_bf16(pa1, PK(l1, h1), od, 0, 0, 0);
  od = __builtin_amdgcn_mfma_f32_32x32x16_bf16(pa2, PK(l2, h2), od, 0, 0, 0);
  od = __builtin_amdgcn_mfma_f32_32x32x16_bf16(pa3, PK(l3, h3), od, 0, 0, 0);
#undef PK
}
__device__ __forceinline__ void pv_d0(f32x16* o, int vb, bf16x8 pa0, bf16x8 pa1, bf16x8 pa2, bf16x8 pa3) {
  pv_one<0>(o[0], vb, pa0, pa1, pa2, pa3); pv_one<1>(o[1], vb, pa0, pa1, pa2, pa3); pv_one<2>(o[2], vb, pa0, pa1, pa2, pa3); pv_one<3>(o[3], vb, pa0, pa1, pa2, pa3);
}

__device__ __forceinline__ void attn_unit(const bf16_t* __restrict__ Qb, const bf16_t* __restrict__ Kh, const bf16_t* __restrict__ Vh, bf16_t* __restrict__ Ob,
                                          const float* __restrict__ gd, float lam, int seq, char* lds) {
  const int tid = otid(), wid = tid >> 6, lane = tid & 63, r32 = lane & 31, hi = lane >> 5;
  const int qw = wid & 3, mp = wid >> 2;
  bf16_t* V_lds = (bf16_t*)lds; bf16_t* K_lds = (bf16_t*)(lds + 2 * SHM_V);
  float* wsf = (float*)(lds + 2 * SHM_V + 2 * SHM_K) + wid * 64; float* li_l = wsf; float* al_l = wsf + 32;
  float m_reg = -1e30f, l_reg = 0; f32x16 o[4] = {}; bf16x8 qr[4];
  const bf16_t* Qw = Qb + (long)(qw * QBLK + r32) * LD + mp * 64 + hi * 8;
#pragma unroll
  for (int d0 = 0; d0 < 4; ++d0) qr[d0] = *reinterpret_cast<const bf16x8*>(Qw + d0 * 16);
  const int sr = tid >> 4, sc = (tid & 15) * 8, vst0 = v_st(sr, sc), vst1 = v_st(32 + sr, sc);
  const int vb0 = (int)(uintptr_t)V_lds + v_rd_base(lane);
  struct { bf16x8 vs0, vs1, ks0, ks1; } sr_[2];
#define SLOAD(i, k0) do { sr_[i].vs0 = *reinterpret_cast<const bf16x8*>(&Vh[(long)((k0) + sr) * LD + sc]); sr_[i].vs1 = *reinterpret_cast<const bf16x8*>(&Vh[(long)((k0) + 32 + sr) * LD + sc]); \
    sr_[i].ks0 = *reinterpret_cast<const bf16x8*>(&Kh[(long)((k0) + sr) * LD + sc]); sr_[i].ks1 = *reinterpret_cast<const bf16x8*>(&Kh[(long)((k0) + 32 + sr) * LD + sc]); } while (0)
#define SWRITE(b, i) do { *(bf16x8*)((char*)V_lds + (b) * SHM_V + vst0) = sr_[i].vs0;          \
    *(bf16x8*)((char*)V_lds + (b) * SHM_V + vst1) = sr_[i].vs1; int kc = sc * 2;               \
    *(bf16x8*)((char*)K_lds + (b) * SHM_K + KSWZ(sr, kc)) = sr_[i].ks0;                       \
    *(bf16x8*)((char*)K_lds + (b) * SHM_K + KSWZ(32 + sr, kc)) = sr_[i].ks1; } while (0)
#define SWAIT() asm volatile("s_waitcnt vmcnt(4)" ::: "memory")
#define RESC(a) do { if (__any((a) < 1.f)) { if (hi == 0) al_l[r32] = (a); asm volatile("s_waitcnt lgkmcnt(0)" ::: "memory"); \
    _Pragma("unroll") for (int d = 0; d < 4; ++d) _Pragma("unroll") for (int r = 0; r < 16; ++r) o[d][r] *= al_l[crow(r, hi)]; } } while (0)
  f32x16 pA0, pA1, pB0, pB1; float mnA, mnB, alA, alB; bf16x8 pa0, pa1, pa2, pa3; const int NT = seq / KVBLK;
  constexpr int SE = 0, SO = 1;
  SLOAD(SE, 0); asm volatile("s_waitcnt vmcnt(0)" ::: "memory"); SWRITE(0, SE); __syncthreads();
  qkt(pA0, pA1, K_lds, qr, r32, hi, mp); partialSM(pA0, pA1, m_reg, mnA, alA);
  SLOAD(SO, KVBLK); if (2 < NT) SLOAD(SE, 2 * KVBLK);
  SWAIT(); SWRITE(1, SO); __syncthreads();
  for (int j = 1; j + 1 < NT; j += 2) {
    SBAR(); qkt(pB0, pB1, (bf16_t*)((char*)K_lds + SHM_K), qr, r32, hi, mp);
    finishSM(pA0, pA1, alA, l_reg, pa0, pa1, pa2, pa3); SBAR();
    SLOAD(SO, (j + 2) * KVBLK); SBAR();
    pv_d0(o, vb0, pa0, pa1, pa2, pa3); partialSM(pB0, pB1, m_reg, mnB, alB);
    __syncthreads(); SWAIT(); SWRITE(0, SE);
    RESC(alB); __syncthreads();
    SBAR(); qkt(pA0, pA1, K_lds, qr, r32, hi, mp);
    finishSM(pB0, pB1, alB, l_reg, pa0, pa1, pa2, pa3); SBAR();
    if (j + 3 < NT) SLOAD(SE, (j + 3) * KVBLK); SBAR();
    pv_d0(o, vb0 + (int)SHM_V, pa0, pa1, pa2, pa3); partialSM(pA0, pA1, m_reg, mnA, alA);
    __syncthreads(); SWAIT(); SWRITE(1, SO);
    RESC(alA); __syncthreads();
  }
  SBAR(); qkt(pB0, pB1, (bf16_t*)((char*)K_lds + SHM_K), qr, r32, hi, mp);
  finishSM(pA0, pA1, alA, l_reg, pa0, pa1, pa2, pa3); SBAR();
  pv_d0(o, vb0, pa0, pa1, pa2, pa3); partialSM(pB0, pB1, m_reg, mnB, alB);
  __syncthreads(); RESC(alB);
  finishSM(pB0, pB1, alB, l_reg, pa0, pa1, pa2, pa3); SBAR();
  pv_d0(o, vb0 + (int)SHM_V, pa0, pa1, pa2, pa3);
  if (hi == 0) li_l[r32] = l_reg; asm volatile("s_waitcnt lgkmcnt(0)" ::: "memory");
  float rli[16];
#pragma unroll
  for (int r = 0; r < 16; ++r) rli[r] = __builtin_amdgcn_rcpf(li_l[crow(r, hi)]);
  __syncthreads();
  float* xch = (float*)lds + qw * 4096 + lane;
  if (mp == 1) {
#pragma unroll
    for (int r = 0; r < 16; ++r)
#pragma unroll
      for (int d0 = 0; d0 < 4; ++d0) xch[(r * 4 + d0) * 64] = o[d0][r] * rli[r] * lam;
  }
  __syncthreads();
  if (mp == 0) {
    float gv[4];
#pragma unroll
    for (int d0 = 0; d0 < 4; ++d0) gv[d0] = gd[d0 * 32 + r32] * (1.0f - LAM_INIT);
#pragma unroll
    for (int r = 0; r < 16; ++r) {
      float dv[4]; float ss = 0.f;
#pragma unroll
      for (int d0 = 0; d0 < 4; ++d0) { dv[d0] = o[d0][r] * rli[r] - xch[(r * 4 + d0) * 64]; ss += dv[d0] * dv[d0]; }
      ss += __shfl_xor(ss, 1); ss += __shfl_xor(ss, 2); ss += __shfl_xor(ss, 4); ss += __shfl_xor(ss, 8); ss += __shfl_xor(ss, 16);
      const float rstd = rsqrtf(ss * (1.0f / 128.0f) + EPS);
      bf16_t* orow = Ob + (long)(qw * QBLK + crow(r, hi)) * LD + r32;
#pragma unroll
      for (int d0 = 0; d0 < 4; ++d0) orow[d0 * 32] = (bf16_t)(cvtpk(dv[d0] * rstd * gv[d0], 0.f) & 0xffffu);
    }
  }
  __syncthreads();
#undef SLOAD
#undef SWRITE
#undef SWAIT
#undef RESC
}
#undef KSWZ
#undef SBAR
}

__device__ __forceinline__ float log_sigmoidf_(float x) { return x >= 0.f ? -log1pf(__expf(-x)) : x - log1pf(__expf(x)); }

__device__ __forceinline__ void transpose_item(const float* __restrict__ W, int ldw, int scol0, bf16_t* WTrow0, int k0, LAS float* scr, int lane) {
#pragma unroll 8
    for (int i = 0; i < 32; ++i) { const int kk = 2 * i + (lane >> 5); scr[kk * 33 + (lane & 31)] = W[(size_t)(k0 + kk) * ldw + scol0 + (lane & 31)]; }
    LDS_WAIT(); asm volatile("" ::: "memory");
    const int c = lane & 7;
#pragma unroll
    for (int j = 0; j < 4; ++j) { const int n = (lane >> 3) + 8 * j; const LAS float* s = scr + (8 * c) * 33 + n;
        u32x4 o; o.x = cvt_pk_bf16(s[0 * 33], s[1 * 33]); o.y = cvt_pk_bf16(s[2 * 33], s[3 * 33]); o.z = cvt_pk_bf16(s[4 * 33], s[5 * 33]); o.w = cvt_pk_bf16(s[6 * 33], s[7 * 33]);
        *(u32x4*)(WTrow0 + (size_t)n * 1024 + k0 + 8 * c) = o; }
    LDS_WAIT(); asm volatile("" ::: "memory");
}

__device__ __forceinline__ void phase_prep(const Params& p, LAS unsigned char* lds, int G) {
    const int tid = otid(), lane = tid & 63, wave = __builtin_amdgcn_readfirstlane(tid >> 6);
    const int gw = blockIdx.x * 8 + wave, NGW = G * 8;
    LAS float* sl = (LAS float*)(lds + 73728);
    for (int i = tid; i < 9 * 1024; i += NTHREADS) { const float v = i < 8192 ? p.c[i] : p.c_ctx[i - 8192]; sl[i] = v / (1.0f + __expf(-v)); }
    __syncthreads();
    float* mod = (float*)(p.ws + WS_MOD);
    if (gw < 384) {
        const int c0 = gw * 16, col = lane & 15, kq = lane >> 4;
        float acc[9];
#pragma unroll
        for (int v = 0; v < 9; ++v) acc[v] = 0.f;
        const float* wp = p.ada_w + (size_t)(kq * 256) * 6144 + c0 + col;
#pragma unroll 8
        for (int i = 0; i < 256; ++i) { const float w = wp[(size_t)i * 6144];
#pragma unroll
            for (int v = 0; v < 9; ++v) acc[v] += sl[v * 1024 + kq * 256 + i] * w; }
#pragma unroll
        for (int v = 0; v < 9; ++v) { acc[v] += __shfl_xor(acc[v], 16); acc[v] += __shfl_xor(acc[v], 32); }
        if (lane < 16) { const float b = p.ada_b[c0 + col];
#pragma unroll
            for (int v = 0; v < 9; ++v) mod[v * 6144 + c0 + col] = acc[v] + b; }
    }
    if (blockIdx.x == 0 && wave == 0) {
        const float s01 = wave_sum(p.dlam[lane] * p.dlam[64 + lane]), s23 = wave_sum(p.dlam[128 + lane] * p.dlam[192 + lane]);
        if (lane == 0) *(float*)(p.ws + WS_LAM) = expf(s01) - expf(s23) + LAM_INIT;
    }
    if (blockIdx.x == 1 && wave == 0 && lane < 16) {
        double th = 1.0; for (int j = 0; j < lane; ++j) th *= 0.5623413251903491;
        double ct = 1.0, st = th, term_c = 1.0, term_s = th; const double t2 = th * th;
        for (int n = 1; n < 14; ++n) { term_c *= -t2 / ((2.0 * n - 1.0) * (2.0 * n)); term_s *= -t2 / ((2.0 * n) * (2.0 * n + 1.0)); ct += term_c; st += term_s; }
        float* rc = (float*)(p.ws + WS_ROPE); float* rs = rc + 1024;
        double cc = 1.0, ss = 0.0;
        for (int pos = 0; pos < 64; ++pos) { rc[pos * 16 + lane] = (float)cc; rs[pos * 16 + lane] = (float)ss; const double c2 = cc * ct - ss * st, s2 = ss * ct + cc * st; cc = c2; ss = s2; }
    }
    LAS float* scr = (LAS float*)(lds + wave * 8448);
    bf16_t* WIN = (bf16_t*)(p.ws + WS_WIN);
    constexpr int I_IN = 16 * 256, I_SQ = 16 * 32, I_W1 = 32 * 16 * 64, I_W2 = 32 * 16 * 32, NITEMS = I_IN + 3 * I_SQ + I_W1 + I_W2;
    for (int it = gw; it < NITEMS; it += NGW) {
        int r = it;
        if (r < I_IN) { const int kb = r >> 8, nb = r & 255, n0 = nb * 32; transpose_item(p.w_in, INCOLS, n0 < 2048 ? n0 : n0 + 16, WIN + (size_t)n0 * 1024, kb * 64, scr, lane); continue; } r -= I_IN;
        if (r < 3 * I_SQ) { const int w = r / I_SQ, r2 = r % I_SQ, kb = r2 >> 5, nb = r2 & 31; const float* W = w == 0 ? p.w_a : (w == 1 ? p.w_b : p.w_o);
            bf16_t* WT = (bf16_t*)(p.ws + (w == 0 ? WS_WA : (w == 1 ? WS_WB : WS_WO))); transpose_item(W, 1024, nb * 32, WT + (size_t)nb * 32 * 1024, kb * 64, scr, lane); continue; } r -= 3 * I_SQ;
        if (r < I_W1) { const int e = r >> 10, r2 = r & 1023, kb = r2 >> 6, g = r2 & 63, pn = g >> 3, bj = (g >> 2) & 1, q = g & 3;
            transpose_item(p.exp_w1 + (size_t)e * 1024 * 2048, 2048, bj * 1024 + 128 * pn + 32 * q, (bf16_t*)(p.ws + WS_W1) + ((size_t)e * 2048 + 32 * g) * 1024, kb * 64, scr, lane); continue; } r -= I_W1;
        { const int e = r >> 9, r2 = r & 511, kb = r2 >> 5, nb = r2 & 31;
            transpose_item(p.exp_w2 + (size_t)e * 1024 * 1024, 1024, nb * 32, (bf16_t*)(p.ws + WS_W2) + ((size_t)e * 1024 + 32 * nb) * 1024, kb * 64, scr, lane); }
    }
}

__device__ __forceinline__ void phase_rows1(const Params& p, LAS unsigned char* lds, int G) {
    const int tid = otid(), lane = tid & 63, wave = __builtin_amdgcn_readfirstlane(tid >> 6);
    const int gw = blockIdx.x * 8 + wave, NGW = G * 8;
    LAS float* wg = (LAS float*)lds;
    for (int i = tid; i < 16 * 1024; i += NTHREADS) { const int k = i >> 4, g = i & 15; wg[g * 1024 + k] = p.w_in[(size_t)k * INCOLS + 2048 + g]; }
    __syncthreads();
    const float* mod = (const float*)(p.ws + WS_MOD); bf16_t* U = (bf16_t*)(p.ws + WS_U); float* GT = (float*)(p.ws + WS_GT);
    f32x4 gn[4];
#pragma unroll
    for (int j = 0; j < 4; ++j) gn[j] = *(const f32x4*)(p.norm1_g + 4 * lane + 256 * j);
    for (int m = gw; m < TT; m += NGW) {
        const float* xr = m < TL ? p.x + (size_t)m * 1024 : p.ctx + (size_t)(m - TL) * 1024;
        const float* md = mod + (size_t)(m < TL ? (m >> 12) : 8) * 6144;
        f32x4 v[4]; float ss = 0.f;
#pragma unroll
        for (int j = 0; j < 4; ++j) { v[j] = *(const f32x4*)(xr + 4 * lane + 256 * j); ss += (v[j][0] * v[j][0] + v[j][1] * v[j][1]) + (v[j][2] * v[j][2] + v[j][3] * v[j][3]); }
        const float rstd = rsqrtf(wave_sum(ss) * (1.0f / 1024.0f) + EPS);
#pragma unroll
        for (int j = 0; j < 4; ++j) { const f32x4 sh = *(const f32x4*)(md + 4 * lane + 256 * j), sc = *(const f32x4*)(md + 1024 + 4 * lane + 256 * j);
            v[j] = (v[j] * rstd * gn[j]) * (sc + 1.0f) + sh;
            u32x2 w; w.x = cvt_pk_bf16(v[j][0], v[j][1]); w.y = cvt_pk_bf16(v[j][2], v[j][3]); *(u32x2*)(U + (size_t)m * 1024 + 4 * lane + 256 * j) = w; }
        float val = 0.f;
#pragma unroll
        for (int g = 0; g < 16; ++g) { float a = 0.f;
#pragma unroll
            for (int j = 0; j < 4; ++j) { const f32x4 w = *(const LAS f32x4*)(wg + g * 1024 + 4 * lane + 256 * j); a += (v[j][0] * w[0] + v[j][1] * w[1]) + (v[j][2] * w[2] + v[j][3] * w[3]); }
            a = wave_sum(a); val = (lane == g) ? a : val; asm volatile("" ::: "memory"); }
        if (lane < 16) {
            val += p.gate_b[lane]; const int type = lane >> 2; if (type & 1) val = log_sigmoidf_(val);
            GT[(size_t)m * 16 + lane] = val; }
    }
}

__device__ __forceinline__ void phase_mlstm_naive(const Params& p, LAS unsigned char* lds_, int item) {
    const int tid = otid(); float* lds = (float*)(unsigned char*)lds_;
    const int dvh = item & 1, dir = (item >> 1) & 1, h = (item >> 2) & 3, b = item >> 4;
    const int dvl = tid >> 2, kq = tid & 3;
    float* Ks = lds; float* Qs = lds + 4096; float* Vs = lds + 8192; float* gi = lds + 12288; float* gf = gi + 32;
    const bf16_t* MQ = (const bf16_t*)(p.ws + WS_MQ); const bf16_t* MK = (const bf16_t*)(p.ws + WS_MK); const bf16_t* MV = (const bf16_t*)(p.ws + WS_MV);
    const float* GT = (const float*)(p.ws + WS_GT); bf16_t* H = (bf16_t*)(p.ws + (dir ? WS_HB : WS_HF));
    float C[32], nn[32];
#pragma unroll
    for (int r = 0; r < 32; ++r) { C[r] = 0.f; nn[r] = 0.f; }
    for (int s0 = 0; s0 < KVLEN; s0 += 32) {
        const bool latent = s0 >= CTX;
        __syncthreads();
        {
            const int j = tid >> 4, c8 = (tid & 15) * 8; const int s = s0 + j;
            const int m = latent ? b * SEQ + (dir ? SEQ - 1 - (s - CTX) : s - CTX) : TL + b * CTX + (dir ? CTX - 1 - s : s);
            const bf16x8 kv = *(const bf16x8*)(MK + (size_t)m * 512 + h * 128 + c8);
            const bf16x8 vv = *(const bf16x8*)(MV + (size_t)m * 1024 + h * 256 + dvh * 128 + c8);
#pragma unroll
            for (int i = 0; i < 8; ++i) { Ks[j * 128 + c8 + i] = bf2f((bf16_t)kv[i]); Vs[j * 128 + c8 + i] = bf2f((bf16_t)vv[i]); }
            if (latent) { const bf16x8 qv = *(const bf16x8*)(MQ + (size_t)m * 512 + h * 128 + c8);
#pragma unroll
                for (int i = 0; i < 8; ++i) Qs[j * 128 + c8 + i] = bf2f((bf16_t)qv[i]); }
            if ((tid & 15) == 0) { gi[j] = GT[(size_t)m * 16 + dir * 8 + h]; gf[j] = GT[(size_t)m * 16 + dir * 8 + 4 + h]; }
        }
        __syncthreads();
        for (int j = 0; j < 32; ++j) {
            const float f = __expf(gf[j]), ig = __expf(gi[j]); const float v = Vs[j * 128 + dvl];
            float num = 0.f, den = 0.f;
            const f32x4* kp = (const f32x4*)(Ks + j * 128 + kq * 32); const f32x4* qp = (const f32x4*)(Qs + j * 128 + kq * 32);
#pragma unroll
            for (int r4 = 0; r4 < 8; ++r4) { const f32x4 k4 = kp[r4]; f32x4 q4 = {0.f, 0.f, 0.f, 0.f}; if (latent) q4 = qp[r4];
#pragma unroll
                for (int i = 0; i < 4; ++i) { const int r = r4 * 4 + i; const float ik = ig * k4[i]; C[r] = f * C[r] + ik * v; nn[r] = f * nn[r] + ik; num += q4[i] * C[r]; den += q4[i] * nn[r]; } }
            if (latent) {
                num += __shfl_xor(num, 1); num += __shfl_xor(num, 2); den += __shfl_xor(den, 1); den += __shfl_xor(den, 2);
                if (kq == 0) { const int s = s0 + j; const int m = b * SEQ + (dir ? SEQ - 1 - (s - CTX) : s - CTX);
                    const float hv = num / fmaxf(fabsf(den), 1.0f);
                    H[(size_t)m * 1024 + h * 256 + dvh * 128 + dvl] = (bf16_t)(cvt_pk_bf16(hv, 0.f) & 0xffffu); }
            }
        }
    }
    __syncthreads();
}

namespace mls {
#define KSWZ(row, colB) ((row) * 256 + ((colB) ^ (((row) & 7) << 4)))
#define SBAR() __builtin_amdgcn_sched_barrier(0)
using att::crow; using att::cvtpk; using att::v_st; using att::v_rd_base; using att::v_rd_off; using att::tr_read;
constexpr int L_KSW = 0, L_KV = 32768, L_V = 65536, L_CT = 98304, L_F = 114688;
__device__ __forceinline__ float swap_add(float v) { auto rr = __builtin_amdgcn_permlane32_swap(__float_as_uint(v), __float_as_uint(v), false, false); return __uint_as_float(rr[0]) + __uint_as_float(rr[1]); }
#define TRPK(L, H) (bf16x8){L[0], L[1], L[2], L[3], H[0], H[1], H[2], H[3]}
__device__ __forceinline__ void mlstm_item(const Params& p, LAS unsigned char* lds_, int item) {
    char* lds = (char*)(unsigned char*)lds_;
    const int tid = otid(), wid = __builtin_amdgcn_readfirstlane(tid >> 6), lane = tid & 63, r32 = lane & 31, hi = lane >> 5;
    const int dvq = item & 3, dir = (item >> 2) & 1, h = (item >> 3) & 3, b = item >> 5;
    const int rb = wid & 3, vh = wid >> 2;
    float* fa = (float*)(lds + L_F); float* a_ = fa; float* bco = fa + 128; float* w_ = fa + 256; float* wint = fa + 384; float* nvec = fa + 512; float* npart = fa + 640; float* denl = fa + 1152 + wid * 32; float* gsc = fa + 1408;
    const bf16_t* MQ = (const bf16_t*)(p.ws + WS_MQ); const bf16_t* MK = (const bf16_t*)(p.ws + WS_MK); const bf16_t* MV = (const bf16_t*)(p.ws + WS_MV);
    const float* GT = (const float*)(p.ws + WS_GT); bf16_t* H = (bf16_t*)(p.ws + (dir ? WS_HB : WS_HF));
    f32x16 Cacc = {};
    { u32x4 z = {0u, 0u, 0u, 0u}; *(u32x4*)(lds + L_CT + tid * 32) = z; *(u32x4*)(lds + L_CT + tid * 32 + 16) = z; if (tid < 128) nvec[tid] = 0.f; }
    const int tid_outer = tid;
    for (int c = 0; c < 34; ++c) {
        int tid = tid_outer; asm volatile("" : "+v"(tid));
        const int lane = tid & 63, r32 = lane & 31, hi = lane >> 5;
        const int vbV = (int)(uintptr_t)(lds + L_V) + v_rd_base(lane), vbK = (int)(uintptr_t)(lds + L_KV) + v_rd_base(lane);
        const bool latent = c >= 2;
        const int mrow0 = latent ? b * SEQ + (dir ? 33 - c : c - 2) * 128 : TL + b * CTX + (dir ? 1 - c : c) * 128;
        bf16x8 kreg[4], vreg[2], qr[8];
#pragma unroll
        for (int i = 0; i < 4; ++i) { const int pc = tid + 512 * i, pr = pc >> 4, c8 = (pc & 15) * 8; kreg[i] = *(const bf16x8*)(MK + (size_t)(mrow0 + (dir ? 127 - pr : pr)) * 512 + h * 128 + c8); }
#pragma unroll
        for (int i = 0; i < 2; ++i) { const int pc = tid + 512 * i, pr = pc >> 3, c8 = (pc & 7) * 8; vreg[i] = *(const bf16x8*)(MV + (size_t)(mrow0 + (dir ? 127 - pr : pr)) * 1024 + h * 256 + dvq * 64 + c8); }
        if (latent) { const int pr = rb * 32 + r32; const bf16_t* qp = MQ + (size_t)(mrow0 + (dir ? 127 - pr : pr)) * 512 + h * 128 + hi * 8;
#pragma unroll
            for (int d0 = 0; d0 < 8; ++d0) qr[d0] = *(const bf16x8*)(qp + d0 * 16); }
        else {
#pragma unroll
            for (int d0 = 0; d0 < 8; ++d0) qr[d0] = bf16x8{};
        }
        if (wid == 0) {
            const int p0 = 2 * lane, p1 = 2 * lane + 1; const size_t m0 = (size_t)(mrow0 + (dir ? 127 - p0 : p0)) * 16, m1 = (size_t)(mrow0 + (dir ? 127 - p1 : p1)) * 16;
            const float i0 = GT[m0 + dir * 8 + h], lf0 = GT[m0 + dir * 8 + 4 + h], i1 = GT[m1 + dir * 8 + h], lf1 = GT[m1 + dir * 8 + 4 + h];
            float incl = lf0 + lf1;
#pragma unroll
            for (int o = 1; o < 64; o <<= 1) { const float t = __shfl_up(incl, o); if (lane >= o) incl += t; }
            const float F1 = incl, F0 = incl - lf1, Ftot = __shfl(incl, 63);
            a_[p0] = F0; a_[p1] = F1; bco[p0] = i0 - F0; bco[p1] = i1 - F1; wint[p0] = __expf(F0); wint[p1] = __expf(F1);
            w_[p0] = __expf(Ftot - F0 + i0); w_[p1] = __expf(Ftot - F1 + i1); if (lane == 0) gsc[0] = __expf(Ftot);
        }
        __syncthreads();
#pragma unroll
        for (int i = 0; i < 4; ++i) { const int pc = tid + 512 * i, pr = pc >> 4, c8 = (pc & 15) * 8;
            *(bf16x8*)(lds + L_KSW + KSWZ(pr, c8 * 2)) = kreg[i]; *(bf16x8*)(lds + L_KV + (pr >> 6) * 16384 + v_st(pr & 63, c8)) = kreg[i]; }
#pragma unroll
        for (int i = 0; i < 2; ++i) { const int pc = tid + 512 * i, pr = pc >> 3, c8 = (pc & 7) * 8; const float ws_ = w_[pr];
            *(bf16x8*)(lds + L_V + (pr >> 6) * 16384 + v_st(pr & 63, c8)) = vreg[i];
            u32x4 sv; const u32x4 raw = *reinterpret_cast<const u32x4*>(&vreg[i]);
            sv.x = cvtpk(bf_lo(raw.x) * ws_, bf_hi(raw.x) * ws_); sv.y = cvtpk(bf_lo(raw.y) * ws_, bf_hi(raw.y) * ws_); sv.z = cvtpk(bf_lo(raw.z) * ws_, bf_hi(raw.z) * ws_); sv.w = cvtpk(bf_lo(raw.w) * ws_, bf_hi(raw.w) * ws_);
            *(u32x4*)(lds + L_V + (pr >> 6) * 16384 + v_st(pr & 63, 64 + c8)) = sv; }
        __syncthreads();
        const float g = gsc[0];
        if (latent) {
            const int qidx = rb * 32 + r32;
            float qn = 0.f;
#pragma unroll
            for (int d0 = 0; d0 < 8; ++d0) { const f32x4 n0 = *(const f32x4*)(nvec + d0 * 16 + hi * 8), n1 = *(const f32x4*)(nvec + d0 * 16 + hi * 8 + 4); const u32x4 q4 = *reinterpret_cast<const u32x4*>(&qr[d0]);
                qn += bf_lo(q4.x) * n0[0] + bf_hi(q4.x) * n0[1] + bf_lo(q4.y) * n0[2] + bf_hi(q4.y) * n0[3] + bf_lo(q4.z) * n1[0] + bf_hi(q4.z) * n1[1] + bf_lo(q4.w) * n1[2] + bf_hi(q4.w) * n1[3]; }
            qn = swap_add(qn);
            f32x16 o = {};
#pragma unroll
            for (int d0 = 0; d0 < 8; ++d0) { const bf16x8 cf = *(const bf16x8*)(lds + L_CT + KSWZ(32 * vh + r32, (d0 * 16 + hi * 8) * 2)); o = __builtin_amdgcn_mfma_f32_32x32x16_bf16(qr[d0], cf, o, 0, 0, 0); }
#pragma unroll
            for (int g4 = 0; g4 < 4; ++g4) { const f32x4 wi = *(const f32x4*)(wint + rb * 32 + 8 * g4 + 4 * hi);
#pragma unroll
                for (int i = 0; i < 4; ++i) o[g4 * 4 + i] *= wi[i]; }
            const float aq = a_[qidx]; float den = 0.f;
            for (int jt = 0; jt <= (rb >> 1); ++jt) {
                f32x16 p0 = {}, p1 = {};
#pragma unroll
                for (int d0 = 0; d0 < 8; ++d0) { const int cbb = (d0 * 16 + hi * 8) * 2;
                    const bf16x8 b0 = *(const bf16x8*)(lds + L_KSW + KSWZ(64 * jt + r32, cbb)), b1 = *(const bf16x8*)(lds + L_KSW + KSWZ(64 * jt + 32 + r32, cbb));
                    p0 = __builtin_amdgcn_mfma_f32_32x32x16_bf16(b0, qr[d0], p0, 0, 0, 0); p1 = __builtin_amdgcn_mfma_f32_32x32x16_bf16(b1, qr[d0], p1, 0, 0, 0); }
                float ps = 0.f;
#pragma unroll
                for (int g4 = 0; g4 < 4; ++g4) { const int k0 = 64 * jt + 8 * g4 + 4 * hi; const f32x4 bb0 = *(const f32x4*)(bco + k0), bb1 = *(const f32x4*)(bco + k0 + 32);
#pragma unroll
                    for (int i = 0; i < 4; ++i) { const int r = g4 * 4 + i;
                        const float e0 = __expf(aq + bb0[i]), e1 = __expf(aq + bb1[i]);
                        p0[r] = (k0 + i <= qidx) ? p0[r] * e0 : 0.f; p1[r] = (k0 + 32 + i <= qidx) ? p1[r] * e1 : 0.f; ps += p0[r] + p1[r]; } }
                den += swap_add(ps);
                bf16x8 pa0, pa1, pa2, pa3;
#define PK4(P, BASE, OUT) do { unsigned a0 = cvtpk(P[BASE + 0], P[BASE + 1]), a1 = cvtpk(P[BASE + 2], P[BASE + 3]);   \
    unsigned b0_ = cvtpk(P[BASE + 4], P[BASE + 5]), b1_ = cvtpk(P[BASE + 6], P[BASE + 7]);                              \
    auto r0 = __builtin_amdgcn_permlane32_swap(a0, b0_, false, false); auto r1 = __builtin_amdgcn_permlane32_swap(a1, b1_, false, false); \
    u32x4 w4 = {r0[0], r1[0], r0[1], r1[1]}; OUT = *reinterpret_cast<bf16x8*>(&w4); } while (0)
                PK4(p0, 0, pa0); PK4(p0, 8, pa1); PK4(p1, 0, pa2); PK4(p1, 8, pa3);
#undef PK4
                const int vb = vbV + jt * 16384 + vh * 512;
                const s16x4 l0 = tr_read<v_rd_off(0, 0, 0)>(vb), h0 = tr_read<v_rd_off(0, 0, 1)>(vb), l1 = tr_read<v_rd_off(0, 1, 0)>(vb), h1 = tr_read<v_rd_off(0, 1, 1)>(vb);
                const s16x4 l2 = tr_read<v_rd_off(0, 2, 0)>(vb), h2 = tr_read<v_rd_off(0, 2, 1)>(vb), l3 = tr_read<v_rd_off(0, 3, 0)>(vb), h3 = tr_read<v_rd_off(0, 3, 1)>(vb);
                asm volatile("s_waitcnt lgkmcnt(0)" ::: "memory"); SBAR();
                o = __builtin_amdgcn_mfma_f32_32x32x16_bf16(pa0, TRPK(l0, h0), o, 0, 0, 0); o = __builtin_amdgcn_mfma_f32_32x32x16_bf16(pa1, TRPK(l1, h1), o, 0, 0, 0);
                o = __builtin_amdgcn_mfma_f32_32x32x16_bf16(pa2, TRPK(l2, h2), o, 0, 0, 0); o = __builtin_amdgcn_mfma_f32_32x32x16_bf16(pa3, TRPK(l3, h3), o, 0, 0, 0);
            }
            const float dtot = den + wint[qidx] * qn;
            if (hi == 0) denl[r32] = dtot;
            asm volatile("s_waitcnt lgkmcnt(0)" ::: "memory");
#pragma unroll
            for (int g4 = 0; g4 < 4; ++g4) { const f32x4 dd = *(const f32x4*)(denl + 8 * g4 + 4 * hi);
#pragma unroll
                for (int i = 0; i < 4; ++i) { const int r = g4 * 4 + i, pr = rb * 32 + 8 * g4 + 4 * hi + i;
                    const float hv = o[r] / fmaxf(fabsf(dd[i]), 1.0f);
                    H[(size_t)(mrow0 + (dir ? 127 - pr : pr)) * 1024 + h * 256 + dvq * 64 + vh * 32 + r32] = (bf16_t)(cvtpk(hv, 0.f) & 0xffffu); } }
        }
#pragma unroll
        for (int r = 0; r < 16; ++r) Cacc[r] *= g;
#pragma unroll
        for (int jt = 0; jt < 2; ++jt) {
            const int va = vbV + jt * 16384 + (2 + vh) * 512, ka = vbK + jt * 16384 + rb * 512;
            const s16x4 al0 = tr_read<v_rd_off(0, 0, 0)>(va), ah0 = tr_read<v_rd_off(0, 0, 1)>(va), al1 = tr_read<v_rd_off(0, 1, 0)>(va), ah1 = tr_read<v_rd_off(0, 1, 1)>(va);
            const s16x4 al2 = tr_read<v_rd_off(0, 2, 0)>(va), ah2 = tr_read<v_rd_off(0, 2, 1)>(va), al3 = tr_read<v_rd_off(0, 3, 0)>(va), ah3 = tr_read<v_rd_off(0, 3, 1)>(va);
            const s16x4 bl0 = tr_read<v_rd_off(0, 0, 0)>(ka), bh0 = tr_read<v_rd_off(0, 0, 1)>(ka), bl1 = tr_read<v_rd_off(0, 1, 0)>(ka), bh1 = tr_read<v_rd_off(0, 1, 1)>(ka);
            const s16x4 bl2 = tr_read<v_rd_off(0, 2, 0)>(ka), bh2 = tr_read<v_rd_off(0, 2, 1)>(ka), bl3 = tr_read<v_rd_off(0, 3, 0)>(ka), bh3 = tr_read<v_rd_off(0, 3, 1)>(ka);
            asm volatile("s_waitcnt lgkmcnt(0)" ::: "memory"); SBAR();
            Cacc = __builtin_amdgcn_mfma_f32_32x32x16_bf16(TRPK(al0, ah0), TRPK(bl0, bh0), Cacc, 0, 0, 0); Cacc = __builtin_amdgcn_mfma_f32_32x32x16_bf16(TRPK(al1, ah1), TRPK(bl1, bh1), Cacc, 0, 0, 0);
            Cacc = __builtin_amdgcn_mfma_f32_32x32x16_bf16(TRPK(al2, ah2), TRPK(bl2, bh2), Cacc, 0, 0, 0); Cacc = __builtin_amdgcn_mfma_f32_32x32x16_bf16(TRPK(al3, ah3), TRPK(bl3, bh3), Cacc, 0, 0, 0);
        }
        { const int k = tid & 127, sq = tid >> 7; float part = 0.f;
#pragma unroll 8
            for (int s = sq * 32; s < sq * 32 + 32; ++s) part += w_[s] * bf2f(*(const bf16_t*)(lds + L_KSW + KSWZ(s, 2 * k)));
            npart[sq * 128 + k] = part; }
        __syncthreads();
#pragma unroll
        for (int r = 0; r < 16; ++r) *(bf16_t*)(lds + L_CT + KSWZ(32 * vh + crow(r, hi), 2 * (32 * rb + r32))) = (bf16_t)(cvtpk(Cacc[r], 0.f) & 0xffffu);
        if (tid < 128) nvec[tid] = g * nvec[tid] + ((npart[tid] + npart[128 + tid]) + (npart[256 + tid] + npart[384 + tid]));
    }
    __syncthreads();
}
#undef TRPK
#undef KSWZ
#undef SBAR
}

__device__ __forceinline__ void phase_mfinal(const Params& p, int G) {
    const int tid = otid(), lane = tid & 63, wave = __builtin_amdgcn_readfirstlane(tid >> 6);
    const int gw = blockIdx.x * 8 + wave, NGW = G * 8;
    bf16_t* HF = (bf16_t*)(p.ws + WS_HF); const bf16_t* HB = (const bf16_t*)(p.ws + WS_HB); const bf16_t* MO = (const bf16_t*)(p.ws + WS_MO);
    for (int m = gw; m < TL; m += NGW) {
#pragma unroll
        for (int j = 0; j < 4; ++j) {
            const size_t o = (size_t)m * 1024 + 256 * j + 4 * lane;
            const u32x2 a = *(const u32x2*)(HF + o), bq = *(const u32x2*)(HB + o), og = *(const u32x2*)(MO + o);
            f32x4 hs = {bf_lo(a.x) + bf_lo(bq.x), bf_hi(a.x) + bf_hi(bq.x), bf_lo(a.y) + bf_lo(bq.y), bf_hi(a.y) + bf_hi(bq.y)};
            const float rstd = rsqrtf(wave_sum((hs[0] * hs[0] + hs[1] * hs[1]) + (hs[2] * hs[2] + hs[3] * hs[3])) * (1.0f / 256.0f) + EPS);
            const f32x4 g = *(const f32x4*)(p.mnorm_g + 256 * j + 4 * lane);
            const f32x4 ov = {sigmoidf_(bf_lo(og.x)), sigmoidf_(bf_hi(og.x)), sigmoidf_(bf_lo(og.y)), sigmoidf_(bf_hi(og.y))};
            const f32x4 r = hs * rstd * g * ov;
            u32x2 w; w.x = cvt_pk_bf16(r[0], r[1]); w.y = cvt_pk_bf16(r[2], r[3]); *(u32x2*)(HF + o) = w;
        }
    }
}

__device__ __forceinline__ void phase_rows2(const Params& p, LAS unsigned char* lds, int grp) {
    const int tid = otid(), lane = tid & 63, wave = __builtin_amdgcn_readfirstlane(tid >> 6);
    LAS float* rw = (LAS float*)lds;
    LAS int* hist = (LAS int*)(lds + 131072);
    LAS int* basee = hist + 32;
    LAS int* a_e = basee + 32;
    LAS int* a_p = a_e + 512;
    LAS float* a_g = (LAS float*)(a_p + 512);
    for (int i = tid; i < 32 * 1024; i += NTHREADS) { const int k = i >> 5, e = i & 31; rw[e * 1024 + k] = p.router_w[i]; }
    if (tid < 32) hist[tid] = 0;
    __syncthreads();
    const float* mod = (const float*)(p.ws + WS_MOD); bf16_t* U2 = (bf16_t*)(p.ws + WS_U2);
    unsigned* cnt = (unsigned*)(p.ws + WS_CTL) + CW_CNT; int* asg = (int*)(p.ws + WS_ASG); int* list = (int*)(p.ws + WS_LIST); float* lgate = (float*)(p.ws + WS_LGATE);
    f32x4 gn[4];
#pragma unroll
    for (int j = 0; j < 4; ++j) gn[j] = *(const f32x4*)(p.norm2_g + 4 * lane + 256 * j);
    const int tok0 = grp * 128 + wave * 16;
    for (int it = 0; it < 16; ++it) {
        const int m = tok0 + it; const float* xr = p.out + (size_t)m * 1024; const float* md = mod + (size_t)(m >> 12) * 6144;
        f32x4 v[4]; float ss = 0.f;
#pragma unroll
        for (int j = 0; j < 4; ++j) { v[j] = *(const f32x4*)(xr + 4 * lane + 256 * j); ss += (v[j][0] * v[j][0] + v[j][1] * v[j][1]) + (v[j][2] * v[j][2] + v[j][3] * v[j][3]); }
        const float rstd = rsqrtf(wave_sum(ss) * (1.0f / 1024.0f) + EPS);
#pragma unroll
        for (int j = 0; j < 4; ++j) { const f32x4 sh = *(const f32x4*)(md + 3072 + 4 * lane + 256 * j), sc = *(const f32x4*)(md + 4096 + 4 * lane + 256 * j);
            v[j] = (v[j] * rstd * gn[j]) * (sc + 1.0f) + sh;
            u32x2 w; w.x = cvt_pk_bf16(v[j][0], v[j][1]); w.y = cvt_pk_bf16(v[j][2], v[j][3]); *(u32x2*)(U2 + (size_t)m * 1024 + 4 * lane + 256 * j) = w; }
        float mine = 0.f;
#pragma unroll 4
        for (int e = 0; e < 32; ++e) { float a = 0.f;
#pragma unroll
            for (int j = 0; j < 4; ++j) { const f32x4 w = *(const LAS f32x4*)(rw + e * 1024 + 4 * lane + 256 * j); a += (v[j][0] * w[0] + v[j][1] * w[1]) + (v[j][2] * w[2] + v[j][3] * w[3]); }
            a = wave_sum(a); mine = (lane == e) ? a : mine; }
        if (lane < 32) mine += p.router_b[lane];
        float val = lane < 32 ? mine : -INFINITY; int sel_e[4]; float sel_v[4];
#pragma unroll
        for (int k = 0; k < 4; ++k) {
            float bv = val; int bi = lane;
#pragma unroll
            for (int o = 1; o < 64; o <<= 1) { const float ov = __shfl_xor(bv, o); const int oi = __shfl_xor(bi, o); if (ov > bv || (ov == bv && oi < bi)) { bv = ov; bi = oi; } }
            sel_e[k] = bi; sel_v[k] = bv; if (lane == bi) val = -INFINITY;
        }
        if (lane == 0) {
            const float e1 = __expf(sel_v[1] - sel_v[0]), e2 = __expf(sel_v[2] - sel_v[0]), e3 = __expf(sel_v[3] - sel_v[0]); const float inv = 1.0f / (1.0f + e1 + e2 + e3);
            const float gk[4] = {inv, e1 * inv, e2 * inv, e3 * inv};
#pragma unroll
            for (int k = 0; k < 4; ++k) { const int a = (wave * 16 + it) * 4 + k; a_e[a] = sel_e[k]; a_p[a] = atomicAdd((int*)&hist[sel_e[k]], 1); a_g[a] = gk[k]; }
        }
    }
    __syncthreads();
    if (tid < 32) basee[tid] = (int)atomicAdd(cnt + tid, (unsigned)hist[tid]);
    __syncthreads();
    {
        const int a = tid; const int e = a_e[a]; const int pos = basee[e] + a_p[a]; const int tok = grp * 128 + (a >> 2);
        list[(size_t)e * CAP + pos] = tok; lgate[(size_t)e * CAP + pos] = a_g[a]; asg[tok * 4 + (a & 3)] = e * CAP + pos;
    }
    __syncthreads();
}

__device__ __forceinline__ void moe_tables(const Params& p, LAS int* tb, LAS int* cn) {
    if (threadIdx.x == 0) { const unsigned* cnt = (const unsigned*)(p.ws + WS_CTL) + CW_CNT; int acc = 0;
        for (int e = 0; e < 32; ++e) { const int c = (int)__hip_atomic_load(cnt + e, __ATOMIC_RELAXED, __HIP_MEMORY_SCOPE_AGENT); cn[e] = c; tb[e] = acc; acc += (c + 255) >> 8; } tb[32] = acc; }
    __syncthreads();
}

__device__ __forceinline__ void phase_final(const Params& p, const LAS int* tb, int G) {
    const int tid = otid(), lane = tid & 63, wave = __builtin_amdgcn_readfirstlane(tid >> 6);
    const int gw = blockIdx.x * 8 + wave, NGW = G * 8;
    const float* mod = (const float*)(p.ws + WS_MOD); const bf16_t* YS = (const bf16_t*)(p.ws + WS_YS); const int* asg = (const int*)(p.ws + WS_ASG);
    f32x4 gn[4];
#pragma unroll
    for (int j = 0; j < 4; ++j) gn[j] = *(const f32x4*)(p.final_g + 4 * lane + 256 * j);
    for (int m = gw; m < TL; m += NGW) {
        float* xr = p.out + (size_t)m * 1024; const float* g2 = mod + (size_t)(m >> 12) * 6144 + 5120;
        size_t rows[4];
#pragma unroll
        for (int k = 0; k < 4; ++k) { const int a = asg[m * 4 + k]; const int e = a >> 15, pos = a & (CAP - 1); rows[k] = (size_t)(tb[e] * 256 + pos) * 1024; }
        f32x4 v[4]; float ss = 0.f;
#pragma unroll
        for (int j = 0; j < 4; ++j) {
            f32x4 y = {0.f, 0.f, 0.f, 0.f};
#pragma unroll
            for (int k = 0; k < 4; ++k) { const u32x2 w = *(const u32x2*)(YS + rows[k] + 4 * lane + 256 * j); y[0] += bf_lo(w.x); y[1] += bf_hi(w.x); y[2] += bf_lo(w.y); y[3] += bf_hi(w.y); }
            v[j] = *(const f32x4*)(xr + 4 * lane + 256 * j) + *(const f32x4*)(g2 + 4 * lane + 256 * j) * y;
            ss += (v[j][0] * v[j][0] + v[j][1] * v[j][1]) + (v[j][2] * v[j][2] + v[j][3] * v[j][3]);
        }
        const float rstd = rsqrtf(wave_sum(ss) * (1.0f / 1024.0f) + EPS);
#pragma unroll
        for (int j = 0; j < 4; ++j) *(f32x4*)(xr + 4 * lane + 256 * j) = v[j] * rstd * gn[j];
    }
}

__device__ __forceinline__ void phase_attn(const Params& p, LAS unsigned char* lds_, int G) {
    char* lds = (char*)(unsigned char*)lds_;
    volatile int* uslot = (volatile int*)(lds + att::SHM_ATTN);
    unsigned* ctr = (unsigned*)(p.ws + WS_CTL) + CW_ATT;
    const float lam = *(const float*)(p.ws + WS_LAM);
    const bf16_t* DQ = (const bf16_t*)(p.ws + WS_DQ); const bf16_t* DK = (const bf16_t*)(p.ws + WS_DK); const bf16_t* DV = (const bf16_t*)(p.ws + WS_DV); bf16_t* BO = (bf16_t*)(p.ws + WS_BO);
    for (;;) {
        __syncthreads();
        if (threadIdx.x == 0) uslot[0] = (int)atomicAdd(ctr, 1u);
        __syncthreads();
        const int u = uslot[0];
        if (u >= 2048) break;
        const int bh = u >> 5, qb = u & 31, b = bh >> 3, h = bh & 7;
        const size_t qoff = ((size_t)b * SEQ + qb * 128) * 1024 + h * 128, koff = (size_t)b * KVLEN * 1024 + h * 128;
        att::attn_unit(DQ + qoff, DK + koff, DV + koff, BO + qoff, p.dnorm_g + h * 128, lam, KVLEN, lds);
    }
}

__global__ void __launch_bounds__(NTHREADS, 2) fwd_megakernel(Params p) {
    extern __shared__ __attribute__((aligned(16))) unsigned char smem[];
    LAS unsigned char* lds = (LAS unsigned char*)smem;
    cg::grid_group grid = cg::this_grid();
    const int G = gridDim.x, c = blockIdx.x;
    unsigned char* ws = p.ws;

#ifndef PH_MASK
#define PH_MASK 0xFFFF
#endif
#define PH(k) if constexpr (((PH_MASK) >> (k)) & 1)
    PH(0) phase_prep(p, lds, G);
    grid.sync();
    PH(1) phase_rows1(p, lds, G);
    grid.sync();
    PH(2) {
        SchedIn S{(const char*)(ws + WS_U), (const char*)(ws + WS_WIN), G, c};
        EpiIn E{ws, (const float*)(ws + WS_ROPE), (const float*)(ws + WS_ROPE) + 1024};
        pg8::gemm_phase<EpiIn, SchedIn, false>(lds, S, E);
    }
    grid.sync();
#ifdef MLSTM_NAIVE
    PH(3) for (int item = c; item < 128; item += G) phase_mlstm_naive(p, lds, item);
#else
    PH(3) for (int item = c; item < 256; item += G) mls::mlstm_item(p, lds, item);
#endif
    PH(4) phase_attn(p, lds, G);
    grid.sync();
    PH(5) phase_mfinal(p, G);
    grid.sync();
    PH(6) {
        SchedStatic S{(const char*)(ws + WS_AO), (const char*)(ws + WS_WA), 128, 4, G, c};
        EpiMerge<0> E{(const bf16_t*)(ws + WS_GA), nullptr, (bf16_t*)(ws + WS_T)};
        pg8::gemm_phase<EpiMerge<0>, SchedStatic, false>(lds, S, E);
    }
    grid.sync();
    PH(7) {
        SchedStatic S{(const char*)(ws + WS_BO), (const char*)(ws + WS_WB), 128, 4, G, c};
        EpiMerge<1> E{(const bf16_t*)(ws + WS_GB), (const bf16_t*)(ws + WS_T), (bf16_t*)(ws + WS_Y)};
        pg8::gemm_phase<EpiMerge<1>, SchedStatic, false>(lds, S, E);
    }
    grid.sync();
    PH(8) {
        SchedStatic S{(const char*)(ws + WS_Y), (const char*)(ws + WS_WO), 128, 4, G, c};
        EpiOut E{p.x, (const float*)(ws + WS_MOD), p.out};
        pg8::gemm_phase<EpiOut, SchedStatic, false>(lds, S, E);
    }
    grid.sync();
    PH(9) for (int grp = c; grp < 256; grp += G) phase_rows2(p, lds, grp);
    grid.sync();
    LAS int* tb = (LAS int*)(lds + 131072); LAS int* cn = tb + 64;
    moe_tables(p, tb, cn);
    PH(10) {
        SchedMoe1 S{(const char*)(ws + WS_U2), (const char*)(ws + WS_W1), (const int*)(ws + WS_LIST), tb, cn, G, c};
        EpiMoe1 E{(bf16_t*)(ws + WS_ACT), p.exp_b1};
        pg8::gemm_phase<EpiMoe1, SchedMoe1, true>(lds, S, E);
    }
    grid.sync();
    PH(11) {
        SchedMoe2 S{(const char*)(ws + WS_ACT), (const char*)(ws + WS_W2), tb, G, c};
        EpiMoe2 E{(bf16_t*)(ws + WS_YS), p.exp_b2, (const float*)(ws + WS_LGATE), cn};
        pg8::gemm_phase<EpiMoe2, SchedMoe2, false>(lds, S, E);
    }
    grid.sync();
    PH(12) phase_final(p, tb, G);
}

extern "C" void kernel_launch(void* const* d_in, const int* in_sizes, int n_in, void* d_out, int out_size, void* d_ws, size_t ws_size, hipStream_t stream) {
    static int grid = 0;
    if (grid == 0) {
        if (n_in != 23 || out_size != TL * D || ws_size < WS_END) { fprintf(stderr, "kernel_launch: unexpected shapes: n_in %d out %d ws %zu (need %zu)\n", n_in, out_size, ws_size, (size_t)WS_END); grid = -1; return; }
        int dev = 0, cus = 0, per_cu = 0;
        hipGetDevice(&dev); hipDeviceGetAttribute(&cus, hipDeviceAttributeMultiprocessorCount, dev);
        if (hipFuncSetAttribute((const void*)fwd_megakernel, hipFuncAttributeMaxDynamicSharedMemorySize, LDS_BYTES) != hipSuccess) { fprintf(stderr, "kernel_launch: hipFuncSetAttribute failed\n"); grid = -1; return; }
        if (hipOccupancyMaxActiveBlocksPerMultiprocessor(&per_cu, (const void*)fwd_megakernel, NTHREADS, LDS_BYTES) != hipSuccess || per_cu < 1) { fprintf(stderr, "kernel_launch: occupancy query says %d\n", per_cu); per_cu = 1; }
        (void)hipGetLastError();
        grid = cus;
        if (grid > 256) grid = 256;
    }
    if (grid < 0) return;
    hipMemsetAsync((char*)d_ws + WS_CTL, 0, 4096, stream);
    Params p{};
    const float** pp = (const float**)&p;
    for (int i = 0; i < 23; ++i) pp[i] = (const float*)d_in[i];
    p.out = (float*)d_out; p.ws = (unsigned char*)d_ws;
    void* args[] = {&p};
    hipError_t e = hipLaunchCooperativeKernel((const void*)fwd_megakernel, dim3(grid), dim3(NTHREADS), args, LDS_BYTES, stream);
    if (e != hipSuccess) fprintf(stderr, "cooperative launch failed: %s (grid %d)\n", hipGetErrorString(e), grid);
}
```

```cpp
#include <hip/hip_runtime.h>
#include <hip/hip_cooperative_groups.h>
#include <cstdio>
#include <cstdint>
namespace cg = cooperative_groups;

#define LAS __attribute__((address_space(3)))
typedef unsigned short bf16_t;
typedef short bf16x8 __attribute__((ext_vector_type(8)));
typedef short s16x4 __attribute__((ext_vector_type(4)));
typedef float f32x4 __attribute__((ext_vector_type(4)));
typedef float f32x8 __attribute__((ext_vector_type(8)));
typedef float f32x16 __attribute__((ext_vector_type(16)));
typedef unsigned u32x4 __attribute__((ext_vector_type(4)));
typedef unsigned u32x2 __attribute__((ext_vector_type(2)));

constexpr int D = 1024, BATCH = 8, SEQ = 4096, CTX = 256;
constexpr int TL = BATCH * SEQ, TC = BATCH * CTX, TT = TL + TC;
constexpr int KVLEN = CTX + SEQ;
constexpr int NEXP = 32, CAP = 32768, ACT_ROWS = 139264;
constexpr int INCOLS = 8208;
constexpr float EPS = 1e-6f;
constexpr float LAM_INIT = 0.2f;

constexpr size_t MiB = 1u << 20;
constexpr size_t WS_CTL = 0;
constexpr size_t WS_MOD = 1 * MiB;
constexpr size_t WS_ROPE = 1 * MiB + 256 * 1024;
constexpr size_t WS_LAM = 1 * MiB + 300 * 1024;
constexpr size_t WS_GT = 2 * MiB;
constexpr size_t WS_ASG = 5 * MiB;
constexpr size_t WS_LIST = 6 * MiB;
constexpr size_t WS_LGATE = 10 * MiB;
constexpr size_t WS_WIN = 16 * MiB;
constexpr size_t WS_WA = 32 * MiB, WS_WB = 34 * MiB, WS_WO = 36 * MiB;
constexpr size_t WS_W1 = 40 * MiB;
constexpr size_t WS_W2 = 168 * MiB;
constexpr size_t WS_U = 232 * MiB;
constexpr size_t WS_MQ = 300 * MiB;
constexpr size_t WS_MK = 332 * MiB;
constexpr size_t WS_MV = 366 * MiB;
constexpr size_t WS_MO = 434 * MiB;
constexpr size_t WS_HB = 498 * MiB;
constexpr size_t WS_DQ = 562 * MiB;
constexpr size_t WS_DK = 626 * MiB;
constexpr size_t WS_DV = 694 * MiB;
constexpr size_t WS_GA = 762 * MiB;
constexpr size_t WS_GB = 826 * MiB;
constexpr size_t WS_END = 890 * MiB;
constexpr size_t WS_HF = WS_U, WS_AO = WS_U, WS_BO = WS_DQ, WS_T = WS_MV, WS_Y = WS_MO, WS_U2 = WS_MQ, WS_ACT = WS_DQ, WS_YS = WS_U;
static_assert(WS_ACT + (size_t)ACT_ROWS * 2048 <= WS_END, "ACT fits");
static_assert(WS_YS + (size_t)ACT_ROWS * 2048 <= WS_DQ, "YS fits");

constexpr int CW_CNT = 0, CW_ATT = 64, CW_BAR = 1024;
constexpr int LDS_BYTES = 147456;
constexpr int NTHREADS = 512;

struct Params {
    const float *x, *c, *ctx, *c_ctx, *ada_w, *ada_b, *norm1_g, *norm2_g, *w_in, *gate_b, *mnorm_g, *dlam, *dnorm_g, *w_a, *w_b, *w_o, *router_w, *router_b,
        *exp_w1, *exp_b1, *exp_w2, *exp_b2, *final_g;
    float* out;
    unsigned char* ws;
};

#define LDS_WAIT() asm volatile("s_waitcnt lgkmcnt(0)" ::: "memory")
#define VM_WAIT() asm volatile("s_waitcnt vmcnt(0)" ::: "memory")
typedef float f32x2_t __attribute__((ext_vector_type(2))); typedef __bf16 bf16x2_t __attribute__((ext_vector_type(2)));
__device__ __forceinline__ unsigned cvt_pk_bf16(float lo, float hi) { f32x2_t v = {lo, hi}; bf16x2_t b = __builtin_convertvector(v, bf16x2_t); return __builtin_bit_cast(unsigned, b); }
__device__ __forceinline__ float bf_lo(unsigned w) { return __uint_as_float(w << 16); }
__device__ __forceinline__ float bf_hi(unsigned w) { return __uint_as_float(w & 0xffff0000u); }
__device__ __forceinline__ float bf2f(bf16_t b) { return __uint_as_float(((unsigned)b) << 16); }
__device__ __forceinline__ float wave_sum(float v) {
#pragma unroll
    for (int o = 1; o < 64; o <<= 1) v += __shfl_xor(v, o);
    return v;
}
__device__ __forceinline__ float sigmoidf_(float x) { return 1.0f / (1.0f + __expf(-x)); }
__device__ __forceinline__ int otid() { int t = threadIdx.x; asm volatile("" : "+v"(t)); return t; }

namespace pg8 {
constexpr int BM = 256, BK = 64, HALF = 128, HTB = HALF * BK * 2, STAGE_BYTES = 8 * HTB, KD = 1024;
__host__ __device__ __forceinline__ int lds_byte(int r, int c) { const int st = (r >> 4) * 2 + (c >> 5), rr = r & 15, cc = c & 31, ob = rr * 64 + cc * 2; return st * 1024 + (ob ^ (((ob >> 9) & 1) << 5)); }
__host__ __device__ __forceinline__ void stage_rc(int b, int& R, int& C) { const int st = b / 1024, sb = b % 1024, swz = sb ^ (((sb >> 9) & 1) << 5); R = (st >> 1) * 16 + swz / 64; C = (st & 1) * 32 + (swz % 64) / 2; }

struct Unit { const char* A; const char* B; int row0; int pn; int aux; int aux2; };

__device__ __forceinline__ void tile_map(int L, int nM, int nN, int& pm, int& pn) {
    const int nwg = nM * nN; int wgid = L; { const int q = nwg / 8, r = nwg % 8, xcd = wgid % 8, off = wgid / 8; wgid = (xcd < r ? xcd * (q + 1) : r * (q + 1) + (xcd - r) * q) + off; }
    const int nig = 8 * nN, gid = wgid / nig, fm = gid * 8, gsz = (nM - fm) < 8 ? (nM - fm) : 8;
    pm = fm + ((wgid % nig) % gsz); pn = (wgid % nig) / gsz;
}

template <class Epi, class Sched, bool GATHER>
__device__ __forceinline__ void gemm_phase(LAS unsigned char* lds, const Sched& S, const Epi& E) {
    const int tid = otid(), wid = __builtin_amdgcn_readfirstlane(tid >> 6), lane = tid & 63, wr = wid >> 2, wc = wid & 3, fr = lane & 15, fq = lane >> 4;
    constexpr int K = KD, nt = K / BK;
    unsigned voffB[2], voffA0[2], voffA1[2], nvA0[2], nvA1[2];
    int sR[2], sC[2];
#pragma unroll
    for (int i = 0; i < 2; ++i) { int R, C; stage_rc(tid * 16 + i * 8192, R, C); sR[i] = R; sC[i] = C;
        voffB[i] = (unsigned)(R * K + C) * 2u; voffA0[i] = voffB[i]; voffA1[i] = voffB[i] + (unsigned)HALF * K * 2u; nvA0[i] = voffA0[i]; nvA1[i] = voffA1[i]; }
    const size_t kstep = (size_t)(BK * 2);
    const size_t hstep = (size_t)HALF * K * 2;
    const unsigned ldsw = (unsigned)wid * 1024u;
    const int aoff = lds_byte(wr * 64 + fr, fq * 8), boff = lds_byte(wc * 32 + fr, fq * 8);
#define PG8_SA(b, h) (((b) * 2 + (h)) * HTB)
#define PG8_SB(b, h) ((4 + (b) * 2 + (h)) * HTB)
#define PG8_STAGE(bufoff, gbase, voff) do { _Pragma("unroll") for (int _i = 0; _i < 2; ++_i) \
        __builtin_amdgcn_global_load_lds((const unsigned*)((const char*)(gbase) + (voff)[_i]), (LAS unsigned*)(lds + (bufoff) + ldsw + _i * 8192), 16, 0, 0); } while (0)
#define PG8_LDA(dst, b, h) do { _Pragma("unroll") for (int m = 0; m < 4; ++m) _Pragma("unroll") for (int k = 0; k < 2; ++k) dst[m][k] = *(const LAS bf16x8*)(lds + PG8_SA(b, h) + aoff + m * 2048 + k * 1024); } while (0)
#define PG8_LDB(dst, b, h) do { _Pragma("unroll") for (int n = 0; n < 2; ++n) _Pragma("unroll") for (int k = 0; k < 2; ++k) dst[n][k] = *(const LAS bf16x8*)(lds + PG8_SB(b, h) + boff + n * 2048 + k * 1024); } while (0)
#define PG8_MMA(ai, bj, At, Bt) do { __builtin_amdgcn_s_setprio(1); _Pragma("unroll") for (int m = 0; m < 4; ++m) _Pragma("unroll") for (int n = 0; n < 2; ++n) _Pragma("unroll") for (int k = 0; k < 2; ++k) \
        acc[ai][bj][m][n] = __builtin_amdgcn_mfma_f32_16x16x32_bf16(Bt[n][k], At[m][k], acc[ai][bj][m][n], 0, 0, 0); __builtin_amdgcn_s_setprio(0); } while (0)
#define PG8_WAIT_V(n) asm volatile("s_waitcnt vmcnt(" #n ")" ::: "memory")
#define PG8_WAIT_L(n) asm volatile("s_waitcnt lgkmcnt(" #n ")" ::: "memory")
#define PG8_BAR __builtin_amdgcn_s_barrier()
#define PG8_SCHED __builtin_amdgcn_sched_barrier(0)
    Unit cur, nxt; int ui = 0;
    if (!S.next(0, cur)) return;
    if constexpr (GATHER) { S.offsets(cur, sR, sC, voffA0, voffA1); }
    f32x4 acc[2][2][4][2];
#pragma unroll
    for (int a = 0; a < 2; ++a)
#pragma unroll
        for (int b = 0; b < 2; ++b)
#pragma unroll
            for (int m = 0; m < 4; ++m)
#pragma unroll
                for (int n = 0; n < 2; ++n) acc[a][b][m][n] = (f32x4){0.f, 0.f, 0.f, 0.f};
    bf16x8 At[4][2], B0[2][2], B1[2][2];
    const char* cA = cur.A; const char* cB = cur.B;
    PG8_STAGE(PG8_SB(0, 0), cB, voffB); PG8_STAGE(PG8_SB(0, 1), cB + hstep, voffB); PG8_STAGE(PG8_SA(0, 0), cA, voffA0); PG8_STAGE(PG8_SA(0, 1), cA, voffA1);
    if (wr == 1) PG8_BAR;
    PG8_WAIT_V(2); PG8_BAR;
    PG8_STAGE(PG8_SB(1, 0), cB + kstep, voffB); PG8_STAGE(PG8_SA(1, 0), cA + kstep, voffA0); PG8_STAGE(PG8_SB(1, 1), cB + hstep + kstep, voffB);
    PG8_WAIT_V(6); PG8_BAR;
    for (;;) {
        const bool has_next = S.next(ui + 1, nxt);
        if constexpr (GATHER) { if (has_next) S.offsets(nxt, sR, sC, nvA0, nvA1); }
        const char* nA = has_next ? nxt.A : cA; const char* nB = has_next ? nxt.B : cB;
        for (int t = 0; t < nt; t += 2) {
            const bool last = (t == nt - 2);
            const char* a1 = cA + (size_t)(t + 1) * kstep;
            const char* a2 = last ? nA : cA + (size_t)(t + 2) * kstep; const char* b2 = last ? nB : cB + (size_t)(t + 2) * kstep;
            const char* a3 = a2 + kstep; const char* b3 = b2 + kstep;
            unsigned w0[2], w1[2];
            if constexpr (GATHER) { const bool sw = last && has_next; w0[0] = sw ? nvA0[0] : voffA0[0]; w0[1] = sw ? nvA0[1] : voffA0[1]; w1[0] = sw ? nvA1[0] : voffA1[0]; w1[1] = sw ? nvA1[1] : voffA1[1]; }
            else { w0[0] = voffA0[0]; w0[1] = voffA0[1]; w1[0] = voffA1[0]; w1[1] = voffA1[1]; }
            PG8_LDB(B0, 0, 0); PG8_LDB(B1, 0, 1); PG8_SCHED; PG8_LDA(At, 0, 0); PG8_STAGE(PG8_SA(1, 1), a1, voffA1);
            PG8_WAIT_V(8); PG8_WAIT_L(0); PG8_BAR; PG8_MMA(0, 0, At, B0); PG8_MMA(0, 1, At, B1); PG8_BAR; PG8_SCHED;
            PG8_LDA(At, 0, 1); PG8_STAGE(PG8_SB(0, 0), b2, voffB); PG8_STAGE(PG8_SB(0, 1), b2 + hstep, voffB); PG8_STAGE(PG8_SA(0, 0), a2, w0);
            PG8_WAIT_V(8); PG8_WAIT_L(0); PG8_BAR; PG8_MMA(1, 0, At, B0); PG8_MMA(1, 1, At, B1); PG8_BAR; PG8_SCHED;
            PG8_LDB(B0, 1, 0); PG8_LDB(B1, 1, 1); PG8_SCHED; PG8_LDA(At, 1, 0); PG8_STAGE(PG8_SA(0, 1), a2, w1);
            PG8_WAIT_V(8); PG8_WAIT_L(0); PG8_BAR; PG8_MMA(0, 0, At, B0); PG8_MMA(0, 1, At, B1); PG8_BAR; PG8_SCHED;
            PG8_LDA(At, 1, 1); PG8_STAGE(PG8_SB(1, 0), b3, voffB); PG8_STAGE(PG8_SB(1, 1), b3 + hstep, voffB); PG8_STAGE(PG8_SA(1, 0), a3, w0);
            PG8_WAIT_V(8); PG8_WAIT_L(0); PG8_BAR; PG8_MMA(1, 0, At, B0); PG8_MMA(1, 1, At, B1); PG8_BAR; PG8_SCHED;
        }
        if (wr == 0) PG8_BAR;
        E(acc, cur, wr, wc, fr, fq);
        if (!has_next) break;
#pragma unroll
        for (int a = 0; a < 2; ++a)
#pragma unroll
            for (int b = 0; b < 2; ++b)
#pragma unroll
                for (int m = 0; m < 4; ++m)
#pragma unroll
                    for (int n = 0; n < 2; ++n) acc[a][b][m][n] = (f32x4){0.f, 0.f, 0.f, 0.f};
        cur = nxt; cA = nA; cB = nB; ++ui;
        if constexpr (GATHER) { voffA0[0] = nvA0[0]; voffA0[1] = nvA0[1]; voffA1[0] = nvA1[0]; voffA1[1] = nvA1[1]; }
        if (wr == 1) PG8_BAR;
    }
    PG8_WAIT_V(0);
    PG8_BAR;
#undef PG8_SA
#undef PG8_SB
#undef PG8_STAGE
#undef PG8_LDA
#undef PG8_LDB
#undef PG8_MMA
#undef PG8_WAIT_V
#undef PG8_WAIT_L
#undef PG8_BAR
#undef PG8_SCHED
}
}

using pg8::Unit;
constexpr size_t TSTEP = (size_t)256 * 1024 * 2;

struct SchedIn {
    const char* A; const char* B; int G, c;
    __device__ __forceinline__ bool next(int i, Unit& u) const {
        const int L = i * G + c; int pm, pn;
        if (L < 4096) { pg8::tile_map(L, 128, 32, pm, pn); }
        else { const int j = L - 4096; if (j >= 112) return false; pm = 128 + (j & 7); const int cj = j >> 3; pn = cj < 2 ? 2 + cj : (cj < 6 ? 4 + (cj - 2) : 16 + (cj - 6)); }
        u.A = A + (size_t)pm * TSTEP; u.B = B + (size_t)pn * TSTEP; u.row0 = pm * 256; u.pn = pn; u.aux = 0; u.aux2 = 0; return true;
    }
};
struct EpiIn {
    unsigned char* ws; const float* ropec; const float* ropes;
    __device__ __forceinline__ void operator()(const f32x4 (&acc)[2][2][4][2], const Unit& u, int wr, int wc, int fr, int fq) const {
        const int pn = u.pn, row0 = u.row0; const bool latent = row0 < TL;
        bf16_t* base; int ldc, col0, mode = 0; float sc = 1.f; int drow0 = row0;
        int kvrow0; if (latent) { const int b = row0 >> 12, t = row0 & 4095; kvrow0 = b * KVLEN + CTX + t; } else { const int cc = row0 - TL; kvrow0 = (cc >> 8) * KVLEN + (cc & 255); }
        if (pn < 2)       { base = (bf16_t*)(ws + WS_MQ); ldc = 512;  col0 = pn * 256;        sc = 0.08838834764831845f; }
        else if (pn < 4)  { base = (bf16_t*)(ws + WS_MK); ldc = 512;  col0 = (pn - 2) * 256; }
        else if (pn < 8)  { base = (bf16_t*)(ws + WS_MV); ldc = 1024; col0 = (pn - 4) * 256; }
        else if (pn < 12) { base = (bf16_t*)(ws + WS_MO); ldc = 1024; col0 = (pn - 8) * 256; }
        else if (pn < 16) { base = (bf16_t*)(ws + WS_DQ); ldc = 1024; col0 = (pn - 12) * 256; mode = 1; }
        else if (pn < 20) { base = (bf16_t*)(ws + WS_DK); ldc = 1024; col0 = (pn - 16) * 256; mode = latent ? 1 : 0; drow0 = kvrow0; }
        else if (pn < 24) { base = (bf16_t*)(ws + WS_DV); ldc = 1024; col0 = (pn - 20) * 256; drow0 = kvrow0; }
        else if (pn < 28) { base = (bf16_t*)(ws + WS_GA); ldc = 1024; col0 = (pn - 24) * 256; mode = 2; }
        else              { base = (bf16_t*)(ws + WS_GB); ldc = 1024; col0 = (pn - 28) * 256; mode = 2; }
        const bool permt = !(pn >= 12 && pn < 20);
        const int cl = col0 + wc * 32 + (permt ? 8 * fq : 4 * fq);
#pragma unroll
        for (int ai = 0; ai < 2; ++ai)
#pragma unroll
            for (int m = 0; m < 4; ++m) {
                const int rl = ai * 128 + wr * 64 + m * 16 + fr;
                bf16_t* rowp = base + (size_t)(drow0 + rl) * ldc + cl;
                f32x4 cs = {1.f, 1.f, 1.f, 1.f}, sn = {0.f, 0.f, 0.f, 0.f};
                if (mode == 1) { const int t = (row0 + rl) & 4095; const int pos = (wc & 1) ? (t & 63) : (t >> 6); cs = *(const f32x4*)(ropec + pos * 16 + 4 * fq); sn = *(const f32x4*)(ropes + pos * 16 + 4 * fq); }
#pragma unroll
                for (int bj = 0; bj < 2; ++bj) {
                    f32x4 v0 = acc[ai][bj][m][0], v1 = acc[ai][bj][m][1];
                    if (mode == 1) { const f32x4 a = v0 * cs - v1 * sn, b = v1 * cs + v0 * sn; v0 = a; v1 = b; }
                    else if (mode == 2) {
#pragma unroll
                        for (int i = 0; i < 4; ++i) { v0[i] = sigmoidf_(v0[i]); v1[i] = sigmoidf_(v1[i]); }
                    } else { v0 = v0 * sc; v1 = v1 * sc; }
                    u32x2 w0, w1; w0.x = cvt_pk_bf16(v0[0], v0[1]); w0.y = cvt_pk_bf16(v0[2], v0[3]); w1.x = cvt_pk_bf16(v1[0], v1[1]); w1.y = cvt_pk_bf16(v1[2], v1[3]);
                    if (permt) { u32x4 w; w.x = w0.x; w.y = w0.y; w.z = w1.x; w.w = w1.y; *(u32x4*)(rowp + bj * 128) = w; }
                    else { *(u32x2*)(rowp + bj * 128) = w0; *(u32x2*)(rowp + bj * 128 + 16) = w1; }
                }
            }
    }
};

struct SchedStatic {
    const char* A; const char* B; int nM, nN, G, c;
    __device__ __forceinline__ bool next(int i, Unit& u) const {
        const int L = i * G + c; if (L >= nM * nN) return false; int pm, pn; pg8::tile_map(L, nM, nN, pm, pn);
        u.A = A + (size_t)pm * TSTEP; u.B = B + (size_t)pn * TSTEP; u.row0 = pm * 256; u.pn = pn; u.aux = 0; u.aux2 = 0; return true;
    }
};
template <int MODE> struct EpiMerge {
    const bf16_t* gate; const bf16_t* tin; bf16_t* outp;
    __device__ __forceinline__ void operator()(const f32x4 (&acc)[2][2][4][2], const Unit& u, int wr, int wc, int fr, int fq) const {
        const int cl = u.pn * 256 + wc * 32 + 8 * fq;
#pragma unroll
        for (int ai = 0; ai < 2; ++ai)
#pragma unroll
            for (int m = 0; m < 4; ++m) {
                const size_t ro = (size_t)(u.row0 + ai * 128 + wr * 64 + m * 16 + fr) * 1024 + cl;
#pragma unroll
                for (int bj = 0; bj < 2; ++bj) {
                    const size_t o = ro + bj * 128;
                    const u32x4 g = *(const u32x4*)(gate + o);
                    f32x4 v0 = acc[ai][bj][m][0], v1 = acc[ai][bj][m][1];
                    v0[0] *= bf_lo(g.x); v0[1] *= bf_hi(g.x); v0[2] *= bf_lo(g.y); v0[3] *= bf_hi(g.y); v1[0] *= bf_lo(g.z); v1[1] *= bf_hi(g.z); v1[2] *= bf_lo(g.w); v1[3] *= bf_hi(g.w);
                    if (MODE == 1) { const u32x4 t = *(const u32x4*)(tin + o);
                        v0[0] += bf_lo(t.x); v0[1] += bf_hi(t.x); v0[2] += bf_lo(t.y); v0[3] += bf_hi(t.y); v1[0] += bf_lo(t.z); v1[1] += bf_hi(t.z); v1[2] += bf_lo(t.w); v1[3] += bf_hi(t.w); }
                    u32x4 w; w.x = cvt_pk_bf16(v0[0], v0[1]); w.y = cvt_pk_bf16(v0[2], v0[3]); w.z = cvt_pk_bf16(v1[0], v1[1]); w.w = cvt_pk_bf16(v1[2], v1[3]);
                    *(u32x4*)(outp + o) = w;
                }
            }
    }
};
struct EpiOut {
    const float* x; const float* mod; float* x1;
    __device__ __forceinline__ void operator()(const f32x4 (&acc)[2][2][4][2], const Unit& u, int wr, int wc, int fr, int fq) const {
        const int cl = u.pn * 256 + wc * 32 + 8 * fq; const float* g1 = mod + (size_t)(u.row0 >> 12) * 6144 + 2048;
#pragma unroll
        for (int bj = 0; bj < 2; ++bj)
#pragma unroll
            for (int n = 0; n < 2; ++n) {
                const f32x4 g = *(const f32x4*)(g1 + cl + bj * 128 + n * 4);
#pragma unroll
                for (int ai = 0; ai < 2; ++ai)
#pragma unroll
                    for (int m = 0; m < 4; ++m) {
                        const size_t o = (size_t)(u.row0 + ai * 128 + wr * 64 + m * 16 + fr) * 1024 + cl + bj * 128 + n * 4;
                        const f32x4 xv = *(const f32x4*)(x + o);
                        *(f32x4*)(x1 + o) = xv + g * acc[ai][bj][m][n];
                    }
            }
    }
};

struct SchedMoe1 {
    const char* U2; const char* W1; const int* list; const LAS int* tb; const LAS int* cnt; int G, c;
    __device__ __forceinline__ bool next(int i, Unit& u) const {
        const int L = i * G + c; const int xcd = L & 7, j = L >> 3; const int pn = j & 7, rt = (j >> 3) * 8 + xcd;
        const int NRT = tb[32];
        if (rt >= NRT) return false;
        int e = 0;
#pragma unroll 1
        for (int k = 1; k < 32; ++k) e = (tb[k] <= rt) ? k : e;
        u.A = U2; u.B = W1 + ((size_t)e * 2048 + (size_t)pn * 256) * 2048; u.row0 = rt * 256; u.pn = pn; u.aux = e; u.aux2 = (rt - tb[e]) * 256; return true;
    }
    __device__ __forceinline__ void offsets(const Unit& u, const int (&sR)[2], const int (&sC)[2], unsigned (&o0)[2], unsigned (&o1)[2]) const {
        const int e = u.aux < 0 ? 0 : u.aux; const int n = u.aux < 0 ? 0 : cnt[e] - u.aux2; const int* lp = list + (size_t)e * CAP + u.aux2;
#pragma unroll
        for (int i = 0; i < 2; ++i) {
            const int r0 = sR[i], r1 = 128 + sR[i];
            const int t0 = r0 < n ? lp[r0] : 0, t1 = r1 < n ? lp[r1] : 0;
            o0[i] = (unsigned)t0 * 2048u + (unsigned)sC[i] * 2u; o1[i] = (unsigned)t1 * 2048u + (unsigned)sC[i] * 2u;
        }
    }
};
struct EpiMoe1 {
    bf16_t* act; const float* b1;
    __device__ __forceinline__ void operator()(const f32x4 (&acc)[2][2][4][2], const Unit& u, int wr, int wc, int fr, int fq) const {
        if (u.aux < 0) return;
        const int cl = u.pn * 128 + wc * 32 + 8 * fq; const float* bb = b1 + (size_t)u.aux * 2048;
        f32x4 bg[2], bl[2];
#pragma unroll
        for (int n = 0; n < 2; ++n) { bg[n] = *(const f32x4*)(bb + cl + n * 4); bl[n] = *(const f32x4*)(bb + 1024 + cl + n * 4); }
#pragma unroll
        for (int ai = 0; ai < 2; ++ai)
#pragma unroll
            for (int m = 0; m < 4; ++m) {
                f32x4 a[2];
#pragma unroll
                for (int n = 0; n < 2; ++n) { const f32x4 g = acc[ai][0][m][n] + bg[n], l = acc[ai][1][m][n] + bl[n];
#pragma unroll
                    for (int i = 0; i < 4; ++i) { const float gg = fminf(g[i], 7.0f), ll = fminf(fmaxf(l[i], -7.0f), 7.0f); a[n][i] = gg * sigmoidf_(1.702f * gg) * (ll + 1.0f); } }
                u32x4 w; w.x = cvt_pk_bf16(a[0][0], a[0][1]); w.y = cvt_pk_bf16(a[0][2], a[0][3]); w.z = cvt_pk_bf16(a[1][0], a[1][1]); w.w = cvt_pk_bf16(a[1][2], a[1][3]);
                *(u32x4*)(act + (size_t)(u.row0 + ai * 128 + wr * 64 + m * 16 + fr) * 1024 + cl) = w;
            }
    }
};
struct SchedMoe2 {
    const char* ACT; const char* W2; const LAS int* tb; int G, c;
    __device__ __forceinline__ bool next(int i, Unit& u) const {
        const int L = i * G + c; const int xcd = L & 7, j = L >> 3; const int pn = j & 3, rt = (j >> 2) * 8 + xcd;
        const int NRT = tb[32];
        if (rt >= NRT) return false;
        int e = 0;
#pragma unroll 1
        for (int k = 1; k < 32; ++k) e = (tb[k] <= rt) ? k : e;
        u.A = ACT + (size_t)rt * TSTEP; u.B = W2 + ((size_t)e * 1024 + (size_t)pn * 256) * 2048; u.row0 = rt * 256; u.pn = pn; u.aux = e; u.aux2 = (rt - tb[e]) * 256; return true;
    }
};
struct EpiMoe2 {
    bf16_t* ys; const float* b2; const float* lgate; const LAS int* cnt;
    __device__ __forceinline__ void operator()(const f32x4 (&acc)[2][2][4][2], const Unit& u, int wr, int wc, int fr, int fq) const {
        if (u.aux < 0) return;
        const int cl = u.pn * 256 + wc * 32 + 8 * fq; const float* bb = b2 + (size_t)u.aux * 1024; const int n = cnt[u.aux] - u.aux2; const float* gp = lgate + (size_t)u.aux * CAP + u.aux2;
        f32x4 bv[2][2];
#pragma unroll
        for (int bj = 0; bj < 2; ++bj)
#pragma unroll
            for (int nn = 0; nn < 2; ++nn) bv[bj][nn] = *(const f32x4*)(bb + cl + bj * 128 + nn * 4);
#pragma unroll
        for (int ai = 0; ai < 2; ++ai)
#pragma unroll
            for (int m = 0; m < 4; ++m) {
                const int rl = ai * 128 + wr * 64 + m * 16 + fr; const float gw = rl < n ? gp[rl] : 0.f;
#pragma unroll
                for (int bj = 0; bj < 2; ++bj) {
                    const f32x4 v0 = (acc[ai][bj][m][0] + bv[bj][0]) * gw, v1 = (acc[ai][bj][m][1] + bv[bj][1]) * gw;
                    u32x4 w; w.x = cvt_pk_bf16(v0[0], v0[1]); w.y = cvt_pk_bf16(v0[2], v0[3]); w.z = cvt_pk_bf16(v1[0], v1[1]); w.w = cvt_pk_bf16(v1[2], v1[3]);
                    *(u32x4*)(ys + (size_t)(u.row0 + rl) * 1024 + cl + bj * 128) = w;
                }
            }
    }
};

namespace att {
constexpr int NW = 8, QBLK = 32, KVBLK = 64, LD = 1024;
constexpr float SCALE = 0.125f;
constexpr float THR = 8.f;
constexpr int SHM_V = KVBLK * 128 * 2, SHM_K = KVBLK * 128 * 2, SHM_ATTN = 2 * SHM_V + 2 * SHM_K + NW * 64 * 4;
#define KSWZ(row, colB) ((row) * 256 + ((colB) ^ (((row) & 7) << 4)))
#define SBAR() __builtin_amdgcn_sched_barrier(0)
__device__ __forceinline__ int crow(int r, int hi) { return (r & 3) + 8 * (r >> 2) + 4 * hi; }
__device__ __forceinline__ unsigned cvtpk(float lo, float hi) { return cvt_pk_bf16(lo, hi); }

__device__ __forceinline__ void partialSM(f32x16& p0, f32x16& p1, float& m_reg, float& mn, float& alpha) {
  constexpr float C = SCALE * 1.4426950408889634f;
  float pmax = p0[0];
#pragma unroll
  for (int r = 1; r < 16; ++r) pmax = fmaxf(pmax, p0[r]);
#pragma unroll
  for (int r = 0; r < 16; ++r) pmax = fmaxf(pmax, p1[r]);
  { auto rr = __builtin_amdgcn_permlane32_swap(__float_as_uint(pmax), __float_as_uint(pmax), false, false);
    pmax = fmaxf(__uint_as_float(rr[0]), __uint_as_float(rr[1])); }
  if (__builtin_expect(__all(pmax - m_reg <= THR / SCALE), 1)) { mn = m_reg; alpha = 1.f; }
  else { mn = fmaxf(m_reg, pmax); alpha = __builtin_amdgcn_exp2f((m_reg - mn) * C); m_reg = mn; }
  float mnC = -mn * C;
#pragma unroll
  for (int r = 0; r < 16; ++r) p0[r] = fmaf(p0[r], C, mnC);
#pragma unroll
  for (int r = 0; r < 16; ++r) p1[r] = fmaf(p1[r], C, mnC);
#pragma unroll
  for (int r = 0; r < 16; ++r) p0[r] = __builtin_amdgcn_exp2f(p0[r]);
}
__device__ __forceinline__ void finishSM(f32x16& p0, f32x16& p1, float alpha, float& l_reg, bf16x8& pa0, bf16x8& pa1, bf16x8& pa2, bf16x8& pa3) {
#pragma unroll
  for (int r = 0; r < 16; ++r) p1[r] = __builtin_amdgcn_exp2f(p1[r]);
  float ps = 0;
#pragma unroll
  for (int r = 0; r < 16; ++r) ps += p0[r];
#pragma unroll
  for (int r = 0; r < 16; ++r) ps += p1[r];
  { auto rr = __builtin_amdgcn_permlane32_swap(__float_as_uint(ps), __float_as_uint(ps), false, false);
    ps = __uint_as_float(rr[0]) + __uint_as_float(rr[1]); }
  l_reg = l_reg * alpha + ps;
#define PK4(P, BASE, OUT) do { unsigned a0 = cvtpk(P[BASE + 0], P[BASE + 1]), a1 = cvtpk(P[BASE + 2], P[BASE + 3]);   \
    unsigned b0 = cvtpk(P[BASE + 4], P[BASE + 5]), b1 = cvtpk(P[BASE + 6], P[BASE + 7]);                              \
    auto r0 = __builtin_amdgcn_permlane32_swap(a0, b0, false, false); auto r1 = __builtin_amdgcn_permlane32_swap(a1, b1, false, false); \
    u32x4 w = {r0[0], r1[0], r0[1], r1[1]}; OUT = *reinterpret_cast<bf16x8*>(&w); } while (0)
  PK4(p0, 0, pa0); PK4(p0, 8, pa1); PK4(p1, 0, pa2); PK4(p1, 8, pa3);
#undef PK4
}
__device__ __forceinline__ void qkt(f32x16& p0, f32x16& p1, const bf16_t* Ks, const bf16x8* qr, int r32, int hi, int mp) {
  p0 = f32x16{}; p1 = f32x16{};
#pragma unroll
  for (int d0 = 0; d0 < 4; ++d0) { int cb = (mp * 64 + d0 * 16 + hi * 8) * 2;
    bf16x8 b0 = *reinterpret_cast<const bf16x8*>((const char*)Ks + KSWZ(r32, cb));
    bf16x8 b1 = *reinterpret_cast<const bf16x8*>((const char*)Ks + KSWZ(32 + r32, cb));
    p0 = __builtin_amdgcn_mfma_f32_32x32x16_bf16(b0, qr[d0], p0, 0, 0, 0);
    p1 = __builtin_amdgcn_mfma_f32_32x32x16_bf16(b1, qr[d0], p1, 0, 0, 0); }
}
__device__ __forceinline__ int v_st(int k, int c) { const int kk = (k & ~0xC) | ((k & 4) << 1) | ((k & 8) >> 1); return ((kk >> 3) * 4 + (c >> 5)) * 512 + ((kk & 7) * 32 + (c & 31)) * 2; }
__device__ __forceinline__ int v_rd_base(int lane) { return ((lane & 3) << 3) | (((lane >> 2) & 3) << 6) | (((lane >> 4) & 1) << 5) | (((lane >> 5) & 1) << 8); }
constexpr int v_rd_off(int d0, int ks, int half) { return d0 * 512 + ks * 4096 + half * 2048; }
template <int OFF> __device__ __forceinline__ s16x4 tr_read(int vb) {
  s16x4 r; asm volatile("ds_read_b64_tr_b16 %0, %1 offset:%2" : "=&v"(r) : "v"(vb), "i"(OFF) : "memory"); return r;
}
template <int D0> __device__ __forceinline__ void pv_one(f32x16& od, int vb, bf16x8 pa0, bf16x8 pa1, bf16x8 pa2, bf16x8 pa3) {
  const s16x4 l0 = tr_read<v_rd_off(D0, 0, 0)>(vb), h0 = tr_read<v_rd_off(D0, 0, 1)>(vb), l1 = tr_read<v_rd_off(D0, 1, 0)>(vb), h1 = tr_read<v_rd_off(D0, 1, 1)>(vb);
  const s16x4 l2 = tr_read<v_rd_off(D0, 2, 0)>(vb), h2 = tr_read<v_rd_off(D0, 2, 1)>(vb), l3 = tr_read<v_rd_off(D0, 3, 0)>(vb), h3 = tr_read<v_rd_off(D0, 3, 1)>(vb);
  asm volatile("s_waitcnt lgkmcnt(0)" ::: "memory"); SBAR();
#define PK(L, H) (bf16x8){L[0], L[1], L[2], L[3], H[0], H[1], H[2], H[3]}
  od = __builtin_amdgcn_mfma_f32_32x32x16_bf16(pa0, PK(l0, h0), od, 0, 0, 0);
  od = __builtin_amdgcn_mfma_f32_32x32x16_bf16(pa1, PK(l1, h1), od, 0, 0, 0);
  od = __builtin_amdgcn_mfma_f32_32x32x16_bf16(pa2, PK(l2, h2), od, 0, 0, 0);
  od = __builtin_amdgcn_mfma_f32_32x32x16_bf16(pa3, PK(l3, h3), od, 0, 0, 0);
#undef PK
}
__device__ __forceinline__ void pv_d0(f32x16* o, int vb, bf16x8 pa0, bf16x8 pa1, bf16x8 pa2, bf16x8 pa3) {
  pv_one<0>(o[0], vb, pa0, pa1, pa2, pa3); pv_one<1>(o[1], vb, pa0, pa1, pa2, pa3); pv_one<2>(o[2], vb, pa0, pa1, pa2, pa3); pv_one<3>(o[3], vb, pa0, pa1, pa2, pa3);
}

__device__ __forceinline__ void attn_unit(const bf16_t* __restrict__ Qb, const bf16_t* __restrict__ Kh, const bf16_t* __restrict__ Vh, bf16_t* __restrict__ Ob,
                                          const float* __restrict__ gd, float lam, int seq, char* lds) {
  const int tid = otid(), wid = tid >> 6, lane = tid & 63, r32 = lane & 31, hi = lane >> 5;
  const int qw = wid & 3, mp = wid >> 2;
  bf16_t* V_lds = (bf16_t*)lds; bf16_t* K_lds = (bf16_t*)(lds + 2 * SHM_V);
  float* wsf = (float*)(lds + 2 * SHM_V + 2 * SHM_K) + wid * 64; float* li_l = wsf; float* al_l = wsf + 32;
  float m_reg = -1e30f, l_reg = 0; f32x16 o[4] = {}; bf16x8 qr[4];
  const bf16_t* Qw = Qb + (long)(qw * QBLK + r32) * LD + mp * 64 + hi * 8;
#pragma unroll
  for (int d0 = 0; d0 < 4; ++d0) qr[d0] = *reinterpret_cast<const bf16x8*>(Qw + d0 * 16);
  const int sr = tid >> 4, sc = (tid & 15) * 8, vst0 = v_st(sr, sc), vst1 = v_st(32 + sr, sc);
  const int vb0 = (int)(uintptr_t)V_lds + v_rd_base(lane);
  struct { bf16x8 vs0, vs1, ks0, ks1; } sr_[2];
#define SLOAD(i, k0) do { sr_[i].vs0 = *reinterpret_cast<const bf16x8*>(&Vh[(long)((k0) + sr) * LD + sc]); sr_[i].vs1 = *reinterpret_cast<const bf16x8*>(&Vh[(long)((k0) + 32 + sr) * LD + sc]); \
    sr_[i].ks0 = *reinterpret_cast<const bf16x8*>(&Kh[(long)((k0) + sr) * LD + sc]); sr_[i].ks1 = *reinterpret_cast<const bf16x8*>(&Kh[(long)((k0) + 32 + sr) * LD + sc]); } while (0)
#define SWRITE(b, i) do { *(bf16x8*)((char*)V_lds + (b) * SHM_V + vst0) = sr_[i].vs0;          \
    *(bf16x8*)((char*)V_lds + (b) * SHM_V + vst1) = sr_[i].vs1; int kc = sc * 2;               \
    *(bf16x8*)((char*)K_lds + (b) * SHM_K + KSWZ(sr, kc)) = sr_[i].ks0;                       \
    *(bf16x8*)((char*)K_lds + (b) * SHM_K + KSWZ(32 + sr, kc)) = sr_[i].ks1; } while (0)
#define SWAIT() asm volatile("s_waitcnt vmcnt(4)" ::: "memory")
#define RESC(a) do { if (__any((a) < 1.f)) { if (hi == 0) al_l[r32] = (a); asm volatile("s_waitcnt lgkmcnt(0)" ::: "memory"); \
    _Pragma("unroll") for (int d = 0; d < 4; ++d) _Pragma("unroll") for (int r = 0; r < 16; ++r) o[d][r] *= al_l[crow(r, hi)]; } } while (0)
  f32x16 pA0, pA1, pB0, pB1; float mnA, mnB, alA, alB; bf16x8 pa0, pa1, pa2, pa3; const int NT = seq / KVBLK;
  constexpr int SE = 0, SO = 1;
  SLOAD(SE, 0); asm volatile("s_waitcnt vmcnt(0)" ::: "memory"); SWRITE(0, SE); __syncthreads();
  qkt(pA0, pA1, K_lds, qr, r32, hi, mp); partialSM(pA0, pA1, m_reg, mnA, alA);
  SLOAD(SO, KVBLK); if (2 < NT) SLOAD(SE, 2 * KVBLK);
  SWAIT(); SWRITE(1, SO); __syncthreads();
  for (int j = 1; j + 1 < NT; j += 2) {
    SBAR(); qkt(pB0, pB1, (bf16_t*)((char*)K_lds + SHM_K), qr, r32, hi, mp);
    finishSM(pA0, pA1, alA, l_reg, pa0, pa1, pa2, pa3); SBAR();
    SLOAD(SO, (j + 2) * KVBLK); SBAR();
    pv_d0(o, vb0, pa0, pa1, pa2, pa3); partialSM(pB0, pB1, m_reg, mnB, alB);
    __syncthreads(); SWAIT(); SWRITE(0, SE);
    RESC(alB); __syncthreads();
    SBAR(); qkt(pA0, pA1, K_lds, qr, r32, hi, mp);
    finishSM(pB0, pB1, alB, l_reg, pa0, pa1, pa2, pa3); SBAR();
    if (j + 3 < NT) SLOAD(SE, (j + 3) * KVBLK); SBAR();
    pv_d0(o, vb0 + (int)SHM_V, pa0, pa1, pa2, pa3); partialSM(pA0, pA1, m_reg, mnA, alA);
    __syncthreads(); SWAIT(); SWRITE(1, SO);
    RESC(alA); __syncthreads();
  }
  SBAR(); qkt(pB0, pB1, (bf16_t*)((char*)K_lds + SHM_K), qr, r32, hi, mp);
  finishSM(pA0, pA1, alA, l_reg, pa0, pa1, pa2, pa3); SBAR();
  pv_d0(o, vb0, pa0, pa1, pa2, pa3); partialSM(pB0, pB1, m_reg, mnB, alB);
  __syncthreads(); RESC(alB);
  finishSM(pB0, pB1, alB, l_reg, pa0, pa1, pa2, pa3); SBAR();
  pv_d0(o, vb0 + (int)SHM_V, pa0, pa1, pa2, pa3);
  if (hi == 0) li_l[r32] = l_reg; asm volatile("s_waitcnt lgkmcnt(0)" ::: "memory");
  float rli[16];
#pragma unroll
  for (int r = 0; r < 16; ++r) rli[r] = __builtin_amdgcn_rcpf(li_l[crow(r, hi)]);
  __syncthreads();
  float* xch = (float*)lds + qw * 4096 + lane;
  if (mp == 1) {
#pragma unroll
    for (int r = 0; r < 16; ++r)
#pragma unroll
      for (int d0 = 0; d0 < 4; ++d0) xch[(r * 4 + d0) * 64] = o[d0][r] * rli[r] * lam;
  }
  __syncthreads();
  if (mp == 0) {
    float gv[4];
#pragma unroll
    for (int d0 = 0; d0 < 4; ++d0) gv[d0] = gd[d0 * 32 + r32] * (1.0f - LAM_INIT);
#pragma unroll
    for (int r = 0; r < 16; ++r) {
      float dv[4]; float ss = 0.f;
#pragma unroll
      for (int d0 = 0; d0 < 4; ++d0) { dv[d0] = o[d0][r] * rli[r] - xch[(r * 4 + d0) * 64]; ss += dv[d0] * dv[d0]; }
      ss += __shfl_xor(ss, 1); ss += __shfl_xor(ss, 2); ss += __shfl_xor(ss, 4); ss += __shfl_xor(ss, 8); ss += __shfl_xor(ss, 16);
      const float rstd = rsqrtf(ss * (1.0f / 128.0f) + EPS);
      bf16_t* orow = Ob + (long)(qw * QBLK + crow(r, hi)) * LD + r32;
#pragma unroll
      for (int d0 = 0; d0 < 4; ++d0) orow[d0 * 32] = (bf16_t)(cvtpk(dv[d0] * rstd * gv[d0], 0.f) & 0xffffu);
    }
  }
  __syncthreads();
#undef SLOAD
#undef SWRITE
#undef SWAIT
#undef RESC
}
#undef KSWZ
#undef SBAR
}

__device__ __forceinline__ float log_sigmoidf_(float x) { return x >= 0.f ? -log1pf(__expf(-x)) : x - log1pf(__expf(x)); }

__device__ __forceinline__ int perm32(int rho) { const int n = rho >> 4, i = rho & 15; return 8 * (i >> 2) + 4 * n + (i & 3); }
__device__ __forceinline__ void transpose_item(const float* __restrict__ W, int ldw, int scol0, bf16_t* WTrow0, int k0, LAS float* scr, int lane, bool perm) {
#pragma unroll 8
    for (int i = 0; i < 32; ++i) { const int kk = 2 * i + (lane >> 5); scr[kk * 33 + (lane & 31)] = W[(size_t)(k0 + kk) * ldw + scol0 + (lane & 31)]; }
    LDS_WAIT(); asm volatile("" ::: "memory");
    const int c = lane & 7;
#pragma unroll
    for (int j = 0; j < 4; ++j) { const int n = (lane >> 3) + 8 * j; const LAS float* s = scr + (8 * c) * 33 + (perm ? perm32(n) : n);
        u32x4 o; o.x = cvt_pk_bf16(s[0 * 33], s[1 * 33]); o.y = cvt_pk_bf16(s[2 * 33], s[3 * 33]); o.z = cvt_pk_bf16(s[4 * 33], s[5 * 33]); o.w = cvt_pk_bf16(s[6 * 33], s[7 * 33]);
        *(u32x4*)(WTrow0 + (size_t)n * 1024 + k0 + 8 * c) = o; }
    LDS_WAIT(); asm volatile("" ::: "memory");
}

__device__ __forceinline__ void phase_prep(const Params& p, LAS unsigned char* lds, int G) {
    const int tid = otid(), lane = tid & 63, wave = __builtin_amdgcn_readfirstlane(tid >> 6);
    const int gw = blockIdx.x * 8 + wave, NGW = G * 8;
    LAS float* sl = (LAS float*)(lds + 73728);
    for (int i = tid; i < 9 * 1024; i += NTHREADS) { const float v = i < 8192 ? p.c[i] : p.c_ctx[i - 8192]; sl[i] = v / (1.0f + __expf(-v)); }
    __syncthreads();
    float* mod = (float*)(p.ws + WS_MOD);
    if (gw < 384) {
        const int c0 = gw * 16, col = lane & 15, kq = lane >> 4;
        float acc[9];
#pragma unroll
        for (int v = 0; v < 9; ++v) acc[v] = 0.f;
        const float* wp = p.ada_w + (size_t)(kq * 256) * 6144 + c0 + col;
#pragma unroll 8
        for (int i = 0; i < 256; ++i) { const float w = wp[(size_t)i * 6144];
#pragma unroll
            for (int v = 0; v < 9; ++v) acc[v] += sl[v * 1024 + kq * 256 + i] * w; }
#pragma unroll
        for (int v = 0; v < 9; ++v) { acc[v] += __shfl_xor(acc[v], 16); acc[v] += __shfl_xor(acc[v], 32); }
        if (lane < 16) { const float b = p.ada_b[c0 + col];
#pragma unroll
            for (int v = 0; v < 9; ++v) mod[v * 6144 + c0 + col] = acc[v] + b; }
    }
    if (blockIdx.x == 0 && wave == 0) {
        const float s01 = wave_sum(p.dlam[lane] * p.dlam[64 + lane]), s23 = wave_sum(p.dlam[128 + lane] * p.dlam[192 + lane]);
        if (lane == 0) *(float*)(p.ws + WS_LAM) = expf(s01) - expf(s23) + LAM_INIT;
    }
    if (blockIdx.x == 1 && wave == 0 && lane < 16) {
        double th = 1.0; for (int j = 0; j < lane; ++j) th *= 0.5623413251903491;
        double ct = 1.0, st = th, term_c = 1.0, term_s = th; const double t2 = th * th;
        for (int n = 1; n < 14; ++n) { term_c *= -t2 / ((2.0 * n - 1.0) * (2.0 * n)); term_s *= -t2 / ((2.0 * n) * (2.0 * n + 1.0)); ct += term_c; st += term_s; }
        float* rc = (float*)(p.ws + WS_ROPE); float* rs = rc + 1024;
        double cc = 1.0, ss = 0.0;
        for (int pos = 0; pos < 64; ++pos) { rc[pos * 16 + lane] = (float)cc; rs[pos * 16 + lane] = (float)ss; const double c2 = cc * ct - ss * st, s2 = ss * ct + cc * st; cc = c2; ss = s2; }
    }
    LAS float* scr = (LAS float*)(lds + wave * 8448);
    bf16_t* WIN = (bf16_t*)(p.ws + WS_WIN);
    constexpr int I_IN = 16 * 256, I_SQ = 16 * 32, I_W1 = 32 * 16 * 64, I_W2 = 32 * 16 * 32, NITEMS = I_IN + 3 * I_SQ + I_W1 + I_W2;
    for (int it = gw; it < NITEMS; it += NGW) {
        int r = it;
        if (r < I_IN) { const int kb = r >> 8, nb = r & 255, n0 = nb * 32; transpose_item(p.w_in, INCOLS, n0 < 2048 ? n0 : n0 + 16, WIN + (size_t)n0 * 1024, kb * 64, scr, lane, !(n0 >= 3072 && n0 < 5120)); continue; } r -= I_IN;
        if (r < 3 * I_SQ) { const int w = r / I_SQ, r2 = r % I_SQ, kb = r2 >> 5, nb = r2 & 31; const float* W = w == 0 ? p.w_a : (w == 1 ? p.w_b : p.w_o);
            bf16_t* WT = (bf16_t*)(p.ws + (w == 0 ? WS_WA : (w == 1 ? WS_WB : WS_WO))); transpose_item(W, 1024, nb * 32, WT + (size_t)nb * 32 * 1024, kb * 64, scr, lane, true); continue; } r -= 3 * I_SQ;
        if (r < I_W1) { const int e = r >> 10, r2 = r & 1023, kb = r2 >> 6, g = r2 & 63, pn = g >> 3, bj = (g >> 2) & 1, q = g & 3;
            transpose_item(p.exp_w1 + (size_t)e * 1024 * 2048, 2048, bj * 1024 + 128 * pn + 32 * q, (bf16_t*)(p.ws + WS_W1) + ((size_t)e * 2048 + 32 * g) * 1024, kb * 64, scr, lane, true); continue; } r -= I_W1;
        { const int e = r >> 9, r2 = r & 511, kb = r2 >> 5, nb = r2 & 31;
            transpose_item(p.exp_w2 + (size_t)e * 1024 * 1024, 1024, nb * 32, (bf16_t*)(p.ws + WS_W2) + ((size_t)e * 1024 + 32 * nb) * 1024, kb * 64, scr, lane, true); }
    }
}

__device__ __forceinline__ void phase_rows1(const Params& p, LAS unsigned char* lds, int G) {
    const int tid = otid(), lane = tid & 63, wave = __builtin_amdgcn_readfirstlane(tid >> 6);
    const int gw = blockIdx.x * 8 + wave, NGW = G * 8;
    LAS float* wg = (LAS float*)lds;
    for (int i = tid; i < 16 * 1024; i += NTHREADS) { const int k = i >> 4, g = i & 15; wg[g * 1024 + k] = p.w_in[(size_t)k * INCOLS + 2048 + g]; }
    __syncthreads();
    const float* mod = (const float*)(p.ws + WS_MOD); bf16_t* U = (bf16_t*)(p.ws + WS_U); float* GT = (float*)(p.ws + WS_GT);
    f32x4 gn[4];
#pragma unroll
    for (int j = 0; j < 4; ++j) gn[j] = *(const f32x4*)(p.norm1_g + 4 * lane + 256 * j);
    for (int m = gw; m < TT; m += NGW) {
        const float* xr = m < TL ? p.x + (size_t)m * 1024 : p.ctx + (size_t)(m - TL) * 1024;
        const float* md = mod + (size_t)(m < TL ? (m >> 12) : 8) * 6144;
        f32x4 v[4]; float ss = 0.f;
#pragma unroll
        for (int j = 0; j < 4; ++j) { v[j] = *(const f32x4*)(xr + 4 * lane + 256 * j); ss += (v[j][0] * v[j][0] + v[j][1] * v[j][1]) + (v[j][2] * v[j][2] + v[j][3] * v[j][3]); }
        const float rstd = rsqrtf(wave_sum(ss) * (1.0f / 1024.0f) + EPS);
#pragma unroll
        for (int j = 0; j < 4; ++j) { const f32x4 sh = *(const f32x4*)(md + 4 * lane + 256 * j), sc = *(const f32x4*)(md + 1024 + 4 * lane + 256 * j);
            v[j] = (v[j] * rstd * gn[j]) * (sc + 1.0f) + sh;
            u32x2 w; w.x = cvt_pk_bf16(v[j][0], v[j][1]); w.y = cvt_pk_bf16(v[j][2], v[j][3]); *(u32x2*)(U + (size_t)m * 1024 + 4 * lane + 256 * j) = w; }
        float val = 0.f;
#pragma unroll
        for (int g = 0; g < 16; ++g) { float a = 0.f;
#pragma unroll
            for (int j = 0; j < 4; ++j) { const f32x4 w = *(const LAS f32x4*)(wg + g * 1024 + 4 * lane + 256 * j); a += (v[j][0] * w[0] + v[j][1] * w[1]) + (v[j][2] * w[2] + v[j][3] * w[3]); }
            a = wave_sum(a); val = (lane == g) ? a : val; asm volatile("" ::: "memory"); }
        if (lane < 16) {
            val += p.gate_b[lane]; const int type = lane >> 2; if (type & 1) val = log_sigmoidf_(val);
            GT[(size_t)m * 16 + lane] = val; }
    }
}

__device__ __forceinline__ void phase_mlstm_naive(const Params& p, LAS unsigned char* lds_, int item) {
    const int tid = otid(); float* lds = (float*)(unsigned char*)lds_;
    const int dvh = item & 1, dir = (item >> 1) & 1, h = (item >> 2) & 3, b = item >> 4;
    const int dvl = tid >> 2, kq = tid & 3;
    float* Ks = lds; float* Qs = lds + 4096; float* Vs = lds + 8192; float* gi = lds + 12288; float* gf = gi + 32;
    const bf16_t* MQ = (const bf16_t*)(p.ws + WS_MQ); const bf16_t* MK = (const bf16_t*)(p.ws + WS_MK); const bf16_t* MV = (const bf16_t*)(p.ws + WS_MV);
    const float* GT = (const float*)(p.ws + WS_GT); bf16_t* H = (bf16_t*)(p.ws + (dir ? WS_HB : WS_HF));
    float C[32], nn[32];
#pragma unroll
    for (int r = 0; r < 32; ++r) { C[r] = 0.f; nn[r] = 0.f; }
    for (int s0 = 0; s0 < KVLEN; s0 += 32) {
        const bool latent = s0 >= CTX;
        __syncthreads();
        {
            const int j = tid >> 4, c8 = (tid & 15) * 8; const int s = s0 + j;
            const int m = latent ? b * SEQ + (dir ? SEQ - 1 - (s - CTX) : s - CTX) : TL + b * CTX + (dir ? CTX - 1 - s : s);
            const bf16x8 kv = *(const bf16x8*)(MK + (size_t)m * 512 + h * 128 + c8);
            const bf16x8 vv = *(const bf16x8*)(MV + (size_t)m * 1024 + h * 256 + dvh * 128 + c8);
#pragma unroll
            for (int i = 0; i < 8; ++i) { Ks[j * 128 + c8 + i] = bf2f((bf16_t)kv[i]); Vs[j * 128 + c8 + i] = bf2f((bf16_t)vv[i]); }
            if (latent) { const bf16x8 qv = *(const bf16x8*)(MQ + (size_t)m * 512 + h * 128 + c8);
#pragma unroll
                for (int i = 0; i < 8; ++i) Qs[j * 128 + c8 + i] = bf2f((bf16_t)qv[i]); }
            if ((tid & 15) == 0) { gi[j] = GT[(size_t)m * 16 + dir * 8 + h]; gf[j] = GT[(size_t)m * 16 + dir * 8 + 4 + h]; }
        }
        __syncthreads();
        for (int j = 0; j < 32; ++j) {
            const float f = __expf(gf[j]), ig = __expf(gi[j]); const float v = Vs[j * 128 + dvl];
            float num = 0.f, den = 0.f;
            const f32x4* kp = (const f32x4*)(Ks + j * 128 + kq * 32); const f32x4* qp = (const f32x4*)(Qs + j * 128 + kq * 32);
#pragma unroll
            for (int r4 = 0; r4 < 8; ++r4) { const f32x4 k4 = kp[r4]; f32x4 q4 = {0.f, 0.f, 0.f, 0.f}; if (latent) q4 = qp[r4];
#pragma unroll
                for (int i = 0; i < 4; ++i) { const int r = r4 * 4 + i; const float ik = ig * k4[i]; C[r] = f * C[r] + ik * v; nn[r] = f * nn[r] + ik; num += q4[i] * C[r]; den += q4[i] * nn[r]; } }
            if (latent) {
                num += __shfl_xor(num, 1); num += __shfl_xor(num, 2); den += __shfl_xor(den, 1); den += __shfl_xor(den, 2);
                if (kq == 0) { const int s = s0 + j; const int m = b * SEQ + (dir ? SEQ - 1 - (s - CTX) : s - CTX);
                    const float hv = num / fmaxf(fabsf(den), 1.0f);
                    H[(size_t)m * 1024 + h * 256 + dvh * 128 + dvl] = (bf16_t)(cvt_pk_bf16(hv, 0.f) & 0xffffu); }
            }
        }
    }
    __syncthreads();
}

namespace mls {
#define KSWZ(row, colB) ((row) * 256 + ((colB) ^ (((row) & 7) << 4)))
#define SBAR() __builtin_amdgcn_sched_barrier(0)
using att::crow; using att::cvtpk; using att::v_st; using att::v_rd_base; using att::v_rd_off; using att::tr_read;
constexpr int L_KSW = 0, L_KV = 32768, L_V = 65536, L_CT = 98304, L_F = 114688;
__device__ __forceinline__ float swap_add(float v) { auto rr = __builtin_amdgcn_permlane32_swap(__float_as_uint(v), __float_as_uint(v), false, false); return __uint_as_float(rr[0]) + __uint_as_float(rr[1]); }
#define TRPK(L, H) (bf16x8){L[0], L[1], L[2], L[3], H[0], H[1], H[2], H[3]}
__device__ __forceinline__ void mlstm_item(const Params& p, LAS unsigned char* lds_, int item) {
    char* lds = (char*)(unsigned char*)lds_;
    const int tid = otid(), wid = __builtin_amdgcn_readfirstlane(tid >> 6), lane = tid & 63, r32 = lane & 31, hi = lane >> 5;
    const int dvq = item & 3, dir = (item >> 2) & 1, h = (item >> 3) & 3, b = item >> 5;
    const int rb = wid & 3, vh = wid >> 2;
    float* fa = (float*)(lds + L_F); float* a_ = fa; float* bco = fa + 128; float* w_ = fa + 256; float* wint = fa + 384; float* nvec = fa + 512; float* npart = fa + 640; float* denl = fa + 1152 + wid * 32; float* gsc = fa + 1408;
    const bf16_t* MQ = (const bf16_t*)(p.ws + WS_MQ); const bf16_t* MK = (const bf16_t*)(p.ws + WS_MK); const bf16_t* MV = (const bf16_t*)(p.ws + WS_MV);
    const float* GT = (const float*)(p.ws + WS_GT); bf16_t* H = (bf16_t*)(p.ws + (dir ? WS_HB : WS_HF));
    f32x16 Cacc = {};
    { u32x4 z = {0u, 0u, 0u, 0u}; *(u32x4*)(lds + L_CT + tid * 32) = z; *(u32x4*)(lds + L_CT + tid * 32 + 16) = z; if (tid < 128) nvec[tid] = 0.f; }
    const int tid_outer = tid;
    bf16x8 kreg[4], vreg[2], qnx[8]; float gi0 = 0.f, glf0 = 0.f, gi1 = 0.f, glf1 = 0.f;
#define MROW0(cc_) ((cc_) >= 2 ? b * SEQ + (dir ? 33 - (cc_) : (cc_) - 2) * 128 : TL + b * CTX + (dir ? 1 - (cc_) : (cc_)) * 128)
#define LOADS(cn_, T_) do { const int mr_ = MROW0(cn_); const int ln_ = (T_) & 63; \
        _Pragma("unroll") for (int i = 0; i < 4; ++i) { const int pc = (T_) + 512 * i, pr = pc >> 4, c8 = (pc & 15) * 8; kreg[i] = *(const bf16x8*)(MK + (size_t)(mr_ + (dir ? 127 - pr : pr)) * 512 + h * 128 + c8); } \
        _Pragma("unroll") for (int i = 0; i < 2; ++i) { const int pc = (T_) + 512 * i, pr = pc >> 3, c8 = (pc & 7) * 8; vreg[i] = *(const bf16x8*)(MV + (size_t)(mr_ + (dir ? 127 - pr : pr)) * 1024 + h * 256 + dvq * 64 + c8); } \
        if ((cn_) >= 2) { const int pr = rb * 32 + (ln_ & 31); const bf16_t* qp = MQ + (size_t)(mr_ + (dir ? 127 - pr : pr)) * 512 + h * 128 + (ln_ >> 5) * 8; \
            _Pragma("unroll") for (int d0 = 0; d0 < 8; ++d0) qnx[d0] = *(const bf16x8*)(qp + d0 * 16); } \
        else { _Pragma("unroll") for (int d0 = 0; d0 < 8; ++d0) qnx[d0] = bf16x8{}; } \
        if (wid == 0) { const int p0 = 2 * ln_, p1 = 2 * ln_ + 1; const size_t m0 = (size_t)(mr_ + (dir ? 127 - p0 : p0)) * 16, m1 = (size_t)(mr_ + (dir ? 127 - p1 : p1)) * 16; \
            gi0 = GT[m0 + dir * 8 + h]; glf0 = GT[m0 + dir * 8 + 4 + h]; gi1 = GT[m1 + dir * 8 + h]; glf1 = GT[m1 + dir * 8 + 4 + h]; } } while (0)
    LOADS(0, tid_outer);
    for (int c = 0; c < 34; ++c) {
        int tid = tid_outer; asm volatile("" : "+v"(tid));
        const int lane = tid & 63, r32 = lane & 31, hi = lane >> 5;
        const int vbV = (int)(uintptr_t)(lds + L_V) + v_rd_base(lane), vbK = (int)(uintptr_t)(lds + L_KV) + v_rd_base(lane);
        const bool latent = c >= 2;
        const int mrow0 = MROW0(c);
        bf16x8 qr[8];
        if (wid == 0) {
            const int p0 = 2 * lane, p1 = 2 * lane + 1;
            const float i0 = gi0, lf0 = glf0, i1 = gi1, lf1 = glf1;
            float incl = lf0 + lf1;
#pragma unroll
            for (int o = 1; o < 64; o <<= 1) { const float t = __shfl_up(incl, o); if (lane >= o) incl += t; }
            const float F1 = incl, F0 = incl - lf1, Ftot = __shfl(incl, 63);
            a_[p0] = F0; a_[p1] = F1; bco[p0] = i0 - F0; bco[p1] = i1 - F1; wint[p0] = __expf(F0); wint[p1] = __expf(F1);
            w_[p0] = __expf(Ftot - F0 + i0); w_[p1] = __expf(Ftot - F1 + i1); if (lane == 0) gsc[0] = __expf(Ftot);
        }
        __syncthreads();
#pragma unroll
        for (int i = 0; i < 4; ++i) { const int pc = tid + 512 * i, pr = pc >> 4, c8 = (pc & 15) * 8;
            *(bf16x8*)(lds + L_KSW + KSWZ(pr, c8 * 2)) = kreg[i]; *(bf16x8*)(lds + L_KV + (pr >> 6) * 16384 + v_st(pr & 63, c8)) = kreg[i]; }
#pragma unroll
        for (int i = 0; i < 2; ++i) { const int pc = tid + 512 * i, pr = pc >> 3, c8 = (pc & 7) * 8; const float ws_ = w_[pr];
            *(bf16x8*)(lds + L_V + (pr >> 6) * 16384 + v_st(pr & 63, c8)) = vreg[i];
            u32x4 sv; const u32x4 raw = *reinterpret_cast<const u32x4*>(&vreg[i]);
            sv.x = cvtpk(bf_lo(raw.x) * ws_, bf_hi(raw.x) * ws_); sv.y = cvtpk(bf_lo(raw.y) * ws_, bf_hi(raw.y) * ws_); sv.z = cvtpk(bf_lo(raw.z) * ws_, bf_hi(raw.z) * ws_); sv.w = cvtpk(bf_lo(raw.w) * ws_, bf_hi(raw.w) * ws_);
            *(u32x4*)(lds + L_V + (pr >> 6) * 16384 + v_st(pr & 63, 64 + c8)) = sv; }
#pragma unroll
        for (int d0 = 0; d0 < 8; ++d0) qr[d0] = qnx[d0];
        __syncthreads();
        if (c + 1 < 34) LOADS(c + 1, tid);
        const float g = gsc[0];
        if (latent) {
            const int qidx = rb * 32 + r32;
            float qn = 0.f;
#pragma unroll
            for (int d0 = 0; d0 < 8; ++d0) { const f32x4 n0 = *(const f32x4*)(nvec + d0 * 16 + hi * 8), n1 = *(const f32x4*)(nvec + d0 * 16 + hi * 8 + 4); const u32x4 q4 = *reinterpret_cast<const u32x4*>(&qr[d0]);
                qn += bf_lo(q4.x) * n0[0] + bf_hi(q4.x) * n0[1] + bf_lo(q4.y) * n0[2] + bf_hi(q4.y) * n0[3] + bf_lo(q4.z) * n1[0] + bf_hi(q4.z) * n1[1] + bf_lo(q4.w) * n1[2] + bf_hi(q4.w) * n1[3]; }
            qn = swap_add(qn);
            f32x16 o = {};
#pragma unroll
            for (int d0 = 0; d0 < 8; ++d0) { const bf16x8 cf = *(const bf16x8*)(lds + L_CT + KSWZ(32 * vh + r32, (d0 * 16 + hi * 8) * 2)); o = __builtin_amdgcn_mfma_f32_32x32x16_bf16(qr[d0], cf, o, 0, 0, 0); }
#pragma unroll
            for (int g4 = 0; g4 < 4; ++g4) { const f32x4 wi = *(const f32x4*)(wint + rb * 32 + 8 * g4 + 4 * hi);
#pragma unroll
                for (int i = 0; i < 4; ++i) o[g4 * 4 + i] *= wi[i]; }
            const float aq = a_[qidx]; float den = 0.f;
            for (int jt = 0; jt <= (rb >> 1); ++jt) {
                f32x16 p0 = {}, p1 = {};
#pragma unroll
                for (int d0 = 0; d0 < 8; ++d0) { const int cbb = (d0 * 16 + hi * 8) * 2;
                    const bf16x8 b0 = *(const bf16x8*)(lds + L_KSW + KSWZ(64 * jt + r32, cbb)), b1 = *(const bf16x8*)(lds + L_KSW + KSWZ(64 * jt + 32 + r32, cbb));
                    p0 = __builtin_amdgcn_mfma_f32_32x32x16_bf16(b0, qr[d0], p0, 0, 0, 0); p1 = __builtin_amdgcn_mfma_f32_32x32x16_bf16(b1, qr[d0], p1, 0, 0, 0); }
                float ps = 0.f;
#pragma unroll
                for (int g4 = 0; g4 < 4; ++g4) { const int k0 = 64 * jt + 8 * g4 + 4 * hi; const f32x4 bb0 = *(const f32x4*)(bco + k0), bb1 = *(const f32x4*)(bco + k0 + 32);
#pragma unroll
                    for (int i = 0; i < 4; ++i) { const int r = g4 * 4 + i;
                        const float e0 = __expf(aq + bb0[i]), e1 = __expf(aq + bb1[i]);
                        p0[r] = (k0 + i <= qidx) ? p0[r] * e0 : 0.f; p1[r] = (k0 + 32 + i <= qidx) ? p1[r] * e1 : 0.f; ps += p0[r] + p1[r]; } }
                den += swap_add(ps);
                bf16x8 pa0, pa1, pa2, pa3;
#define PK4(P, BASE, OUT) do { unsigned a0 = cvtpk(P[BASE + 0], P[BASE + 1]), a1 = cvtpk(P[BASE + 2], P[BASE + 3]);   \
    unsigned b0_ = cvtpk(P[BASE + 4], P[BASE + 5]), b1_ = cvtpk(P[BASE + 6], P[BASE + 7]);                              \
    auto r0 = __builtin_amdgcn_permlane32_swap(a0, b0_, false, false); auto r1 = __builtin_amdgcn_permlane32_swap(a1, b1_, false, false); \
    u32x4 w4 = {r0[0], r1[0], r0[1], r1[1]}; OUT = *reinterpret_cast<bf16x8*>(&w4); } while (0)
                PK4(p0, 0, pa0); PK4(p0, 8, pa1); PK4(p1, 0, pa2); PK4(p1, 8, pa3);
#undef PK4
                const int vb = vbV + jt * 16384 + vh * 512;
                const s16x4 l0 = tr_read<v_rd_off(0, 0, 0)>(vb), h0 = tr_read<v_rd_off(0, 0, 1)>(vb), l1 = tr_read<v_rd_off(0, 1, 0)>(vb), h1 = tr_read<v_rd_off(0, 1, 1)>(vb);
                const s16x4 l2 = tr_read<v_rd_off(0, 2, 0)>(vb), h2 = tr_read<v_rd_off(0, 2, 1)>(vb), l3 = tr_read<v_rd_off(0, 3, 0)>(vb), h3 = tr_read<v_rd_off(0, 3, 1)>(vb);
                asm volatile("s_waitcnt lgkmcnt(0)" ::: "memory"); SBAR();
                o = __builtin_amdgcn_mfma_f32_32x32x16_bf16(pa0, TRPK(l0, h0), o, 0, 0, 0); o = __builtin_amdgcn_mfma_f32_32x32x16_bf16(pa1, TRPK(l1, h1), o, 0, 0, 0);
                o = __builtin_amdgcn_mfma_f32_32x32x16_bf16(pa2, TRPK(l2, h2), o, 0, 0, 0); o = __builtin_amdgcn_mfma_f32_32x32x16_bf16(pa3, TRPK(l3, h3), o, 0, 0, 0);
            }
            const float dtot = den + wint[qidx] * qn;
            if (hi == 0) denl[r32] = dtot;
            asm volatile("s_waitcnt lgkmcnt(0)" ::: "memory");
#pragma unroll
            for (int g4 = 0; g4 < 4; ++g4) { const f32x4 dd = *(const f32x4*)(denl + 8 * g4 + 4 * hi);
#pragma unroll
                for (int i = 0; i < 4; ++i) { const int r = g4 * 4 + i, pr = rb * 32 + 8 * g4 + 4 * hi + i;
                    const float hv = o[r] / fmaxf(fabsf(dd[i]), 1.0f);
                    H[(size_t)(mrow0 + (dir ? 127 - pr : pr)) * 1024 + h * 256 + dvq * 64 + vh * 32 + r32] = (bf16_t)(cvtpk(hv, 0.f) & 0xffffu); } }
        }
#pragma unroll
        for (int r = 0; r < 16; ++r) Cacc[r] *= g;
#pragma unroll
        for (int jt = 0; jt < 2; ++jt) {
            const int va = vbV + jt * 16384 + (2 + vh) * 512, ka = vbK + jt * 16384 + rb * 512;
            const s16x4 al0 = tr_read<v_rd_off(0, 0, 0)>(va), ah0 = tr_read<v_rd_off(0, 0, 1)>(va), al1 = tr_read<v_rd_off(0, 1, 0)>(va), ah1 = tr_read<v_rd_off(0, 1, 1)>(va);
            const s16x4 al2 = tr_read<v_rd_off(0, 2, 0)>(va), ah2 = tr_read<v_rd_off(0, 2, 1)>(va), al3 = tr_read<v_rd_off(0, 3, 0)>(va), ah3 = tr_read<v_rd_off(0, 3, 1)>(va);
            const s16x4 bl0 = tr_read<v_rd_off(0, 0, 0)>(ka), bh0 = tr_read<v_rd_off(0, 0, 1)>(ka), bl1 = tr_read<v_rd_off(0, 1, 0)>(ka), bh1 = tr_read<v_rd_off(0, 1, 1)>(ka);
            const s16x4 bl2 = tr_read<v_rd_off(0, 2, 0)>(ka), bh2 = tr_read<v_rd_off(0, 2, 1)>(ka), bl3 = tr_read<v_rd_off(0, 3, 0)>(ka), bh3 = tr_read<v_rd_off(0, 3, 1)>(ka);
            asm volatile("s_waitcnt lgkmcnt(0)" ::: "memory"); SBAR();
            Cacc = __builtin_amdgcn_mfma_f32_32x32x16_bf16(TRPK(al0, ah0), TRPK(bl0, bh0), Cacc, 0, 0, 0); Cacc = __builtin_amdgcn_mfma_f32_32x32x16_bf16(TRPK(al1, ah1), TRPK(bl1, bh1), Cacc, 0, 0, 0);
            Cacc = __builtin_amdgcn_mfma_f32_32x32x16_bf16(TRPK(al2, ah2), TRPK(bl2, bh2), Cacc, 0, 0, 0); Cacc = __builtin_amdgcn_mfma_f32_32x32x16_bf16(TRPK(al3, ah3), TRPK(bl3, bh3), Cacc, 0, 0, 0);
        }
        { const int k = tid & 127, sq = tid >> 7; float part = 0.f;
#pragma unroll 8
            for (int s = sq * 32; s < sq * 32 + 32; ++s) part += w_[s] * bf2f(*(const bf16_t*)(lds + L_KSW + KSWZ(s, 2 * k)));
            npart[sq * 128 + k] = part; }
        __syncthreads();
#pragma unroll
        for (int r = 0; r < 16; ++r) *(bf16_t*)(lds + L_CT + KSWZ(32 * vh + crow(r, hi), 2 * (32 * rb + r32))) = (bf16_t)(cvtpk(Cacc[r], 0.f) & 0xffffu);
        if (tid < 128) nvec[tid] = g * nvec[tid] + ((npart[tid] + npart[128 + tid]) + (npart[256 + tid] + npart[384 + tid]));
    }
    __syncthreads();
}
#undef TRPK
#undef KSWZ
#undef SBAR
#undef LOADS
#undef MROW0
}

__device__ __forceinline__ void phase_mfinal(const Params& p, int G) {
    const int tid = otid(), lane = tid & 63, wave = __builtin_amdgcn_readfirstlane(tid >> 6);
    const int gw = blockIdx.x * 8 + wave, NGW = G * 8;
    bf16_t* HF = (bf16_t*)(p.ws + WS_HF); const bf16_t* HB = (const bf16_t*)(p.ws + WS_HB); const bf16_t* MO = (const bf16_t*)(p.ws + WS_MO);
    for (int m = gw; m < TL; m += NGW) {
#pragma unroll
        for (int j = 0; j < 4; ++j) {
            const size_t o = (size_t)m * 1024 + 256 * j + 4 * lane;
            const u32x2 a = *(const u32x2*)(HF + o), bq = *(const u32x2*)(HB + o), og = *(const u32x2*)(MO + o);
            f32x4 hs = {bf_lo(a.x) + bf_lo(bq.x), bf_hi(a.x) + bf_hi(bq.x), bf_lo(a.y) + bf_lo(bq.y), bf_hi(a.y) + bf_hi(bq.y)};
            const float rstd = rsqrtf(wave_sum((hs[0] * hs[0] + hs[1] * hs[1]) + (hs[2] * hs[2] + hs[3] * hs[3])) * (1.0f / 256.0f) + EPS);
            const f32x4 g = *(const f32x4*)(p.mnorm_g + 256 * j + 4 * lane);
            const f32x4 ov = {sigmoidf_(bf_lo(og.x)), sigmoidf_(bf_hi(og.x)), sigmoidf_(bf_lo(og.y)), sigmoidf_(bf_hi(og.y))};
            const f32x4 r = hs * rstd * g * ov;
            u32x2 w; w.x = cvt_pk_bf16(r[0], r[1]); w.y = cvt_pk_bf16(r[2], r[3]); *(u32x2*)(HF + o) = w;
        }
    }
}

__device__ __forceinline__ void phase_rows2(const Params& p, LAS unsigned char* lds, int grp) {
    const int tid = otid(), lane = tid & 63, wave = __builtin_amdgcn_readfirstlane(tid >> 6);
    LAS float* rw = (LAS float*)lds;
    LAS int* hist = (LAS int*)(lds + 131072);
    LAS int* basee = hist + 32;
    LAS int* a_e = basee + 32;
    LAS int* a_p = a_e + 512;
    LAS float* a_g = (LAS float*)(a_p + 512);
    for (int i = tid; i < 32 * 1024; i += NTHREADS) { const int k = i >> 5, e = i & 31; rw[e * 1024 + k] = p.router_w[i]; }
    if (tid < 32) hist[tid] = 0;
    __syncthreads();
    const float* mod = (const float*)(p.ws + WS_MOD); bf16_t* U2 = (bf16_t*)(p.ws + WS_U2);
    unsigned* cnt = (unsigned*)(p.ws + WS_CTL) + CW_CNT; int* asg = (int*)(p.ws + WS_ASG); int* list = (int*)(p.ws + WS_LIST); float* lgate = (float*)(p.ws + WS_LGATE);
    f32x4 gn[4];
#pragma unroll
    for (int j = 0; j < 4; ++j) gn[j] = *(const f32x4*)(p.norm2_g + 4 * lane + 256 * j);
    const int tok0 = grp * 128 + wave * 16;
    for (int it = 0; it < 16; ++it) {
        const int m = tok0 + it; const float* xr = p.out + (size_t)m * 1024; const float* md = mod + (size_t)(m >> 12) * 6144;
        f32x4 v[4]; float ss = 0.f;
#pragma unroll
        for (int j = 0; j < 4; ++j) { v[j] = *(const f32x4*)(xr + 4 * lane + 256 * j); ss += (v[j][0] * v[j][0] + v[j][1] * v[j][1]) + (v[j][2] * v[j][2] + v[j][3] * v[j][3]); }
        const float rstd = rsqrtf(wave_sum(ss) * (1.0f / 1024.0f) + EPS);
#pragma unroll
        for (int j = 0; j < 4; ++j) { const f32x4 sh = *(const f32x4*)(md + 3072 + 4 * lane + 256 * j), sc = *(const f32x4*)(md + 4096 + 4 * lane + 256 * j);
            v[j] = (v[j] * rstd * gn[j]) * (sc + 1.0f) + sh;
            u32x2 w; w.x = cvt_pk_bf16(v[j][0], v[j][1]); w.y = cvt_pk_bf16(v[j][2], v[j][3]); *(u32x2*)(U2 + (size_t)m * 1024 + 4 * lane + 256 * j) = w; }
        float mine = 0.f;
#pragma unroll 4
        for (int e = 0; e < 32; ++e) { float a = 0.f;
#pragma unroll
            for (int j = 0; j < 4; ++j) { const f32x4 w = *(const LAS f32x4*)(rw + e * 1024 + 4 * lane + 256 * j); a += (v[j][0] * w[0] + v[j][1] * w[1]) + (v[j][2] * w[2] + v[j][3] * w[3]); }
            a = wave_sum(a); mine = (lane == e) ? a : mine; }
        if (lane < 32) mine += p.router_b[lane];
        float val = lane < 32 ? mine : -INFINITY; int sel_e[4]; float sel_v[4];
#pragma unroll
        for (int k = 0; k < 4; ++k) {
            float bv = val; int bi = lane;
#pragma unroll
            for (int o = 1; o < 64; o <<= 1) { const float ov = __shfl_xor(bv, o); const int oi = __shfl_xor(bi, o); if (ov > bv || (ov == bv && oi < bi)) { bv = ov; bi = oi; } }
            sel_e[k] = bi; sel_v[k] = bv; if (lane == bi) val = -INFINITY;
        }
        if (lane == 0) {
            const float e1 = __expf(sel_v[1] - sel_v[0]), e2 = __expf(sel_v[2] - sel_v[0]), e3 = __expf(sel_v[3] - sel_v[0]); const float inv = 1.0f / (1.0f + e1 + e2 + e3);
            const float gk[4] = {inv, e1 * inv, e2 * inv, e3 * inv};
#pragma unroll
            for (int k = 0; k < 4; ++k) { const int a = (wave * 16 + it) * 4 + k; a_e[a] = sel_e[k]; a_p[a] = atomicAdd((int*)&hist[sel_e[k]], 1); a_g[a] = gk[k]; }
        }
    }
    __syncthreads();
    if (tid < 32) basee[tid] = (int)atomicAdd(cnt + tid, (unsigned)hist[tid]);
    __syncthreads();
    {
        const int a = tid; const int e = a_e[a]; const int pos = basee[e] + a_p[a]; const int tok = grp * 128 + (a >> 2);
        list[(size_t)e * CAP + pos] = tok; lgate[(size_t)e * CAP + pos] = a_g[a]; asg[tok * 4 + (a & 3)] = e * CAP + pos;
    }
    __syncthreads();
}

__device__ __forceinline__ void moe_tables(const Params& p, LAS int* tb, LAS int* cn) {
    if (threadIdx.x == 0) { const unsigned* cnt = (const unsigned*)(p.ws + WS_CTL) + CW_CNT; int acc = 0;
        for (int e = 0; e < 32; ++e) { const int c = (int)__hip_atomic_load(cnt + e, __ATOMIC_RELAXED, __HIP_MEMORY_SCOPE_AGENT); cn[e] = c; tb[e] = acc; acc += (c + 255) >> 8; } tb[32] = acc; }
    __syncthreads();
}

__device__ __forceinline__ void phase_final(const Params& p, const LAS int* tb, int G) {
    const int tid = otid(), lane = tid & 63, wave = __builtin_amdgcn_readfirstlane(tid >> 6);
    const int gw = blockIdx.x * 8 + wave, NGW = G * 8;
    const float* mod = (const float*)(p.ws + WS_MOD); const bf16_t* YS = (const bf16_t*)(p.ws + WS_YS); const int* asg = (const int*)(p.ws + WS_ASG);
    f32x4 gn[4];
#pragma unroll
    for (int j = 0; j < 4; ++j) gn[j] = *(const f32x4*)(p.final_g + 4 * lane + 256 * j);
    for (int m = gw; m < TL; m += NGW) {
        float* xr = p.out + (size_t)m * 1024; const float* g2 = mod + (size_t)(m >> 12) * 6144 + 5120;
        size_t rows[4];
#pragma unroll
        for (int k = 0; k < 4; ++k) { const int a = asg[m * 4 + k]; const int e = a >> 15, pos = a & (CAP - 1); rows[k] = (size_t)(tb[e] * 256 + pos) * 1024; }
        f32x4 v[4]; float ss = 0.f;
#pragma unroll
        for (int j = 0; j < 4; ++j) {
            f32x4 y = {0.f, 0.f, 0.f, 0.f};
#pragma unroll
            for (int k = 0; k < 4; ++k) { const u32x2 w = *(const u32x2*)(YS + rows[k] + 4 * lane + 256 * j); y[0] += bf_lo(w.x); y[1] += bf_hi(w.x); y[2] += bf_lo(w.y); y[3] += bf_hi(w.y); }
            v[j] = *(const f32x4*)(xr + 4 * lane + 256 * j) + *(const f32x4*)(g2 + 4 * lane + 256 * j) * y;
            ss += (v[j][0] * v[j][0] + v[j][1] * v[j][1]) + (v[j][2] * v[j][2] + v[j][3] * v[j][3]);
        }
        const float rstd = rsqrtf(wave_sum(ss) * (1.0f / 1024.0f) + EPS);
#pragma unroll
        for (int j = 0; j < 4; ++j) *(f32x4*)(xr + 4 * lane + 256 * j) = v[j] * rstd * gn[j];
    }
}

__device__ __forceinline__ void phase_attn(const Params& p, LAS unsigned char* lds_, int G, bf16_t* BO, unsigned* ctr) {
    char* lds = (char*)(unsigned char*)lds_;
    volatile int* uslot = (volatile int*)(lds + att::SHM_ATTN);
    const float lam = *(const float*)(p.ws + WS_LAM);
    const bf16_t* DQ = (const bf16_t*)(p.ws + WS_DQ); const bf16_t* DK = (const bf16_t*)(p.ws + WS_DK); const bf16_t* DV = (const bf16_t*)(p.ws + WS_DV);
    for (;;) {
        __syncthreads();
        if (threadIdx.x == 0) uslot[0] = (int)atomicAdd(ctr, 1u);
        __syncthreads();
        const int u = uslot[0];
        if (u >= 2048) break;
        const int bh = u >> 5, qb = u & 31, b = bh >> 3, h = bh & 7;
        const size_t qoff = ((size_t)b * SEQ + qb * 128) * 1024 + h * 128, koff = (size_t)b * KVLEN * 1024 + h * 128;
        att::attn_unit(DQ + qoff, DK + koff, DV + koff, BO + qoff, p.dnorm_g + h * 128, lam, KVLEN, lds);
    }
}


#define XB_TMO      128
#define XB_XCNT(j)  (256  + 64 * (j))
#define XB_XSUB(j)  (1280 + 64 * (j))
#define XB_XGEN(j)  (2304 + 64 * (j))
#define XB_TOP      3328
#define XB_TOPGEN   3392
#define XCD_BAR_WORDS 3456
#define XB_SPIN_CAP (1u << 22)
__device__ __forceinline__ unsigned xb_ld(unsigned* p)              { return __hip_atomic_load(p, __ATOMIC_RELAXED, __HIP_MEMORY_SCOPE_AGENT); }
__device__ __forceinline__ unsigned xb_add(unsigned* p, unsigned v) { return __hip_atomic_fetch_add(p, v, __ATOMIC_RELAXED, __HIP_MEMORY_SCOPE_AGENT); }
__device__ __forceinline__ unsigned xb_xcc_id() { return (unsigned)__builtin_amdgcn_s_getreg((3 << 11) | 20) & 0xFu; }
#define XB_SPIN(cond, bar) do { unsigned _sp = 0; while (cond) { __builtin_amdgcn_s_sleep(1); \
    if ((++_sp & 255u) == 0u) { if (xb_ld(&(bar)[XB_TMO])) break; if (_sp > XB_SPIN_CAP) { atomicAdd(&(bar)[XB_TMO], 1u); break; } } } } while (0)
struct XcdBarrier { unsigned* bar; unsigned x; volatile LAS unsigned* st; };
__device__ __forceinline__ XcdBarrier xcd_barrier_post(unsigned* bar, volatile LAS unsigned* st) {
    XcdBarrier b; b.bar = bar; b.x = xb_xcc_id(); b.st = st;
    if (threadIdx.x == 0) (void)xb_add(&bar[XB_XCNT(b.x)], 1u);
    return b;
}
__device__ __forceinline__ void xcd_barrier_complete(unsigned* bar, unsigned x, unsigned& nloc, unsigned& nx) {
    const unsigned G = gridDim.x * gridDim.y * gridDim.z;
    unsigned sum, cnt, mine, sp = 0u;
    for (;;) {
        sum = 0u; cnt = 0u; mine = 0u;
#pragma unroll
        for (unsigned j = 0; j < 16; ++j) { const unsigned c = xb_ld(&bar[XB_XCNT(j)]); sum += c; cnt += (c > 0u) ? 1u : 0u; mine = (j == x) ? c : mine; }
        if (sum == G) break;
        __builtin_amdgcn_s_sleep(1);
        if ((++sp & 255u) == 0u) { if (xb_ld(&bar[XB_TMO])) break; if (sp > XB_SPIN_CAP) { atomicAdd(&bar[XB_TMO], 1u); break; } }
    }
    nloc = mine > 0u ? mine : 1u; nx = cnt > 0u ? cnt : 1u;
}
__device__ __forceinline__ void xcd_barrier(const XcdBarrier& b) {
    asm volatile("s_waitcnt vmcnt(0)" ::: "memory");
    __syncthreads();
    if (threadIdx.x == 0) {
        unsigned* bar = b.bar;
        __builtin_amdgcn_s_waitcnt(0);
        unsigned nloc = b.st[0], nx = b.st[1];
        if (nloc == 0u) { xcd_barrier_complete(bar, b.x, nloc, nx); b.st[0] = nloc; b.st[1] = nx; }
        const unsigned old = xb_add(&bar[XB_XSUB(b.x)], 1u);
        const unsigned gen = old / nloc;
        if (old + 1u == (gen + 1u) * nloc) {
            __builtin_amdgcn_fence(__ATOMIC_RELEASE, "agent");
            asm volatile("s_waitcnt vmcnt(0)" ::: "memory");
            const unsigned og = xb_add(&bar[XB_TOP], 1u);
            const unsigned tg = og / nx;
            if (og + 1u == (tg + 1u) * nx) xb_add(&bar[XB_TOPGEN], 1u);
            else XB_SPIN(xb_ld(&bar[XB_TOPGEN]) == tg, bar);
            __builtin_amdgcn_fence(__ATOMIC_ACQUIRE, "agent");
            xb_add(&bar[XB_XGEN(b.x)], 1u);
            asm volatile("s_waitcnt vmcnt(0)" ::: "memory");
        } else {
            XB_SPIN(xb_ld(&bar[XB_XGEN(b.x)]) == gen, bar);
            __builtin_amdgcn_fence(__ATOMIC_ACQUIRE, "agent");
            asm volatile("s_waitcnt vmcnt(0)" ::: "memory");
        }
    }
    __syncthreads();
}

__global__ void __launch_bounds__(NTHREADS, 2) fwd_megakernel(Params p) {
    extern __shared__ __attribute__((aligned(16))) unsigned char smem[];
    LAS unsigned char* lds = (LAS unsigned char*)smem;
    cg::grid_group grid = cg::this_grid();
    const int G = gridDim.x, c = blockIdx.x;
    unsigned char* ws = p.ws;
    volatile LAS unsigned* bst = (volatile LAS unsigned*)(lds + LDS_BYTES - 64);
    if (threadIdx.x < 16) bst[threadIdx.x] = 0u;
    __syncthreads();
    const XcdBarrier xbar = xcd_barrier_post((unsigned*)(ws + WS_CTL) + CW_BAR, bst);
#define GSYNC() xcd_barrier(xbar)

#ifndef PH_MASK
#define PH_MASK 0xFFFF
#endif
#define PH(k) if constexpr (((PH_MASK) >> (k)) & 1)
#ifndef REP_MASK
#define REP_MASK 0
#endif
#define REP(k) for (int rep_ = 0; rep_ < ((((REP_MASK) >> (k)) & 1) ? 2 : 1); ++rep_)
    PH(0) REP(0) { phase_prep(p, lds, G); __syncthreads(); }
    grid.sync();
    PH(1) phase_rows1(p, lds, G);
    GSYNC();
    PH(2) REP(2) {
        SchedIn S{(const char*)(ws + WS_U), (const char*)(ws + WS_WIN), G, c};
        EpiIn E{ws, (const float*)(ws + WS_ROPE), (const float*)(ws + WS_ROPE) + 1024};
        pg8::gemm_phase<EpiIn, SchedIn, false>(lds, S, E);
    }
    GSYNC();
#ifdef MLSTM_NAIVE
    PH(3) for (int item = c; item < 128; item += G) phase_mlstm_naive(p, lds, item);
#else
    PH(3) REP(3) for (int item = c; item < 256; item += G) mls::mlstm_item(p, lds, item);
#endif
    if constexpr ((REP_MASK >> 4) & 1) { phase_attn(p, lds, G, (bf16_t*)(ws + WS_END), (unsigned*)(ws + WS_CTL) + CW_ATT + 64); }
    PH(4) phase_attn(p, lds, G, (bf16_t*)(ws + WS_BO), (unsigned*)(ws + WS_CTL) + CW_ATT);
    GSYNC();
    PH(5) phase_mfinal(p, G);
    GSYNC();
    PH(6) REP(6) {
        SchedStatic S{(const char*)(ws + WS_AO), (const char*)(ws + WS_WA), 128, 4, G, c};
        EpiMerge<0> E{(const bf16_t*)(ws + WS_GA), nullptr, (bf16_t*)(ws + WS_T)};
        pg8::gemm_phase<EpiMerge<0>, SchedStatic, false>(lds, S, E);
    }
    GSYNC();
    PH(7) REP(7) {
        SchedStatic S{(const char*)(ws + WS_BO), (const char*)(ws + WS_WB), 128, 4, G, c};
        EpiMerge<1> E{(const bf16_t*)(ws + WS_GB), (const bf16_t*)(ws + WS_T), (bf16_t*)(ws + WS_Y)};
        pg8::gemm_phase<EpiMerge<1>, SchedStatic, false>(lds, S, E);
    }
    GSYNC();
    PH(8) REP(8) {
        SchedStatic S{(const char*)(ws + WS_Y), (const char*)(ws + WS_WO), 128, 4, G, c};
        EpiOut E{p.x, (const float*)(ws + WS_MOD), p.out};
        pg8::gemm_phase<EpiOut, SchedStatic, false>(lds, S, E);
    }
    GSYNC();
    PH(9) for (int grp = c; grp < 256; grp += G) phase_rows2(p, lds, grp);
    GSYNC();
    LAS int* tb = (LAS int*)(lds + 131072); LAS int* cn = tb + 64;
    moe_tables(p, tb, cn);
    PH(10) REP(10) {
        SchedMoe1 S{(const char*)(ws + WS_U2), (const char*)(ws + WS_W1), (const int*)(ws + WS_LIST), tb, cn, G, c};
        EpiMoe1 E{(bf16_t*)(ws + WS_ACT), p.exp_b1};
        pg8::gemm_phase<EpiMoe1, SchedMoe1, true>(lds, S, E);
    }
    GSYNC();
    PH(11) REP(11) {
        SchedMoe2 S{(const char*)(ws + WS_ACT), (const char*)(ws + WS_W2), tb, G, c};
        EpiMoe2 E{(bf16_t*)(ws + WS_YS), p.exp_b2, (const float*)(ws + WS_LGATE), cn};
        pg8::gemm_phase<EpiMoe2, SchedMoe2, false>(lds, S, E);
    }
    GSYNC();
    PH(12) phase_final(p, tb, G);
}

extern "C" void kernel_launch(void* const* d_in, const int* in_sizes, int n_in, void* d_out, int out_size, void* d_ws, size_t ws_size, hipStream_t stream) {
    static int grid = 0;
    if (grid == 0) {
        if (n_in != 23 || out_size != TL * D || ws_size < WS_END) { fprintf(stderr, "kernel_launch: unexpected shapes: n_in %d out %d ws %zu (need %zu)\n", n_in, out_size, ws_size, (size_t)WS_END); grid = -1; return; }
        int dev = 0, cus = 0, per_cu = 0;
        (void)hipGetDevice(&dev); (void)hipDeviceGetAttribute(&cus, hipDeviceAttributeMultiprocessorCount, dev);
        if (hipFuncSetAttribute((const void*)fwd_megakernel, hipFuncAttributeMaxDynamicSharedMemorySize, LDS_BYTES) != hipSuccess) { fprintf(stderr, "kernel_launch: hipFuncSetAttribute failed\n"); grid = -1; return; }
        if (hipOccupancyMaxActiveBlocksPerMultiprocessor(&per_cu, (const void*)fwd_megakernel, NTHREADS, LDS_BYTES) != hipSuccess || per_cu < 1) { fprintf(stderr, "kernel_launch: occupancy query says %d\n", per_cu); per_cu = 1; }
        (void)hipGetLastError();
        grid = cus;
        if (grid > 256) grid = 256;
    }
    if (grid < 0) return;
    (void)hipMemsetAsync((char*)d_ws + WS_CTL, 0, 32768, stream);
    Params p{};
    const float** pp = (const float**)&p;
    for (int i = 0; i < 23; ++i) pp[i] = (const float*)d_in[i];
    p.out = (float*)d_out; p.ws = (unsigned char*)d_ws;
    void* args[] = {&p};
    hipError_t e = hipLaunchCooperativeKernel((const void*)fwd_megakernel, dim3(grid), dim3(NTHREADS), args, LDS_BYTES, stream);
    if (e != hipSuccess) fprintf(stderr, "cooperative launch failed: %s (grid %d)\n", hipGetErrorString(e), grid);
}
```

```cpp
#include <hip/hip_runtime.h>
#include <hip/hip_cooperative_groups.h>
#include <cstdio>
#include <cstdint>
namespace cg = cooperative_groups;

#define LAS __attribute__((address_space(3)))
typedef unsigned short bf16_t;
typedef short bf16x8 __attribute__((ext_vector_type(8)));
typedef short s16x4 __attribute__((ext_vector_type(4)));
typedef float f32x4 __attribute__((ext_vector_type(4)));
typedef float f32x8 __attribute__((ext_vector_type(8)));
typedef float f32x16 __attribute__((ext_vector_type(16)));
typedef unsigned u32x4 __attribute__((ext_vector_type(4)));
typedef unsigned u32x2 __attribute__((ext_vector_type(2)));

constexpr int D = 1024, BATCH = 8, SEQ = 4096, CTX = 256;
constexpr int TL = BATCH * SEQ, TC = BATCH * CTX, TT = TL + TC;
constexpr int KVLEN = CTX + SEQ;
constexpr int NEXP = 32, CAP = 32768, ACT_ROWS = 139264;
constexpr int INCOLS = 8208;
constexpr float EPS = 1e-6f;
constexpr float LAM_INIT = 0.2f;

constexpr size_t MiB = 1u << 20;
constexpr size_t WS_CTL = 0;
constexpr size_t WS_MOD = 1 * MiB;
constexpr size_t WS_ROPE = 1 * MiB + 256 * 1024;
constexpr size_t WS_LAM = 1 * MiB + 300 * 1024;
constexpr size_t WS_GT = 2 * MiB;
constexpr size_t WS_ASG = 5 * MiB;
constexpr size_t WS_LIST = 6 * MiB;
constexpr size_t WS_LGATE = 10 * MiB;
constexpr size_t WS_WIN = 16 * MiB;
constexpr size_t WS_WA = 32 * MiB, WS_WB = 34 * MiB, WS_WO = 36 * MiB;
constexpr size_t WS_W1 = 40 * MiB;
constexpr size_t WS_W2 = 168 * MiB;
constexpr size_t WS_U = 232 * MiB;
constexpr size_t WS_MQ = 300 * MiB;
constexpr size_t WS_MK = 332 * MiB;
constexpr size_t WS_MV = 366 * MiB;
constexpr size_t WS_MO = 434 * MiB;
constexpr size_t WS_HB = 498 * MiB;
constexpr size_t WS_DQ = 562 * MiB;
constexpr size_t WS_DK = 626 * MiB;
constexpr size_t WS_DV = 694 * MiB;
constexpr size_t WS_GA = 762 * MiB;
constexpr size_t WS_GB = 826 * MiB;
constexpr size_t WS_END = 890 * MiB;
constexpr size_t WS_HF = WS_U, WS_AO = WS_U, WS_BO = WS_DQ, WS_T = WS_MV, WS_Y = WS_MO, WS_U2 = 370 * MiB, WS_XS = WS_U, WS_ACT = WS_DQ, WS_YS = WS_U;
static_assert(WS_ACT + (size_t)ACT_ROWS * 2048 <= WS_END, "ACT fits");
static_assert(WS_YS + (size_t)ACT_ROWS * 2048 <= WS_DQ, "YS fits");

constexpr int CW_CNT = 0, CW_ATT = 64, CW_BAR = 1024;
constexpr int LDS_BYTES = 147456;
constexpr int NTHREADS = 512;

struct Params {
    const float *x, *c, *ctx, *c_ctx, *ada_w, *ada_b, *norm1_g, *norm2_g, *w_in, *gate_b, *mnorm_g, *dlam, *dnorm_g, *w_a, *w_b, *w_o, *router_w, *router_b,
        *exp_w1, *exp_b1, *exp_w2, *exp_b2, *final_g;
    float* out;
    unsigned char* ws;
};

#define LDS_WAIT() asm volatile("s_waitcnt lgkmcnt(0)" ::: "memory")
#define VM_WAIT() asm volatile("s_waitcnt vmcnt(0)" ::: "memory")
typedef float f32x2_t __attribute__((ext_vector_type(2))); typedef __bf16 bf16x2_t __attribute__((ext_vector_type(2)));
__device__ __forceinline__ unsigned cvt_pk_bf16(float lo, float hi) { f32x2_t v = {lo, hi}; bf16x2_t b = __builtin_convertvector(v, bf16x2_t); return __builtin_bit_cast(unsigned, b); }
__device__ __forceinline__ unsigned pk4_fp8(float a, float b, float c, float d) { int w = 0; w = __builtin_amdgcn_cvt_pk_fp8_f32(a, b, w, false); w = __builtin_amdgcn_cvt_pk_fp8_f32(c, d, w, true); return (unsigned)w; }
__device__ __forceinline__ float bf_lo(unsigned w) { return __uint_as_float(w << 16); }
__device__ __forceinline__ float bf_hi(unsigned w) { return __uint_as_float(w & 0xffff0000u); }
__device__ __forceinline__ float bf2f(bf16_t b) { return __uint_as_float(((unsigned)b) << 16); }
__device__ __forceinline__ float wave_sum(float v) {
#pragma unroll
    for (int o = 1; o < 64; o <<= 1) v += __shfl_xor(v, o);
    return v;
}
__device__ __forceinline__ float sigmoidf_(float x) { return __builtin_amdgcn_rcpf(1.0f + __expf(-x)); }
__device__ __forceinline__ int otid() { unsigned ones = ~0u; asm volatile("" : "+s"(ones));
    const int lane = __builtin_amdgcn_mbcnt_hi(ones, __builtin_amdgcn_mbcnt_lo(ones, 0u)); int t = __builtin_amdgcn_readfirstlane(threadIdx.x >> 6) * 64 + lane; asm volatile("" : "+v"(t)); return t; }

namespace pg8 {
constexpr int BM = 256, BK = 64, HALF = 128, HTB = HALF * BK * 2, STAGE_BYTES = 8 * HTB, KD = 1024;
__host__ __device__ __forceinline__ int lds_byte(int r, int c) { const int st = (r >> 4) * 2 + (c >> 5), rr = r & 15, cc = c & 31, ob = rr * 64 + cc * 2; return st * 1024 + (ob ^ (((ob >> 9) & 1) << 5)); }
__host__ __device__ __forceinline__ void stage_rc(int b, int& R, int& C) { const int st = b / 1024, sb = b % 1024, swz = sb ^ (((sb >> 9) & 1) << 5); R = (st >> 1) * 16 + swz / 64; C = (st & 1) * 32 + (swz % 64) / 2; }

struct Unit { const char* A; const char* B; int row0; int pn; int aux; int aux2; };

__device__ __forceinline__ void tile_map(int L, int nM, int nN, int& pm, int& pn) {
    const int nwg = nM * nN; int wgid = L; { const int q = nwg / 8, r = nwg % 8, xcd = wgid % 8, off = wgid / 8; wgid = (xcd < r ? xcd * (q + 1) : r * (q + 1) + (xcd - r) * q) + off; }
    const int nig = 8 * nN, gid = wgid / nig, fm = gid * 8, gsz = (nM - fm) < 8 ? (nM - fm) : 8;
    pm = fm + ((wgid % nig) % gsz); pn = (wgid % nig) / gsz;
}

typedef int v8i_t __attribute__((ext_vector_type(8)));
typedef int v8i_a16 __attribute__((ext_vector_type(8), aligned(16)));
template <class Epi, class Sched, bool GATHER, bool FP8 = false>
__device__ __forceinline__ void gemm_phase(LAS unsigned char* lds, const Sched& S, const Epi& E) {
    const int tid = otid(), wid = __builtin_amdgcn_readfirstlane(tid >> 6), lane = tid & 63, wr = wid >> 2, wc = wid & 3, fr = lane & 15, fq = lane >> 4;
    constexpr int K = FP8 ? KD / 2 : KD, nt = K / BK;
    unsigned voffB[2], voffA0[2], voffA1[2], nvA0[2], nvA1[2];
#pragma unroll
    for (int i = 0; i < 2; ++i) { int R, C; stage_rc(tid * 16 + i * 8192, R, C);
        voffB[i] = (unsigned)(R * K + C) * 2u; voffA0[i] = voffB[i]; voffA1[i] = voffB[i] + (unsigned)HALF * K * 2u; nvA0[i] = voffA0[i]; nvA1[i] = voffA1[i]; }
    const size_t kstep = (size_t)(BK * 2);
    const size_t hstep = (size_t)HALF * K * 2;
    const unsigned ldsw = (unsigned)wid * 1024u;
    const int aoff = FP8 ? lds_byte(wr * 64 + fr, (fq & 1) * 16) + (fq >> 1) * 1024 : lds_byte(wr * 64 + fr, fq * 8);
    const int boff = FP8 ? lds_byte(wc * 32 + fr, (fq & 1) * 16) + (fq >> 1) * 1024 : lds_byte(wc * 32 + fr, fq * 8);
#define PG8_SA(b, h) (((b) * 2 + (h)) * HTB)
#define PG8_SB(b, h) ((4 + (b) * 2 + (h)) * HTB)
#define PG8_STAGE(bufoff, gbase, voff) do { _Pragma("unroll") for (int _i = 0; _i < 2; ++_i) { unsigned _v = (voff)[_i]; asm volatile("" : "+v"(_v));   \
        __builtin_amdgcn_global_load_lds((const unsigned*)((const char*)(gbase) + _v), (LAS unsigned*)(lds + (bufoff) + ldsw + _i * 8192), 16, 0, 0); } } while (0)
#define PG8_LDA(dst, b, h) do { if constexpr (FP8) { _Pragma("unroll") for (int m = 0; m < 4; ++m) dst##8[m] = *(const LAS v8i_a16*)(lds + PG8_SA(b, h) + aoff + m * 2048); } \
        else { _Pragma("unroll") for (int m = 0; m < 4; ++m) _Pragma("unroll") for (int k = 0; k < 2; ++k) dst[m][k] = *(const LAS bf16x8*)(lds + PG8_SA(b, h) + aoff + m * 2048 + k * 1024); } } while (0)
#define PG8_LDB(dst, b, h) do { if constexpr (FP8) { _Pragma("unroll") for (int n = 0; n < 2; ++n) dst##8[n] = *(const LAS v8i_a16*)(lds + PG8_SB(b, h) + boff + n * 2048); } \
        else { _Pragma("unroll") for (int n = 0; n < 2; ++n) _Pragma("unroll") for (int k = 0; k < 2; ++k) dst[n][k] = *(const LAS bf16x8*)(lds + PG8_SB(b, h) + boff + n * 2048 + k * 1024); } } while (0)
#define PG8_MMA(ai, bj, At, Bt) do { __builtin_amdgcn_s_setprio(1); _Pragma("unroll") for (int m = 0; m < 4; ++m) _Pragma("unroll") for (int n = 0; n < 2; ++n) { \
        if constexpr (FP8) { asm volatile("v_mfma_scale_f32_16x16x128_f8f6f4 %0, %1, %2, %0, %3, %4 op_sel_hi:[0,0,0]" : "+v"(acc[ai][bj][m][n]) : "v"(Bt##8[n]), "v"(At##8[m]), "v"(sc_w), "v"(sc_a)); } \
        else { _Pragma("unroll") for (int k = 0; k < 2; ++k) acc[ai][bj][m][n] = __builtin_amdgcn_mfma_f32_16x16x32_bf16(Bt[n][k], At[m][k], acc[ai][bj][m][n], 0, 0, 0); } } \
        __builtin_amdgcn_s_setprio(0); } while (0)
#define PG8_WAIT_V(n) asm volatile("s_waitcnt vmcnt(" #n ")" ::: "memory")
#define PG8_WAIT_L(n) asm volatile("s_waitcnt lgkmcnt(" #n ")" ::: "memory")
#define PG8_BAR __builtin_amdgcn_s_barrier()
#define PG8_SCHED __builtin_amdgcn_sched_barrier(0)
    Unit cur, nxt; int ui = 0;
    if (!S.next(0, cur)) return;
    if constexpr (GATHER) { S.offsets(cur, tid, voffA0, voffA1); }
    f32x4 acc[2][2][4][2];
#pragma unroll
    for (int a = 0; a < 2; ++a)
#pragma unroll
        for (int b = 0; b < 2; ++b)
#pragma unroll
            for (int m = 0; m < 4; ++m)
#pragma unroll
                for (int n = 0; n < 2; ++n) acc[a][b][m][n] = (f32x4){0.f, 0.f, 0.f, 0.f};
    bf16x8 At[4][2], B0[2][2], B1[2][2]; v8i_t At8[4], B08[2], B18[2];
    int sc_w = 0x79797979, sc_a = 0x7f7f7f7f; asm volatile("" : "+v"(sc_w), "+v"(sc_a));
    const char* cA = cur.A; const char* cB = cur.B;
    PG8_STAGE(PG8_SB(0, 0), cB, voffB); PG8_STAGE(PG8_SB(0, 1), cB + hstep, voffB); PG8_STAGE(PG8_SA(0, 0), cA, voffA0); PG8_STAGE(PG8_SA(0, 1), cA, voffA1);
    if (wr == 1) PG8_BAR;
    PG8_WAIT_V(2); PG8_BAR;
    PG8_STAGE(PG8_SB(1, 0), cB + kstep, voffB); PG8_STAGE(PG8_SA(1, 0), cA + kstep, voffA0); PG8_STAGE(PG8_SB(1, 1), cB + hstep + kstep, voffB);
    PG8_WAIT_V(6); PG8_BAR;
    for (;;) {
        const bool has_next = S.next(ui + 1, nxt);
        const char* nA = has_next ? nxt.A : cA; const char* nB = has_next ? nxt.B : cB;
#pragma unroll 1
        for (int t = 0; t < nt; t += 2) {
            const bool last = (t == nt - 2);
            if constexpr (GATHER) { if (t == nt - 4 && has_next) { const int tq = otid(); unsigned n0[2], n1[2]; S.offsets(nxt, tq, n0, n1); *(LAS u32x4*)(lds + 132096 + tq * 16) = (u32x4){n0[0], n0[1], n1[0], n1[1]}; } }
            const char* a1 = cA + (size_t)(t + 1) * kstep;
            const char* a2 = last ? nA : cA + (size_t)(t + 2) * kstep; const char* b2 = last ? nB : cB + (size_t)(t + 2) * kstep;
            const char* a3 = a2 + kstep; const char* b3 = b2 + kstep;
            unsigned w0[2], w1[2];
            if constexpr (GATHER) { w0[0] = voffA0[0]; w0[1] = voffA0[1]; w1[0] = voffA1[0]; w1[1] = voffA1[1];
                if (last && has_next) { const int tq = otid(); const u32x4 nv = *(const LAS u32x4*)(lds + 132096 + tq * 16); w0[0] = nv.x; w0[1] = nv.y; w1[0] = nv.z; w1[1] = nv.w; nvA0[0] = nv.x; nvA0[1] = nv.y; nvA1[0] = nv.z; nvA1[1] = nv.w; } }
            else { w0[0] = voffA0[0]; w0[1] = voffA0[1]; w1[0] = voffA1[0]; w1[1] = voffA1[1]; }
            PG8_LDB(B0, 0, 0); PG8_LDB(B1, 0, 1); PG8_SCHED; PG8_LDA(At, 0, 0); PG8_STAGE(PG8_SA(1, 1), a1, voffA1);
            PG8_WAIT_V(8); PG8_WAIT_L(0); PG8_BAR; PG8_MMA(0, 0, At, B0); PG8_MMA(0, 1, At, B1); PG8_BAR; PG8_SCHED;
            PG8_LDA(At, 0, 1); PG8_STAGE(PG8_SB(0, 0), b2, voffB); PG8_STAGE(PG8_SB(0, 1), b2 + hstep, voffB); PG8_STAGE(PG8_SA(0, 0), a2, w0);
            PG8_WAIT_V(8); PG8_WAIT_L(0); PG8_BAR; PG8_MMA(1, 0, At, B0); PG8_MMA(1, 1, At, B1); PG8_BAR; PG8_SCHED;
            PG8_LDB(B0, 1, 0); PG8_LDB(B1, 1, 1); PG8_SCHED; PG8_LDA(At, 1, 0); PG8_STAGE(PG8_SA(0, 1), a2, w1);
            PG8_WAIT_V(8); PG8_WAIT_L(0); PG8_BAR; PG8_MMA(0, 0, At, B0); PG8_MMA(0, 1, At, B1); PG8_BAR; PG8_SCHED;
            PG8_LDA(At, 1, 1); PG8_STAGE(PG8_SB(1, 0), b3, voffB); PG8_STAGE(PG8_SB(1, 1), b3 + hstep, voffB); PG8_STAGE(PG8_SA(1, 0), a3, w0);
            PG8_WAIT_V(8); PG8_WAIT_L(0); PG8_BAR; PG8_MMA(1, 0, At, B0); PG8_MMA(1, 1, At, B1); PG8_BAR; PG8_SCHED;
        }
        if (wr == 0) PG8_BAR;
        if constexpr (FP8) asm volatile("s_nop 15\n\ts_nop 7" ::: "memory");
        { const int t2_ = otid(); E(acc, cur, wr, wc, t2_ & 15, (t2_ & 63) >> 4); }
        if (!has_next) break;
#pragma unroll
        for (int a = 0; a < 2; ++a)
#pragma unroll
            for (int b = 0; b < 2; ++b)
#pragma unroll
                for (int m = 0; m < 4; ++m)
#pragma unroll
                    for (int n = 0; n < 2; ++n) acc[a][b][m][n] = (f32x4){0.f, 0.f, 0.f, 0.f};
        cur = nxt; cA = nA; cB = nB; ++ui;
        if constexpr (GATHER) { voffA0[0] = nvA0[0]; voffA0[1] = nvA0[1]; voffA1[0] = nvA1[0]; voffA1[1] = nvA1[1]; }
        if (wr == 1) PG8_BAR;
    }
    PG8_WAIT_V(0);
    PG8_BAR;
#undef PG8_SA
#undef PG8_SB
#undef PG8_STAGE
#undef PG8_LDA
#undef PG8_LDB
#undef PG8_MMA
#undef PG8_WAIT_V
#undef PG8_WAIT_L
#undef PG8_BAR
#undef PG8_SCHED
}
}

using pg8::Unit;
constexpr size_t TSTEP = (size_t)256 * 1024 * 2;

struct SchedIn {
    const char* A; const char* B; int G, c;
    __device__ __forceinline__ bool next(int i, Unit& u) const {
        const int L = i * G + c; int pm, pn;
        if (L < 4096) { pg8::tile_map(L, 128, 32, pm, pn); }
        else { const int j = L - 4096; if (j >= 112) return false; pm = 128 + (j & 7); const int cj = j >> 3; pn = cj < 2 ? 2 + cj : (cj < 6 ? 4 + (cj - 2) : 16 + (cj - 6)); }
        u.A = A + (size_t)pm * TSTEP; u.B = B + (size_t)pn * TSTEP; u.row0 = pm * 256; u.pn = pn; u.aux = 0; u.aux2 = 0; return true;
    }
};
struct EpiIn {
    unsigned char* ws; const float* ropec; const float* ropes;
    __device__ __forceinline__ void operator()(const f32x4 (&acc)[2][2][4][2], const Unit& u, int wr, int wc, int fr, int fq) const {
        const int pn = u.pn, row0 = u.row0; const bool latent = row0 < TL;
        bf16_t* base; int ldc, col0, mode = 0; float sc = 1.f; int drow0 = row0;
        int kvrow0; if (latent) { const int b = row0 >> 12, t = row0 & 4095; kvrow0 = b * KVLEN + CTX + t; } else { const int cc = row0 - TL; kvrow0 = (cc >> 8) * KVLEN + (cc & 255); }
        if (pn < 2)       { base = (bf16_t*)(ws + WS_MQ); ldc = 512;  col0 = pn * 256;        sc = 0.08838834764831845f; }
        else if (pn < 4)  { base = (bf16_t*)(ws + WS_MK); ldc = 512;  col0 = (pn - 2) * 256; }
        else if (pn < 8)  { base = (bf16_t*)(ws + WS_MV); ldc = 1024; col0 = (pn - 4) * 256; }
        else if (pn < 12) { base = (bf16_t*)(ws + WS_MO); ldc = 1024; col0 = (pn - 8) * 256; }
        else if (pn < 16) { base = (bf16_t*)(ws + WS_DQ); ldc = 1024; col0 = (pn - 12) * 256; mode = 1; }
        else if (pn < 20) { base = (bf16_t*)(ws + WS_DK); ldc = 1024; col0 = (pn - 16) * 256; mode = latent ? 1 : 0; drow0 = kvrow0; }
        else if (pn < 24) { base = (bf16_t*)(ws + WS_DV); ldc = 1024; col0 = (pn - 20) * 256; drow0 = kvrow0; }
        else if (pn < 28) { base = (bf16_t*)(ws + WS_GA); ldc = 1024; col0 = (pn - 24) * 256; mode = 2; }
        else              { base = (bf16_t*)(ws + WS_GB); ldc = 1024; col0 = (pn - 28) * 256; mode = 2; }
        const bool permt = !(pn >= 12 && pn < 20);
        const int cl = col0 + wc * 32 + (permt ? 8 * fq : 4 * fq);
#pragma unroll
        for (int ai = 0; ai < 2; ++ai)
#pragma unroll
            for (int m = 0; m < 4; ++m) {
                const int rl = ai * 128 + wr * 64 + m * 16 + fr;
                bf16_t* rowp = base + (size_t)(drow0 + rl) * ldc + cl;
                f32x4 cs = {1.f, 1.f, 1.f, 1.f}, sn = {0.f, 0.f, 0.f, 0.f};
                if (mode == 1) { const int t = (row0 + rl) & 4095; const int pos = (wc & 1) ? (t & 63) : (t >> 6); cs = *(const f32x4*)(ropec + pos * 16 + 4 * fq); sn = *(const f32x4*)(ropes + pos * 16 + 4 * fq); }
#pragma unroll
                for (int bj = 0; bj < 2; ++bj) {
                    f32x4 v0 = acc[ai][bj][m][0], v1 = acc[ai][bj][m][1];
                    if (mode == 1) { const f32x4 a = v0 * cs - v1 * sn, b = v1 * cs + v0 * sn; v0 = a; v1 = b; }
                    else if (mode == 2) {
#pragma unroll
                        for (int i = 0; i < 4; ++i) { v0[i] = sigmoidf_(v0[i]); v1[i] = sigmoidf_(v1[i]); }
                    } else { v0 = v0 * sc; v1 = v1 * sc; }
                    u32x2 w0, w1; w0.x = cvt_pk_bf16(v0[0], v0[1]); w0.y = cvt_pk_bf16(v0[2], v0[3]); w1.x = cvt_pk_bf16(v1[0], v1[1]); w1.y = cvt_pk_bf16(v1[2], v1[3]);
                    if (permt) { u32x4 w; w.x = w0.x; w.y = w0.y; w.z = w1.x; w.w = w1.y; *(u32x4*)(rowp + bj * 128) = w; }
                    else { *(u32x2*)(rowp + bj * 128) = w0; *(u32x2*)(rowp + bj * 128 + 16) = w1; }
                }
            }
    }
};

struct SchedStatic {
    const char* A; const char* B; int nM, nN, G, c;
    __device__ __forceinline__ bool next(int i, Unit& u) const {
        const int L = i * G + c; if (L >= nM * nN) return false; int pm, pn; pg8::tile_map(L, nM, nN, pm, pn);
        u.A = A + (size_t)pm * TSTEP; u.B = B + (size_t)pn * TSTEP; u.row0 = pm * 256; u.pn = pn; u.aux = 0; u.aux2 = 0; return true;
    }
};
template <int MODE> struct EpiMerge {
    const bf16_t* gate; const bf16_t* tin; bf16_t* outp;
    __device__ __forceinline__ void operator()(const f32x4 (&acc)[2][2][4][2], const Unit& u, int wr, int wc, int fr, int fq) const {
        const int cl = u.pn * 256 + wc * 32 + 8 * fq;
#pragma unroll
        for (int ai = 0; ai < 2; ++ai)
#pragma unroll
            for (int m = 0; m < 4; ++m) {
                const size_t ro = (size_t)(u.row0 + ai * 128 + wr * 64 + m * 16 + fr) * 1024 + cl;
#pragma unroll
                for (int bj = 0; bj < 2; ++bj) {
                    const size_t o = ro + bj * 128;
                    const u32x4 g = *(const u32x4*)(gate + o);
                    f32x4 v0 = acc[ai][bj][m][0], v1 = acc[ai][bj][m][1];
                    v0[0] *= bf_lo(g.x); v0[1] *= bf_hi(g.x); v0[2] *= bf_lo(g.y); v0[3] *= bf_hi(g.y); v1[0] *= bf_lo(g.z); v1[1] *= bf_hi(g.z); v1[2] *= bf_lo(g.w); v1[3] *= bf_hi(g.w);
                    if (MODE == 1) { const u32x4 t = *(const u32x4*)(tin + o);
                        v0[0] += bf_lo(t.x); v0[1] += bf_hi(t.x); v0[2] += bf_lo(t.y); v0[3] += bf_hi(t.y); v1[0] += bf_lo(t.z); v1[1] += bf_hi(t.z); v1[2] += bf_lo(t.w); v1[3] += bf_hi(t.w); }
                    u32x4 w; w.x = cvt_pk_bf16(v0[0], v0[1]); w.y = cvt_pk_bf16(v0[2], v0[3]); w.z = cvt_pk_bf16(v1[0], v1[1]); w.w = cvt_pk_bf16(v1[2], v1[3]);
                    *(u32x4*)(outp + o) = w;
                }
            }
    }
};
struct EpiOut {
    const float* x; const float* mod; float* x1;
    __device__ __forceinline__ void operator()(const f32x4 (&acc)[2][2][4][2], const Unit& u, int wr, int wc, int fr, int fq) const {
        const int cl = u.pn * 256 + wc * 32 + 8 * fq; const float* g1 = mod + (size_t)(u.row0 >> 12) * 6144 + 2048;
#pragma unroll
        for (int bj = 0; bj < 2; ++bj)
#pragma unroll
            for (int n = 0; n < 2; ++n) {
                const f32x4 g = *(const f32x4*)(g1 + cl + bj * 128 + n * 4);
#pragma unroll
                for (int ai = 0; ai < 2; ++ai)
#pragma unroll
                    for (int m = 0; m < 4; ++m) {
                        const size_t o = (size_t)(u.row0 + ai * 128 + wr * 64 + m * 16 + fr) * 1024 + cl + bj * 128 + n * 4;
                        const f32x4 xv = *(const f32x4*)(x + o);
                        *(f32x4*)(x1 + o) = xv + g * acc[ai][bj][m][n];
                    }
            }
    }
};

struct SchedMoe1 {
    const char* XS; const char* W1; const LAS int* tb; int G, c;
    __device__ __forceinline__ bool next(int i, Unit& u) const {
        const int L = i * G + c; const int xcd = L & 7, j = L >> 3; const int pn = j & 7, rt = (j >> 3) * 8 + xcd;
        const int NRT = __builtin_amdgcn_readfirstlane(tb[32]);
        if (rt >= NRT) return false;
        int e = 0;
#pragma unroll 1
        for (int k = 1; k < 32; ++k) e = (__builtin_amdgcn_readfirstlane(tb[k]) <= rt) ? k : e;
        u.A = XS + (size_t)rt * (TSTEP / 2); u.B = W1 + ((size_t)e * 2048 + (size_t)pn * 256) * 1024; u.row0 = rt * 256; u.pn = pn; u.aux = e; u.aux2 = 0; return true;
    }
};
struct EpiMoe1 {
    unsigned char* act; const float* b1;
    __device__ __forceinline__ void operator()(const f32x4 (&acc)[2][2][4][2], const Unit& u, int wr, int wc, int fr, int fq) const {
        if (u.aux < 0) return;
        const int cl = u.pn * 128 + wc * 32 + 8 * fq; const float* bb = b1 + (size_t)u.aux * 2048;
        f32x4 bg[2], bl[2];
#pragma unroll
        for (int n = 0; n < 2; ++n) { bg[n] = *(const f32x4*)(bb + cl + n * 4); bl[n] = *(const f32x4*)(bb + 1024 + cl + n * 4); }
#pragma unroll
        for (int ai = 0; ai < 2; ++ai)
#pragma unroll
            for (int m = 0; m < 4; ++m) {
                f32x4 a[2];
#pragma unroll
                for (int n = 0; n < 2; ++n) { const f32x4 g = acc[ai][0][m][n] + bg[n], l = acc[ai][1][m][n] + bl[n];
#pragma unroll
                    for (int i = 0; i < 4; ++i) { const float gg = fminf(g[i], 7.0f), ll = fminf(fmaxf(l[i], -7.0f), 7.0f); a[n][i] = gg * sigmoidf_(1.702f * gg) * (ll + 1.0f); } }
                u32x2 w; w.x = pk4_fp8(a[0][0], a[0][1], a[0][2], a[0][3]); w.y = pk4_fp8(a[1][0], a[1][1], a[1][2], a[1][3]);
                *(u32x2*)(act + (size_t)(u.row0 + ai * 128 + wr * 64 + m * 16 + fr) * 1024 + cl) = w;
            }
    }
};
struct SchedMoe2 {
    const char* ACT; const char* W2; const LAS int* tb; int G, c;
    __device__ __forceinline__ bool next(int i, Unit& u) const {
        const int L = i * G + c; const int xcd = L & 7, j = L >> 3; const int pn = j & 3, rt = (j >> 2) * 8 + xcd;
        const int NRT = __builtin_amdgcn_readfirstlane(tb[32]);
        if (rt >= NRT) return false;
        int e = 0;
#pragma unroll 1
        for (int k = 1; k < 32; ++k) e = (__builtin_amdgcn_readfirstlane(tb[k]) <= rt) ? k : e;
        const int tbe = __builtin_amdgcn_readfirstlane(tb[e]);
        u.A = ACT + (size_t)rt * (TSTEP / 2); u.B = W2 + ((size_t)e * 1024 + (size_t)pn * 256) * 1024; u.row0 = rt * 256; u.pn = pn; u.aux = e; u.aux2 = (rt - tbe) * 256; return true;
    }
};
struct EpiMoe2 {
    bf16_t* ys; const float* b2; const float* lgate; const LAS int* cnt;
    __device__ __forceinline__ void operator()(const f32x4 (&acc)[2][2][4][2], const Unit& u, int wr, int wc, int fr, int fq) const {
        if (u.aux < 0) return;
        const int cl = u.pn * 256 + wc * 32 + 8 * fq; const float* bb = b2 + (size_t)u.aux * 1024; const int n = __builtin_amdgcn_readfirstlane(cnt[u.aux]) - u.aux2; const float* gp = lgate + (size_t)u.aux * CAP + u.aux2;
        f32x4 bv[2][2];
#pragma unroll
        for (int bj = 0; bj < 2; ++bj)
#pragma unroll
            for (int nn = 0; nn < 2; ++nn) bv[bj][nn] = *(const f32x4*)(bb + cl + bj * 128 + nn * 4);
#pragma unroll
        for (int ai = 0; ai < 2; ++ai)
#pragma unroll
            for (int m = 0; m < 4; ++m) {
                const int rl = ai * 128 + wr * 64 + m * 16 + fr; const float gw = rl < n ? gp[rl] : 0.f;
#pragma unroll
                for (int bj = 0; bj < 2; ++bj) {
                    const f32x4 v0 = (acc[ai][bj][m][0] + bv[bj][0]) * gw, v1 = (acc[ai][bj][m][1] + bv[bj][1]) * gw;
                    u32x4 w; w.x = cvt_pk_bf16(v0[0], v0[1]); w.y = cvt_pk_bf16(v0[2], v0[3]); w.z = cvt_pk_bf16(v1[0], v1[1]); w.w = cvt_pk_bf16(v1[2], v1[3]);
                    *(u32x4*)(ys + (size_t)(u.row0 + rl) * 1024 + cl + bj * 128) = w;
                }
            }
    }
};

namespace att {
constexpr int NW = 8, QBLK = 32, KVBLK = 64, LD = 1024;
constexpr float SCALE = 0.125f;
constexpr float THR = 8.f;
constexpr int SHM_V = KVBLK * 128 * 2, SHM_K = KVBLK * 128 * 2, SHM_ATTN = 2 * SHM_V + 2 * SHM_K + NW * 64 * 4;
#define KSWZ(row, colB) ((row) * 256 + ((colB) ^ (((row) & 7) << 4)))
#define SBAR() __builtin_amdgcn_sched_barrier(0)
__device__ __forceinline__ int crow(int r, int hi) { return (r & 3) + 8 * (r >> 2) + 4 * hi; }
__device__ __forceinline__ unsigned cvtpk(float lo, float hi) { return cvt_pk_bf16(lo, hi); }

__device__ __forceinline__ void partialSM(f32x16& p0, f32x16& p1, float& m_reg, float& mn, float& alpha) {
  constexpr float C = SCALE * 1.4426950408889634f;
  float pmax = p0[0];
#pragma unroll
  for (int r = 1; r < 16; ++r) pmax = fmaxf(pmax, p0[r]);
#pragma unroll
  for (int r = 0; r < 16; ++r) pmax = fmaxf(pmax, p1[r]);
  { auto rr = __builtin_amdgcn_permlane32_swap(__float_as_uint(pmax), __float_as_uint(pmax), false, false);
    pmax = fmaxf(__uint_as_float(rr[0]), __uint_as_float(rr[1])); }
  if (__builtin_expect(__all(pmax - m_reg <= THR / SCALE), 1)) { mn = m_reg; alpha = 1.f; }
  else { mn = fmaxf(m_reg, pmax); alpha = __builtin_amdgcn_exp2f((m_reg - mn) * C); m_reg = mn; }
  float mnC = -mn * C;
#pragma unroll
  for (int r = 0; r < 16; ++r) p0[r] = fmaf(p0[r], C, mnC);
#pragma unroll
  for (int r = 0; r < 16; ++r) p1[r] = fmaf(p1[r], C, mnC);
#pragma unroll
  for (int r = 0; r < 16; ++r) p0[r] = __builtin_amdgcn_exp2f(p0[r]);
}
__device__ __forceinline__ void finishSM(f32x16& p0, f32x16& p1, float alpha, float& l_reg, bf16x8& pa0, bf16x8& pa1, bf16x8& pa2, bf16x8& pa3) {
#pragma unroll
  for (int r = 0; r < 16; ++r) p1[r] = __builtin_amdgcn_exp2f(p1[r]);
  float ps = 0;
#pragma unroll
  for (int r = 0; r < 16; ++r) ps += p0[r];
#pragma unroll
  for (int r = 0; r < 16; ++r) ps += p1[r];
  { auto rr = __builtin_amdgcn_permlane32_swap(__float_as_uint(ps), __float_as_uint(ps), false, false);
    ps = __uint_as_float(rr[0]) + __uint_as_float(rr[1]); }
  l_reg = l_reg * alpha + ps;
#define PK4(P, BASE, OUT) do { unsigned a0 = cvtpk(P[BASE + 0], P[BASE + 1]), a1 = cvtpk(P[BASE + 2], P[BASE + 3]);   \
    unsigned b0 = cvtpk(P[BASE + 4], P[BASE + 5]), b1 = cvtpk(P[BASE + 6], P[BASE + 7]);                              \
    auto r0 = __builtin_amdgcn_permlane32_swap(a0, b0, false, false); auto r1 = __builtin_amdgcn_permlane32_swap(a1, b1, false, false); \
    u32x4 w = {r0[0], r1[0], r0[1], r1[1]}; OUT = *reinterpret_cast<bf16x8*>(&w); } while (0)
  PK4(p0, 0, pa0); PK4(p0, 8, pa1); PK4(p1, 0, pa2); PK4(p1, 8, pa3);
#undef PK4
}
__device__ __forceinline__ void qkt(f32x16& p0, f32x16& p1, const bf16_t* Ks, const bf16x8* qr, int r32, int hi, int mp) {
  p0 = f32x16{}; p1 = f32x16{};
#pragma unroll
  for (int d0 = 0; d0 < 4; ++d0) { int cb = (mp * 64 + d0 * 16 + hi * 8) * 2;
    bf16x8 b0 = *reinterpret_cast<const bf16x8*>((const char*)Ks + KSWZ(r32, cb));
    bf16x8 b1 = *reinterpret_cast<const bf16x8*>((const char*)Ks + KSWZ(32 + r32, cb));
    p0 = __builtin_amdgcn_mfma_f32_32x32x16_bf16(b0, qr[d0], p0, 0, 0, 0);
    p1 = __builtin_amdgcn_mfma_f32_32x32x16_bf16(b1, qr[d0], p1, 0, 0, 0); }
}
__device__ __forceinline__ int v_st(int k, int c) { const int kk = (k & ~0xC) | ((k & 4) << 1) | ((k & 8) >> 1); return ((kk >> 3) * 4 + (c >> 5)) * 512 + ((kk & 7) * 32 + (c & 31)) * 2; }
__device__ __forceinline__ int v_rd_base(int lane) { return ((lane & 3) << 3) | (((lane >> 2) & 3) << 6) | (((lane >> 4) & 1) << 5) | (((lane >> 5) & 1) << 8); }
constexpr int v_rd_off(int d0, int ks, int half) { return d0 * 512 + ks * 4096 + half * 2048; }
template <int OFF> __device__ __forceinline__ s16x4 tr_read(int vb) {
  s16x4 r; asm volatile("ds_read_b64_tr_b16 %0, %1 offset:%2" : "=&v"(r) : "v"(vb), "i"(OFF) : "memory"); return r;
}
template <int D0> __device__ __forceinline__ void pv_one(f32x16& od, int vb, bf16x8 pa0, bf16x8 pa1, bf16x8 pa2, bf16x8 pa3) {
  const s16x4 l0 = tr_read<v_rd_off(D0, 0, 0)>(vb), h0 = tr_read<v_rd_off(D0, 0, 1)>(vb), l1 = tr_read<v_rd_off(D0, 1, 0)>(vb), h1 = tr_read<v_rd_off(D0, 1, 1)>(vb);
  const s16x4 l2 = tr_read<v_rd_off(D0, 2, 0)>(vb), h2 = tr_read<v_rd_off(D0, 2, 1)>(vb), l3 = tr_read<v_rd_off(D0, 3, 0)>(vb), h3 = tr_read<v_rd_off(D0, 3, 1)>(vb);
  asm volatile("s_waitcnt lgkmcnt(0)" ::: "memory"); SBAR();
#define PK(L, H) (bf16x8){L[0], L[1], L[2], L[3], H[0], H[1], H[2], H[3]}
  od = __builtin_amdgcn_mfma_f32_32x32x16_bf16(pa0, PK(l0, h0), od, 0, 0, 0);
  od = __builtin_amdgcn_mfma_f32_32x32x16_bf16(pa1, PK(l1, h1), od, 0, 0, 0);
  od = __builtin_amdgcn_mfma_f32_32x32x16_bf16(pa2, PK(l2, h2), od, 0, 0, 0);
  od = __builtin_amdgcn_mfma_f32_32x32x16_bf16(pa3, PK(l3, h3), od, 0, 0, 0);
#undef PK
}
__device__ __forceinline__ void pv_d0(f32x16* o, int vb, bf16x8 pa0, bf16x8 pa1, bf16x8 pa2, bf16x8 pa3) {
  pv_one<0>(o[0], vb, pa0, pa1, pa2, pa3); pv_one<1>(o[1], vb, pa0, pa1, pa2, pa3); pv_one<2>(o[2], vb, pa0, pa1, pa2, pa3); pv_one<3>(o[3], vb, pa0, pa1, pa2, pa3);
}

__device__ __forceinline__ void attn_unit(const bf16_t* __restrict__ Qb, const bf16_t* __restrict__ Kh, const bf16_t* __restrict__ Vh, bf16_t* __restrict__ Ob,
                                          const float* __restrict__ gd, float lam, int seq, char* lds) {
  const int tid = otid(), wid = tid >> 6, lane = tid & 63, r32 = lane & 31, hi = lane >> 5;
  const int qw = wid & 3, mp = wid >> 2;
  bf16_t* V_lds = (bf16_t*)lds; bf16_t* K_lds = (bf16_t*)(lds + 2 * SHM_V);
  float* wsf = (float*)(lds + 2 * SHM_V + 2 * SHM_K) + wid * 64; float* li_l = wsf; float* al_l = wsf + 32;
  float m_reg = -1e30f, l_reg = 0; f32x16 o[4] = {}; bf16x8 qr[4];
  const bf16_t* Qw = Qb + (long)(qw * QBLK + r32) * LD + mp * 64 + hi * 8;
#pragma unroll
  for (int d0 = 0; d0 < 4; ++d0) qr[d0] = *reinterpret_cast<const bf16x8*>(Qw + d0 * 16);
  const int sr = tid >> 4, sc = (tid & 15) * 8, vst0 = v_st(sr, sc), vst1 = v_st(32 + sr, sc);
  const int vb0 = (int)(uintptr_t)V_lds + v_rd_base(lane);
  struct { bf16x8 vs0, vs1, ks0, ks1; } sr_[2];
#define SLOAD(i, k0) do { sr_[i].vs0 = *reinterpret_cast<const bf16x8*>(&Vh[(long)((k0) + sr) * LD + sc]); sr_[i].vs1 = *reinterpret_cast<const bf16x8*>(&Vh[(long)((k0) + 32 + sr) * LD + sc]); \
    sr_[i].ks0 = *reinterpret_cast<const bf16x8*>(&Kh[(long)((k0) + sr) * LD + sc]); sr_[i].ks1 = *reinterpret_cast<const bf16x8*>(&Kh[(long)((k0) + 32 + sr) * LD + sc]); } while (0)
#define SWRITE(b, i) do { *(bf16x8*)((char*)V_lds + (b) * SHM_V + vst0) = sr_[i].vs0;          \
    *(bf16x8*)((char*)V_lds + (b) * SHM_V + vst1) = sr_[i].vs1; int kc = sc * 2;               \
    *(bf16x8*)((char*)K_lds + (b) * SHM_K + KSWZ(sr, kc)) = sr_[i].ks0;                       \
    *(bf16x8*)((char*)K_lds + (b) * SHM_K + KSWZ(32 + sr, kc)) = sr_[i].ks1; } while (0)
#define SWAIT() asm volatile("s_waitcnt vmcnt(4)" ::: "memory")
#define RESC(a) do { if (__any((a) < 1.f)) { if (hi == 0) al_l[r32] = (a); asm volatile("s_waitcnt lgkmcnt(0)" ::: "memory"); \
    _Pragma("unroll") for (int d = 0; d < 4; ++d) _Pragma("unroll") for (int r = 0; r < 16; ++r) o[d][r] *= al_l[crow(r, hi)]; } } while (0)
  f32x16 pA0, pA1, pB0, pB1; float mnA, mnB, alA, alB; bf16x8 pa0, pa1, pa2, pa3; const int NT = seq / KVBLK;
  constexpr int SE = 0, SO = 1;
  SLOAD(SE, 0); asm volatile("s_waitcnt vmcnt(0)" ::: "memory"); SWRITE(0, SE); __syncthreads();
  qkt(pA0, pA1, K_lds, qr, r32, hi, mp); partialSM(pA0, pA1, m_reg, mnA, alA);
  SLOAD(SO, KVBLK); if (2 < NT) SLOAD(SE, 2 * KVBLK);
  SWAIT(); SWRITE(1, SO); __syncthreads();
  for (int j = 1; j + 1 < NT; j += 2) {
    SBAR(); qkt(pB0, pB1, (bf16_t*)((char*)K_lds + SHM_K), qr, r32, hi, mp);
    finishSM(pA0, pA1, alA, l_reg, pa0, pa1, pa2, pa3); SBAR();
    SLOAD(SO, (j + 2) * KVBLK); SBAR();
    pv_d0(o, vb0, pa0, pa1, pa2, pa3); partialSM(pB0, pB1, m_reg, mnB, alB);
    __syncthreads(); SWAIT(); SWRITE(0, SE);
    RESC(alB); __syncthreads();
    SBAR(); qkt(pA0, pA1, K_lds, qr, r32, hi, mp);
    finishSM(pB0, pB1, alB, l_reg, pa0, pa1, pa2, pa3); SBAR();
    if (j + 3 < NT) SLOAD(SE, (j + 3) * KVBLK); SBAR();
    pv_d0(o, vb0 + (int)SHM_V, pa0, pa1, pa2, pa3); partialSM(pA0, pA1, m_reg, mnA, alA);
    __syncthreads(); SWAIT(); SWRITE(1, SO);
    RESC(alA); __syncthreads();
  }
  SBAR(); qkt(pB0, pB1, (bf16_t*)((char*)K_lds + SHM_K), qr, r32, hi, mp);
  finishSM(pA0, pA1, alA, l_reg, pa0, pa1, pa2, pa3); SBAR();
  pv_d0(o, vb0, pa0, pa1, pa2, pa3); partialSM(pB0, pB1, m_reg, mnB, alB);
  __syncthreads(); RESC(alB);
  finishSM(pB0, pB1, alB, l_reg, pa0, pa1, pa2, pa3); SBAR();
  pv_d0(o, vb0 + (int)SHM_V, pa0, pa1, pa2, pa3);
  if (hi == 0) li_l[r32] = l_reg; asm volatile("s_waitcnt lgkmcnt(0)" ::: "memory");
  float rli[16];
#pragma unroll
  for (int r = 0; r < 16; ++r) rli[r] = __builtin_amdgcn_rcpf(li_l[crow(r, hi)]);
  __syncthreads();
  float* xch = (float*)lds + qw * 4096 + lane;
  if (mp == 1) {
#pragma unroll
    for (int r = 0; r < 16; ++r)
#pragma unroll
      for (int d0 = 0; d0 < 4; ++d0) xch[(r * 4 + d0) * 64] = o[d0][r] * rli[r] * lam;
  }
  __syncthreads();
  if (mp == 0) {
    float gv[4];
#pragma unroll
    for (int d0 = 0; d0 < 4; ++d0) gv[d0] = gd[d0 * 32 + r32] * (1.0f - LAM_INIT);
#pragma unroll
    for (int r = 0; r < 16; ++r) {
      float dv[4]; float ss = 0.f;
#pragma unroll
      for (int d0 = 0; d0 < 4; ++d0) { dv[d0] = o[d0][r] * rli[r] - xch[(r * 4 + d0) * 64]; ss += dv[d0] * dv[d0]; }
      ss += __shfl_xor(ss, 1); ss += __shfl_xor(ss, 2); ss += __shfl_xor(ss, 4); ss += __shfl_xor(ss, 8); ss += __shfl_xor(ss, 16);
      const float rstd = rsqrtf(ss * (1.0f / 128.0f) + EPS);
      bf16_t* orow = Ob + (long)(qw * QBLK + crow(r, hi)) * LD + r32;
#pragma unroll
      for (int d0 = 0; d0 < 4; ++d0) orow[d0 * 32] = (bf16_t)(cvtpk(dv[d0] * rstd * gv[d0], 0.f) & 0xffffu);
    }
  }
  __syncthreads();
#undef SLOAD
#undef SWRITE
#undef SWAIT
#undef RESC
}
#undef KSWZ
#undef SBAR
}

__device__ __forceinline__ float log_sigmoidf_(float x) { return x >= 0.f ? -log1pf(__expf(-x)) : x - log1pf(__expf(x)); }

__device__ __forceinline__ int perm32(int rho) { const int n = rho >> 4, i = rho & 15; return 8 * (i >> 2) + 4 * n + (i & 3); }
__device__ __forceinline__ void transpose_item(const float* __restrict__ W, int ldw, int scol0, bf16_t* WTrow0, int k0, LAS float* scr, int lane, bool perm) {
#pragma unroll 8
    for (int i = 0; i < 32; ++i) { const int kk = 2 * i + (lane >> 5); scr[kk * 33 + (lane & 31)] = W[(size_t)(k0 + kk) * ldw + scol0 + (lane & 31)]; }
    LDS_WAIT(); asm volatile("" ::: "memory");
    const int c = lane & 7;
#pragma unroll
    for (int j = 0; j < 4; ++j) { const int n = (lane >> 3) + 8 * j; const LAS float* s = scr + (8 * c) * 33 + (perm ? perm32(n) : n);
        u32x4 o; o.x = cvt_pk_bf16(s[0 * 33], s[1 * 33]); o.y = cvt_pk_bf16(s[2 * 33], s[3 * 33]); o.z = cvt_pk_bf16(s[4 * 33], s[5 * 33]); o.w = cvt_pk_bf16(s[6 * 33], s[7 * 33]);
        *(u32x4*)(WTrow0 + (size_t)n * 1024 + k0 + 8 * c) = o; }
    LDS_WAIT(); asm volatile("" ::: "memory");
}

__device__ __forceinline__ void transpose_item8(const float* __restrict__ W, int ldw, int scol0, unsigned char* WTrow0, int k0, LAS float* scr, int lane, float scale) {
#pragma unroll 8
    for (int i = 0; i < 32; ++i) { const int kk = 2 * i + (lane >> 5); scr[kk * 33 + (lane & 31)] = W[(size_t)(k0 + kk) * ldw + scol0 + (lane & 31)]; }
    LDS_WAIT(); asm volatile("" ::: "memory");
    const int c = lane & 7;
#pragma unroll
    for (int j = 0; j < 4; ++j) { const int n = (lane >> 3) + 8 * j; const LAS float* s = scr + (8 * c) * 33 + perm32(n);
        u32x2 o; o.x = pk4_fp8(s[0 * 33] * scale, s[1 * 33] * scale, s[2 * 33] * scale, s[3 * 33] * scale); o.y = pk4_fp8(s[4 * 33] * scale, s[5 * 33] * scale, s[6 * 33] * scale, s[7 * 33] * scale);
        *(u32x2*)(WTrow0 + (size_t)n * 1024 + k0 + 8 * c) = o; }
    LDS_WAIT(); asm volatile("" ::: "memory");
}

__device__ __forceinline__ void phase_prep(const Params& p, LAS unsigned char* lds, int G) {
    const int tid = otid(), lane = tid & 63, wave = __builtin_amdgcn_readfirstlane(tid >> 6);
    const int gw = blockIdx.x * 8 + wave, NGW = G * 8;
    LAS float* sl = (LAS float*)(lds + 73728);
    for (int i = tid; i < 9 * 1024; i += NTHREADS) { const float v = i < 8192 ? p.c[i] : p.c_ctx[i - 8192]; sl[i] = v / (1.0f + __expf(-v)); }
    __syncthreads();
    float* mod = (float*)(p.ws + WS_MOD);
    if (gw < 384) {
        const int c0 = gw * 16, col = lane & 15, kq = lane >> 4;
        float acc[9];
#pragma unroll
        for (int v = 0; v < 9; ++v) acc[v] = 0.f;
        const float* wp = p.ada_w + (size_t)(kq * 256) * 6144 + c0 + col;
#pragma unroll 8
        for (int i = 0; i < 256; ++i) { const float w = wp[(size_t)i * 6144];
#pragma unroll
            for (int v = 0; v < 9; ++v) acc[v] += sl[v * 1024 + kq * 256 + i] * w; }
#pragma unroll
        for (int v = 0; v < 9; ++v) { acc[v] += __shfl_xor(acc[v], 16); acc[v] += __shfl_xor(acc[v], 32); }
        if (lane < 16) { const float b = p.ada_b[c0 + col];
#pragma unroll
            for (int v = 0; v < 9; ++v) mod[v * 6144 + c0 + col] = acc[v] + b; }
    }
    if (blockIdx.x == 0 && wave == 0) {
        const float s01 = wave_sum(p.dlam[lane] * p.dlam[64 + lane]), s23 = wave_sum(p.dlam[128 + lane] * p.dlam[192 + lane]);
        if (lane == 0) *(float*)(p.ws + WS_LAM) = expf(s01) - expf(s23) + LAM_INIT;
    }
    if (blockIdx.x == 1 && wave == 0 && lane < 16) {
        double th = 1.0; for (int j = 0; j < lane; ++j) th *= 0.5623413251903491;
        double ct = 1.0, st = th, term_c = 1.0, term_s = th; const double t2 = th * th;
        for (int n = 1; n < 14; ++n) { term_c *= -t2 / ((2.0 * n - 1.0) * (2.0 * n)); term_s *= -t2 / ((2.0 * n) * (2.0 * n + 1.0)); ct += term_c; st += term_s; }
        float* rc = (float*)(p.ws + WS_ROPE); float* rs = rc + 1024;
        double cc = 1.0, ss = 0.0;
        for (int pos = 0; pos < 64; ++pos) { rc[pos * 16 + lane] = (float)cc; rs[pos * 16 + lane] = (float)ss; const double c2 = cc * ct - ss * st, s2 = ss * ct + cc * st; cc = c2; ss = s2; }
    }
    LAS float* scr = (LAS float*)(lds + wave * 8448);
    bf16_t* WIN = (bf16_t*)(p.ws + WS_WIN);
    constexpr int I_IN = 16 * 256, I_SQ = 16 * 32, I_W1 = 32 * 16 * 64, I_W2 = 32 * 16 * 32, NITEMS = I_IN + 3 * I_SQ + I_W1 + I_W2;
    for (int it = gw; it < NITEMS; it += NGW) {
        int r = it;
        if (r < I_IN) { const int kb = r >> 8, nb = r & 255, n0 = nb * 32; transpose_item(p.w_in, INCOLS, n0 < 2048 ? n0 : n0 + 16, WIN + (size_t)n0 * 1024, kb * 64, scr, lane, !(n0 >= 3072 && n0 < 5120)); continue; } r -= I_IN;
        if (r < 3 * I_SQ) { const int w = r / I_SQ, r2 = r % I_SQ, kb = r2 >> 5, nb = r2 & 31; const float* W = w == 0 ? p.w_a : (w == 1 ? p.w_b : p.w_o);
            bf16_t* WT = (bf16_t*)(p.ws + (w == 0 ? WS_WA : (w == 1 ? WS_WB : WS_WO))); transpose_item(W, 1024, nb * 32, WT + (size_t)nb * 32 * 1024, kb * 64, scr, lane, true); continue; } r -= 3 * I_SQ;
        if (r < I_W1) { const int e = r >> 10, r2 = r & 1023, kb = r2 >> 6, g = r2 & 63, pn = g >> 3, bj = (g >> 2) & 1, q = g & 3;
            transpose_item8(p.exp_w1 + (size_t)e * 1024 * 2048, 2048, bj * 1024 + 128 * pn + 32 * q, p.ws + WS_W1 + ((size_t)e * 2048 + 32 * g) * 1024, kb * 64, scr, lane, 64.0f); continue; } r -= I_W1;
        { const int e = r >> 9, r2 = r & 511, kb = r2 >> 5, nb = r2 & 31;
            transpose_item8(p.exp_w2 + (size_t)e * 1024 * 1024, 1024, nb * 32, p.ws + WS_W2 + ((size_t)e * 1024 + 32 * nb) * 1024, kb * 64, scr, lane, 64.0f); }
    }
}

__device__ __forceinline__ void phase_rows1(const Params& p, LAS unsigned char* lds, int G) {
    const int tid = otid(), lane = tid & 63, wave = __builtin_amdgcn_readfirstlane(tid >> 6);
    const int gw = blockIdx.x * 8 + wave, NGW = G * 8;
    LAS float* wg = (LAS float*)lds;
    for (int i = tid; i < 16 * 1024; i += NTHREADS) { const int k = i >> 4, g = i & 15; wg[g * 1024 + k] = p.w_in[(size_t)k * INCOLS + 2048 + g]; }
    __syncthreads();
    const float* mod = (const float*)(p.ws + WS_MOD); bf16_t* U = (bf16_t*)(p.ws + WS_U); float* GT = (float*)(p.ws + WS_GT);
    f32x4 gn[4];
#pragma unroll
    for (int j = 0; j < 4; ++j) gn[j] = *(const f32x4*)(p.norm1_g + 4 * lane + 256 * j);
    for (int m = gw; m < TT; m += NGW) {
        const float* xr = m < TL ? p.x + (size_t)m * 1024 : p.ctx + (size_t)(m - TL) * 1024;
        const float* md = mod + (size_t)(m < TL ? (m >> 12) : 8) * 6144;
        f32x4 v[4]; float ss = 0.f;
#pragma unroll
        for (int j = 0; j < 4; ++j) { v[j] = *(const f32x4*)(xr + 4 * lane + 256 * j); ss += (v[j][0] * v[j][0] + v[j][1] * v[j][1]) + (v[j][2] * v[j][2] + v[j][3] * v[j][3]); }
        const float rstd = rsqrtf(wave_sum(ss) * (1.0f / 1024.0f) + EPS);
#pragma unroll
        for (int j = 0; j < 4; ++j) { const f32x4 sh = *(const f32x4*)(md + 4 * lane + 256 * j), sc = *(const f32x4*)(md + 1024 + 4 * lane + 256 * j);
            v[j] = (v[j] * rstd * gn[j]) * (sc + 1.0f) + sh;
            u32x2 w; w.x = cvt_pk_bf16(v[j][0], v[j][1]); w.y = cvt_pk_bf16(v[j][2], v[j][3]); *(u32x2*)(U + (size_t)m * 1024 + 4 * lane + 256 * j) = w; }
        float val = 0.f;
#pragma unroll
        for (int g = 0; g < 16; ++g) { float a = 0.f;
#pragma unroll
            for (int j = 0; j < 4; ++j) { const f32x4 w = *(const LAS f32x4*)(wg + g * 1024 + 4 * lane + 256 * j); a += (v[j][0] * w[0] + v[j][1] * w[1]) + (v[j][2] * w[2] + v[j][3] * w[3]); }
            a = wave_sum(a); val = (lane == g) ? a : val; asm volatile("" ::: "memory"); }
        if (lane < 16) {
            val += p.gate_b[lane]; const int type = lane >> 2; if (type & 1) val = log_sigmoidf_(val);
            GT[(size_t)m * 16 + lane] = val; }
    }
}

__device__ __forceinline__ void phase_mlstm_naive(const Params& p, LAS unsigned char* lds_, int item) {
    const int tid = otid(); float* lds = (float*)(unsigned char*)lds_;
    const int dvh = item & 1, dir = (item >> 1) & 1, h = (item >> 2) & 3, b = item >> 4;
    const int dvl = tid >> 2, kq = tid & 3;
    float* Ks = lds; float* Qs = lds + 4096; float* Vs = lds + 8192; float* gi = lds + 12288; float* gf = gi + 32;
    const bf16_t* MQ = (const bf16_t*)(p.ws + WS_MQ); const bf16_t* MK = (const bf16_t*)(p.ws + WS_MK); const bf16_t* MV = (const bf16_t*)(p.ws + WS_MV);
    const float* GT = (const float*)(p.ws + WS_GT); bf16_t* H = (bf16_t*)(p.ws + (dir ? WS_HB : WS_HF));
    float C[32], nn[32];
#pragma unroll
    for (int r = 0; r < 32; ++r) { C[r] = 0.f; nn[r] = 0.f; }
    for (int s0 = 0; s0 < KVLEN; s0 += 32) {
        const bool latent = s0 >= CTX;
        __syncthreads();
        {
            const int j = tid >> 4, c8 = (tid & 15) * 8; const int s = s0 + j;
            const int m = latent ? b * SEQ + (dir ? SEQ - 1 - (s - CTX) : s - CTX) : TL + b * CTX + (dir ? CTX - 1 - s : s);
            const bf16x8 kv = *(const bf16x8*)(MK + (size_t)m * 512 + h * 128 + c8);
            const bf16x8 vv = *(const bf16x8*)(MV + (size_t)m * 1024 + h * 256 + dvh * 128 + c8);
#pragma unroll
            for (int i = 0; i < 8; ++i) { Ks[j * 128 + c8 + i] = bf2f((bf16_t)kv[i]); Vs[j * 128 + c8 + i] = bf2f((bf16_t)vv[i]); }
            if (latent) { const bf16x8 qv = *(const bf16x8*)(MQ + (size_t)m * 512 + h * 128 + c8);
#pragma unroll
                for (int i = 0; i < 8; ++i) Qs[j * 128 + c8 + i] = bf2f((bf16_t)qv[i]); }
            if ((tid & 15) == 0) { gi[j] = GT[(size_t)m * 16 + dir * 8 + h]; gf[j] = GT[(size_t)m * 16 + dir * 8 + 4 + h]; }
        }
        __syncthreads();
        for (int j = 0; j < 32; ++j) {
            const float f = __expf(gf[j]), ig = __expf(gi[j]); const float v = Vs[j * 128 + dvl];
            float num = 0.f, den = 0.f;
            const f32x4* kp = (const f32x4*)(Ks + j * 128 + kq * 32); const f32x4* qp = (const f32x4*)(Qs + j * 128 + kq * 32);
#pragma unroll
            for (int r4 = 0; r4 < 8; ++r4) { const f32x4 k4 = kp[r4]; f32x4 q4 = {0.f, 0.f, 0.f, 0.f}; if (latent) q4 = qp[r4];
#pragma unroll
                for (int i = 0; i < 4; ++i) { const int r = r4 * 4 + i; const float ik = ig * k4[i]; C[r] = f * C[r] + ik * v; nn[r] = f * nn[r] + ik; num += q4[i] * C[r]; den += q4[i] * nn[r]; } }
            if (latent) {
                num += __shfl_xor(num, 1); num += __shfl_xor(num, 2); den += __shfl_xor(den, 1); den += __shfl_xor(den, 2);
                if (kq == 0) { const int s = s0 + j; const int m = b * SEQ + (dir ? SEQ - 1 - (s - CTX) : s - CTX);
                    const float hv = num / fmaxf(fabsf(den), 1.0f);
                    H[(size_t)m * 1024 + h * 256 + dvh * 128 + dvl] = (bf16_t)(cvt_pk_bf16(hv, 0.f) & 0xffffu); }
            }
        }
    }
    __syncthreads();
}

namespace mls {
#define KSWZ(row, colB) ((row) * 256 + ((colB) ^ (((row) & 7) << 4)))
#define SBAR() __builtin_amdgcn_sched_barrier(0)
using att::crow; using att::cvtpk; using att::v_st; using att::v_rd_base; using att::v_rd_off; using att::tr_read;
constexpr int L_KSW = 0, L_KV = 32768, L_V = 65536, L_CT = 98304, L_F = 114688;
__device__ __forceinline__ float swap_add(float v) { auto rr = __builtin_amdgcn_permlane32_swap(__float_as_uint(v), __float_as_uint(v), false, false); return __uint_as_float(rr[0]) + __uint_as_float(rr[1]); }
#define TRPK(L, H) (bf16x8){L[0], L[1], L[2], L[3], H[0], H[1], H[2], H[3]}
__device__ __forceinline__ void mlstm_item(const Params& p, LAS unsigned char* lds_, int item) {
    char* lds = (char*)(unsigned char*)lds_;
    const int tid = otid(), wid = __builtin_amdgcn_readfirstlane(tid >> 6), lane = tid & 63, r32 = lane & 31, hi = lane >> 5;
    const int dvq = item & 3, dir = (item >> 2) & 1, h = (item >> 3) & 3, b = item >> 5;
    const int rb = wid & 3, vh = wid >> 2;
    float* fa = (float*)(lds + L_F); float* a_ = fa; float* bco = fa + 128; float* w_ = fa + 256; float* wint = fa + 384; float* nvec = fa + 512; float* npart = fa + 640; float* denl = fa + 1152 + wid * 32; float* gsc = fa + 1408;
    const bf16_t* MQ = (const bf16_t*)(p.ws + WS_MQ); const bf16_t* MK = (const bf16_t*)(p.ws + WS_MK); const bf16_t* MV = (const bf16_t*)(p.ws + WS_MV);
    const float* GT = (const float*)(p.ws + WS_GT); bf16_t* H = (bf16_t*)(p.ws + (dir ? WS_HB : WS_HF));
    f32x16 Cacc = {};
    { u32x4 z = {0u, 0u, 0u, 0u}; *(u32x4*)(lds + L_CT + tid * 32) = z; *(u32x4*)(lds + L_CT + tid * 32 + 16) = z; if (tid < 128) nvec[tid] = 0.f; }
    const int tid_outer = tid;
    bf16x8 kreg[4], vreg[2], qnx[8]; float gi0 = 0.f, glf0 = 0.f, gi1 = 0.f, glf1 = 0.f;
#define MROW0(cc_) ((cc_) >= 2 ? b * SEQ + (dir ? 33 - (cc_) : (cc_) - 2) * 128 : TL + b * CTX + (dir ? 1 - (cc_) : (cc_)) * 128)
#define LOADS(cn_, T_) do { const int mr_ = MROW0(cn_); const int ln_ = (T_) & 63; \
        _Pragma("unroll") for (int i = 0; i < 4; ++i) { const int pc = (T_) + 512 * i, pr = pc >> 4, c8 = (pc & 15) * 8; kreg[i] = *(const bf16x8*)(MK + (size_t)(mr_ + (dir ? 127 - pr : pr)) * 512 + h * 128 + c8); } \
        _Pragma("unroll") for (int i = 0; i < 2; ++i) { const int pc = (T_) + 512 * i, pr = pc >> 3, c8 = (pc & 7) * 8; vreg[i] = *(const bf16x8*)(MV + (size_t)(mr_ + (dir ? 127 - pr : pr)) * 1024 + h * 256 + dvq * 64 + c8); } \
        if ((cn_) >= 2) { const int pr = rb * 32 + (ln_ & 31); const bf16_t* qp = MQ + (size_t)(mr_ + (dir ? 127 - pr : pr)) * 512 + h * 128 + (ln_ >> 5) * 8; \
            _Pragma("unroll") for (int d0 = 0; d0 < 8; ++d0) qnx[d0] = *(const bf16x8*)(qp + d0 * 16); } \
        else { _Pragma("unroll") for (int d0 = 0; d0 < 8; ++d0) qnx[d0] = bf16x8{}; } \
        if (wid == 0) { const int p0 = 2 * ln_, p1 = 2 * ln_ + 1; const size_t m0 = (size_t)(mr_ + (dir ? 127 - p0 : p0)) * 16, m1 = (size_t)(mr_ + (dir ? 127 - p1 : p1)) * 16; \
            gi0 = GT[m0 + dir * 8 + h]; glf0 = GT[m0 + dir * 8 + 4 + h]; gi1 = GT[m1 + dir * 8 + h]; glf1 = GT[m1 + dir * 8 + 4 + h]; } } while (0)
    LOADS(0, tid_outer);
    for (int c = 0; c < 34; ++c) {
        int tid = tid_outer; asm volatile("" : "+v"(tid));
        const int lane = tid & 63, r32 = lane & 31, hi = lane >> 5;
        const int vbV = (int)(uintptr_t)(lds + L_V) + v_rd_base(lane), vbK = (int)(uintptr_t)(lds + L_KV) + v_rd_base(lane);
        const bool latent = c >= 2;
        const int mrow0 = MROW0(c);
        bf16x8 qr[8];
        if (wid == 0) {
            const int p0 = 2 * lane, p1 = 2 * lane + 1;
            const float i0 = gi0, lf0 = glf0, i1 = gi1, lf1 = glf1;
            float incl = lf0 + lf1;
#pragma unroll
            for (int o = 1; o < 64; o <<= 1) { const float t = __shfl_up(incl, o); if (lane >= o) incl += t; }
            const float F1 = incl, F0 = incl - lf1, Ftot = __shfl(incl, 63);
            a_[p0] = F0; a_[p1] = F1; bco[p0] = i0 - F0; bco[p1] = i1 - F1; wint[p0] = __expf(F0); wint[p1] = __expf(F1);
            w_[p0] = __expf(Ftot - F0 + i0); w_[p1] = __expf(Ftot - F1 + i1); if (lane == 0) gsc[0] = __expf(Ftot);
        }
        __syncthreads();
#pragma unroll
        for (int i = 0; i < 4; ++i) { const int pc = tid + 512 * i, pr = pc >> 4, c8 = (pc & 15) * 8;
            *(bf16x8*)(lds + L_KSW + KSWZ(pr, c8 * 2)) = kreg[i]; *(bf16x8*)(lds + L_KV + (pr >> 6) * 16384 + v_st(pr & 63, c8)) = kreg[i]; }
#pragma unroll
        for (int i = 0; i < 2; ++i) { const int pc = tid + 512 * i, pr = pc >> 3, c8 = (pc & 7) * 8; const float ws_ = w_[pr];
            *(bf16x8*)(lds + L_V + (pr >> 6) * 16384 + v_st(pr & 63, c8)) = vreg[i];
            u32x4 sv; const u32x4 raw = *reinterpret_cast<const u32x4*>(&vreg[i]);
            sv.x = cvtpk(bf_lo(raw.x) * ws_, bf_hi(raw.x) * ws_); sv.y = cvtpk(bf_lo(raw.y) * ws_, bf_hi(raw.y) * ws_); sv.z = cvtpk(bf_lo(raw.z) * ws_, bf_hi(raw.z) * ws_); sv.w = cvtpk(bf_lo(raw.w) * ws_, bf_hi(raw.w) * ws_);
            *(u32x4*)(lds + L_V + (pr >> 6) * 16384 + v_st(pr & 63, 64 + c8)) = sv; }
#pragma unroll
        for (int d0 = 0; d0 < 8; ++d0) qr[d0] = qnx[d0];
        __syncthreads();
        if (c + 1 < 34) LOADS(c + 1, tid);
        const float g = gsc[0];
        if (latent) {
            const int qidx = rb * 32 + r32;
            float qn = 0.f;
#pragma unroll
            for (int d0 = 0; d0 < 8; ++d0) { const f32x4 n0 = *(const f32x4*)(nvec + d0 * 16 + hi * 8), n1 = *(const f32x4*)(nvec + d0 * 16 + hi * 8 + 4); const u32x4 q4 = *reinterpret_cast<const u32x4*>(&qr[d0]);
                qn += bf_lo(q4.x) * n0[0] + bf_hi(q4.x) * n0[1] + bf_lo(q4.y) * n0[2] + bf_hi(q4.y) * n0[3] + bf_lo(q4.z) * n1[0] + bf_hi(q4.z) * n1[1] + bf_lo(q4.w) * n1[2] + bf_hi(q4.w) * n1[3]; }
            qn = swap_add(qn);
            f32x16 o = {};
#pragma unroll
            for (int d0 = 0; d0 < 8; ++d0) { const bf16x8 cf = *(const bf16x8*)(lds + L_CT + KSWZ(32 * vh + r32, (d0 * 16 + hi * 8) * 2)); o = __builtin_amdgcn_mfma_f32_32x32x16_bf16(qr[d0], cf, o, 0, 0, 0); }
#pragma unroll
            for (int g4 = 0; g4 < 4; ++g4) { const f32x4 wi = *(const f32x4*)(wint + rb * 32 + 8 * g4 + 4 * hi);
#pragma unroll
                for (int i = 0; i < 4; ++i) o[g4 * 4 + i] *= wi[i]; }
            const float aq = a_[qidx]; float den = 0.f;
            for (int jt = 0; jt <= (rb >> 1); ++jt) {
                f32x16 p0 = {}, p1 = {};
#pragma unroll
                for (int d0 = 0; d0 < 8; ++d0) { const int cbb = (d0 * 16 + hi * 8) * 2;
                    const bf16x8 b0 = *(const bf16x8*)(lds + L_KSW + KSWZ(64 * jt + r32, cbb)), b1 = *(const bf16x8*)(lds + L_KSW + KSWZ(64 * jt + 32 + r32, cbb));
                    p0 = __builtin_amdgcn_mfma_f32_32x32x16_bf16(b0, qr[d0], p0, 0, 0, 0); p1 = __builtin_amdgcn_mfma_f32_32x32x16_bf16(b1, qr[d0], p1, 0, 0, 0); }
                float ps = 0.f;
#pragma unroll
                for (int g4 = 0; g4 < 4; ++g4) { const int k0 = 64 * jt + 8 * g4 + 4 * hi; const f32x4 bb0 = *(const f32x4*)(bco + k0), bb1 = *(const f32x4*)(bco + k0 + 32);
#pragma unroll
                    for (int i = 0; i < 4; ++i) { const int r = g4 * 4 + i;
                        const float e0 = __expf(aq + bb0[i]), e1 = __expf(aq + bb1[i]);
                        p0[r] = (k0 + i <= qidx) ? p0[r] * e0 : 0.f; p1[r] = (k0 + 32 + i <= qidx) ? p1[r] * e1 : 0.f; ps += p0[r] + p1[r]; } }
                den += swap_add(ps);
                bf16x8 pa0, pa1, pa2, pa3;
#define PK4(P, BASE, OUT) do { unsigned a0 = cvtpk(P[BASE + 0], P[BASE + 1]), a1 = cvtpk(P[BASE + 2], P[BASE + 3]);   \
    unsigned b0_ = cvtpk(P[BASE + 4], P[BASE + 5]), b1_ = cvtpk(P[BASE + 6], P[BASE + 7]);                              \
    auto r0 = __builtin_amdgcn_permlane32_swap(a0, b0_, false, false); auto r1 = __builtin_amdgcn_permlane32_swap(a1, b1_, false, false); \
    u32x4 w4 = {r0[0], r1[0], r0[1], r1[1]}; OUT = *reinterpret_cast<bf16x8*>(&w4); } while (0)
                PK4(p0, 0, pa0); PK4(p0, 8, pa1); PK4(p1, 0, pa2); PK4(p1, 8, pa3);
#undef PK4
                const int vb = vbV + jt * 16384 + vh * 512;
                const s16x4 l0 = tr_read<v_rd_off(0, 0, 0)>(vb), h0 = tr_read<v_rd_off(0, 0, 1)>(vb), l1 = tr_read<v_rd_off(0, 1, 0)>(vb), h1 = tr_read<v_rd_off(0, 1, 1)>(vb);
                const s16x4 l2 = tr_read<v_rd_off(0, 2, 0)>(vb), h2 = tr_read<v_rd_off(0, 2, 1)>(vb), l3 = tr_read<v_rd_off(0, 3, 0)>(vb), h3 = tr_read<v_rd_off(0, 3, 1)>(vb);
                asm volatile("s_waitcnt lgkmcnt(0)" ::: "memory"); SBAR();
                o = __builtin_amdgcn_mfma_f32_32x32x16_bf16(pa0, TRPK(l0, h0), o, 0, 0, 0); o = __builtin_amdgcn_mfma_f32_32x32x16_bf16(pa1, TRPK(l1, h1), o, 0, 0, 0);
                o = __builtin_amdgcn_mfma_f32_32x32x16_bf16(pa2, TRPK(l2, h2), o, 0, 0, 0); o = __builtin_amdgcn_mfma_f32_32x32x16_bf16(pa3, TRPK(l3, h3), o, 0, 0, 0);
            }
            const float dtot = den + wint[qidx] * qn;
            if (hi == 0) denl[r32] = dtot;
            asm volatile("s_waitcnt lgkmcnt(0)" ::: "memory");
#pragma unroll
            for (int g4 = 0; g4 < 4; ++g4) { const f32x4 dd = *(const f32x4*)(denl + 8 * g4 + 4 * hi);
#pragma unroll
                for (int i = 0; i < 4; ++i) { const int r = g4 * 4 + i, pr = rb * 32 + 8 * g4 + 4 * hi + i;
                    const float hv = o[r] / fmaxf(fabsf(dd[i]), 1.0f);
                    H[(size_t)(mrow0 + (dir ? 127 - pr : pr)) * 1024 + h * 256 + dvq * 64 + vh * 32 + r32] = (bf16_t)(cvtpk(hv, 0.f) & 0xffffu); } }
        }
#pragma unroll
        for (int r = 0; r < 16; ++r) Cacc[r] *= g;
#pragma unroll
        for (int jt = 0; jt < 2; ++jt) {
            const int va = vbV + jt * 16384 + (2 + vh) * 512, ka = vbK + jt * 16384 + rb * 512;
            const s16x4 al0 = tr_read<v_rd_off(0, 0, 0)>(va), ah0 = tr_read<v_rd_off(0, 0, 1)>(va), al1 = tr_read<v_rd_off(0, 1, 0)>(va), ah1 = tr_read<v_rd_off(0, 1, 1)>(va);
            const s16x4 al2 = tr_read<v_rd_off(0, 2, 0)>(va), ah2 = tr_read<v_rd_off(0, 2, 1)>(va), al3 = tr_read<v_rd_off(0, 3, 0)>(va), ah3 = tr_read<v_rd_off(0, 3, 1)>(va);
            const s16x4 bl0 = tr_read<v_rd_off(0, 0, 0)>(ka), bh0 = tr_read<v_rd_off(0, 0, 1)>(ka), bl1 = tr_read<v_rd_off(0, 1, 0)>(ka), bh1 = tr_read<v_rd_off(0, 1, 1)>(ka);
            const s16x4 bl2 = tr_read<v_rd_off(0, 2, 0)>(ka), bh2 = tr_read<v_rd_off(0, 2, 1)>(ka), bl3 = tr_read<v_rd_off(0, 3, 0)>(ka), bh3 = tr_read<v_rd_off(0, 3, 1)>(ka);
            asm volatile("s_waitcnt lgkmcnt(0)" ::: "memory"); SBAR();
            Cacc = __builtin_amdgcn_mfma_f32_32x32x16_bf16(TRPK(al0, ah0), TRPK(bl0, bh0), Cacc, 0, 0, 0); Cacc = __builtin_amdgcn_mfma_f32_32x32x16_bf16(TRPK(al1, ah1), TRPK(bl1, bh1), Cacc, 0, 0, 0);
            Cacc = __builtin_amdgcn_mfma_f32_32x32x16_bf16(TRPK(al2, ah2), TRPK(bl2, bh2), Cacc, 0, 0, 0); Cacc = __builtin_amdgcn_mfma_f32_32x32x16_bf16(TRPK(al3, ah3), TRPK(bl3, bh3), Cacc, 0, 0, 0);
        }
        { const int k = tid & 127, sq = tid >> 7; float part = 0.f;
#pragma unroll 8
            for (int s = sq * 32; s < sq * 32 + 32; ++s) part += w_[s] * bf2f(*(const bf16_t*)(lds + L_KSW + KSWZ(s, 2 * k)));
            npart[sq * 128 + k] = part; }
        __syncthreads();
#pragma unroll
        for (int r = 0; r < 16; ++r) *(bf16_t*)(lds + L_CT + KSWZ(32 * vh + crow(r, hi), 2 * (32 * rb + r32))) = (bf16_t)(cvtpk(Cacc[r], 0.f) & 0xffffu);
        if (tid < 128) nvec[tid] = g * nvec[tid] + ((npart[tid] + npart[128 + tid]) + (npart[256 + tid] + npart[384 + tid]));
    }
    __syncthreads();
}
#undef TRPK
#undef KSWZ
#undef SBAR
#undef LOADS
#undef MROW0
}

__device__ __forceinline__ void phase_mfinal(const Params& p, int G) {
    const int tid = otid(), lane = tid & 63, wave = __builtin_amdgcn_readfirstlane(tid >> 6);
    const int gw = blockIdx.x * 8 + wave, NGW = G * 8;
    bf16_t* HF = (bf16_t*)(p.ws + WS_HF); const bf16_t* HB = (const bf16_t*)(p.ws + WS_HB); const bf16_t* MO = (const bf16_t*)(p.ws + WS_MO);
    for (int m = gw; m < TL; m += NGW) {
#pragma unroll
        for (int j = 0; j < 4; ++j) {
            const size_t o = (size_t)m * 1024 + 256 * j + 4 * lane;
            const u32x2 a = *(const u32x2*)(HF + o), bq = *(const u32x2*)(HB + o), og = *(const u32x2*)(MO + o);
            f32x4 hs = {bf_lo(a.x) + bf_lo(bq.x), bf_hi(a.x) + bf_hi(bq.x), bf_lo(a.y) + bf_lo(bq.y), bf_hi(a.y) + bf_hi(bq.y)};
            const float rstd = rsqrtf(wave_sum((hs[0] * hs[0] + hs[1] * hs[1]) + (hs[2] * hs[2] + hs[3] * hs[3])) * (1.0f / 256.0f) + EPS);
            const f32x4 g = *(const f32x4*)(p.mnorm_g + 256 * j + 4 * lane);
            const f32x4 ov = {sigmoidf_(bf_lo(og.x)), sigmoidf_(bf_hi(og.x)), sigmoidf_(bf_lo(og.y)), sigmoidf_(bf_hi(og.y))};
            const f32x4 r = hs * rstd * g * ov;
            u32x2 w; w.x = cvt_pk_bf16(r[0], r[1]); w.y = cvt_pk_bf16(r[2], r[3]); *(u32x2*)(HF + o) = w;
        }
    }
}

__device__ __forceinline__ void phase_rows2(const Params& p, LAS unsigned char* lds, int grp) {
    const int tid = otid(), lane = tid & 63, wave = __builtin_amdgcn_readfirstlane(tid >> 6);
    LAS float* rw = (LAS float*)lds;
    LAS int* hist = (LAS int*)(lds + 131072);
    LAS int* basee = hist + 32;
    LAS int* a_e = basee + 32;
    LAS int* a_p = a_e + 512;
    LAS float* a_g = (LAS float*)(a_p + 512);
    for (int i = tid; i < 32 * 1024; i += NTHREADS) { const int k = i >> 5, e = i & 31; rw[e * 1024 + k] = p.router_w[i]; }
    if (tid < 32) hist[tid] = 0;
    __syncthreads();
    const float* mod = (const float*)(p.ws + WS_MOD); unsigned char* U2 = p.ws + WS_U2;
    unsigned* cnt = (unsigned*)(p.ws + WS_CTL) + CW_CNT; int* asg = (int*)(p.ws + WS_ASG); int* list = (int*)(p.ws + WS_LIST); float* lgate = (float*)(p.ws + WS_LGATE);
    f32x4 gn[4];
#pragma unroll
    for (int j = 0; j < 4; ++j) gn[j] = *(const f32x4*)(p.norm2_g + 4 * lane + 256 * j);
    const int tok0 = grp * 128 + wave * 16;
    for (int it = 0; it < 16; ++it) {
        const int m = tok0 + it; const float* xr = p.out + (size_t)m * 1024; const float* md = mod + (size_t)(m >> 12) * 6144;
        f32x4 v[4]; float ss = 0.f;
#pragma unroll
        for (int j = 0; j < 4; ++j) { v[j] = *(const f32x4*)(xr + 4 * lane + 256 * j); ss += (v[j][0] * v[j][0] + v[j][1] * v[j][1]) + (v[j][2] * v[j][2] + v[j][3] * v[j][3]); }
        const float rstd = rsqrtf(wave_sum(ss) * (1.0f / 1024.0f) + EPS);
#pragma unroll
        for (int j = 0; j < 4; ++j) { const f32x4 sh = *(const f32x4*)(md + 3072 + 4 * lane + 256 * j), sc = *(const f32x4*)(md + 4096 + 4 * lane + 256 * j);
            v[j] = (v[j] * rstd * gn[j]) * (sc + 1.0f) + sh;
            *(unsigned*)(U2 + (size_t)m * 1024 + 4 * lane + 256 * j) = pk4_fp8(v[j][0], v[j][1], v[j][2], v[j][3]); }
        float mine = 0.f;
#pragma unroll 4
        for (int e = 0; e < 32; ++e) { float a = 0.f;
#pragma unroll
            for (int j = 0; j < 4; ++j) { const f32x4 w = *(const LAS f32x4*)(rw + e * 1024 + 4 * lane + 256 * j); a += (v[j][0] * w[0] + v[j][1] * w[1]) + (v[j][2] * w[2] + v[j][3] * w[3]); }
            a = wave_sum(a); mine = (lane == e) ? a : mine; }
        if (lane < 32) mine += p.router_b[lane];
        float val = lane < 32 ? mine : -INFINITY; int sel_e[4]; float sel_v[4];
#pragma unroll
        for (int k = 0; k < 4; ++k) {
            float bv = val; int bi = lane;
#pragma unroll
            for (int o = 1; o < 64; o <<= 1) { const float ov = __shfl_xor(bv, o); const int oi = __shfl_xor(bi, o); if (ov > bv || (ov == bv && oi < bi)) { bv = ov; bi = oi; } }
            sel_e[k] = bi; sel_v[k] = bv; if (lane == bi) val = -INFINITY;
        }
        if (lane == 0) {
            const float e1 = __expf(sel_v[1] - sel_v[0]), e2 = __expf(sel_v[2] - sel_v[0]), e3 = __expf(sel_v[3] - sel_v[0]); const float inv = 1.0f / (1.0f + e1 + e2 + e3);
            const float gk[4] = {inv, e1 * inv, e2 * inv, e3 * inv};
#pragma unroll
            for (int k = 0; k < 4; ++k) { const int a = (wave * 16 + it) * 4 + k; a_e[a] = sel_e[k]; a_p[a] = atomicAdd((int*)&hist[sel_e[k]], 1); a_g[a] = gk[k]; }
        }
    }
    __syncthreads();
    if (tid < 32) basee[tid] = (int)atomicAdd(cnt + tid, (unsigned)hist[tid]);
    __syncthreads();
    {
        const int a = tid; const int e = a_e[a]; const int pos = basee[e] + a_p[a]; const int tok = grp * 128 + (a >> 2);
        list[(size_t)e * CAP + pos] = tok; lgate[(size_t)e * CAP + pos] = a_g[a]; asg[tok * 4 + (a & 3)] = e * CAP + pos;
    }
    __syncthreads();
}

__device__ __forceinline__ void moe_tables(const Params& p, LAS int* tb, LAS int* cn) {
    if (threadIdx.x == 0) { const unsigned* cnt = (const unsigned*)(p.ws + WS_CTL) + CW_CNT; int acc = 0;
        for (int e = 0; e < 32; ++e) { const int c = (int)__hip_atomic_load(cnt + e, __ATOMIC_RELAXED, __HIP_MEMORY_SCOPE_AGENT); cn[e] = c; tb[e] = acc; acc += (c + 255) >> 8; } tb[32] = acc; }
    __syncthreads();
}

__device__ __forceinline__ void phase_final(const Params& p, const LAS int* tb, int G) {
    const int tid = otid(), lane = tid & 63, wave = __builtin_amdgcn_readfirstlane(tid >> 6);
    const int gw = blockIdx.x * 8 + wave, NGW = G * 8;
    const float* mod = (const float*)(p.ws + WS_MOD); const bf16_t* YS = (const bf16_t*)(p.ws + WS_YS); const int* asg = (const int*)(p.ws + WS_ASG);
    f32x4 gn[4];
#pragma unroll
    for (int j = 0; j < 4; ++j) gn[j] = *(const f32x4*)(p.final_g + 4 * lane + 256 * j);
    for (int m = gw; m < TL; m += NGW) {
        float* xr = p.out + (size_t)m * 1024; const float* g2 = mod + (size_t)(m >> 12) * 6144 + 5120;
        size_t rows[4];
#pragma unroll
        for (int k = 0; k < 4; ++k) { const int a = asg[m * 4 + k]; const int e = a >> 15, pos = a & (CAP - 1); rows[k] = (size_t)(tb[e] * 256 + pos) * 1024; }
        f32x4 v[4]; float ss = 0.f;
#pragma unroll
        for (int j = 0; j < 4; ++j) {
            f32x4 y = {0.f, 0.f, 0.f, 0.f};
#pragma unroll
            for (int k = 0; k < 4; ++k) { const u32x2 w = *(const u32x2*)(YS + rows[k] + 4 * lane + 256 * j); y[0] += bf_lo(w.x); y[1] += bf_hi(w.x); y[2] += bf_lo(w.y); y[3] += bf_hi(w.y); }
            v[j] = *(const f32x4*)(xr + 4 * lane + 256 * j) + *(const f32x4*)(g2 + 4 * lane + 256 * j) * y;
            ss += (v[j][0] * v[j][0] + v[j][1] * v[j][1]) + (v[j][2] * v[j][2] + v[j][3] * v[j][3]);
        }
        const float rstd = rsqrtf(wave_sum(ss) * (1.0f / 1024.0f) + EPS);
#pragma unroll
        for (int j = 0; j < 4; ++j) *(f32x4*)(xr + 4 * lane + 256 * j) = v[j] * rstd * gn[j];
    }
}

__device__ __forceinline__ void phase_attn(const Params& p, LAS unsigned char* lds_, int G, bf16_t* BO, unsigned* ctr) {
    char* lds = (char*)(unsigned char*)lds_;
    volatile int* uslot = (volatile int*)(lds + att::SHM_ATTN);
    const float lam = *(const float*)(p.ws + WS_LAM);
    const bf16_t* DQ = (const bf16_t*)(p.ws + WS_DQ); const bf16_t* DK = (const bf16_t*)(p.ws + WS_DK); const bf16_t* DV = (const bf16_t*)(p.ws + WS_DV);
    for (;;) {
        __syncthreads();
        if (threadIdx.x == 0) uslot[0] = (int)atomicAdd(ctr, 1u);
        __syncthreads();
        const int u = uslot[0];
        if (u >= 2048) break;
        const int bh = u >> 5, qb = u & 31, b = bh >> 3, h = bh & 7;
        const size_t qoff = ((size_t)b * SEQ + qb * 128) * 1024 + h * 128, koff = (size_t)b * KVLEN * 1024 + h * 128;
        att::attn_unit(DQ + qoff, DK + koff, DV + koff, BO + qoff, p.dnorm_g + h * 128, lam, KVLEN, lds);
    }
}


#define XB_TMO      128
#define XB_XCNT(j)  (256  + 64 * (j))
#define XB_XSUB(j)  (1280 + 64 * (j))
#define XB_XGEN(j)  (2304 + 64 * (j))
#define XB_TOP      3328
#define XB_TOPGEN   3392
#define XCD_BAR_WORDS 3456
#define XB_SPIN_CAP (1u << 22)
__device__ __forceinline__ unsigned xb_ld(unsigned* p)              { return __hip_atomic_load(p, __ATOMIC_RELAXED, __HIP_MEMORY_SCOPE_AGENT); }
__device__ __forceinline__ unsigned xb_add(unsigned* p, unsigned v) { return __hip_atomic_fetch_add(p, v, __ATOMIC_RELAXED, __HIP_MEMORY_SCOPE_AGENT); }
__device__ __forceinline__ unsigned xb_xcc_id() { return (unsigned)__builtin_amdgcn_s_getreg((3 << 11) | 20) & 0xFu; }
#define XB_SPIN(cond, bar) do { unsigned _sp = 0; while (cond) { __builtin_amdgcn_s_sleep(1); \
    if ((++_sp & 255u) == 0u) { if (xb_ld(&(bar)[XB_TMO])) break; if (_sp > XB_SPIN_CAP) { atomicAdd(&(bar)[XB_TMO], 1u); break; } } } } while (0)
struct XcdBarrier { unsigned* bar; unsigned x; volatile LAS unsigned* st; };
__device__ __forceinline__ XcdBarrier xcd_barrier_post(unsigned* bar, volatile LAS unsigned* st) {
    XcdBarrier b; b.bar = bar; b.x = xb_xcc_id(); b.st = st;
    if (threadIdx.x == 0) (void)xb_add(&bar[XB_XCNT(b.x)], 1u);
    return b;
}
__device__ __forceinline__ void xcd_barrier_complete(unsigned* bar, unsigned x, unsigned& nloc, unsigned& nx) {
    const unsigned G = gridDim.x * gridDim.y * gridDim.z;
    unsigned sum, cnt, mine, sp = 0u;
    for (;;) {
        sum = 0u; cnt = 0u; mine = 0u;
#pragma unroll
        for (unsigned j = 0; j < 16; ++j) { const unsigned c = xb_ld(&bar[XB_XCNT(j)]); sum += c; cnt += (c > 0u) ? 1u : 0u; mine = (j == x) ? c : mine; }
        if (sum == G) break;
        __builtin_amdgcn_s_sleep(1);
        if ((++sp & 255u) == 0u) { if (xb_ld(&bar[XB_TMO])) break; if (sp > XB_SPIN_CAP) { atomicAdd(&bar[XB_TMO], 1u); break; } }
    }
    nloc = mine > 0u ? mine : 1u; nx = cnt > 0u ? cnt : 1u;
}
__device__ __forceinline__ void xcd_barrier(const XcdBarrier& b) {
    asm volatile("s_waitcnt vmcnt(0)" ::: "memory");
    __syncthreads();
    if (threadIdx.x == 0) {
        unsigned* bar = b.bar;
        __builtin_amdgcn_s_waitcnt(0);
        unsigned nloc = b.st[0], nx = b.st[1];
        if (nloc == 0u) { xcd_barrier_complete(bar, b.x, nloc, nx); b.st[0] = nloc; b.st[1] = nx; }
        const unsigned old = xb_add(&bar[XB_XSUB(b.x)], 1u);
        const unsigned gen = old / nloc;
        if (old + 1u == (gen + 1u) * nloc) {
            __builtin_amdgcn_fence(__ATOMIC_RELEASE, "agent");
            asm volatile("s_waitcnt vmcnt(0)" ::: "memory");
            const unsigned og = xb_add(&bar[XB_TOP], 1u);
            const unsigned tg = og / nx;
            if (og + 1u == (tg + 1u) * nx) xb_add(&bar[XB_TOPGEN], 1u);
            else XB_SPIN(xb_ld(&bar[XB_TOPGEN]) == tg, bar);
            __builtin_amdgcn_fence(__ATOMIC_ACQUIRE, "agent");
            xb_add(&bar[XB_XGEN(b.x)], 1u);
            asm volatile("s_waitcnt vmcnt(0)" ::: "memory");
        } else {
            XB_SPIN(xb_ld(&bar[XB_XGEN(b.x)]) == gen, bar);
            __builtin_amdgcn_fence(__ATOMIC_ACQUIRE, "agent");
            asm volatile("s_waitcnt vmcnt(0)" ::: "memory");
        }
    }
    __syncthreads();
}


#define FP8_SELFTEST 0
#if FP8_SELFTEST
typedef int v8i __attribute__((ext_vector_type(8)));
__device__ __forceinline__ int fp8_selftest(int lane) {
    const int i = lane & 15, kb = lane >> 4;
    v8i A, B;
#pragma unroll
    for (int d = 0; d < 8; ++d) {
        float av[4], bv[4];
#pragma unroll
        for (int t = 0; t < 4; ++t) { const int k = 32 * kb + 4 * d + t; av[t] = (float)(((i * 7 + k * 3) % 5) - 2); bv[t] = (float)(((k * 5 + i) % 7) - 3); }
        int wa = 0, wb = 0;
        wa = __builtin_amdgcn_cvt_pk_fp8_f32(av[0], av[1], wa, false); wa = __builtin_amdgcn_cvt_pk_fp8_f32(av[2], av[3], wa, true);
        wb = __builtin_amdgcn_cvt_pk_fp8_f32(bv[0], bv[1], wb, false); wb = __builtin_amdgcn_cvt_pk_fp8_f32(bv[2], bv[3], wb, true);
        A[d] = wa; B[d] = wb;
    }
    f32x4 C = {0.f, 0.f, 0.f, 0.f}, C2 = {0.f, 0.f, 0.f, 0.f};
    C = __builtin_amdgcn_mfma_scale_f32_16x16x128_f8f6f4(A, B, C, 0, 0, 0, 0x7f7f7f7f, 0, 0x7f7f7f7f);
    C2 = __builtin_amdgcn_mfma_scale_f32_16x16x128_f8f6f4(A, B, C2, 0, 0, 0, 0x79797979, 0, 0x7f7f7f7f);
    bool ok = true;
#pragma unroll
    for (int r = 0; r < 4; ++r) { const int row = 4 * kb + r, col = i; float ref = 0.f;
        for (int k = 0; k < 128; ++k) ref += (float)(((row * 7 + k * 3) % 5) - 2) * (float)(((k * 5 + col) % 7) - 3);
        ok = ok && (C[r] == ref) && (C2[r] == ref * 0.015625f); }
    return __all(ok) ? 1 : 0;
}
#endif

__global__ void __launch_bounds__(NTHREADS, 2) fwd_megakernel(Params p) {
    extern __shared__ __attribute__((aligned(16))) unsigned char smem[];
    LAS unsigned char* lds = (LAS unsigned char*)smem;
    cg::grid_group grid = cg::this_grid();
    const int G = gridDim.x, c = blockIdx.x;
    unsigned char* ws = p.ws;
    volatile LAS unsigned* bst = (volatile LAS unsigned*)(lds + LDS_BYTES - 64);
    if (threadIdx.x < 16) bst[threadIdx.x] = 0u;
    __syncthreads();
    const XcdBarrier xbar = xcd_barrier_post((unsigned*)(ws + WS_CTL) + CW_BAR, bst);
#define GSYNC() xcd_barrier(xbar)

#ifndef PH_MASK
#define PH_MASK 0xFFFF
#endif
#define PH(k) if constexpr (((PH_MASK) >> (k)) & 1)
#ifndef REP_MASK
#define REP_MASK 0
#endif
#define REP(k) for (int rep_ = 0; rep_ < ((((REP_MASK) >> (k)) & 1) ? 2 : 1); ++rep_)
    PH(0) REP(0) { phase_prep(p, lds, G); __syncthreads(); }
    grid.sync();
    PH(1) phase_rows1(p, lds, G);
    GSYNC();
    PH(2) REP(2) {
        SchedIn S{(const char*)(ws + WS_U), (const char*)(ws + WS_WIN), G, c};
        EpiIn E{ws, (const float*)(ws + WS_ROPE), (const float*)(ws + WS_ROPE) + 1024};
        pg8::gemm_phase<EpiIn, SchedIn, false>(lds, S, E);
    }
    GSYNC();
#ifdef MLSTM_NAIVE
    PH(3) for (int item = c; item < 128; item += G) phase_mlstm_naive(p, lds, item);
#else
    PH(3) REP(3) for (int item = c; item < 256; item += G) mls::mlstm_item(p, lds, item);
#endif
    if constexpr ((REP_MASK >> 4) & 1) { phase_attn(p, lds, G, (bf16_t*)(ws + WS_END), (unsigned*)(ws + WS_CTL) + CW_ATT + 64); }
    PH(4) phase_attn(p, lds, G, (bf16_t*)(ws + WS_BO), (unsigned*)(ws + WS_CTL) + CW_ATT);
    GSYNC();
    PH(5) phase_mfinal(p, G);
    GSYNC();
    PH(6) REP(6) {
        SchedStatic S{(const char*)(ws + WS_AO), (const char*)(ws + WS_WA), 128, 4, G, c};
        EpiMerge<0> E{(const bf16_t*)(ws + WS_GA), nullptr, (bf16_t*)(ws + WS_T)};
        pg8::gemm_phase<EpiMerge<0>, SchedStatic, false>(lds, S, E);
    }
    GSYNC();
    PH(7) REP(7) {
        SchedStatic S{(const char*)(ws + WS_BO), (const char*)(ws + WS_WB), 128, 4, G, c};
        EpiMerge<1> E{(const bf16_t*)(ws + WS_GB), (const bf16_t*)(ws + WS_T), (bf16_t*)(ws + WS_Y)};
        pg8::gemm_phase<EpiMerge<1>, SchedStatic, false>(lds, S, E);
    }
    GSYNC();
    PH(8) REP(8) {
        SchedStatic S{(const char*)(ws + WS_Y), (const char*)(ws + WS_WO), 128, 4, G, c};
        EpiOut E{p.x, (const float*)(ws + WS_MOD), p.out};
        pg8::gemm_phase<EpiOut, SchedStatic, false>(lds, S, E);
    }
    GSYNC();
    PH(9) for (int grp = c; grp < 256; grp += G) phase_rows2(p, lds, grp);
    GSYNC();
    LAS int* tb = (LAS int*)(lds + 131072); LAS int* cn = tb + 64;
    moe_tables(p, tb, cn);
    PH(10) {
        const int tidg = otid(), lane = tidg & 63, gw = c * 8 + __builtin_amdgcn_readfirstlane(tidg >> 6), NGW = G * 8;
        const int NG = __builtin_amdgcn_readfirstlane(tb[32]) * 16; const int* list = (const int*)(ws + WS_LIST);
        for (int g = gw; g < NG; g += NGW) {
            const int rt = g >> 4; int e = 0;
#pragma unroll 1
            for (int k = 1; k < 32; ++k) e = (__builtin_amdgcn_readfirstlane(tb[k]) <= rt) ? k : e;
            const int pos0 = g * 16 - __builtin_amdgcn_readfirstlane(tb[e]) * 256, ne = __builtin_amdgcn_readfirstlane(cn[e]);
            const int pl = pos0 + (lane & 15); const int tl = pl < ne ? list[(size_t)e * CAP + pl] : 0;
            u32x4 v[16];
#pragma unroll
            for (int i = 0; i < 16; ++i) { const int tok = __shfl(tl, i); v[i] = *(const u32x4*)(ws + WS_U2 + (size_t)tok * 1024 + lane * 16); }
#pragma unroll
            for (int i = 0; i < 16; ++i) *(u32x4*)(ws + WS_XS + (size_t)(g * 16 + i) * 1024 + lane * 16) = v[i];
        }
    }
    GSYNC();
    PH(10) REP(10) {
        SchedMoe1 S{(const char*)(ws + WS_XS), (const char*)(ws + WS_W1), tb, G, c};
        EpiMoe1 E{ws + WS_ACT, p.exp_b1};
        pg8::gemm_phase<EpiMoe1, SchedMoe1, false, true>(lds, S, E);
    }
    GSYNC();
    PH(11) REP(11) {
        SchedMoe2 S{(const char*)(ws + WS_ACT), (const char*)(ws + WS_W2), tb, G, c};
        EpiMoe2 E{(bf16_t*)(ws + WS_YS), p.exp_b2, (const float*)(ws + WS_LGATE), cn};
        pg8::gemm_phase<EpiMoe2, SchedMoe2, false, true>(lds, S, E);
    }
    GSYNC();
    PH(12) phase_final(p, tb, G);
#if FP8_SELFTEST
    if (blockIdx.x == 0 && threadIdx.x < 64) { const int okf = fp8_selftest(threadIdx.x); VM_WAIT(); if (!okf && threadIdx.x == 0) p.out[0] = __builtin_nanf(""); }
#endif
}

extern "C" void kernel_launch(void* const* d_in, const int* in_sizes, int n_in, void* d_out, int out_size, void* d_ws, size_t ws_size, hipStream_t stream) {
    static int grid = 0;
    if (grid == 0) {
        if (n_in != 23 || out_size != TL * D || ws_size < WS_END) { fprintf(stderr, "kernel_launch: unexpected shapes: n_in %d out %d ws %zu (need %zu)\n", n_in, out_size, ws_size, (size_t)WS_END); grid = -1; return; }
        int dev = 0, cus = 0, per_cu = 0;
        (void)hipGetDevice(&dev); (void)hipDeviceGetAttribute(&cus, hipDeviceAttributeMultiprocessorCount, dev);
        if (hipFuncSetAttribute((const void*)fwd_megakernel, hipFuncAttributeMaxDynamicSharedMemorySize, LDS_BYTES) != hipSuccess) { fprintf(stderr, "kernel_launch: hipFuncSetAttribute failed\n"); grid = -1; return; }
        if (hipOccupancyMaxActiveBlocksPerMultiprocessor(&per_cu, (const void*)fwd_megakernel, NTHREADS, LDS_BYTES) != hipSuccess || per_cu < 1) { fprintf(stderr, "kernel_launch: occupancy query says %d\n", per_cu); per_cu = 1; }
        (void)hipGetLastError();
        grid = cus;
        if (grid > 256) grid = 256;
    }
    if (grid < 0) return;
    (void)hipMemsetAsync((char*)d_ws + WS_CTL, 0, 32768, stream);
    Params p{};
    const float** pp = (const float**)&p;
    for (int i = 0; i < 23; ++i) pp[i] = (const float*)d_in[i];
    p.out = (float*)d_out; p.ws = (unsigned char*)d_ws;
    void* args[] = {&p};
    hipError_t e = hipLaunchCooperativeKernel((const void*)fwd_megakernel, dim3(grid), dim3(NTHREADS), args, LDS_BYTES, stream);
    if (e != hipSuccess) fprintf(stderr, "cooperative launch failed: %s (grid %d)\n", hipGetErrorString(e), grid);
}
```

```cpp
#include <hip/hip_runtime.h>
#include <hip/hip_cooperative_groups.h>
#include <cstdio>
#include <cstdint>
namespace cg = cooperative_groups;

#define LAS __attribute__((address_space(3)))
typedef unsigned short bf16_t;
typedef short bf16x8 __attribute__((ext_vector_type(8)));
typedef short s16x4 __attribute__((ext_vector_type(4)));
typedef float f32x4 __attribute__((ext_vector_type(4)));
typedef float f32x8 __attribute__((ext_vector_type(8)));
typedef float f32x16 __attribute__((ext_vector_type(16)));
typedef unsigned u32x4 __attribute__((ext_vector_type(4)));
typedef unsigned u32x2 __attribute__((ext_vector_type(2)));

constexpr int D = 1024, BATCH = 8, SEQ = 4096, CTX = 256;
constexpr int TL = BATCH * SEQ, TC = BATCH * CTX, TT = TL + TC;
constexpr int KVLEN = CTX + SEQ;
constexpr int NEXP = 32, CAP = 32768, ACT_ROWS = 139264;
constexpr int INCOLS = 8208;
constexpr float EPS = 1e-6f;
constexpr float LAM_INIT = 0.2f;

constexpr size_t MiB = 1u << 20;
constexpr size_t WS_CTL = 0;
constexpr size_t WS_MOD = 1 * MiB;
constexpr size_t WS_ROPE = 1 * MiB + 256 * 1024;
constexpr size_t WS_LAM = 1 * MiB + 300 * 1024;
constexpr size_t WS_GT = 2 * MiB;
constexpr size_t WS_ASG = 5 * MiB;
constexpr size_t WS_LIST = 6 * MiB;
constexpr size_t WS_LGATE = 10 * MiB;
constexpr size_t WS_WIN = 16 * MiB;
constexpr size_t WS_WA = 32 * MiB, WS_WB = 34 * MiB, WS_WO = 36 * MiB;
constexpr size_t WS_W1 = 40 * MiB;
constexpr size_t WS_W2 = 168 * MiB;
constexpr size_t WS_U = 232 * MiB;
constexpr size_t WS_MQ = 300 * MiB;
constexpr size_t WS_MK = 332 * MiB;
constexpr size_t WS_MV = 366 * MiB;
constexpr size_t WS_MO = 434 * MiB;
constexpr size_t WS_HB = 498 * MiB;
constexpr size_t WS_DQ = 562 * MiB;
constexpr size_t WS_DK = 626 * MiB;
constexpr size_t WS_DV = 694 * MiB;
constexpr size_t WS_GA = 762 * MiB;
constexpr size_t WS_GB = 826 * MiB;
constexpr size_t WS_END = 890 * MiB;
constexpr size_t WS_HF = WS_U, WS_AO = WS_U, WS_BO = WS_DQ, WS_T = WS_MV, WS_Y = WS_MO, WS_U2 = 370 * MiB, WS_XS = WS_U, WS_ACT = WS_DQ, WS_YS = WS_U;
static_assert(WS_ACT + (size_t)ACT_ROWS * 2048 <= WS_END, "ACT fits");
static_assert(WS_YS + (size_t)ACT_ROWS * 2048 <= WS_DQ, "YS fits");

constexpr int CW_CNT = 0, CW_ATT = 64, CW_KMAX = 256, CW_BAR = 1024;
constexpr int LDS_BYTES = 147456;
constexpr int NTHREADS = 512;

struct Params {
    const float *x, *c, *ctx, *c_ctx, *ada_w, *ada_b, *norm1_g, *norm2_g, *w_in, *gate_b, *mnorm_g, *dlam, *dnorm_g, *w_a, *w_b, *w_o, *router_w, *router_b,
        *exp_w1, *exp_b1, *exp_w2, *exp_b2, *final_g;
    float* out;
    unsigned char* ws;
};

#define LDS_WAIT() asm volatile("s_waitcnt lgkmcnt(0)" ::: "memory")
#define VM_WAIT() asm volatile("s_waitcnt vmcnt(0)" ::: "memory")
typedef float f32x2_t __attribute__((ext_vector_type(2))); typedef __bf16 bf16x2_t __attribute__((ext_vector_type(2)));
__device__ __forceinline__ unsigned cvt_pk_bf16(float lo, float hi) { f32x2_t v = {lo, hi}; bf16x2_t b = __builtin_convertvector(v, bf16x2_t); return __builtin_bit_cast(unsigned, b); }
__device__ __forceinline__ unsigned pk4_fp8(float a, float b, float c, float d) { int w = 0; w = __builtin_amdgcn_cvt_pk_fp8_f32(a, b, w, false); w = __builtin_amdgcn_cvt_pk_fp8_f32(c, d, w, true); return (unsigned)w; }
__device__ __forceinline__ float bf_lo(unsigned w) { return __uint_as_float(w << 16); }
__device__ __forceinline__ float bf_hi(unsigned w) { return __uint_as_float(w & 0xffff0000u); }
__device__ __forceinline__ float bf2f(bf16_t b) { return __uint_as_float(((unsigned)b) << 16); }
__device__ __forceinline__ float wave_sum(float v) {
#pragma unroll
    for (int o = 1; o < 64; o <<= 1) v += __shfl_xor(v, o);
    return v;
}
__device__ __forceinline__ float sigmoidf_(float x) { return __builtin_amdgcn_rcpf(1.0f + __expf(-x)); }
__device__ __forceinline__ int otid() { unsigned ones = ~0u; asm volatile("" : "+s"(ones));
    const int lane = __builtin_amdgcn_mbcnt_hi(ones, __builtin_amdgcn_mbcnt_lo(ones, 0u)); int t = __builtin_amdgcn_readfirstlane(threadIdx.x >> 6) * 64 + lane; asm volatile("" : "+v"(t)); return t; }

namespace pg8 {
constexpr int BM = 256, BK = 64, HALF = 128, HTB = HALF * BK * 2, STAGE_BYTES = 8 * HTB, KD = 1024;
__host__ __device__ __forceinline__ int lds_byte(int r, int c) { const int st = (r >> 4) * 2 + (c >> 5), rr = r & 15, cc = c & 31, ob = rr * 64 + cc * 2; return st * 1024 + (ob ^ (((ob >> 9) & 1) << 5)); }
__host__ __device__ __forceinline__ void stage_rc(int b, int& R, int& C) { const int st = b / 1024, sb = b % 1024, swz = sb ^ (((sb >> 9) & 1) << 5); R = (st >> 1) * 16 + swz / 64; C = (st & 1) * 32 + (swz % 64) / 2; }

struct Unit { const char* A; const char* B; int row0; int pn; int aux; int aux2; };

__device__ __forceinline__ void tile_map(int L, int nM, int nN, int& pm, int& pn) {
    const int nwg = nM * nN; int wgid = L; { const int q = nwg / 8, r = nwg % 8, xcd = wgid % 8, off = wgid / 8; wgid = (xcd < r ? xcd * (q + 1) : r * (q + 1) + (xcd - r) * q) + off; }
    const int nig = 8 * nN, gid = wgid / nig, fm = gid * 8, gsz = (nM - fm) < 8 ? (nM - fm) : 8;
    pm = fm + ((wgid % nig) % gsz); pn = (wgid % nig) / gsz;
}

typedef int v8i_t __attribute__((ext_vector_type(8)));
typedef int v8i_a16 __attribute__((ext_vector_type(8), aligned(16)));
template <class Epi, class Sched, bool GATHER, bool FP8 = false>
__device__ __forceinline__ void gemm_phase(LAS unsigned char* lds, const Sched& S, const Epi& E) {
    const int tid = otid(), wid = __builtin_amdgcn_readfirstlane(tid >> 6), lane = tid & 63, wr = wid >> 2, wc = wid & 3, fr = lane & 15, fq = lane >> 4;
    constexpr int K = FP8 ? KD / 2 : KD, nt = K / BK;
    unsigned voffB[2], voffA0[2], voffA1[2], nvA0[2], nvA1[2];
#pragma unroll
    for (int i = 0; i < 2; ++i) { int R, C; stage_rc(tid * 16 + i * 8192, R, C);
        voffB[i] = (unsigned)(R * K + C) * 2u; voffA0[i] = voffB[i]; voffA1[i] = voffB[i] + (unsigned)HALF * K * 2u; nvA0[i] = voffA0[i]; nvA1[i] = voffA1[i]; }
    const size_t kstep = (size_t)(BK * 2);
    const size_t hstep = (size_t)HALF * K * 2;
    const unsigned ldsw = (unsigned)wid * 1024u;
    const int aoff = FP8 ? lds_byte(wr * 64 + fr, (fq & 1) * 16) + (fq >> 1) * 1024 : lds_byte(wr * 64 + fr, fq * 8);
    const int boff = FP8 ? lds_byte(wc * 32 + fr, (fq & 1) * 16) + (fq >> 1) * 1024 : lds_byte(wc * 32 + fr, fq * 8);
#define PG8_SA(b, h) (((b) * 2 + (h)) * HTB)
#define PG8_SB(b, h) ((4 + (b) * 2 + (h)) * HTB)
#define PG8_STAGE(bufoff, gbase, voff) do { _Pragma("unroll") for (int _i = 0; _i < 2; ++_i) { unsigned _v = (voff)[_i]; asm volatile("" : "+v"(_v));   \
        __builtin_amdgcn_global_load_lds((const unsigned*)((const char*)(gbase) + _v), (LAS unsigned*)(lds + (bufoff) + ldsw + _i * 8192), 16, 0, 0); } } while (0)
#define PG8_LDA(dst, b, h) do { if constexpr (FP8) { _Pragma("unroll") for (int m = 0; m < 4; ++m) dst##8[m] = *(const LAS v8i_a16*)(lds + PG8_SA(b, h) + aoff + m * 2048); } \
        else { _Pragma("unroll") for (int m = 0; m < 4; ++m) _Pragma("unroll") for (int k = 0; k < 2; ++k) dst[m][k] = *(const LAS bf16x8*)(lds + PG8_SA(b, h) + aoff + m * 2048 + k * 1024); } } while (0)
#define PG8_LDB(dst, b, h) do { if constexpr (FP8) { _Pragma("unroll") for (int n = 0; n < 2; ++n) dst##8[n] = *(const LAS v8i_a16*)(lds + PG8_SB(b, h) + boff + n * 2048); } \
        else { _Pragma("unroll") for (int n = 0; n < 2; ++n) _Pragma("unroll") for (int k = 0; k < 2; ++k) dst[n][k] = *(const LAS bf16x8*)(lds + PG8_SB(b, h) + boff + n * 2048 + k * 1024); } } while (0)
#define PG8_MMA(ai, bj, At, Bt) do { __builtin_amdgcn_s_setprio(1); _Pragma("unroll") for (int m = 0; m < 4; ++m) _Pragma("unroll") for (int n = 0; n < 2; ++n) { \
        if constexpr (FP8) { asm volatile("v_mfma_scale_f32_16x16x128_f8f6f4 %0, %1, %2, %0, %3, %4 op_sel_hi:[0,0,0]" : "+v"(acc[ai][bj][m][n]) : "v"(Bt##8[n]), "v"(At##8[m]), "v"(sc_w), "v"(sc_a)); } \
        else { _Pragma("unroll") for (int k = 0; k < 2; ++k) acc[ai][bj][m][n] = __builtin_amdgcn_mfma_f32_16x16x32_bf16(Bt[n][k], At[m][k], acc[ai][bj][m][n], 0, 0, 0); } } \
        __builtin_amdgcn_s_setprio(0); } while (0)
#define PG8_WAIT_V(n) asm volatile("s_waitcnt vmcnt(" #n ")" ::: "memory")
#define PG8_WAIT_L(n) asm volatile("s_waitcnt lgkmcnt(" #n ")" ::: "memory")
#define PG8_BAR __builtin_amdgcn_s_barrier()
#define PG8_SCHED __builtin_amdgcn_sched_barrier(0)
    Unit cur, nxt; int ui = 0;
    if (!S.next(0, cur)) return;
    if constexpr (GATHER) { S.offsets(cur, tid, voffA0, voffA1); }
    f32x4 acc[2][2][4][2];
#pragma unroll
    for (int a = 0; a < 2; ++a)
#pragma unroll
        for (int b = 0; b < 2; ++b)
#pragma unroll
            for (int m = 0; m < 4; ++m)
#pragma unroll
                for (int n = 0; n < 2; ++n) acc[a][b][m][n] = (f32x4){0.f, 0.f, 0.f, 0.f};
    bf16x8 At[4][2], B0[2][2], B1[2][2]; v8i_t At8[4], B08[2], B18[2];
    int sc_w = 0x79797979, sc_a = 0x7f7f7f7f; asm volatile("" : "+v"(sc_w), "+v"(sc_a));
    const char* cA = cur.A; const char* cB = cur.B;
    PG8_STAGE(PG8_SB(0, 0), cB, voffB); PG8_STAGE(PG8_SB(0, 1), cB + hstep, voffB); PG8_STAGE(PG8_SA(0, 0), cA, voffA0); PG8_STAGE(PG8_SA(0, 1), cA, voffA1);
    if (wr == 1) PG8_BAR;
    PG8_WAIT_V(2); PG8_BAR;
    PG8_STAGE(PG8_SB(1, 0), cB + kstep, voffB); PG8_STAGE(PG8_SA(1, 0), cA + kstep, voffA0); PG8_STAGE(PG8_SB(1, 1), cB + hstep + kstep, voffB);
    PG8_WAIT_V(6); PG8_BAR;
    for (;;) {
        const bool has_next = S.next(ui + 1, nxt);
        const char* nA = has_next ? nxt.A : cA; const char* nB = has_next ? nxt.B : cB;
#pragma unroll 1
        for (int t = 0; t < nt; t += 2) {
            const bool last = (t == nt - 2);
            if constexpr (GATHER) { if (t == nt - 4 && has_next) { const int tq = otid(); unsigned n0[2], n1[2]; S.offsets(nxt, tq, n0, n1); *(LAS u32x4*)(lds + 132096 + tq * 16) = (u32x4){n0[0], n0[1], n1[0], n1[1]}; } }
            const char* a1 = cA + (size_t)(t + 1) * kstep;
            const char* a2 = last ? nA : cA + (size_t)(t + 2) * kstep; const char* b2 = last ? nB : cB + (size_t)(t + 2) * kstep;
            const char* a3 = a2 + kstep; const char* b3 = b2 + kstep;
            unsigned w0[2], w1[2];
            if constexpr (GATHER) { w0[0] = voffA0[0]; w0[1] = voffA0[1]; w1[0] = voffA1[0]; w1[1] = voffA1[1];
                if (last && has_next) { const int tq = otid(); const u32x4 nv = *(const LAS u32x4*)(lds + 132096 + tq * 16); w0[0] = nv.x; w0[1] = nv.y; w1[0] = nv.z; w1[1] = nv.w; nvA0[0] = nv.x; nvA0[1] = nv.y; nvA1[0] = nv.z; nvA1[1] = nv.w; } }
            else { w0[0] = voffA0[0]; w0[1] = voffA0[1]; w1[0] = voffA1[0]; w1[1] = voffA1[1]; }
            PG8_LDB(B0, 0, 0); PG8_LDB(B1, 0, 1); PG8_SCHED; PG8_LDA(At, 0, 0); PG8_STAGE(PG8_SA(1, 1), a1, voffA1);
            PG8_WAIT_V(8); PG8_WAIT_L(0); PG8_BAR; PG8_MMA(0, 0, At, B0); PG8_MMA(0, 1, At, B1); PG8_BAR; PG8_SCHED;
            PG8_LDA(At, 0, 1); PG8_STAGE(PG8_SB(0, 0), b2, voffB); PG8_STAGE(PG8_SB(0, 1), b2 + hstep, voffB); PG8_STAGE(PG8_SA(0, 0), a2, w0);
            PG8_WAIT_V(8); PG8_WAIT_L(0); PG8_BAR; PG8_MMA(1, 0, At, B0); PG8_MMA(1, 1, At, B1); PG8_BAR; PG8_SCHED;
            PG8_LDB(B0, 1, 0); PG8_LDB(B1, 1, 1); PG8_SCHED; PG8_LDA(At, 1, 0); PG8_STAGE(PG8_SA(0, 1), a2, w1);
            PG8_WAIT_V(8); PG8_WAIT_L(0); PG8_BAR; PG8_MMA(0, 0, At, B0); PG8_MMA(0, 1, At, B1); PG8_BAR; PG8_SCHED;
            PG8_LDA(At, 1, 1); PG8_STAGE(PG8_SB(1, 0), b3, voffB); PG8_STAGE(PG8_SB(1, 1), b3 + hstep, voffB); PG8_STAGE(PG8_SA(1, 0), a3, w0);
            PG8_WAIT_V(8); PG8_WAIT_L(0); PG8_BAR; PG8_MMA(1, 0, At, B0); PG8_MMA(1, 1, At, B1); PG8_BAR; PG8_SCHED;
        }
        if (wr == 0) PG8_BAR;
        if constexpr (FP8) asm volatile("s_nop 15\n\ts_nop 7" ::: "memory");
        { const int t2_ = otid(); E(acc, cur, wr, wc, t2_ & 15, (t2_ & 63) >> 4); }
        if (!has_next) break;
#pragma unroll
        for (int a = 0; a < 2; ++a)
#pragma unroll
            for (int b = 0; b < 2; ++b)
#pragma unroll
                for (int m = 0; m < 4; ++m)
#pragma unroll
                    for (int n = 0; n < 2; ++n) acc[a][b][m][n] = (f32x4){0.f, 0.f, 0.f, 0.f};
        cur = nxt; cA = nA; cB = nB; ++ui;
        if constexpr (GATHER) { voffA0[0] = nvA0[0]; voffA0[1] = nvA0[1]; voffA1[0] = nvA1[0]; voffA1[1] = nvA1[1]; }
        if (wr == 1) PG8_BAR;
    }
    PG8_WAIT_V(0);
    PG8_BAR;
#undef PG8_SA
#undef PG8_SB
#undef PG8_STAGE
#undef PG8_LDA
#undef PG8_LDB
#undef PG8_MMA
#undef PG8_WAIT_V
#undef PG8_WAIT_L
#undef PG8_BAR
#undef PG8_SCHED
}
}

using pg8::Unit;
constexpr size_t TSTEP = (size_t)256 * 1024 * 2;

struct SchedIn {
    const char* A; const char* B; int G, c;
    __device__ __forceinline__ bool next(int i, Unit& u) const {
        const int L = i * G + c; int pm, pn;
        if (L < 4096) { pg8::tile_map(L, 128, 32, pm, pn); }
        else { const int j = L - 4096; if (j >= 112) return false; pm = 128 + (j & 7); const int cj = j >> 3; pn = cj < 2 ? 2 + cj : (cj < 6 ? 4 + (cj - 2) : 16 + (cj - 6)); }
        u.A = A + (size_t)pm * TSTEP; u.B = B + (size_t)pn * TSTEP; u.row0 = pm * 256; u.pn = pn; u.aux = 0; u.aux2 = 0; return true;
    }
};
struct EpiIn {
    unsigned char* ws; const float* ropec; const float* ropes;
    __device__ __forceinline__ void operator()(const f32x4 (&acc)[2][2][4][2], const Unit& u, int wr, int wc, int fr, int fq) const {
        const int pn = u.pn, row0 = u.row0; const bool latent = row0 < TL;
        bf16_t* base; int ldc, col0, mode = 0; float sc = 1.f, qsc = 1.f; int drow0 = row0;
        int kvrow0; if (latent) { const int b = row0 >> 12, t = row0 & 4095; kvrow0 = b * KVLEN + CTX + t; } else { const int cc = row0 - TL; kvrow0 = (cc >> 8) * KVLEN + (cc & 255); }
        if (pn < 2)       { base = (bf16_t*)(ws + WS_MQ); ldc = 512;  col0 = pn * 256;        sc = 0.08838834764831845f; }
        else if (pn < 4)  { base = (bf16_t*)(ws + WS_MK); ldc = 512;  col0 = (pn - 2) * 256; }
        else if (pn < 8)  { base = (bf16_t*)(ws + WS_MV); ldc = 1024; col0 = (pn - 4) * 256; }
        else if (pn < 12) { base = (bf16_t*)(ws + WS_MO); ldc = 1024; col0 = (pn - 8) * 256; }
        else if (pn < 16) { base = (bf16_t*)(ws + WS_DQ); ldc = 1024; col0 = (pn - 12) * 256; mode = 1; qsc = 0.125f * 1.4426950408889634f; }
        else if (pn < 20) { base = (bf16_t*)(ws + WS_DK); ldc = 1024; col0 = (pn - 16) * 256; mode = latent ? 1 : 0; drow0 = kvrow0; }
        else if (pn < 24) { base = (bf16_t*)(ws + WS_DV); ldc = 1024; col0 = (pn - 20) * 256; drow0 = kvrow0; }
        else if (pn < 28) { base = (bf16_t*)(ws + WS_GA); ldc = 1024; col0 = (pn - 24) * 256; mode = 2; }
        else              { base = (bf16_t*)(ws + WS_GB); ldc = 1024; col0 = (pn - 28) * 256; mode = 2; }
        const bool isk = (pn >= 16 && pn < 20); const int kb = latent ? (row0 >> 12) : ((row0 - TL) >> 8); float kmx[2] = {0.f, 0.f};
        const bool permt = !(pn >= 12 && pn < 20);
        const int cl = col0 + wc * 32 + (permt ? 8 * fq : 4 * fq);
#pragma unroll
        for (int ai = 0; ai < 2; ++ai)
#pragma unroll
            for (int m = 0; m < 4; ++m) {
                const int rl = ai * 128 + wr * 64 + m * 16 + fr;
                bf16_t* rowp = base + (size_t)(drow0 + rl) * ldc + cl;
                f32x4 cs = {1.f, 1.f, 1.f, 1.f}, sn = {0.f, 0.f, 0.f, 0.f};
                if (mode == 1) { const int t = (row0 + rl) & 4095; const int pos = (wc & 1) ? (t & 63) : (t >> 6); cs = *(const f32x4*)(ropec + pos * 16 + 4 * fq); sn = *(const f32x4*)(ropes + pos * 16 + 4 * fq); }
#pragma unroll
                for (int bj = 0; bj < 2; ++bj) {
                    f32x4 v0 = acc[ai][bj][m][0], v1 = acc[ai][bj][m][1];
                    if (mode == 1) { const f32x4 a = v0 * cs - v1 * sn, b = v1 * cs + v0 * sn; v0 = a * qsc; v1 = b * qsc; }
                    else if (mode == 2) {
#pragma unroll
                        for (int i = 0; i < 4; ++i) { v0[i] = sigmoidf_(v0[i]); v1[i] = sigmoidf_(v1[i]); }
                    } else { v0 = v0 * sc; v1 = v1 * sc; }
                    u32x2 w0, w1; w0.x = cvt_pk_bf16(v0[0], v0[1]); w0.y = cvt_pk_bf16(v0[2], v0[3]); w1.x = cvt_pk_bf16(v1[0], v1[1]); w1.y = cvt_pk_bf16(v1[2], v1[3]);
                    if (permt) { u32x4 w; w.x = w0.x; w.y = w0.y; w.z = w1.x; w.w = w1.y; *(u32x4*)(rowp + bj * 128) = w; }
                    else { *(u32x2*)(rowp + bj * 128) = w0; *(u32x2*)(rowp + bj * 128 + 16) = w1; }
                    if (isk) { float ss = (v0[0] * v0[0] + v0[1] * v0[1]) + (v0[2] * v0[2] + v0[3] * v0[3]) + (v1[0] * v1[0] + v1[1] * v1[1]) + (v1[2] * v1[2] + v1[3] * v1[3]);
                        ss += __shfl_xor(ss, 16); ss += __shfl_xor(ss, 32); kmx[bj] = fmaxf(kmx[bj], ss); }
                }
            }
        if (isk) {
#pragma unroll
            for (int bj = 0; bj < 2; ++bj) { float m = kmx[bj]; m = fmaxf(m, __shfl_xor(m, 1)); m = fmaxf(m, __shfl_xor(m, 2)); m = fmaxf(m, __shfl_xor(m, 4)); m = fmaxf(m, __shfl_xor(m, 8));
                if (fr == 0 && fq == 0) atomicMax((unsigned*)(ws + WS_CTL) + CW_KMAX + kb * 32 + ((col0 + bj * 128 + wc * 32) >> 5), __float_as_uint(sqrtf(m))); }
        }
    }
};

struct SchedStatic {
    const char* A; const char* B; int nM, nN, G, c;
    __device__ __forceinline__ bool next(int i, Unit& u) const {
        const int L = i * G + c; if (L >= nM * nN) return false; int pm, pn; pg8::tile_map(L, nM, nN, pm, pn);
        u.A = A + (size_t)pm * TSTEP; u.B = B + (size_t)pn * TSTEP; u.row0 = pm * 256; u.pn = pn; u.aux = 0; u.aux2 = 0; return true;
    }
};
template <int MODE> struct EpiMerge {
    const bf16_t* gate; const bf16_t* tin; bf16_t* outp;
    __device__ __forceinline__ void operator()(const f32x4 (&acc)[2][2][4][2], const Unit& u, int wr, int wc, int fr, int fq) const {
        const int cl = u.pn * 256 + wc * 32 + 8 * fq;
#pragma unroll
        for (int ai = 0; ai < 2; ++ai)
#pragma unroll
            for (int m = 0; m < 4; ++m) {
                const size_t ro = (size_t)(u.row0 + ai * 128 + wr * 64 + m * 16 + fr) * 1024 + cl;
#pragma unroll
                for (int bj = 0; bj < 2; ++bj) {
                    const size_t o = ro + bj * 128;
                    const u32x4 g = *(const u32x4*)(gate + o);
                    f32x4 v0 = acc[ai][bj][m][0], v1 = acc[ai][bj][m][1];
                    v0[0] *= bf_lo(g.x); v0[1] *= bf_hi(g.x); v0[2] *= bf_lo(g.y); v0[3] *= bf_hi(g.y); v1[0] *= bf_lo(g.z); v1[1] *= bf_hi(g.z); v1[2] *= bf_lo(g.w); v1[3] *= bf_hi(g.w);
                    if (MODE == 1) { const u32x4 t = *(const u32x4*)(tin + o);
                        v0[0] += bf_lo(t.x); v0[1] += bf_hi(t.x); v0[2] += bf_lo(t.y); v0[3] += bf_hi(t.y); v1[0] += bf_lo(t.z); v1[1] += bf_hi(t.z); v1[2] += bf_lo(t.w); v1[3] += bf_hi(t.w); }
                    u32x4 w; w.x = cvt_pk_bf16(v0[0], v0[1]); w.y = cvt_pk_bf16(v0[2], v0[3]); w.z = cvt_pk_bf16(v1[0], v1[1]); w.w = cvt_pk_bf16(v1[2], v1[3]);
                    *(u32x4*)(outp + o) = w;
                }
            }
    }
};
struct EpiOut {
    const float* x; const float* mod; float* x1;
    __device__ __forceinline__ void operator()(const f32x4 (&acc)[2][2][4][2], const Unit& u, int wr, int wc, int fr, int fq) const {
        const int cl = u.pn * 256 + wc * 32 + 8 * fq; const float* g1 = mod + (size_t)(u.row0 >> 12) * 6144 + 2048;
#pragma unroll
        for (int bj = 0; bj < 2; ++bj)
#pragma unroll
            for (int n = 0; n < 2; ++n) {
                const f32x4 g = *(const f32x4*)(g1 + cl + bj * 128 + n * 4);
#pragma unroll
                for (int ai = 0; ai < 2; ++ai)
#pragma unroll
                    for (int m = 0; m < 4; ++m) {
                        const size_t o = (size_t)(u.row0 + ai * 128 + wr * 64 + m * 16 + fr) * 1024 + cl + bj * 128 + n * 4;
                        const f32x4 xv = *(const f32x4*)(x + o);
                        *(f32x4*)(x1 + o) = xv + g * acc[ai][bj][m][n];
                    }
            }
    }
};

struct SchedMoe1 {
    const char* XS; const char* W1; const LAS int* tb; int G, c;
    __device__ __forceinline__ bool next(int i, Unit& u) const {
        const int L = i * G + c; const int xcd = L & 7, j = L >> 3; const int pn = j & 7, rt = (j >> 3) * 8 + xcd;
        const int NRT = __builtin_amdgcn_readfirstlane(tb[32]);
        if (rt >= NRT) return false;
        int e = 0;
#pragma unroll 1
        for (int k = 1; k < 32; ++k) e = (__builtin_amdgcn_readfirstlane(tb[k]) <= rt) ? k : e;
        u.A = XS + (size_t)rt * (TSTEP / 2); u.B = W1 + ((size_t)e * 2048 + (size_t)pn * 256) * 1024; u.row0 = rt * 256; u.pn = pn; u.aux = e; u.aux2 = 0; return true;
    }
};
struct EpiMoe1 {
    unsigned char* act; const float* b1;
    __device__ __forceinline__ void operator()(const f32x4 (&acc)[2][2][4][2], const Unit& u, int wr, int wc, int fr, int fq) const {
        if (u.aux < 0) return;
        const int cl = u.pn * 128 + wc * 32 + 8 * fq; const float* bb = b1 + (size_t)u.aux * 2048;
        f32x4 bg[2], bl[2];
#pragma unroll
        for (int n = 0; n < 2; ++n) { bg[n] = *(const f32x4*)(bb + cl + n * 4); bl[n] = *(const f32x4*)(bb + 1024 + cl + n * 4); }
#pragma unroll
        for (int ai = 0; ai < 2; ++ai)
#pragma unroll
            for (int m = 0; m < 4; ++m) {
                f32x4 a[2];
#pragma unroll
                for (int n = 0; n < 2; ++n) { const f32x4 g = acc[ai][0][m][n] + bg[n], l = acc[ai][1][m][n] + bl[n];
#pragma unroll
                    for (int i = 0; i < 4; ++i) { const float gg = fminf(g[i], 7.0f), ll = fminf(fmaxf(l[i], -7.0f), 7.0f); a[n][i] = gg * sigmoidf_(1.702f * gg) * (ll + 1.0f); } }
                u32x2 w; w.x = pk4_fp8(a[0][0], a[0][1], a[0][2], a[0][3]); w.y = pk4_fp8(a[1][0], a[1][1], a[1][2], a[1][3]);
                *(u32x2*)(act + (size_t)(u.row0 + ai * 128 + wr * 64 + m * 16 + fr) * 1024 + cl) = w;
            }
    }
};
struct SchedMoe2 {
    const char* ACT; const char* W2; const LAS int* tb; int G, c;
    __device__ __forceinline__ bool next(int i, Unit& u) const {
        const int L = i * G + c; const int xcd = L & 7, j = L >> 3; const int pn = j & 3, rt = (j >> 2) * 8 + xcd;
        const int NRT = __builtin_amdgcn_readfirstlane(tb[32]);
        if (rt >= NRT) return false;
        int e = 0;
#pragma unroll 1
        for (int k = 1; k < 32; ++k) e = (__builtin_amdgcn_readfirstlane(tb[k]) <= rt) ? k : e;
        const int tbe = __builtin_amdgcn_readfirstlane(tb[e]);
        u.A = ACT + (size_t)rt * (TSTEP / 2); u.B = W2 + ((size_t)e * 1024 + (size_t)pn * 256) * 1024; u.row0 = rt * 256; u.pn = pn; u.aux = e; u.aux2 = (rt - tbe) * 256; return true;
    }
};
struct EpiMoe2 {
    bf16_t* ys; const float* b2; const float* lgate; const LAS int* cnt;
    __device__ __forceinline__ void operator()(const f32x4 (&acc)[2][2][4][2], const Unit& u, int wr, int wc, int fr, int fq) const {
        if (u.aux < 0) return;
        const int cl = u.pn * 256 + wc * 32 + 8 * fq; const float* bb = b2 + (size_t)u.aux * 1024; const int n = __builtin_amdgcn_readfirstlane(cnt[u.aux]) - u.aux2; const float* gp = lgate + (size_t)u.aux * CAP + u.aux2;
        f32x4 bv[2][2];
#pragma unroll
        for (int bj = 0; bj < 2; ++bj)
#pragma unroll
            for (int nn = 0; nn < 2; ++nn) bv[bj][nn] = *(const f32x4*)(bb + cl + bj * 128 + nn * 4);
#pragma unroll
        for (int ai = 0; ai < 2; ++ai)
#pragma unroll
            for (int m = 0; m < 4; ++m) {
                const int rl = ai * 128 + wr * 64 + m * 16 + fr; const float gw = rl < n ? gp[rl] : 0.f;
#pragma unroll
                for (int bj = 0; bj < 2; ++bj) {
                    const f32x4 v0 = (acc[ai][bj][m][0] + bv[bj][0]) * gw, v1 = (acc[ai][bj][m][1] + bv[bj][1]) * gw;
                    u32x4 w; w.x = cvt_pk_bf16(v0[0], v0[1]); w.y = cvt_pk_bf16(v0[2], v0[3]); w.z = cvt_pk_bf16(v1[0], v1[1]); w.w = cvt_pk_bf16(v1[2], v1[3]);
                    *(u32x4*)(ys + (size_t)(u.row0 + rl) * 1024 + cl + bj * 128) = w;
                }
            }
    }
};

namespace att {
constexpr int NW = 8, QBLK = 32, KVBLK = 64, LD = 1024;
constexpr float SCALE = 0.125f;
constexpr float THR = 8.f;
constexpr int SHM_V = KVBLK * 128 * 2, SHM_K = KVBLK * 128 * 2, SHM_ATTN = 4 * SHM_V + 4 * SHM_K + NW * 64 * 4;
#define KSWZ(row, colB) ((row) * 256 + ((colB) ^ (((row) & 7) << 4)))
#define SBAR() __builtin_amdgcn_sched_barrier(0)
__device__ __forceinline__ int crow(int r, int hi) { return (r & 3) + 8 * (r >> 2) + 4 * hi; }
__device__ __forceinline__ unsigned cvtpk(float lo, float hi) { return cvt_pk_bf16(lo, hi); }

__device__ __forceinline__ void finishSM(f32x16& p0, f32x16& p1, float& l_reg, bf16x8& pa0, bf16x8& pa1, bf16x8& pa2, bf16x8& pa3) {
#pragma unroll
  for (int r = 0; r < 16; ++r) { p0[r] = __builtin_amdgcn_exp2f(p0[r]); p1[r] = __builtin_amdgcn_exp2f(p1[r]); }
  float s0 = p0[0], s1 = p0[8], s2 = p1[0], s3 = p1[8];
#pragma unroll
  for (int r = 1; r < 8; ++r) { s0 += p0[r]; s1 += p0[8 + r]; s2 += p1[r]; s3 += p1[8 + r]; }
  l_reg += (s0 + s1) + (s2 + s3);
#define PK4(P, BASE, OUT) do { unsigned a0 = cvtpk(P[BASE + 0], P[BASE + 1]), a1 = cvtpk(P[BASE + 2], P[BASE + 3]);   \
    unsigned b0 = cvtpk(P[BASE + 4], P[BASE + 5]), b1 = cvtpk(P[BASE + 6], P[BASE + 7]);                              \
    auto r0 = __builtin_amdgcn_permlane32_swap(a0, b0, false, false); auto r1 = __builtin_amdgcn_permlane32_swap(a1, b1, false, false); \
    u32x4 w = {r0[0], r1[0], r0[1], r1[1]}; OUT = *reinterpret_cast<bf16x8*>(&w); } while (0)
  PK4(p0, 0, pa0); PK4(p0, 8, pa1); PK4(p1, 0, pa2); PK4(p1, 8, pa3);
#undef PK4
}
__device__ __forceinline__ void qkt(f32x16& p0, f32x16& p1, const bf16_t* Ks, const bf16x8* qr, int r32, int hi, int mp) {
  p0 = f32x16{}; p1 = f32x16{};
#pragma unroll
  for (int d0 = 0; d0 < 4; ++d0) { int cb = (mp * 64 + d0 * 16 + hi * 8) * 2;
    bf16x8 b0 = *reinterpret_cast<const bf16x8*>((const char*)Ks + KSWZ(r32, cb));
    bf16x8 b1 = *reinterpret_cast<const bf16x8*>((const char*)Ks + KSWZ(32 + r32, cb));
    p0 = __builtin_amdgcn_mfma_f32_32x32x16_bf16(b0, qr[d0], p0, 0, 0, 0);
    p1 = __builtin_amdgcn_mfma_f32_32x32x16_bf16(b1, qr[d0], p1, 0, 0, 0); }
}
__device__ __forceinline__ int v_st(int k, int c) { const int kk = (k & ~0xC) | ((k & 4) << 1) | ((k & 8) >> 1); return ((kk >> 3) * 4 + (c >> 5)) * 512 + ((kk & 7) * 32 + (c & 31)) * 2; }
__device__ __forceinline__ int v_rd_base(int lane) { return ((lane & 3) << 3) | (((lane >> 2) & 3) << 6) | (((lane >> 4) & 1) << 5) | (((lane >> 5) & 1) << 8); }
constexpr int v_rd_off(int d0, int ks, int half) { return d0 * 512 + ks * 4096 + half * 2048; }
template <int OFF> __device__ __forceinline__ s16x4 tr_read(int vb) {
  s16x4 r; asm volatile("ds_read_b64_tr_b16 %0, %1 offset:%2" : "=&v"(r) : "v"(vb), "i"(OFF) : "memory"); return r;
}
template <int D0> __device__ __forceinline__ void pv_one(f32x16& od, int vb, bf16x8 pa0, bf16x8 pa1, bf16x8 pa2, bf16x8 pa3) {
  const s16x4 l0 = tr_read<v_rd_off(D0, 0, 0)>(vb), h0 = tr_read<v_rd_off(D0, 0, 1)>(vb), l1 = tr_read<v_rd_off(D0, 1, 0)>(vb), h1 = tr_read<v_rd_off(D0, 1, 1)>(vb);
  const s16x4 l2 = tr_read<v_rd_off(D0, 2, 0)>(vb), h2 = tr_read<v_rd_off(D0, 2, 1)>(vb), l3 = tr_read<v_rd_off(D0, 3, 0)>(vb), h3 = tr_read<v_rd_off(D0, 3, 1)>(vb);
  asm volatile("s_waitcnt lgkmcnt(0)" ::: "memory"); SBAR();
#define PK(L, H) (bf16x8){L[0], L[1], L[2], L[3], H[0], H[1], H[2], H[3]}
  od = __builtin_amdgcn_mfma_f32_32x32x16_bf16(pa0, PK(l0, h0), od, 0, 0, 0);
  od = __builtin_amdgcn_mfma_f32_32x32x16_bf16(pa1, PK(l1, h1), od, 0, 0, 0);
  od = __builtin_amdgcn_mfma_f32_32x32x16_bf16(pa2, PK(l2, h2), od, 0, 0, 0);
  od = __builtin_amdgcn_mfma_f32_32x32x16_bf16(pa3, PK(l3, h3), od, 0, 0, 0);
#undef PK
}
__device__ __forceinline__ void pv_d0(f32x16* o, int vb, bf16x8 pa0, bf16x8 pa1, bf16x8 pa2, bf16x8 pa3) {
  pv_one<0>(o[0], vb, pa0, pa1, pa2, pa3); pv_one<1>(o[1], vb, pa0, pa1, pa2, pa3); pv_one<2>(o[2], vb, pa0, pa1, pa2, pa3); pv_one<3>(o[3], vb, pa0, pa1, pa2, pa3);
}
template <bool QK, bool PV>
__device__ __forceinline__ void mphase(f32x16& p0, f32x16& p1, f32x16* o, const char* Ks, int vb, const bf16x8* qr, const f32x16& negm,
                                       bf16x8 pa0, bf16x8 pa1, bf16x8 pa2, bf16x8 pa3, int r32, int hi, int mp) {
#define TR8(dst, D0) do { dst[0] = tr_read<v_rd_off(D0, 0, 0)>(vb); dst[1] = tr_read<v_rd_off(D0, 0, 1)>(vb); dst[2] = tr_read<v_rd_off(D0, 1, 0)>(vb); dst[3] = tr_read<v_rd_off(D0, 1, 1)>(vb); \
    dst[4] = tr_read<v_rd_off(D0, 2, 0)>(vb); dst[5] = tr_read<v_rd_off(D0, 2, 1)>(vb); dst[6] = tr_read<v_rd_off(D0, 3, 0)>(vb); dst[7] = tr_read<v_rd_off(D0, 3, 1)>(vb); } while (0)
#define PKV(v, k) (bf16x8){v[2 * (k)][0], v[2 * (k)][1], v[2 * (k)][2], v[2 * (k)][3], v[2 * (k) + 1][0], v[2 * (k) + 1][1], v[2 * (k) + 1][2], v[2 * (k) + 1][3]}
#define PV4(od, v) do { od = __builtin_amdgcn_mfma_f32_32x32x16_bf16(pa0, PKV(v, 0), od, 0, 0, 0); od = __builtin_amdgcn_mfma_f32_32x32x16_bf16(pa1, PKV(v, 1), od, 0, 0, 0); \
    od = __builtin_amdgcn_mfma_f32_32x32x16_bf16(pa2, PKV(v, 2), od, 0, 0, 0); od = __builtin_amdgcn_mfma_f32_32x32x16_bf16(pa3, PKV(v, 3), od, 0, 0, 0); } while (0)
#define LWAIT(n) do { asm volatile("s_waitcnt lgkmcnt(" #n ")" ::: "memory"); SBAR(); } while (0)
  bf16x8 kf0[4], kf1[4]; s16x4 va[8], vc[8];
  if constexpr (QK) {
#pragma unroll
    for (int d0 = 0; d0 < 4; ++d0) { const int cb = (mp * 64 + d0 * 16 + hi * 8) * 2;
      asm volatile("ds_read_b128 %0, %1" : "=&v"(kf0[d0]) : "v"((int)(uintptr_t)Ks + KSWZ(r32, cb)) : "memory");
      asm volatile("ds_read_b128 %0, %1" : "=&v"(kf1[d0]) : "v"((int)(uintptr_t)Ks + KSWZ(32 + r32, cb)) : "memory"); }
  }
  if constexpr (PV) TR8(va, 0);
  if constexpr (QK) {
    if constexpr (PV) LWAIT(8); else LWAIT(0);
    p0 = __builtin_amdgcn_mfma_f32_32x32x16_bf16(kf0[0], qr[0], negm, 0, 0, 0); p1 = __builtin_amdgcn_mfma_f32_32x32x16_bf16(kf1[0], qr[0], negm, 0, 0, 0);
#pragma unroll
    for (int d0 = 1; d0 < 4; ++d0) { p0 = __builtin_amdgcn_mfma_f32_32x32x16_bf16(kf0[d0], qr[d0], p0, 0, 0, 0); p1 = __builtin_amdgcn_mfma_f32_32x32x16_bf16(kf1[d0], qr[d0], p1, 0, 0, 0); }
    SBAR();
  }
  if constexpr (PV) {
    TR8(vc, 1); LWAIT(8); PV4(o[0], va); SBAR();
    TR8(va, 2); LWAIT(8); PV4(o[1], vc); SBAR();
    TR8(vc, 3); LWAIT(8); PV4(o[2], va); SBAR();
    LWAIT(0); PV4(o[3], vc); SBAR();
  }
#undef TR8
#undef PKV
#undef PV4
#undef LWAIT
}

__device__ __forceinline__ void attn_unit(const bf16_t* __restrict__ Qb, const bf16_t* __restrict__ Kh, const bf16_t* __restrict__ Vh, bf16_t* __restrict__ Ob,
                                          const float* __restrict__ gd, const float* __restrict__ kmax, float lam, int seq, char* lds) {
  const int tid = otid(), wid = __builtin_amdgcn_readfirstlane(tid >> 6), lane = tid & 63, r32 = lane & 31, hi = lane >> 5;
  const int qw = wid & 3, mp = wid >> 2;
  char* K_lds = lds; char* V_lds = lds + SHM_K;
  constexpr int SLOT = SHM_K + SHM_V;
  float* wsf = (float*)(lds + 4 * SLOT) + wid * 64; float* li_l = wsf;
  float l_reg = 0; f32x16 o[4] = {}; bf16x8 qr[4];
  const bf16_t* Qw = Qb + (long)(qw * QBLK + r32) * LD + mp * 64 + hi * 8;
#pragma unroll
  for (int d0 = 0; d0 < 4; ++d0) qr[d0] = *reinterpret_cast<const bf16x8*>(Qw + d0 * 16);
  float mnC;
  { float ssa = 0.f, ssb = 0.f;
#pragma unroll
    for (int d0 = 0; d0 < 4; ++d0) { const u32x4 q4 = *reinterpret_cast<const u32x4*>(&qr[d0]);
      const float t = (bf_lo(q4.x) * bf_lo(q4.x) + bf_hi(q4.x) * bf_hi(q4.x)) + (bf_lo(q4.y) * bf_lo(q4.y) + bf_hi(q4.y) * bf_hi(q4.y)) + (bf_lo(q4.z) * bf_lo(q4.z) + bf_hi(q4.z) * bf_hi(q4.z)) + (bf_lo(q4.w) * bf_lo(q4.w) + bf_hi(q4.w) * bf_hi(q4.w));
      if (d0 < 2) ssa += t; else ssb += t; }
    { auto rr = __builtin_amdgcn_permlane32_swap(__float_as_uint(ssa), __float_as_uint(ssa), false, false); ssa = __uint_as_float(rr[0]) + __uint_as_float(rr[1]); }
    { auto rr = __builtin_amdgcn_permlane32_swap(__float_as_uint(ssb), __float_as_uint(ssb), false, false); ssb = __uint_as_float(rr[0]) + __uint_as_float(rr[1]); }
    mnC = -(sqrtf(ssa) * kmax[mp * 2] + sqrtf(ssb) * kmax[mp * 2 + 1]) * 1.01f; }
  f32x16 negm;
#pragma unroll
  for (int r = 0; r < 16; ++r) negm[r] = mnC;
  asm volatile("" : "+v"(negm));
  const int sr = tid >> 4, sc = (tid & 15) * 8, vst0 = v_st(sr, sc), vst1 = v_st(32 + sr, sc), kst0 = KSWZ(sr, sc * 2), kst1 = KSWZ(32 + sr, sc * 2);
  const int vb0 = (int)(uintptr_t)V_lds + v_rd_base(lane);
  bf16x8 sk0, sk1, sv0, sv1;
#define SLOAD(t) do { const long k0_ = (long)(t) * KVBLK; sv0 = *reinterpret_cast<const bf16x8*>(&Vh[(k0_ + sr) * LD + sc]); sv1 = *reinterpret_cast<const bf16x8*>(&Vh[(k0_ + 32 + sr) * LD + sc]); \
    sk0 = *reinterpret_cast<const bf16x8*>(&Kh[(k0_ + sr) * LD + sc]); sk1 = *reinterpret_cast<const bf16x8*>(&Kh[(k0_ + 32 + sr) * LD + sc]); } while (0)
#define SWRITE(t) do { char* kp_ = K_lds + ((t) & 3) * SLOT; char* vp_ = V_lds + ((t) & 3) * SLOT; *(bf16x8*)(vp_ + vst0) = sv0; *(bf16x8*)(vp_ + vst1) = sv1; *(bf16x8*)(kp_ + kst0) = sk0; *(bf16x8*)(kp_ + kst1) = sk1; } while (0)
#define PBAR() do { SBAR(); asm volatile("s_waitcnt lgkmcnt(0)\n\ts_barrier" ::: "memory"); SBAR(); } while (0)
  f32x16 p0, p1; bf16x8 pa0, pa1, pa2, pa3; const int NT = seq / KVBLK;
  SLOAD(0); SWRITE(0); SLOAD(1); SWRITE(1); SLOAD(2);
  PBAR();
  if (mp == 1) PBAR();
  pa0 = pa1 = pa2 = pa3 = bf16x8{};
  __builtin_amdgcn_s_setprio(1); mphase<true, false>(p0, p1, o, K_lds, vb0, qr, negm, pa0, pa1, pa2, pa3, r32, hi, mp); __builtin_amdgcn_s_setprio(0);
  PBAR();
#pragma unroll 1
  for (int t = 0; t + 1 < NT; ++t) {
    finishSM(p0, p1, l_reg, pa0, pa1, pa2, pa3);
    if (t + 2 < NT) { SWRITE(t + 2); if (t + 3 < NT) SLOAD(t + 3); }
    PBAR();
    __builtin_amdgcn_s_setprio(1);
    mphase<true, true>(p0, p1, o, K_lds + ((t + 1) & 3) * SLOT, vb0 + (t & 3) * SLOT, qr, negm, pa0, pa1, pa2, pa3, r32, hi, mp);
    __builtin_amdgcn_s_setprio(0);
    PBAR();
  }
  finishSM(p0, p1, l_reg, pa0, pa1, pa2, pa3);
  PBAR();
  __builtin_amdgcn_s_setprio(1); mphase<false, true>(p0, p1, o, K_lds, vb0 + ((NT - 1) & 3) * SLOT, qr, negm, pa0, pa1, pa2, pa3, r32, hi, mp); __builtin_amdgcn_s_setprio(0);
  if (mp == 0) PBAR();
  { auto rr = __builtin_amdgcn_permlane32_swap(__float_as_uint(l_reg), __float_as_uint(l_reg), false, false); l_reg = __uint_as_float(rr[0]) + __uint_as_float(rr[1]); }
  if (hi == 0) li_l[r32] = l_reg; asm volatile("s_waitcnt lgkmcnt(0)" ::: "memory");
  float rli[16];
#pragma unroll
  for (int r = 0; r < 16; ++r) rli[r] = __builtin_amdgcn_rcpf(li_l[crow(r, hi)]);
  __syncthreads();
  float* xch = (float*)lds + qw * 4096 + lane;
  if (mp == 1) {
#pragma unroll
    for (int r = 0; r < 16; ++r)
#pragma unroll
      for (int d0 = 0; d0 < 4; ++d0) xch[(r * 4 + d0) * 64] = o[d0][r] * rli[r] * lam;
  }
  __syncthreads();
  if (mp == 0) {
    float gv[4];
#pragma unroll
    for (int d0 = 0; d0 < 4; ++d0) gv[d0] = gd[d0 * 32 + r32] * (1.0f - LAM_INIT);
#pragma unroll
    for (int r = 0; r < 16; ++r) {
      float dv[4]; float ss = 0.f;
#pragma unroll
      for (int d0 = 0; d0 < 4; ++d0) { dv[d0] = o[d0][r] * rli[r] - xch[(r * 4 + d0) * 64]; ss += dv[d0] * dv[d0]; }
      ss += __shfl_xor(ss, 1); ss += __shfl_xor(ss, 2); ss += __shfl_xor(ss, 4); ss += __shfl_xor(ss, 8); ss += __shfl_xor(ss, 16);
      const float rstd = rsqrtf(ss * (1.0f / 128.0f) + EPS);
      bf16_t* orow = Ob + (long)(qw * QBLK + crow(r, hi)) * LD + r32;
#pragma unroll
      for (int d0 = 0; d0 < 4; ++d0) orow[d0 * 32] = (bf16_t)(cvtpk(dv[d0] * rstd * gv[d0], 0.f) & 0xffffu);
    }
  }
  __syncthreads();
#undef SLOAD
#undef SWRITE
#undef PBAR
}
#undef KSWZ
#undef SBAR
}

__device__ __forceinline__ float log_sigmoidf_(float x) { return x >= 0.f ? -log1pf(__expf(-x)) : x - log1pf(__expf(x)); }

__device__ __forceinline__ int perm32(int rho) { const int n = rho >> 4, i = rho & 15; return 8 * (i >> 2) + 4 * n + (i & 3); }
__device__ __forceinline__ void transpose_item(const float* __restrict__ W, int ldw, int scol0, bf16_t* WTrow0, int k0, LAS float* scr, int lane, bool perm) {
#pragma unroll 8
    for (int i = 0; i < 32; ++i) { const int kk = 2 * i + (lane >> 5); scr[kk * 33 + (lane & 31)] = W[(size_t)(k0 + kk) * ldw + scol0 + (lane & 31)]; }
    LDS_WAIT(); asm volatile("" ::: "memory");
    const int c = lane & 7;
#pragma unroll
    for (int j = 0; j < 4; ++j) { const int n = (lane >> 3) + 8 * j; const LAS float* s = scr + (8 * c) * 33 + (perm ? perm32(n) : n);
        u32x4 o; o.x = cvt_pk_bf16(s[0 * 33], s[1 * 33]); o.y = cvt_pk_bf16(s[2 * 33], s[3 * 33]); o.z = cvt_pk_bf16(s[4 * 33], s[5 * 33]); o.w = cvt_pk_bf16(s[6 * 33], s[7 * 33]);
        *(u32x4*)(WTrow0 + (size_t)n * 1024 + k0 + 8 * c) = o; }
    LDS_WAIT(); asm volatile("" ::: "memory");
}

__device__ __forceinline__ void transpose_item8(const float* __restrict__ W, int ldw, int scol0, unsigned char* WTrow0, int k0, LAS float* scr, int lane, float scale) {
#pragma unroll 8
    for (int i = 0; i < 32; ++i) { const int kk = 2 * i + (lane >> 5); scr[kk * 33 + (lane & 31)] = W[(size_t)(k0 + kk) * ldw + scol0 + (lane & 31)]; }
    LDS_WAIT(); asm volatile("" ::: "memory");
    const int c = lane & 7;
#pragma unroll
    for (int j = 0; j < 4; ++j) { const int n = (lane >> 3) + 8 * j; const LAS float* s = scr + (8 * c) * 33 + perm32(n);
        u32x2 o; o.x = pk4_fp8(s[0 * 33] * scale, s[1 * 33] * scale, s[2 * 33] * scale, s[3 * 33] * scale); o.y = pk4_fp8(s[4 * 33] * scale, s[5 * 33] * scale, s[6 * 33] * scale, s[7 * 33] * scale);
        *(u32x2*)(WTrow0 + (size_t)n * 1024 + k0 + 8 * c) = o; }
    LDS_WAIT(); asm volatile("" ::: "memory");
}

__device__ __forceinline__ void phase_prep(const Params& p, LAS unsigned char* lds, int G) {
    const int tid = otid(), lane = tid & 63, wave = __builtin_amdgcn_readfirstlane(tid >> 6);
    const int gw = blockIdx.x * 8 + wave, NGW = G * 8;
    LAS float* sl = (LAS float*)(lds + 73728);
    for (int i = tid; i < 9 * 1024; i += NTHREADS) { const float v = i < 8192 ? p.c[i] : p.c_ctx[i - 8192]; sl[i] = v / (1.0f + __expf(-v)); }
    __syncthreads();
    float* mod = (float*)(p.ws + WS_MOD);
    if (gw < 384) {
        const int c0 = gw * 16, col = lane & 15, kq = lane >> 4;
        float acc[9];
#pragma unroll
        for (int v = 0; v < 9; ++v) acc[v] = 0.f;
        const float* wp = p.ada_w + (size_t)(kq * 256) * 6144 + c0 + col;
#pragma unroll 8
        for (int i = 0; i < 256; ++i) { const float w = wp[(size_t)i * 6144];
#pragma unroll
            for (int v = 0; v < 9; ++v) acc[v] += sl[v * 1024 + kq * 256 + i] * w; }
#pragma unroll
        for (int v = 0; v < 9; ++v) { acc[v] += __shfl_xor(acc[v], 16); acc[v] += __shfl_xor(acc[v], 32); }
        if (lane < 16) { const float b = p.ada_b[c0 + col];
#pragma unroll
            for (int v = 0; v < 9; ++v) mod[v * 6144 + c0 + col] = acc[v] + b; }
    }
    if (blockIdx.x == 0 && wave == 0) {
        const float s01 = wave_sum(p.dlam[lane] * p.dlam[64 + lane]), s23 = wave_sum(p.dlam[128 + lane] * p.dlam[192 + lane]);
        if (lane == 0) *(float*)(p.ws + WS_LAM) = expf(s01) - expf(s23) + LAM_INIT;
    }
    if (blockIdx.x == 1 && wave == 0 && lane < 16) {
        double th = 1.0; for (int j = 0; j < lane; ++j) th *= 0.5623413251903491;
        double ct = 1.0, st = th, term_c = 1.0, term_s = th; const double t2 = th * th;
        for (int n = 1; n < 14; ++n) { term_c *= -t2 / ((2.0 * n - 1.0) * (2.0 * n)); term_s *= -t2 / ((2.0 * n) * (2.0 * n + 1.0)); ct += term_c; st += term_s; }
        float* rc = (float*)(p.ws + WS_ROPE); float* rs = rc + 1024;
        double cc = 1.0, ss = 0.0;
        for (int pos = 0; pos < 64; ++pos) { rc[pos * 16 + lane] = (float)cc; rs[pos * 16 + lane] = (float)ss; const double c2 = cc * ct - ss * st, s2 = ss * ct + cc * st; cc = c2; ss = s2; }
    }
    LAS float* scr = (LAS float*)(lds + wave * 8448);
    bf16_t* WIN = (bf16_t*)(p.ws + WS_WIN);
    constexpr int I_IN = 16 * 256, I_SQ = 16 * 32, I_W1 = 32 * 16 * 64, I_W2 = 32 * 16 * 32, NITEMS = I_IN + 3 * I_SQ + I_W1 + I_W2;
    for (int it = gw; it < NITEMS; it += NGW) {
        int r = it;
        if (r < I_IN) { const int kb = r >> 8, nb = r & 255, n0 = nb * 32; transpose_item(p.w_in, INCOLS, n0 < 2048 ? n0 : n0 + 16, WIN + (size_t)n0 * 1024, kb * 64, scr, lane, !(n0 >= 3072 && n0 < 5120)); continue; } r -= I_IN;
        if (r < 3 * I_SQ) { const int w = r / I_SQ, r2 = r % I_SQ, kb = r2 >> 5, nb = r2 & 31; const float* W = w == 0 ? p.w_a : (w == 1 ? p.w_b : p.w_o);
            bf16_t* WT = (bf16_t*)(p.ws + (w == 0 ? WS_WA : (w == 1 ? WS_WB : WS_WO))); transpose_item(W, 1024, nb * 32, WT + (size_t)nb * 32 * 1024, kb * 64, scr, lane, true); continue; } r -= 3 * I_SQ;
        if (r < I_W1) { const int e = r >> 10, r2 = r & 1023, kb = r2 >> 6, g = r2 & 63, pn = g >> 3, bj = (g >> 2) & 1, q = g & 3;
            transpose_item8(p.exp_w1 + (size_t)e * 1024 * 2048, 2048, bj * 1024 + 128 * pn + 32 * q, p.ws + WS_W1 + ((size_t)e * 2048 + 32 * g) * 1024, kb * 64, scr, lane, 64.0f); continue; } r -= I_W1;
        { const int e = r >> 9, r2 = r & 511, kb = r2 >> 5, nb = r2 & 31;
            transpose_item8(p.exp_w2 + (size_t)e * 1024 * 1024, 1024, nb * 32, p.ws + WS_W2 + ((size_t)e * 1024 + 32 * nb) * 1024, kb * 64, scr, lane, 64.0f); }
    }
}

__device__ __forceinline__ void phase_rows1(const Params& p, LAS unsigned char* lds, int G) {
    const int tid = otid(), lane = tid & 63, wave = __builtin_amdgcn_readfirstlane(tid >> 6);
    const int gw = blockIdx.x * 8 + wave, NGW = G * 8;
    LAS float* wg = (LAS float*)lds;
    for (int i = tid; i < 16 * 1024; i += NTHREADS) { const int k = i >> 4, g = i & 15; wg[g * 1024 + k] = p.w_in[(size_t)k * INCOLS + 2048 + g]; }
    __syncthreads();
    const float* mod = (const float*)(p.ws + WS_MOD); bf16_t* U = (bf16_t*)(p.ws + WS_U); float* GT = (float*)(p.ws + WS_GT);
    f32x4 gn[4];
#pragma unroll
    for (int j = 0; j < 4; ++j) gn[j] = *(const f32x4*)(p.norm1_g + 4 * lane + 256 * j);
    for (int m = gw; m < TT; m += NGW) {
        const float* xr = m < TL ? p.x + (size_t)m * 1024 : p.ctx + (size_t)(m - TL) * 1024;
        const float* md = mod + (size_t)(m < TL ? (m >> 12) : 8) * 6144;
        f32x4 v[4]; float ss = 0.f;
#pragma unroll
        for (int j = 0; j < 4; ++j) { v[j] = *(const f32x4*)(xr + 4 * lane + 256 * j); ss += (v[j][0] * v[j][0] + v[j][1] * v[j][1]) + (v[j][2] * v[j][2] + v[j][3] * v[j][3]); }
        const float rstd = rsqrtf(wave_sum(ss) * (1.0f / 1024.0f) + EPS);
#pragma unroll
        for (int j = 0; j < 4; ++j) { const f32x4 sh = *(const f32x4*)(md + 4 * lane + 256 * j), sc = *(const f32x4*)(md + 1024 + 4 * lane + 256 * j);
            v[j] = (v[j] * rstd * gn[j]) * (sc + 1.0f) + sh;
            u32x2 w; w.x = cvt_pk_bf16(v[j][0], v[j][1]); w.y = cvt_pk_bf16(v[j][2], v[j][3]); *(u32x2*)(U + (size_t)m * 1024 + 4 * lane + 256 * j) = w; }
        float val = 0.f;
#pragma unroll
        for (int g = 0; g < 16; ++g) { float a = 0.f;
#pragma unroll
            for (int j = 0; j < 4; ++j) { const f32x4 w = *(const LAS f32x4*)(wg + g * 1024 + 4 * lane + 256 * j); a += (v[j][0] * w[0] + v[j][1] * w[1]) + (v[j][2] * w[2] + v[j][3] * w[3]); }
            a = wave_sum(a); val = (lane == g) ? a : val; asm volatile("" ::: "memory"); }
        if (lane < 16) {
            val += p.gate_b[lane]; const int type = lane >> 2; if (type & 1) val = log_sigmoidf_(val);
            GT[(size_t)m * 16 + lane] = val; }
    }
}

__device__ __forceinline__ void phase_mlstm_naive(const Params& p, LAS unsigned char* lds_, int item) {
    const int tid = otid(); float* lds = (float*)(unsigned char*)lds_;
    const int dvh = item & 1, dir = (item >> 1) & 1, h = (item >> 2) & 3, b = item >> 4;
    const int dvl = tid >> 2, kq = tid & 3;
    float* Ks = lds; float* Qs = lds + 4096; float* Vs = lds + 8192; float* gi = lds + 12288; float* gf = gi + 32;
    const bf16_t* MQ = (const bf16_t*)(p.ws + WS_MQ); const bf16_t* MK = (const bf16_t*)(p.ws + WS_MK); const bf16_t* MV = (const bf16_t*)(p.ws + WS_MV);
    const float* GT = (const float*)(p.ws + WS_GT); bf16_t* H = (bf16_t*)(p.ws + (dir ? WS_HB : WS_HF));
    float C[32], nn[32];
#pragma unroll
    for (int r = 0; r < 32; ++r) { C[r] = 0.f; nn[r] = 0.f; }
    for (int s0 = 0; s0 < KVLEN; s0 += 32) {
        const bool latent = s0 >= CTX;
        __syncthreads();
        {
            const int j = tid >> 4, c8 = (tid & 15) * 8; const int s = s0 + j;
            const int m = latent ? b * SEQ + (dir ? SEQ - 1 - (s - CTX) : s - CTX) : TL + b * CTX + (dir ? CTX - 1 - s : s);
            const bf16x8 kv = *(const bf16x8*)(MK + (size_t)m * 512 + h * 128 + c8);
            const bf16x8 vv = *(const bf16x8*)(MV + (size_t)m * 1024 + h * 256 + dvh * 128 + c8);
#pragma unroll
            for (int i = 0; i < 8; ++i) { Ks[j * 128 + c8 + i] = bf2f((bf16_t)kv[i]); Vs[j * 128 + c8 + i] = bf2f((bf16_t)vv[i]); }
            if (latent) { const bf16x8 qv = *(const bf16x8*)(MQ + (size_t)m * 512 + h * 128 + c8);
#pragma unroll
                for (int i = 0; i < 8; ++i) Qs[j * 128 + c8 + i] = bf2f((bf16_t)qv[i]); }
            if ((tid & 15) == 0) { gi[j] = GT[(size_t)m * 16 + dir * 8 + h]; gf[j] = GT[(size_t)m * 16 + dir * 8 + 4 + h]; }
        }
        __syncthreads();
        for (int j = 0; j < 32; ++j) {
            const float f = __expf(gf[j]), ig = __expf(gi[j]); const float v = Vs[j * 128 + dvl];
            float num = 0.f, den = 0.f;
            const f32x4* kp = (const f32x4*)(Ks + j * 128 + kq * 32); const f32x4* qp = (const f32x4*)(Qs + j * 128 + kq * 32);
#pragma unroll
            for (int r4 = 0; r4 < 8; ++r4) { const f32x4 k4 = kp[r4]; f32x4 q4 = {0.f, 0.f, 0.f, 0.f}; if (latent) q4 = qp[r4];
#pragma unroll
                for (int i = 0; i < 4; ++i) { const int r = r4 * 4 + i; const float ik = ig * k4[i]; C[r] = f * C[r] + ik * v; nn[r] = f * nn[r] + ik; num += q4[i] * C[r]; den += q4[i] * nn[r]; } }
            if (latent) {
                num += __shfl_xor(num, 1); num += __shfl_xor(num, 2); den += __shfl_xor(den, 1); den += __shfl_xor(den, 2);
                if (kq == 0) { const int s = s0 + j; const int m = b * SEQ + (dir ? SEQ - 1 - (s - CTX) : s - CTX);
                    const float hv = num / fmaxf(fabsf(den), 1.0f);
                    H[(size_t)m * 1024 + h * 256 + dvh * 128 + dvl] = (bf16_t)(cvt_pk_bf16(hv, 0.f) & 0xffffu); }
            }
        }
    }
    __syncthreads();
}

namespace mls {
#define KSWZ(row, colB) ((row) * 256 + ((colB) ^ (((row) & 7) << 4)))
#define SBAR() __builtin_amdgcn_sched_barrier(0)
using att::crow; using att::cvtpk; using att::v_st; using att::v_rd_base; using att::v_rd_off; using att::tr_read;
constexpr int L_KSW = 0, L_KV = 32768, L_V = 65536, L_CT = 98304, L_F = 114688;
__device__ __forceinline__ float swap_add(float v) { auto rr = __builtin_amdgcn_permlane32_swap(__float_as_uint(v), __float_as_uint(v), false, false); return __uint_as_float(rr[0]) + __uint_as_float(rr[1]); }
#define TRPK(L, H) (bf16x8){L[0], L[1], L[2], L[3], H[0], H[1], H[2], H[3]}
__device__ __forceinline__ void mlstm_item(const Params& p, LAS unsigned char* lds_, int item) {
    char* lds = (char*)(unsigned char*)lds_;
    const int tid = otid(), wid = __builtin_amdgcn_readfirstlane(tid >> 6), lane = tid & 63, r32 = lane & 31, hi = lane >> 5;
    const int dvq = item & 3, dir = (item >> 2) & 1, h = (item >> 3) & 3, b = item >> 5;
    const int rb = wid & 3, vh = wid >> 2;
    float* fa = (float*)(lds + L_F); float* a_ = fa; float* bco = fa + 128; float* w_ = fa + 256; float* wint = fa + 384; float* nvec = fa + 512; float* npart = fa + 640; float* denl = fa + 1152 + wid * 32; float* gsc = fa + 1408;
    const bf16_t* MQ = (const bf16_t*)(p.ws + WS_MQ); const bf16_t* MK = (const bf16_t*)(p.ws + WS_MK); const bf16_t* MV = (const bf16_t*)(p.ws + WS_MV);
    const float* GT = (const float*)(p.ws + WS_GT); bf16_t* H = (bf16_t*)(p.ws + (dir ? WS_HB : WS_HF));
    f32x16 Cacc = {};
    { u32x4 z = {0u, 0u, 0u, 0u}; *(u32x4*)(lds + L_CT + tid * 32) = z; *(u32x4*)(lds + L_CT + tid * 32 + 16) = z; if (tid < 128) nvec[tid] = 0.f; }
    const int tid_outer = tid;
    bf16x8 kreg[4], vreg[2], qnx[8]; float gi0 = 0.f, glf0 = 0.f, gi1 = 0.f, glf1 = 0.f;
#define MROW0(cc_) ((cc_) >= 2 ? b * SEQ + (dir ? 33 - (cc_) : (cc_) - 2) * 128 : TL + b * CTX + (dir ? 1 - (cc_) : (cc_)) * 128)
#define LOADS(cn_, T_) do { const int mr_ = MROW0(cn_); const int ln_ = (T_) & 63; \
        _Pragma("unroll") for (int i = 0; i < 4; ++i) { const int pc = (T_) + 512 * i, pr = pc >> 4, c8 = (pc & 15) * 8; kreg[i] = *(const bf16x8*)(MK + (size_t)(mr_ + (dir ? 127 - pr : pr)) * 512 + h * 128 + c8); } \
        _Pragma("unroll") for (int i = 0; i < 2; ++i) { const int pc = (T_) + 512 * i, pr = pc >> 3, c8 = (pc & 7) * 8; vreg[i] = *(const bf16x8*)(MV + (size_t)(mr_ + (dir ? 127 - pr : pr)) * 1024 + h * 256 + dvq * 64 + c8); } \
        if ((cn_) >= 2) { const int pr = rb * 32 + (ln_ & 31); const bf16_t* qp = MQ + (size_t)(mr_ + (dir ? 127 - pr : pr)) * 512 + h * 128 + (ln_ >> 5) * 8; \
            _Pragma("unroll") for (int d0 = 0; d0 < 8; ++d0) qnx[d0] = *(const bf16x8*)(qp + d0 * 16); } \
        else { _Pragma("unroll") for (int d0 = 0; d0 < 8; ++d0) qnx[d0] = bf16x8{}; } \
        if (wid == 0) { const int p0 = 2 * ln_, p1 = 2 * ln_ + 1; const size_t m0 = (size_t)(mr_ + (dir ? 127 - p0 : p0)) * 16, m1 = (size_t)(mr_ + (dir ? 127 - p1 : p1)) * 16; \
            gi0 = GT[m0 + dir * 8 + h]; glf0 = GT[m0 + dir * 8 + 4 + h]; gi1 = GT[m1 + dir * 8 + h]; glf1 = GT[m1 + dir * 8 + 4 + h]; } } while (0)
    LOADS(0, tid_outer);
    for (int c = 0; c < 34; ++c) {
        int tid = tid_outer; asm volatile("" : "+v"(tid));
        const int lane = tid & 63, r32 = lane & 31, hi = lane >> 5;
        const int vbV = (int)(uintptr_t)(lds + L_V) + v_rd_base(lane), vbK = (int)(uintptr_t)(lds + L_KV) + v_rd_base(lane);
        const bool latent = c >= 2;
        const int mrow0 = MROW0(c);
        bf16x8 qr[8];
        if (wid == 0) {
            const int p0 = 2 * lane, p1 = 2 * lane + 1;
            const float i0 = gi0, lf0 = glf0, i1 = gi1, lf1 = glf1;
            float incl = lf0 + lf1;
#pragma unroll
            for (int o = 1; o < 64; o <<= 1) { const float t = __shfl_up(incl, o); if (lane >= o) incl += t; }
            const float F1 = incl, F0 = incl - lf1, Ftot = __shfl(incl, 63);
            a_[p0] = F0; a_[p1] = F1; bco[p0] = i0 - F0; bco[p1] = i1 - F1; wint[p0] = __expf(F0); wint[p1] = __expf(F1);
            w_[p0] = __expf(Ftot - F0 + i0); w_[p1] = __expf(Ftot - F1 + i1); if (lane == 0) gsc[0] = __expf(Ftot);
        }
        __syncthreads();
#pragma unroll
        for (int i = 0; i < 4; ++i) { const int pc = tid + 512 * i, pr = pc >> 4, c8 = (pc & 15) * 8;
            *(bf16x8*)(lds + L_KSW + KSWZ(pr, c8 * 2)) = kreg[i]; *(bf16x8*)(lds + L_KV + (pr >> 6) * 16384 + v_st(pr & 63, c8)) = kreg[i]; }
#pragma unroll
        for (int i = 0; i < 2; ++i) { const int pc = tid + 512 * i, pr = pc >> 3, c8 = (pc & 7) * 8; const float ws_ = w_[pr];
            *(bf16x8*)(lds + L_V + (pr >> 6) * 16384 + v_st(pr & 63, c8)) = vreg[i];
            u32x4 sv; const u32x4 raw = *reinterpret_cast<const u32x4*>(&vreg[i]);
            sv.x = cvtpk(bf_lo(raw.x) * ws_, bf_hi(raw.x) * ws_); sv.y = cvtpk(bf_lo(raw.y) * ws_, bf_hi(raw.y) * ws_); sv.z = cvtpk(bf_lo(raw.z) * ws_, bf_hi(raw.z) * ws_); sv.w = cvtpk(bf_lo(raw.w) * ws_, bf_hi(raw.w) * ws_);
            *(u32x4*)(lds + L_V + (pr >> 6) * 16384 + v_st(pr & 63, 64 + c8)) = sv; }
#pragma unroll
        for (int d0 = 0; d0 < 8; ++d0) qr[d0] = qnx[d0];
        __syncthreads();
        if (c + 1 < 34) LOADS(c + 1, tid);
        const float g = gsc[0];
        if (latent) {
            const int qidx = rb * 32 + r32;
            float qn = 0.f;
#pragma unroll
            for (int d0 = 0; d0 < 8; ++d0) { const f32x4 n0 = *(const f32x4*)(nvec + d0 * 16 + hi * 8), n1 = *(const f32x4*)(nvec + d0 * 16 + hi * 8 + 4); const u32x4 q4 = *reinterpret_cast<const u32x4*>(&qr[d0]);
                qn += bf_lo(q4.x) * n0[0] + bf_hi(q4.x) * n0[1] + bf_lo(q4.y) * n0[2] + bf_hi(q4.y) * n0[3] + bf_lo(q4.z) * n1[0] + bf_hi(q4.z) * n1[1] + bf_lo(q4.w) * n1[2] + bf_hi(q4.w) * n1[3]; }
            qn = swap_add(qn);
            f32x16 o = {};
#pragma unroll
            for (int d0 = 0; d0 < 8; ++d0) { const bf16x8 cf = *(const bf16x8*)(lds + L_CT + KSWZ(32 * vh + r32, (d0 * 16 + hi * 8) * 2)); o = __builtin_amdgcn_mfma_f32_32x32x16_bf16(qr[d0], cf, o, 0, 0, 0); }
#pragma unroll
            for (int g4 = 0; g4 < 4; ++g4) { const f32x4 wi = *(const f32x4*)(wint + rb * 32 + 8 * g4 + 4 * hi);
#pragma unroll
                for (int i = 0; i < 4; ++i) o[g4 * 4 + i] *= wi[i]; }
            const float aq = a_[qidx]; float den = 0.f;
            for (int jt = 0; jt <= (rb >> 1); ++jt) {
                f32x16 p0 = {}, p1 = {};
#pragma unroll
                for (int d0 = 0; d0 < 8; ++d0) { const int cbb = (d0 * 16 + hi * 8) * 2;
                    const bf16x8 b0 = *(const bf16x8*)(lds + L_KSW + KSWZ(64 * jt + r32, cbb)), b1 = *(const bf16x8*)(lds + L_KSW + KSWZ(64 * jt + 32 + r32, cbb));
                    p0 = __builtin_amdgcn_mfma_f32_32x32x16_bf16(b0, qr[d0], p0, 0, 0, 0); p1 = __builtin_amdgcn_mfma_f32_32x32x16_bf16(b1, qr[d0], p1, 0, 0, 0); }
                float ps = 0.f;
#pragma unroll
                for (int g4 = 0; g4 < 4; ++g4) { const int k0 = 64 * jt + 8 * g4 + 4 * hi; const f32x4 bb0 = *(const f32x4*)(bco + k0), bb1 = *(const f32x4*)(bco + k0 + 32);
#pragma unroll
                    for (int i = 0; i < 4; ++i) { const int r = g4 * 4 + i;
                        const float e0 = __expf(aq + bb0[i]), e1 = __expf(aq + bb1[i]);
                        p0[r] = (k0 + i <= qidx) ? p0[r] * e0 : 0.f; p1[r] = (k0 + 32 + i <= qidx) ? p1[r] * e1 : 0.f; ps += p0[r] + p1[r]; } }
                den += swap_add(ps);
                bf16x8 pa0, pa1, pa2, pa3;
#define PK4(P, BASE, OUT) do { unsigned a0 = cvtpk(P[BASE + 0], P[BASE + 1]), a1 = cvtpk(P[BASE + 2], P[BASE + 3]);   \
    unsigned b0_ = cvtpk(P[BASE + 4], P[BASE + 5]), b1_ = cvtpk(P[BASE + 6], P[BASE + 7]);                              \
    auto r0 = __builtin_amdgcn_permlane32_swap(a0, b0_, false, false); auto r1 = __builtin_amdgcn_permlane32_swap(a1, b1_, false, false); \
    u32x4 w4 = {r0[0], r1[0], r0[1], r1[1]}; OUT = *reinterpret_cast<bf16x8*>(&w4); } while (0)
                PK4(p0, 0, pa0); PK4(p0, 8, pa1); PK4(p1, 0, pa2); PK4(p1, 8, pa3);
#undef PK4
                const int vb = vbV + jt * 16384 + vh * 512;
                const s16x4 l0 = tr_read<v_rd_off(0, 0, 0)>(vb), h0 = tr_read<v_rd_off(0, 0, 1)>(vb), l1 = tr_read<v_rd_off(0, 1, 0)>(vb), h1 = tr_read<v_rd_off(0, 1, 1)>(vb);
                const s16x4 l2 = tr_read<v_rd_off(0, 2, 0)>(vb), h2 = tr_read<v_rd_off(0, 2, 1)>(vb), l3 = tr_read<v_rd_off(0, 3, 0)>(vb), h3 = tr_read<v_rd_off(0, 3, 1)>(vb);
                asm volatile("s_waitcnt lgkmcnt(0)" ::: "memory"); SBAR();
                o = __builtin_amdgcn_mfma_f32_32x32x16_bf16(pa0, TRPK(l0, h0), o, 0, 0, 0); o = __builtin_amdgcn_mfma_f32_32x32x16_bf16(pa1, TRPK(l1, h1), o, 0, 0, 0);
                o = __builtin_amdgcn_mfma_f32_32x32x16_bf16(pa2, TRPK(l2, h2), o, 0, 0, 0); o = __builtin_amdgcn_mfma_f32_32x32x16_bf16(pa3, TRPK(l3, h3), o, 0, 0, 0);
            }
            const float dtot = den + wint[qidx] * qn;
            if (hi == 0) denl[r32] = dtot;
            asm volatile("s_waitcnt lgkmcnt(0)" ::: "memory");
#pragma unroll
            for (int g4 = 0; g4 < 4; ++g4) { const f32x4 dd = *(const f32x4*)(denl + 8 * g4 + 4 * hi);
#pragma unroll
                for (int i = 0; i < 4; ++i) { const int r = g4 * 4 + i, pr = rb * 32 + 8 * g4 + 4 * hi + i;
                    const float hv = o[r] / fmaxf(fabsf(dd[i]), 1.0f);
                    H[(size_t)(mrow0 + (dir ? 127 - pr : pr)) * 1024 + h * 256 + dvq * 64 + vh * 32 + r32] = (bf16_t)(cvtpk(hv, 0.f) & 0xffffu); } }
        }
#pragma unroll
        for (int r = 0; r < 16; ++r) Cacc[r] *= g;
#pragma unroll
        for (int jt = 0; jt < 2; ++jt) {
            const int va = vbV + jt * 16384 + (2 + vh) * 512, ka = vbK + jt * 16384 + rb * 512;
            const s16x4 al0 = tr_read<v_rd_off(0, 0, 0)>(va), ah0 = tr_read<v_rd_off(0, 0, 1)>(va), al1 = tr_read<v_rd_off(0, 1, 0)>(va), ah1 = tr_read<v_rd_off(0, 1, 1)>(va);
            const s16x4 al2 = tr_read<v_rd_off(0, 2, 0)>(va), ah2 = tr_read<v_rd_off(0, 2, 1)>(va), al3 = tr_read<v_rd_off(0, 3, 0)>(va), ah3 = tr_read<v_rd_off(0, 3, 1)>(va);
            const s16x4 bl0 = tr_read<v_rd_off(0, 0, 0)>(ka), bh0 = tr_read<v_rd_off(0, 0, 1)>(ka), bl1 = tr_read<v_rd_off(0, 1, 0)>(ka), bh1 = tr_read<v_rd_off(0, 1, 1)>(ka);
            const s16x4 bl2 = tr_read<v_rd_off(0, 2, 0)>(ka), bh2 = tr_read<v_rd_off(0, 2, 1)>(ka), bl3 = tr_read<v_rd_off(0, 3, 0)>(ka), bh3 = tr_read<v_rd_off(0, 3, 1)>(ka);
            asm volatile("s_waitcnt lgkmcnt(0)" ::: "memory"); SBAR();
            Cacc = __builtin_amdgcn_mfma_f32_32x32x16_bf16(TRPK(al0, ah0), TRPK(bl0, bh0), Cacc, 0, 0, 0); Cacc = __builtin_amdgcn_mfma_f32_32x32x16_bf16(TRPK(al1, ah1), TRPK(bl1, bh1), Cacc, 0, 0, 0);
            Cacc = __builtin_amdgcn_mfma_f32_32x32x16_bf16(TRPK(al2, ah2), TRPK(bl2, bh2), Cacc, 0, 0, 0); Cacc = __builtin_amdgcn_mfma_f32_32x32x16_bf16(TRPK(al3, ah3), TRPK(bl3, bh3), Cacc, 0, 0, 0);
        }
        { const int k = tid & 127, sq = tid >> 7; float part = 0.f;
#pragma unroll 8
            for (int s = sq * 32; s < sq * 32 + 32; ++s) part += w_[s] * bf2f(*(const bf16_t*)(lds + L_KSW + KSWZ(s, 2 * k)));
            npart[sq * 128 + k] = part; }
        __syncthreads();
#pragma unroll
        for (int r = 0; r < 16; ++r) *(bf16_t*)(lds + L_CT + KSWZ(32 * vh + crow(r, hi), 2 * (32 * rb + r32))) = (bf16_t)(cvtpk(Cacc[r], 0.f) & 0xffffu);
        if (tid < 128) nvec[tid] = g * nvec[tid] + ((npart[tid] + npart[128 + tid]) + (npart[256 + tid] + npart[384 + tid]));
    }
    __syncthreads();
}
#undef TRPK
#undef KSWZ
#undef SBAR
#undef LOADS
#undef MROW0
}

__device__ __forceinline__ void phase_mfinal(const Params& p, int G) {
    const int tid = otid(), lane = tid & 63, wave = __builtin_amdgcn_readfirstlane(tid >> 6);
    const int gw = blockIdx.x * 8 + wave, NGW = G * 8;
    bf16_t* HF = (bf16_t*)(p.ws + WS_HF); const bf16_t* HB = (const bf16_t*)(p.ws + WS_HB); const bf16_t* MO = (const bf16_t*)(p.ws + WS_MO);
    for (int m = gw; m < TL; m += NGW) {
#pragma unroll
        for (int j = 0; j < 4; ++j) {
            const size_t o = (size_t)m * 1024 + 256 * j + 4 * lane;
            const u32x2 a = *(const u32x2*)(HF + o), bq = *(const u32x2*)(HB + o), og = *(const u32x2*)(MO + o);
            f32x4 hs = {bf_lo(a.x) + bf_lo(bq.x), bf_hi(a.x) + bf_hi(bq.x), bf_lo(a.y) + bf_lo(bq.y), bf_hi(a.y) + bf_hi(bq.y)};
            const float rstd = rsqrtf(wave_sum((hs[0] * hs[0] + hs[1] * hs[1]) + (hs[2] * hs[2] + hs[3] * hs[3])) * (1.0f / 256.0f) + EPS);
            const f32x4 g = *(const f32x4*)(p.mnorm_g + 256 * j + 4 * lane);
            const f32x4 ov = {sigmoidf_(bf_lo(og.x)), sigmoidf_(bf_hi(og.x)), sigmoidf_(bf_lo(og.y)), sigmoidf_(bf_hi(og.y))};
            const f32x4 r = hs * rstd * g * ov;
            u32x2 w; w.x = cvt_pk_bf16(r[0], r[1]); w.y = cvt_pk_bf16(r[2], r[3]); *(u32x2*)(HF + o) = w;
        }
    }
}

__device__ __forceinline__ void phase_rows2(const Params& p, LAS unsigned char* lds, int grp) {
    const int tid = otid(), lane = tid & 63, wave = __builtin_amdgcn_readfirstlane(tid >> 6);
    LAS float* rw = (LAS float*)lds;
    LAS int* hist = (LAS int*)(lds + 131072);
    LAS int* basee = hist + 32;
    LAS int* a_e = basee + 32;
    LAS int* a_p = a_e + 512;
    LAS float* a_g = (LAS float*)(a_p + 512);
    for (int i = tid; i < 32 * 1024; i += NTHREADS) { const int k = i >> 5, e = i & 31; rw[e * 1024 + k] = p.router_w[i]; }
    if (tid < 32) hist[tid] = 0;
    __syncthreads();
    const float* mod = (const float*)(p.ws + WS_MOD); unsigned char* U2 = p.ws + WS_U2;
    unsigned* cnt = (unsigned*)(p.ws + WS_CTL) + CW_CNT; int* asg = (int*)(p.ws + WS_ASG); int* list = (int*)(p.ws + WS_LIST); float* lgate = (float*)(p.ws + WS_LGATE);
    f32x4 gn[4];
#pragma unroll
    for (int j = 0; j < 4; ++j) gn[j] = *(const f32x4*)(p.norm2_g + 4 * lane + 256 * j);
    const int tok0 = grp * 128 + wave * 16;
    for (int it = 0; it < 16; ++it) {
        const int m = tok0 + it; const float* xr = p.out + (size_t)m * 1024; const float* md = mod + (size_t)(m >> 12) * 6144;
        f32x4 v[4]; float ss = 0.f;
#pragma unroll
        for (int j = 0; j < 4; ++j) { v[j] = *(const f32x4*)(xr + 4 * lane + 256 * j); ss += (v[j][0] * v[j][0] + v[j][1] * v[j][1]) + (v[j][2] * v[j][2] + v[j][3] * v[j][3]); }
        const float rstd = rsqrtf(wave_sum(ss) * (1.0f / 1024.0f) + EPS);
#pragma unroll
        for (int j = 0; j < 4; ++j) { const f32x4 sh = *(const f32x4*)(md + 3072 + 4 * lane + 256 * j), sc = *(const f32x4*)(md + 4096 + 4 * lane + 256 * j);
            v[j] = (v[j] * rstd * gn[j]) * (sc + 1.0f) + sh;
            *(unsigned*)(U2 + (size_t)m * 1024 + 4 * lane + 256 * j) = pk4_fp8(v[j][0], v[j][1], v[j][2], v[j][3]); }
        float mine = 0.f;
#pragma unroll 4
        for (int e = 0; e < 32; ++e) { float a = 0.f;
#pragma unroll
            for (int j = 0; j < 4; ++j) { const f32x4 w = *(const LAS f32x4*)(rw + e * 1024 + 4 * lane + 256 * j); a += (v[j][0] * w[0] + v[j][1] * w[1]) + (v[j][2] * w[2] + v[j][3] * w[3]); }
            a = wave_sum(a); mine = (lane == e) ? a : mine; }
        if (lane < 32) mine += p.router_b[lane];
        float val = lane < 32 ? mine : -INFINITY; int sel_e[4]; float sel_v[4];
#pragma unroll
        for (int k = 0; k < 4; ++k) {
            float bv = val; int bi = lane;
#pragma unroll
            for (int o = 1; o < 64; o <<= 1) { const float ov = __shfl_xor(bv, o); const int oi = __shfl_xor(bi, o); if (ov > bv || (ov == bv && oi < bi)) { bv = ov; bi = oi; } }
            sel_e[k] = bi; sel_v[k] = bv; if (lane == bi) val = -INFINITY;
        }
        if (lane == 0) {
            const float e1 = __expf(sel_v[1] - sel_v[0]), e2 = __expf(sel_v[2] - sel_v[0]), e3 = __expf(sel_v[3] - sel_v[0]); const float inv = 1.0f / (1.0f + e1 + e2 + e3);
            const float gk[4] = {inv, e1 * inv, e2 * inv, e3 * inv};
#pragma unroll
            for (int k = 0; k < 4; ++k) { const int a = (wave * 16 + it) * 4 + k; a_e[a] = sel_e[k]; a_p[a] = atomicAdd((int*)&hist[sel_e[k]], 1); a_g[a] = gk[k]; }
        }
    }
    __syncthreads();
    if (tid < 32) basee[tid] = (int)atomicAdd(cnt + tid, (unsigned)hist[tid]);
    __syncthreads();
    {
        const int a = tid; const int e = a_e[a]; const int pos = basee[e] + a_p[a]; const int tok = grp * 128 + (a >> 2);
        list[(size_t)e * CAP + pos] = tok; lgate[(size_t)e * CAP + pos] = a_g[a]; asg[tok * 4 + (a & 3)] = e * CAP + pos;
    }
    __syncthreads();
}

__device__ __forceinline__ void moe_tables(const Params& p, LAS int* tb, LAS int* cn) {
    if (threadIdx.x == 0) { const unsigned* cnt = (const unsigned*)(p.ws + WS_CTL) + CW_CNT; int acc = 0;
        for (int e = 0; e < 32; ++e) { const int c = (int)__hip_atomic_load(cnt + e, __ATOMIC_RELAXED, __HIP_MEMORY_SCOPE_AGENT); cn[e] = c; tb[e] = acc; acc += (c + 255) >> 8; } tb[32] = acc; }
    __syncthreads();
}

__device__ __forceinline__ void phase_final(const Params& p, const LAS int* tb, int G) {
    const int tid = otid(), lane = tid & 63, wave = __builtin_amdgcn_readfirstlane(tid >> 6);
    const int gw = blockIdx.x * 8 + wave, NGW = G * 8;
    const float* mod = (const float*)(p.ws + WS_MOD); const bf16_t* YS = (const bf16_t*)(p.ws + WS_YS); const int* asg = (const int*)(p.ws + WS_ASG);
    f32x4 gn[4];
#pragma unroll
    for (int j = 0; j < 4; ++j) gn[j] = *(const f32x4*)(p.final_g + 4 * lane + 256 * j);
    for (int m = gw; m < TL; m += NGW) {
        float* xr = p.out + (size_t)m * 1024; const float* g2 = mod + (size_t)(m >> 12) * 6144 + 5120;
        size_t rows[4];
#pragma unroll
        for (int k = 0; k < 4; ++k) { const int a = asg[m * 4 + k]; const int e = a >> 15, pos = a & (CAP - 1); rows[k] = (size_t)(tb[e] * 256 + pos) * 1024; }
        f32x4 v[4]; float ss = 0.f;
#pragma unroll
        for (int j = 0; j < 4; ++j) {
            f32x4 y = {0.f, 0.f, 0.f, 0.f};
#pragma unroll
            for (int k = 0; k < 4; ++k) { const u32x2 w = *(const u32x2*)(YS + rows[k] + 4 * lane + 256 * j); y[0] += bf_lo(w.x); y[1] += bf_hi(w.x); y[2] += bf_lo(w.y); y[3] += bf_hi(w.y); }
            v[j] = *(const f32x4*)(xr + 4 * lane + 256 * j) + *(const f32x4*)(g2 + 4 * lane + 256 * j) * y;
            ss += (v[j][0] * v[j][0] + v[j][1] * v[j][1]) + (v[j][2] * v[j][2] + v[j][3] * v[j][3]);
        }
        const float rstd = rsqrtf(wave_sum(ss) * (1.0f / 1024.0f) + EPS);
#pragma unroll
        for (int j = 0; j < 4; ++j) *(f32x4*)(xr + 4 * lane + 256 * j) = v[j] * rstd * gn[j];
    }
}

__device__ __forceinline__ void phase_attn(const Params& p, LAS unsigned char* lds_, int G, bf16_t* BO, unsigned* ctr) {
    char* lds = (char*)(unsigned char*)lds_;
    volatile int* uslot = (volatile int*)(lds + att::SHM_ATTN);
    const float lam = *(const float*)(p.ws + WS_LAM);
    const int xcc = (int)(__builtin_amdgcn_s_getreg((3 << 11) | 20) & 7u);
    const bf16_t* DQ = (const bf16_t*)(p.ws + WS_DQ); const bf16_t* DK = (const bf16_t*)(p.ws + WS_DK); const bf16_t* DV = (const bf16_t*)(p.ws + WS_DV);
    int q = 0;
    for (;;) {
        const int xq = (xcc + q) & 7;
        __syncthreads();
        if (threadIdx.x == 0) uslot[0] = (int)atomicAdd(ctr + 16 * xq, 1u);
        __syncthreads();
        const int u = uslot[0];
        if (u >= 256) { if (++q == 8) break; continue; }
        const int bh = (u >> 5) * 8 + xq, qb = u & 31, b = bh >> 3, h = bh & 7;
        const size_t qoff = ((size_t)b * SEQ + qb * 128) * 1024 + h * 128, koff = (size_t)b * KVLEN * 1024 + h * 128;
        att::attn_unit(DQ + qoff, DK + koff, DV + koff, BO + qoff, p.dnorm_g + h * 128, (const float*)(p.ws + WS_CTL) + CW_KMAX + b * 32 + h * 4, lam, KVLEN, lds);
    }
}


#define XB_TMO      128
#define XB_XCNT(j)  (256  + 64 * (j))
#define XB_XSUB(j)  (1280 + 64 * (j))
#define XB_XGEN(j)  (2304 + 64 * (j))
#define XB_TOP      3328
#define XB_TOPGEN   3392
#define XCD_BAR_WORDS 3456
#define XB_SPIN_CAP (1u << 22)
__device__ __forceinline__ unsigned xb_ld(unsigned* p)              { return __hip_atomic_load(p, __ATOMIC_RELAXED, __HIP_MEMORY_SCOPE_AGENT); }
__device__ __forceinline__ unsigned xb_add(unsigned* p, unsigned v) { return __hip_atomic_fetch_add(p, v, __ATOMIC_RELAXED, __HIP_MEMORY_SCOPE_AGENT); }
__device__ __forceinline__ unsigned xb_xcc_id() { return (unsigned)__builtin_amdgcn_s_getreg((3 << 11) | 20) & 0xFu; }
#define XB_SPIN(cond, bar) do { unsigned _sp = 0; while (cond) { __builtin_amdgcn_s_sleep(1); \
    if ((++_sp & 255u) == 0u) { if (xb_ld(&(bar)[XB_TMO])) break; if (_sp > XB_SPIN_CAP) { atomicAdd(&(bar)[XB_TMO], 1u); break; } } } } while (0)
struct XcdBarrier { unsigned* bar; unsigned x; volatile LAS unsigned* st; };
__device__ __forceinline__ XcdBarrier xcd_barrier_post(unsigned* bar, volatile LAS unsigned* st) {
    XcdBarrier b; b.bar = bar; b.x = xb_xcc_id(); b.st = st;
    if (threadIdx.x == 0) (void)xb_add(&bar[XB_XCNT(b.x)], 1u);
    return b;
}
__device__ __forceinline__ void xcd_barrier_complete(unsigned* bar, unsigned x, unsigned& nloc, unsigned& nx) {
    const unsigned G = gridDim.x * gridDim.y * gridDim.z;
    unsigned sum, cnt, mine, sp = 0u;
    for (;;) {
        sum = 0u; cnt = 0u; mine = 0u;
#pragma unroll
        for (unsigned j = 0; j < 16; ++j) { const unsigned c = xb_ld(&bar[XB_XCNT(j)]); sum += c; cnt += (c > 0u) ? 1u : 0u; mine = (j == x) ? c : mine; }
        if (sum == G) break;
        __builtin_amdgcn_s_sleep(1);
        if ((++sp & 255u) == 0u) { if (xb_ld(&bar[XB_TMO])) break; if (sp > XB_SPIN_CAP) { atomicAdd(&bar[XB_TMO], 1u); break; } }
    }
    nloc = mine > 0u ? mine : 1u; nx = cnt > 0u ? cnt : 1u;
}
__device__ __forceinline__ void xcd_barrier(const XcdBarrier& b) {
    asm volatile("s_waitcnt vmcnt(0)" ::: "memory");
    __syncthreads();
    if (threadIdx.x == 0) {
        unsigned* bar = b.bar;
        __builtin_amdgcn_s_waitcnt(0);
        unsigned nloc = b.st[0], nx = b.st[1];
        if (nloc == 0u) { xcd_barrier_complete(bar, b.x, nloc, nx); b.st[0] = nloc; b.st[1] = nx; }
        const unsigned old = xb_add(&bar[XB_XSUB(b.x)], 1u);
        const unsigned gen = old / nloc;
        if (old + 1u == (gen + 1u) * nloc) {
            __builtin_amdgcn_fence(__ATOMIC_RELEASE, "agent");
            asm volatile("s_waitcnt vmcnt(0)" ::: "memory");
            const unsigned og = xb_add(&bar[XB_TOP], 1u);
            const unsigned tg = og / nx;
            if (og + 1u == (tg + 1u) * nx) xb_add(&bar[XB_TOPGEN], 1u);
            else XB_SPIN(xb_ld(&bar[XB_TOPGEN]) == tg, bar);
            __builtin_amdgcn_fence(__ATOMIC_ACQUIRE, "agent");
            xb_add(&bar[XB_XGEN(b.x)], 1u);
            asm volatile("s_waitcnt vmcnt(0)" ::: "memory");
        } else {
            XB_SPIN(xb_ld(&bar[XB_XGEN(b.x)]) == gen, bar);
            __builtin_amdgcn_fence(__ATOMIC_ACQUIRE, "agent");
            asm volatile("s_waitcnt vmcnt(0)" ::: "memory");
        }
    }
    __syncthreads();
}


#define FP8_SELFTEST 0
#if FP8_SELFTEST
typedef int v8i __attribute__((ext_vector_type(8)));
__device__ __forceinline__ int fp8_selftest(int lane) {
    const int i = lane & 15, kb = lane >> 4;
    v8i A, B;
#pragma unroll
    for (int d = 0; d < 8; ++d) {
        float av[4], bv[4];
#pragma unroll
        for (int t = 0; t < 4; ++t) { const int k = 32 * kb + 4 * d + t; av[t] = (float)(((i * 7 + k * 3) % 5) - 2); bv[t] = (float)(((k * 5 + i) % 7) - 3); }
        int wa = 0, wb = 0;
        wa = __builtin_amdgcn_cvt_pk_fp8_f32(av[0], av[1], wa, false); wa = __builtin_amdgcn_cvt_pk_fp8_f32(av[2], av[3], wa, true);
        wb = __builtin_amdgcn_cvt_pk_fp8_f32(bv[0], bv[1], wb, false); wb = __builtin_amdgcn_cvt_pk_fp8_f32(bv[2], bv[3], wb, true);
        A[d] = wa; B[d] = wb;
    }
    f32x4 C = {0.f, 0.f, 0.f, 0.f}, C2 = {0.f, 0.f, 0.f, 0.f};
    C = __builtin_amdgcn_mfma_scale_f32_16x16x128_f8f6f4(A, B, C, 0, 0, 0, 0x7f7f7f7f, 0, 0x7f7f7f7f);
    C2 = __builtin_amdgcn_mfma_scale_f32_16x16x128_f8f6f4(A, B, C2, 0, 0, 0, 0x79797979, 0, 0x7f7f7f7f);
    bool ok = true;
#pragma unroll
    for (int r = 0; r < 4; ++r) { const int row = 4 * kb + r, col = i; float ref = 0.f;
        for (int k = 0; k < 128; ++k) ref += (float)(((row * 7 + k * 3) % 5) - 2) * (float)(((k * 5 + col) % 7) - 3);
        ok = ok && (C[r] == ref) && (C2[r] == ref * 0.015625f); }
    return __all(ok) ? 1 : 0;
}
#endif

__global__ void __launch_bounds__(NTHREADS, 2) fwd_megakernel(Params p) {
    extern __shared__ __attribute__((aligned(16))) unsigned char smem[];
    LAS unsigned char* lds = (LAS unsigned char*)smem;
    cg::grid_group grid = cg::this_grid();
    const int G = gridDim.x, c = blockIdx.x;
    unsigned char* ws = p.ws;
    volatile LAS unsigned* bst = (volatile LAS unsigned*)(lds + LDS_BYTES - 64);
    if (threadIdx.x < 16) bst[threadIdx.x] = 0u;
    __syncthreads();
    const XcdBarrier xbar = xcd_barrier_post((unsigned*)(ws + WS_CTL) + CW_BAR, bst);
#define GSYNC() xcd_barrier(xbar)

#ifndef PH_MASK
#define PH_MASK 0xFFFF
#endif
#define PH(k) if constexpr (((PH_MASK) >> (k)) & 1)
#ifndef REP_MASK
#define REP_MASK 0
#endif
#define REP(k) for (int rep_ = 0; rep_ < ((((REP_MASK) >> (k)) & 1) ? 2 : 1); ++rep_)
    PH(0) REP(0) { phase_prep(p, lds, G); __syncthreads(); }
    grid.sync();
    PH(1) phase_rows1(p, lds, G);
    GSYNC();
    PH(2) REP(2) {
        SchedIn S{(const char*)(ws + WS_U), (const char*)(ws + WS_WIN), G, c};
        EpiIn E{ws, (const float*)(ws + WS_ROPE), (const float*)(ws + WS_ROPE) + 1024};
        pg8::gemm_phase<EpiIn, SchedIn, false>(lds, S, E);
    }
    GSYNC();
#ifdef MLSTM_NAIVE
    PH(3) for (int item = c; item < 128; item += G) phase_mlstm_naive(p, lds, item);
#else
    PH(3) REP(3) for (int item = c; item < 256; item += G) mls::mlstm_item(p, lds, item);
#endif
    if constexpr ((REP_MASK >> 4) & 1) { phase_attn(p, lds, G, (bf16_t*)(ws + WS_END), (unsigned*)(ws + WS_CTL) + CW_ATT + 512); }
    PH(4) phase_attn(p, lds, G, (bf16_t*)(ws + WS_BO), (unsigned*)(ws + WS_CTL) + CW_ATT);
    GSYNC();
    PH(5) phase_mfinal(p, G);
    GSYNC();
    PH(6) REP(6) {
        SchedStatic S{(const char*)(ws + WS_AO), (const char*)(ws + WS_WA), 128, 4, G, c};
        EpiMerge<0> E{(const bf16_t*)(ws + WS_GA), nullptr, (bf16_t*)(ws + WS_T)};
        pg8::gemm_phase<EpiMerge<0>, SchedStatic, false>(lds, S, E);
    }
    GSYNC();
    PH(7) REP(7) {
        SchedStatic S{(const char*)(ws + WS_BO), (const char*)(ws + WS_WB), 128, 4, G, c};
        EpiMerge<1> E{(const bf16_t*)(ws + WS_GB), (const bf16_t*)(ws + WS_T), (bf16_t*)(ws + WS_Y)};
        pg8::gemm_phase<EpiMerge<1>, SchedStatic, false>(lds, S, E);
    }
    GSYNC();
    PH(8) REP(8) {
        SchedStatic S{(const char*)(ws + WS_Y), (const char*)(ws + WS_WO), 128, 4, G, c};
        EpiOut E{p.x, (const float*)(ws + WS_MOD), p.out};
        pg8::gemm_phase<EpiOut, SchedStatic, false>(lds, S, E);
    }
    GSYNC();
    PH(9) for (int grp = c; grp < 256; grp += G) phase_rows2(p, lds, grp);
    GSYNC();
    LAS int* tb = (LAS int*)(lds + 131072); LAS int* cn = tb + 64;
    moe_tables(p, tb, cn);
    PH(10) {
        const int tidg = otid(), lane = tidg & 63, gw = c * 8 + __builtin_amdgcn_readfirstlane(tidg >> 6), NGW = G * 8;
        const int NG = __builtin_amdgcn_readfirstlane(tb[32]) * 16; const int* list = (const int*)(ws + WS_LIST);
        for (int g = gw; g < NG; g += NGW) {
            const int rt = g >> 4; int e = 0;
#pragma unroll 1
            for (int k = 1; k < 32; ++k) e = (__builtin_amdgcn_readfirstlane(tb[k]) <= rt) ? k : e;
            const int pos0 = g * 16 - __builtin_amdgcn_readfirstlane(tb[e]) * 256, ne = __builtin_amdgcn_readfirstlane(cn[e]);
            const int pl = pos0 + (lane & 15); const int tl = pl < ne ? list[(size_t)e * CAP + pl] : 0;
            u32x4 v[16];
#pragma unroll
            for (int i = 0; i < 16; ++i) { const int tok = __shfl(tl, i); v[i] = *(const u32x4*)(ws + WS_U2 + (size_t)tok * 1024 + lane * 16); }
#pragma unroll
            for (int i = 0; i < 16; ++i) *(u32x4*)(ws + WS_XS + (size_t)(g * 16 + i) * 1024 + lane * 16) = v[i];
        }
    }
    GSYNC();
    PH(10) REP(10) {
        SchedMoe1 S{(const char*)(ws + WS_XS), (const char*)(ws + WS_W1), tb, G, c};
        EpiMoe1 E{ws + WS_ACT, p.exp_b1};
        pg8::gemm_phase<EpiMoe1, SchedMoe1, false, true>(lds, S, E);
    }
    GSYNC();
    PH(11) REP(11) {
        SchedMoe2 S{(const char*)(ws + WS_ACT), (const char*)(ws + WS_W2), tb, G, c};
        EpiMoe2 E{(bf16_t*)(ws + WS_YS), p.exp_b2, (const float*)(ws + WS_LGATE), cn};
        pg8::gemm_phase<EpiMoe2, SchedMoe2, false, true>(lds, S, E);
    }
    GSYNC();
    PH(12) phase_final(p, tb, G);
#if FP8_SELFTEST
    if (blockIdx.x == 0 && threadIdx.x < 64) { const int okf = fp8_selftest(threadIdx.x); VM_WAIT(); if (!okf && threadIdx.x == 0) p.out[0] = __builtin_nanf(""); }
#endif
}

extern "C" void kernel_launch(void* const* d_in, const int* in_sizes, int n_in, void* d_out, int out_size, void* d_ws, size_t ws_size, hipStream_t stream) {
    static int grid = 0;
    if (grid == 0) {
        if (n_in != 23 || out_size != TL * D || ws_size < WS_END) { fprintf(stderr, "kernel_launch: unexpected shapes: n_in %d out %d ws %zu (need %zu)\n", n_in, out_size, ws_size, (size_t)WS_END); grid = -1; return; }
        int dev = 0, cus = 0, per_cu = 0;
        (void)hipGetDevice(&dev); (void)hipDeviceGetAttribute(&cus, hipDeviceAttributeMultiprocessorCount, dev);
        if (hipFuncSetAttribute((const void*)fwd_megakernel, hipFuncAttributeMaxDynamicSharedMemorySize, LDS_BYTES) != hipSuccess) { fprintf(stderr, "kernel_launch: hipFuncSetAttribute failed\n"); grid = -1; return; }
        if (hipOccupancyMaxActiveBlocksPerMultiprocessor(&per_cu, (const void*)fwd_megakernel, NTHREADS, LDS_BYTES) != hipSuccess || per_cu < 1) { fprintf(stderr, "kernel_launch: occupancy query says %d\n", per_cu); per_cu = 1; }
        (void)hipGetLastError();
        grid = cus;
        if (grid > 256) grid = 256;
    }
    if (grid < 0) return;
    (void)hipMemsetAsync((char*)d_ws + WS_CTL, 0, 32768, stream);
    Params p{};
    const float** pp = (const float**)&p;
    for (int i = 0; i < 23; ++i) pp[i] = (const float*)d_in[i];
    p.out = (float*)d_out; p.ws = (unsigned char*)d_ws;
    void* args[] = {&p};
    hipError_t e = hipLaunchCooperativeKernel((const void*)fwd_megakernel, dim3(grid), dim3(NTHREADS), args, LDS_BYTES, stream);
    if (e != hipSuccess) fprintf(stderr, "cooperative launch failed: %s (grid %d)\n", hipGetErrorString(e), grid);
}
```

```cpp
#include <hip/hip_runtime.h>
#include <hip/hip_cooperative_groups.h>
#include <cstdio>
#include <cstdint>
namespace cg = cooperative_groups;

#define LAS __attribute__((address_space(3)))
typedef unsigned short bf16_t;
typedef short bf16x8 __attribute__((ext_vector_type(8)));
typedef short s16x4 __attribute__((ext_vector_type(4)));
typedef float f32x4 __attribute__((ext_vector_type(4)));
typedef float f32x8 __attribute__((ext_vector_type(8)));
typedef float f32x16 __attribute__((ext_vector_type(16)));
typedef unsigned u32x4 __attribute__((ext_vector_type(4)));
typedef unsigned u32x2 __attribute__((ext_vector_type(2)));

constexpr int D = 1024, BATCH = 8, SEQ = 4096, CTX = 256;
constexpr int TL = BATCH * SEQ, TC = BATCH * CTX, TT = TL + TC;
constexpr int KVLEN = CTX + SEQ;
constexpr int NEXP = 32, CAP = 32768, ACT_ROWS = 139264;
constexpr int INCOLS = 8208;
constexpr float EPS = 1e-6f;
constexpr float LAM_INIT = 0.2f;

constexpr size_t MiB = 1u << 20;
constexpr size_t WS_CTL = 0;
constexpr size_t WS_MOD = 1 * MiB;
constexpr size_t WS_ROPE = 1 * MiB + 256 * 1024;
constexpr size_t WS_LAM = 1 * MiB + 300 * 1024;
constexpr size_t WS_GT = 2 * MiB;
constexpr size_t WS_ASG = 5 * MiB;
constexpr size_t WS_LIST = 6 * MiB;
constexpr size_t WS_LGATE = 10 * MiB;
constexpr size_t WS_WIN = 16 * MiB;
constexpr size_t WS_WA = 32 * MiB, WS_WB = 34 * MiB, WS_WO = 36 * MiB;
constexpr size_t WS_W1 = 40 * MiB;
constexpr size_t WS_W2 = 168 * MiB;
constexpr size_t WS_U = 232 * MiB;
constexpr size_t WS_MQ = 300 * MiB;
constexpr size_t WS_MK = 332 * MiB;
constexpr size_t WS_MV = 366 * MiB;
constexpr size_t WS_MO = 434 * MiB;
constexpr size_t WS_HB = 498 * MiB;
constexpr size_t WS_DQ = 562 * MiB;
constexpr size_t WS_DK = 626 * MiB;
constexpr size_t WS_DV = 694 * MiB;
constexpr size_t WS_GA = 762 * MiB;
constexpr size_t WS_GB = 826 * MiB;
constexpr size_t WS_END = 890 * MiB;
constexpr size_t WS_HF = WS_U, WS_AO = WS_U, WS_BO = WS_DQ, WS_T = WS_MV, WS_Y = WS_MO, WS_U2 = 370 * MiB, WS_X1 = WS_GA, WS_XS = WS_U, WS_ACT = WS_DQ, WS_YS = WS_U;
static_assert(WS_ACT + (size_t)ACT_ROWS * 2048 <= WS_END, "ACT fits");
static_assert(WS_YS + (size_t)ACT_ROWS * 2048 <= WS_DQ, "YS fits");

constexpr int CW_CNT = 0, CW_ATT = 64, CW_KMAX = 256, CW_MF = 800, CW_BAR = 1024;
constexpr int LDS_BYTES = 147456;
constexpr int NTHREADS = 512;

struct Params {
    const float *x, *c, *ctx, *c_ctx, *ada_w, *ada_b, *norm1_g, *norm2_g, *w_in, *gate_b, *mnorm_g, *dlam, *dnorm_g, *w_a, *w_b, *w_o, *router_w, *router_b,
        *exp_w1, *exp_b1, *exp_w2, *exp_b2, *final_g;
    float* out;
    unsigned char* ws;
};

#define LDS_WAIT() asm volatile("s_waitcnt lgkmcnt(0)" ::: "memory")
#define VM_WAIT() asm volatile("s_waitcnt vmcnt(0)" ::: "memory")
typedef float f32x2_t __attribute__((ext_vector_type(2))); typedef __bf16 bf16x2_t __attribute__((ext_vector_type(2)));
__device__ __forceinline__ unsigned cvt_pk_bf16(float lo, float hi) { f32x2_t v = {lo, hi}; bf16x2_t b = __builtin_convertvector(v, bf16x2_t); return __builtin_bit_cast(unsigned, b); }
__device__ __forceinline__ unsigned pk4_fp8(float a, float b, float c, float d) { int w = 0; w = __builtin_amdgcn_cvt_pk_fp8_f32(a, b, w, false); w = __builtin_amdgcn_cvt_pk_fp8_f32(c, d, w, true); return (unsigned)w; }
__device__ __forceinline__ float bf_lo(unsigned w) { return __uint_as_float(w << 16); }
__device__ __forceinline__ float bf_hi(unsigned w) { return __uint_as_float(w & 0xffff0000u); }
__device__ __forceinline__ float bf2f(bf16_t b) { return __uint_as_float(((unsigned)b) << 16); }
__device__ __forceinline__ float wave_sum(float v) {
#pragma unroll
    for (int o = 1; o < 64; o <<= 1) v += __shfl_xor(v, o);
    return v;
}
__device__ __forceinline__ float sigmoidf_(float x) { return __builtin_amdgcn_rcpf(1.0f + __expf(-x)); }
__device__ __forceinline__ int otid() { unsigned ones = ~0u; asm volatile("" : "+s"(ones));
    const int lane = __builtin_amdgcn_mbcnt_hi(ones, __builtin_amdgcn_mbcnt_lo(ones, 0u)); int t = __builtin_amdgcn_readfirstlane(threadIdx.x >> 6) * 64 + lane; asm volatile("" : "+v"(t)); return t; }

namespace pg8 {
constexpr int BM = 256, BK = 64, HALF = 128, HTB = HALF * BK * 2, STAGE_BYTES = 8 * HTB, KD = 1024;
__host__ __device__ __forceinline__ int lds_byte(int r, int c) { const int st = (r >> 4) * 2 + (c >> 5), rr = r & 15, cc = c & 31, ob = rr * 64 + cc * 2; return st * 1024 + (ob ^ (((ob >> 9) & 1) << 5)); }
__host__ __device__ __forceinline__ void stage_rc(int b, int& R, int& C) { const int st = b / 1024, sb = b % 1024, swz = sb ^ (((sb >> 9) & 1) << 5); R = (st >> 1) * 16 + swz / 64; C = (st & 1) * 32 + (swz % 64) / 2; }

struct Unit { const char* A; const char* B; int row0; int pn; int aux; int aux2; };

__device__ __forceinline__ void tile_map(int L, int nM, int nN, int& pm, int& pn) {
    const int nwg = nM * nN; int wgid = L; { const int q = nwg / 8, r = nwg % 8, xcd = wgid % 8, off = wgid / 8; wgid = (xcd < r ? xcd * (q + 1) : r * (q + 1) + (xcd - r) * q) + off; }
    const int nig = 8 * nN, gid = wgid / nig, fm = gid * 8, gsz = (nM - fm) < 8 ? (nM - fm) : 8;
    pm = fm + ((wgid % nig) % gsz); pn = (wgid % nig) / gsz;
}

typedef int v8i_t __attribute__((ext_vector_type(8)));
typedef int v8i_a16 __attribute__((ext_vector_type(8), aligned(16)));
template <class Epi, class Sched, bool GATHER, bool FP8 = false>
__device__ __forceinline__ void gemm_phase(LAS unsigned char* lds, const Sched& S, const Epi& E, int stagger_ticks = 0) {
    const int tid = otid(), wid = __builtin_amdgcn_readfirstlane(tid >> 6), lane = tid & 63, wr = wid >> 2, wc = wid & 3, fr = lane & 15, fq = lane >> 4;
    constexpr int K = FP8 ? KD / 2 : KD, nt = K / BK;
    unsigned voffB[2], voffA0[2], voffA1[2], nvA0[2], nvA1[2];
#pragma unroll
    for (int i = 0; i < 2; ++i) { int R, C; stage_rc(tid * 16 + i * 8192, R, C);
        voffB[i] = (unsigned)(R * K + C) * 2u; voffA0[i] = voffB[i]; voffA1[i] = voffB[i] + (unsigned)HALF * K * 2u; nvA0[i] = voffA0[i]; nvA1[i] = voffA1[i]; }
    const size_t kstep = (size_t)(BK * 2);
    const size_t hstep = (size_t)HALF * K * 2;
    const unsigned ldsw = (unsigned)wid * 1024u;
    const int aoff = lds_byte(wr * 64 + fr, fq * 8);
    const int boff = lds_byte(wc * 32 + fr, fq * 8);
#define PG8_SA(b, h) (((b) * 2 + (h)) * HTB)
#define PG8_SB(b, h) ((4 + (b) * 2 + (h)) * HTB)
#define PG8_STAGE(bufoff, gbase, voff) do { _Pragma("unroll") for (int _i = 0; _i < 2; ++_i) { unsigned _v = (voff)[_i]; asm volatile("" : "+v"(_v));   \
        __builtin_amdgcn_global_load_lds((const unsigned*)((const char*)(gbase) + _v), (LAS unsigned*)(lds + (bufoff) + ldsw + _i * 8192), 16, 0, 0); } } while (0)
#define PG8_LDA(dst, b, h) do { if constexpr (FP8) { _Pragma("unroll") for (int m = 0; m < 4; ++m) { const u32x4 lo_ = *(const LAS u32x4*)(lds + PG8_SA(b, h) + aoff + m * 2048), hi_ = *(const LAS u32x4*)(lds + PG8_SA(b, h) + aoff + m * 2048 + 1024); dst##8[m] = (v8i_t){(int)lo_.x, (int)lo_.y, (int)lo_.z, (int)lo_.w, (int)hi_.x, (int)hi_.y, (int)hi_.z, (int)hi_.w}; } } \
        else { _Pragma("unroll") for (int m = 0; m < 4; ++m) _Pragma("unroll") for (int k = 0; k < 2; ++k) dst[m][k] = *(const LAS bf16x8*)(lds + PG8_SA(b, h) + aoff + m * 2048 + k * 1024); } } while (0)
#define PG8_LDB(dst, b, h) do { if constexpr (FP8) { _Pragma("unroll") for (int n = 0; n < 2; ++n) { const u32x4 lo_ = *(const LAS u32x4*)(lds + PG8_SB(b, h) + boff + n * 2048), hi_ = *(const LAS u32x4*)(lds + PG8_SB(b, h) + boff + n * 2048 + 1024); dst##8[n] = (v8i_t){(int)lo_.x, (int)lo_.y, (int)lo_.z, (int)lo_.w, (int)hi_.x, (int)hi_.y, (int)hi_.z, (int)hi_.w}; } } \
        else { _Pragma("unroll") for (int n = 0; n < 2; ++n) _Pragma("unroll") for (int k = 0; k < 2; ++k) dst[n][k] = *(const LAS bf16x8*)(lds + PG8_SB(b, h) + boff + n * 2048 + k * 1024); } } while (0)
#define PG8_MMA(ai, bj, At, Bt) do { __builtin_amdgcn_s_setprio(1); _Pragma("unroll") for (int m = 0; m < 4; ++m) _Pragma("unroll") for (int n = 0; n < 2; ++n) { \
        if constexpr (FP8) { asm volatile("v_mfma_f32_16x16x128_f8f6f4 %0, %1, %2, %0" : "+v"(acc[ai][bj][m][n]) : "v"(Bt##8[n]), "v"(At##8[m])); } \
        else { _Pragma("unroll") for (int k = 0; k < 2; ++k) acc[ai][bj][m][n] = __builtin_amdgcn_mfma_f32_16x16x32_bf16(Bt[n][k], At[m][k], acc[ai][bj][m][n], 0, 0, 0); } } \
        __builtin_amdgcn_s_setprio(0); } while (0)
#define PG8_ST1(bufoff, gbase, voff, i) do { unsigned _v = (voff)[i]; asm volatile("" : "+v"(_v)); \
        __builtin_amdgcn_global_load_lds((const unsigned*)((const char*)(gbase) + _v), (LAS unsigned*)(lds + (bufoff) + ldsw + (i) * 8192), 16, 0, 0); } while (0)
#define PG8_MM1(ai, bj, At, Bt, m) do { _Pragma("unroll") for (int n = 0; n < 2; ++n) { \
        if constexpr (FP8) { asm volatile("v_mfma_f32_16x16x128_f8f6f4 %0, %1, %2, %0" : "+v"(acc[ai][bj][m][n]) : "v"(Bt##8[n]), "v"(At##8[m])); } \
        else { _Pragma("unroll") for (int k = 0; k < 2; ++k) acc[ai][bj][m][n] = __builtin_amdgcn_mfma_f32_16x16x32_bf16(Bt[n][k], At[m][k], acc[ai][bj][m][n], 0, 0, 0); } } } while (0)
#define PG8_MMAS(ai, bj, At, Bt, S0, S1, S2, S3) do { __builtin_amdgcn_s_setprio(1); \
        PG8_MM1(ai, bj, At, Bt, 0); PG8_SCHED; S0; PG8_SCHED; PG8_MM1(ai, bj, At, Bt, 1); PG8_SCHED; S1; PG8_SCHED; \
        PG8_MM1(ai, bj, At, Bt, 2); PG8_SCHED; S2; PG8_SCHED; PG8_MM1(ai, bj, At, Bt, 3); PG8_SCHED; S3; PG8_SCHED; \
        __builtin_amdgcn_s_setprio(0); } while (0)
#define PG8_WAIT_V(n) asm volatile("s_waitcnt vmcnt(" #n ")" ::: "memory")
#define PG8_WAIT_L(n) asm volatile("s_waitcnt lgkmcnt(" #n ")" ::: "memory")
#define PG8_BAR __builtin_amdgcn_s_barrier()
#define PG8_SCHED __builtin_amdgcn_sched_barrier(0)
    Unit cur, nxt; int ui = 0;
    if (!S.next(0, cur)) return;
    if (stagger_ticks > 0) {
        const unsigned long long t0 = __builtin_amdgcn_s_memrealtime(); const unsigned long long d = (unsigned long long)((blockIdx.x >> 3) & 7) * (unsigned)stagger_ticks;
        while (__builtin_amdgcn_s_memrealtime() - t0 < d) __builtin_amdgcn_s_sleep(8);
    }
    if constexpr (GATHER) { S.offsets(cur, tid, voffA0, voffA1); }
    f32x4 acc[2][2][4][2];
#pragma unroll
    for (int a = 0; a < 2; ++a)
#pragma unroll
        for (int b = 0; b < 2; ++b)
#pragma unroll
            for (int m = 0; m < 4; ++m)
#pragma unroll
                for (int n = 0; n < 2; ++n) acc[a][b][m][n] = (f32x4){0.f, 0.f, 0.f, 0.f};
    bf16x8 At[4][2], B0[2][2], B1[2][2]; v8i_t At8[4], B08[2], B18[2];
    const char* cA = cur.A; const char* cB = cur.B;
    PG8_STAGE(PG8_SB(0, 0), cB, voffB); PG8_STAGE(PG8_SB(0, 1), cB + hstep, voffB); PG8_STAGE(PG8_SA(0, 0), cA, voffA0); PG8_STAGE(PG8_SA(0, 1), cA, voffA1);
    if (wr == 1) PG8_BAR;
    PG8_WAIT_V(2); PG8_BAR;
    PG8_STAGE(PG8_SB(1, 0), cB + kstep, voffB); PG8_STAGE(PG8_SA(1, 0), cA + kstep, voffA0); PG8_STAGE(PG8_SB(1, 1), cB + hstep + kstep, voffB);
    PG8_WAIT_V(0); PG8_BAR;
    for (;;) {
        const bool has_next = S.next(ui + 1, nxt);
        const char* nA = has_next ? nxt.A : cA; const char* nB = has_next ? nxt.B : cB;
#pragma unroll 1
        for (int t = 0; t < nt; t += 2) {
            const bool last = (t == nt - 2);
            if constexpr (GATHER) { if (t == nt - 4 && has_next) { const int tq = otid(); S.offsets(nxt, tq, nvA0, nvA1); } }
            const char* a1 = cA + (size_t)(t + 1) * kstep;
            const char* a2 = last ? nA : cA + (size_t)(t + 2) * kstep; const char* b2 = last ? nB : cB + (size_t)(t + 2) * kstep;
            const char* a3 = a2 + kstep; const char* b3 = b2 + kstep;
            unsigned w0[2], w1[2];
            if constexpr (GATHER) { w0[0] = voffA0[0]; w0[1] = voffA0[1]; w1[0] = voffA1[0]; w1[1] = voffA1[1];
                if (last && has_next) { w0[0] = nvA0[0]; w0[1] = nvA0[1]; w1[0] = nvA1[0]; w1[1] = nvA1[1]; } }
            else { w0[0] = voffA0[0]; w0[1] = voffA0[1]; w1[0] = voffA1[0]; w1[1] = voffA1[1]; }
            PG8_LDB(B0, 0, 0); PG8_LDB(B1, 0, 1); PG8_SCHED; PG8_LDA(At, 0, 0);
            if (t != 0) PG8_WAIT_V(6);
            PG8_WAIT_L(0); PG8_BAR;
            PG8_MMAS(0, 0, At, B0, PG8_ST1(PG8_SA(1, 1), a1, voffA1, 0), (void)0, PG8_ST1(PG8_SA(1, 1), a1, voffA1, 1), (void)0); PG8_MMAS(0, 1, At, B1, (void)0, (void)0, (void)0, (void)0); PG8_BAR; PG8_SCHED;
            PG8_LDA(At, 0, 1);
            if (t != 0) PG8_WAIT_V(2);
            PG8_WAIT_L(0); PG8_BAR;
            PG8_MMAS(1, 0, At, B0, PG8_ST1(PG8_SB(0, 0), b2, voffB, 0), PG8_ST1(PG8_SB(0, 0), b2, voffB, 1), PG8_ST1(PG8_SB(0, 1), b2 + hstep, voffB, 0), PG8_ST1(PG8_SB(0, 1), b2 + hstep, voffB, 1));
            PG8_MMAS(1, 1, At, B1, PG8_ST1(PG8_SA(0, 0), a2, w0, 0), PG8_ST1(PG8_SA(0, 0), a2, w0, 1), (void)0, (void)0); PG8_BAR; PG8_SCHED;
            PG8_LDB(B0, 1, 0); PG8_LDB(B1, 1, 1); PG8_SCHED; PG8_LDA(At, 1, 0);
            PG8_WAIT_V(6); PG8_WAIT_L(0); PG8_BAR;
            PG8_MMAS(0, 0, At, B0, PG8_ST1(PG8_SA(0, 1), a2, w1, 0), (void)0, PG8_ST1(PG8_SA(0, 1), a2, w1, 1), (void)0); PG8_MMAS(0, 1, At, B1, (void)0, (void)0, (void)0, (void)0); PG8_BAR; PG8_SCHED;
            PG8_LDA(At, 1, 1);
            PG8_WAIT_V(2); PG8_WAIT_L(0); PG8_BAR;
            PG8_MMAS(1, 0, At, B0, PG8_ST1(PG8_SB(1, 0), b3, voffB, 0), PG8_ST1(PG8_SB(1, 0), b3, voffB, 1), PG8_ST1(PG8_SB(1, 1), b3 + hstep, voffB, 0), PG8_ST1(PG8_SB(1, 1), b3 + hstep, voffB, 1));
            PG8_MMAS(1, 1, At, B1, PG8_ST1(PG8_SA(1, 0), a3, w0, 0), PG8_ST1(PG8_SA(1, 0), a3, w0, 1), (void)0, (void)0); PG8_BAR; PG8_SCHED;
        }
        PG8_WAIT_V(0);
        if (wr == 0) PG8_BAR;
        if constexpr (FP8) asm volatile("s_nop 15\n\ts_nop 7" ::: "memory");
        { const int t2_ = otid(); E(acc, cur, wr, wc, t2_ & 15, (t2_ & 63) >> 4); }
        if (!has_next) break;
#pragma unroll
        for (int a = 0; a < 2; ++a)
#pragma unroll
            for (int b = 0; b < 2; ++b)
#pragma unroll
                for (int m = 0; m < 4; ++m)
#pragma unroll
                    for (int n = 0; n < 2; ++n) acc[a][b][m][n] = (f32x4){0.f, 0.f, 0.f, 0.f};
        cur = nxt; cA = nA; cB = nB; ++ui;
        if constexpr (GATHER) { voffA0[0] = nvA0[0]; voffA0[1] = nvA0[1]; voffA1[0] = nvA1[0]; voffA1[1] = nvA1[1]; }
        if (wr == 1) PG8_BAR;
    }
    PG8_WAIT_V(0);
    PG8_BAR;
#undef PG8_SA
#undef PG8_SB
#undef PG8_STAGE
#undef PG8_ST1
#undef PG8_MM1
#undef PG8_MMAS
#undef PG8_LDA
#undef PG8_LDB
#undef PG8_MMA
#undef PG8_WAIT_V
#undef PG8_WAIT_L
#undef PG8_BAR
#undef PG8_SCHED
}
}

using pg8::Unit;
constexpr size_t TSTEP = (size_t)256 * 1024 * 2;

struct SchedIn {
    const char* A; const char* B; int G, c;
    __device__ __forceinline__ bool next(int i, Unit& u) const {
        const int L = i * G + c; int pm, pn;
        if (L < 4096) { pg8::tile_map(L, 128, 32, pm, pn); }
        else { const int j = L - 4096; if (j >= 112) return false; pm = 128 + (j & 7); const int cj = j >> 3; pn = cj < 2 ? 2 + cj : (cj < 6 ? 4 + (cj - 2) : 16 + (cj - 6)); }
        u.A = A + (size_t)pm * (TSTEP / 2); u.B = B + (size_t)pn * (TSTEP / 2); u.row0 = pm * 256; u.pn = pn; u.aux = 0; u.aux2 = 0; return true;
    }
};
__device__ __forceinline__ void xstore16(unsigned char* p, size_t rows8, const u32x4 X, const u32x4 Y, bool up) {
    u32x4 a, b;
#pragma unroll
    for (int i = 0; i < 4; ++i) { const unsigned send = up ? X[i] : Y[i]; const unsigned recv = (unsigned)__builtin_amdgcn_update_dpp(0, (int)send, 0x128, 0xf, 0xf, false);
        a[i] = up ? recv : X[i]; b[i] = up ? Y[i] : recv; }
    *(u32x4*)p = a; *(u32x4*)(p + rows8) = b;
}
struct EpiIn {
    unsigned char* ws; const float* ropec; const float* ropes;
    template <int MODE, bool PERMT, bool ISK>
    __device__ __forceinline__ void body(const f32x4 (&acc)[2][2][4][2], unsigned char* basep, unsigned rowbytes, unsigned off0, float sc, int trow, int wc, int fr, int fq, unsigned* kmaxp) const {
        float kmx[2] = {0.f, 0.f};
#pragma unroll
        for (int ai = 0; ai < 2; ++ai)
#pragma unroll
            for (int m = 0; m < 4; ++m) {
                const unsigned off = off0 + (unsigned)(ai * 128 + m * 16) * rowbytes;
                f32x4 cs, sn;
                if (MODE == 1) { const int t = (trow + ai * 128 + m * 16) & 4095; const int pos = (wc & 1) ? (t & 63) : (t >> 6); cs = *(const f32x4*)(ropec + pos * 16 + 4 * fq); sn = *(const f32x4*)(ropes + pos * 16 + 4 * fq); }
                u32x4 wq[2];
#pragma unroll
                for (int bj = 0; bj < 2; ++bj) {
                    f32x4 v0 = acc[ai][bj][m][0], v1 = acc[ai][bj][m][1];
                    if (MODE == 1) { const f32x4 a = v0 * cs - v1 * sn, b = v1 * cs + v0 * sn; v0 = a * sc; v1 = b * sc; }
                    else if (MODE == 2) {
#pragma unroll
                        for (int i = 0; i < 4; ++i) { v0[i] = __builtin_amdgcn_rcpf(1.0f + __builtin_amdgcn_exp2f(v0[i] * (-1.4426950408889634f * 0.015625f))); v1[i] = __builtin_amdgcn_rcpf(1.0f + __builtin_amdgcn_exp2f(v1[i] * (-1.4426950408889634f * 0.015625f))); }
                    } else { v0 = v0 * sc; v1 = v1 * sc; }
                    u32x2 w0, w1; w0.x = cvt_pk_bf16(v0[0], v0[1]); w0.y = cvt_pk_bf16(v0[2], v0[3]); w1.x = cvt_pk_bf16(v1[0], v1[1]); w1.y = cvt_pk_bf16(v1[2], v1[3]);
                    if (PERMT) { wq[bj].x = w0.x; wq[bj].y = w0.y; wq[bj].z = w1.x; wq[bj].w = w1.y; }
                    else { *(u32x2*)(basep + off + bj * 256) = w0; *(u32x2*)(basep + off + bj * 256 + 32) = w1; }
                    if (ISK) { float ss = (v0[0] * v0[0] + v0[1] * v0[1]) + (v0[2] * v0[2] + v0[3] * v0[3]) + (v1[0] * v1[0] + v1[1] * v1[1]) + (v1[2] * v1[2] + v1[3] * v1[3]);
                        ss += __shfl_xor(ss, 16); ss += __shfl_xor(ss, 32); kmx[bj] = fmaxf(kmx[bj], ss); }
                }
                if (PERMT) xstore16(basep + off, (size_t)8 * rowbytes, wq[0], wq[1], (fr & 8) != 0);
            }
        if (ISK) {
#pragma unroll
            for (int bj = 0; bj < 2; ++bj) { float m = kmx[bj]; m = fmaxf(m, __shfl_xor(m, 1)); m = fmaxf(m, __shfl_xor(m, 2)); m = fmaxf(m, __shfl_xor(m, 4)); m = fmaxf(m, __shfl_xor(m, 8));
                if (fr == 0 && fq == 0) atomicMax(kmaxp + bj * 4, __float_as_uint(sqrtf(m))); }
        }
    }
    __device__ __forceinline__ void operator()(const f32x4 (&acc)[2][2][4][2], const Unit& u, int wr, int wc, int fr, int fq) const {
        const int pn = u.pn, row0 = u.row0; const bool latent = row0 < TL;
        int kvrow0; if (latent) { const int b = row0 >> 12, t = row0 & 4095; kvrow0 = b * KVLEN + CTX + t; } else { const int cc = row0 - TL; kvrow0 = (cc >> 8) * KVLEN + (cc & 255); }
        size_t wsoff; unsigned rowbytes = 2048; int col0, drow0 = row0; float sc = 1.f;
        if (pn < 2)       { wsoff = WS_MQ; rowbytes = 1024; col0 = pn * 256;        sc = 0.08838834764831845f; }
        else if (pn < 4)  { wsoff = WS_MK; rowbytes = 1024; col0 = (pn - 2) * 256; }
        else if (pn < 8)  { wsoff = WS_MV; col0 = (pn - 4) * 256; }
        else if (pn < 12) { wsoff = WS_MO; col0 = (pn - 8) * 256; }
        else if (pn < 16) { wsoff = WS_DQ; col0 = (pn - 12) * 256; sc = 0.125f * 1.4426950408889634f; }
        else if (pn < 20) { wsoff = WS_DK; col0 = (pn - 16) * 256; drow0 = kvrow0; }
        else if (pn < 24) { wsoff = WS_DV; col0 = (pn - 20) * 256; drow0 = kvrow0; }
        else if (pn < 28) { wsoff = WS_GA; col0 = (pn - 24) * 256; }
        else              { wsoff = WS_GB; col0 = (pn - 28) * 256; }
        unsigned char* basep = ws + wsoff + (size_t)drow0 * rowbytes;
        const bool permt = !(pn >= 12 && pn < 20);
        const unsigned off0 = permt ? (unsigned)(wr * 64 + (fr & 7)) * rowbytes + (unsigned)(col0 + wc * 64 + ((fr & 8) ? 32 : 0) + 8 * fq) * 2u
                                    : (unsigned)(wr * 64 + fr) * rowbytes + (unsigned)(col0 + wc * 32 + 4 * fq) * 2u;
        const int kb = latent ? (row0 >> 12) : ((row0 - TL) >> 8);
        unsigned* kmaxp = (unsigned*)(ws + WS_CTL) + CW_KMAX + kb * 32 + ((col0 + wc * 32) >> 5);
        const int trow = row0 + wr * 64 + fr;
        sc *= 0.015625f;
        if (permt) { if (pn >= 24) body<2, true, false>(acc, basep, rowbytes, off0, sc, trow, wc, fr, fq, kmaxp); else body<0, true, false>(acc, basep, rowbytes, off0, sc, trow, wc, fr, fq, kmaxp); }
        else if (pn < 16) body<1, false, false>(acc, basep, rowbytes, off0, sc, trow, wc, fr, fq, kmaxp);
        else if (latent) body<1, false, true>(acc, basep, rowbytes, off0, sc, trow, wc, fr, fq, kmaxp);
        else body<0, false, true>(acc, basep, rowbytes, off0, sc, trow, wc, fr, fq, kmaxp);
    }
};

struct SchedStatic {
    const char* A; const char* B; int nM, nN, G, c;
    __device__ __forceinline__ bool next(int i, Unit& u) const {
        const int L = i * G + c; if (L >= nM * nN) return false; int pm, pn; pg8::tile_map(L, nM, nN, pm, pn);
        u.A = A + (size_t)pm * TSTEP; u.B = B + (size_t)pn * TSTEP; u.row0 = pm * 256; u.pn = pn; u.aux = 0; u.aux2 = 0; return true;
    }
};
template <int MODE> struct EpiMerge {
    const bf16_t* gate; const bf16_t* tin; bf16_t* outp;
    __device__ __forceinline__ void operator()(const f32x4 (&acc)[2][2][4][2], const Unit& u, int wr, int wc, int fr, int fq) const {
        const int cl = u.pn * 256 + wc * 64 + 8 * fq;
        const bool up = (fr & 8) != 0;
#pragma unroll
        for (int ai = 0; ai < 2; ++ai)
#pragma unroll
            for (int m = 0; m < 4; ++m) {
                const int rbase = u.row0 + ai * 128 + wr * 64 + m * 16;
                const size_t ro = (size_t)(rbase + fr) * 1024 + cl;
                u32x4 wq[2];
#pragma unroll
                for (int bj = 0; bj < 2; ++bj) {
                    const size_t o = ro + bj * 32;
                    const u32x4 g = *(const u32x4*)(gate + o);
                    f32x4 v0 = acc[ai][bj][m][0], v1 = acc[ai][bj][m][1];
                    v0[0] *= bf_lo(g.x); v0[1] *= bf_hi(g.x); v0[2] *= bf_lo(g.y); v0[3] *= bf_hi(g.y); v1[0] *= bf_lo(g.z); v1[1] *= bf_hi(g.z); v1[2] *= bf_lo(g.w); v1[3] *= bf_hi(g.w);
                    if (MODE == 1) { const u32x4 t = *(const u32x4*)(tin + o);
                        v0[0] += bf_lo(t.x); v0[1] += bf_hi(t.x); v0[2] += bf_lo(t.y); v0[3] += bf_hi(t.y); v1[0] += bf_lo(t.z); v1[1] += bf_hi(t.z); v1[2] += bf_lo(t.w); v1[3] += bf_hi(t.w); }
                    wq[bj].x = cvt_pk_bf16(v0[0], v0[1]); wq[bj].y = cvt_pk_bf16(v0[2], v0[3]); wq[bj].z = cvt_pk_bf16(v1[0], v1[1]); wq[bj].w = cvt_pk_bf16(v1[2], v1[3]);
                }
                xstore16((unsigned char*)(outp + (size_t)(rbase + (fr & 7)) * 1024 + cl + (up ? 32 : 0)), (size_t)8 * 2048, wq[0], wq[1], up);
            }
    }
};
struct SchedMerge2 {
    const char* A0; const char* B0; const char* A1; const char* B1; int nM, nN, G, c;
    __device__ __forceinline__ bool next(int i, Unit& u) const {
        const int L = (i >> 1) * G + c; if (L >= nM * nN) return false; int pm, pn; pg8::tile_map(L, nM, nN, pm, pn); const int h = i & 1;
        u.A = (h ? A1 : A0) + (size_t)pm * TSTEP; u.B = (h ? B1 : B0) + (size_t)pn * TSTEP; u.row0 = pm * 256; u.pn = pn; u.aux = h; u.aux2 = 0; return true;
    }
};
struct EpiMerge2 {
    const bf16_t* ga; const bf16_t* gb; bf16_t* t; bf16_t* y;
    __device__ __forceinline__ void operator()(const f32x4 (&acc)[2][2][4][2], const Unit& u, int wr, int wc, int fr, int fq) const {
        if (u.aux == 0) { EpiMerge<0> E{ga, nullptr, t}; E(acc, u, wr, wc, fr, fq); } else { EpiMerge<1> E{gb, t, y}; E(acc, u, wr, wc, fr, fq); }
    }
};
struct EpiOut {
    const float* x; const float* mod; bf16_t* x1;
    __device__ __forceinline__ void operator()(const f32x4 (&acc)[2][2][4][2], const Unit& u, int wr, int wc, int fr, int fq) const {
        const int cl = u.pn * 256 + wc * 64 + 8 * fq; const float* g1 = mod + (size_t)(u.row0 >> 12) * 6144 + 2048;
        const bool up = (fr & 8) != 0;
        f32x4 g0[2], g1v[2];
#pragma unroll
        for (int bj = 0; bj < 2; ++bj) { g0[bj] = *(const f32x4*)(g1 + cl + bj * 32); g1v[bj] = *(const f32x4*)(g1 + cl + bj * 32 + 4); }
#pragma unroll
        for (int ai = 0; ai < 2; ++ai)
#pragma unroll
            for (int m = 0; m < 4; ++m) {
                const int rbase = u.row0 + ai * 128 + wr * 64 + m * 16;
                u32x4 wq[2];
#pragma unroll
                for (int bj = 0; bj < 2; ++bj) {
                    const size_t o = (size_t)(rbase + fr) * 1024 + cl + bj * 32;
                    const f32x4 a = *(const f32x4*)(x + o) + g0[bj] * acc[ai][bj][m][0], c = *(const f32x4*)(x + o + 4) + g1v[bj] * acc[ai][bj][m][1];
                    wq[bj].x = cvt_pk_bf16(a[0], a[1]); wq[bj].y = cvt_pk_bf16(a[2], a[3]); wq[bj].z = cvt_pk_bf16(c[0], c[1]); wq[bj].w = cvt_pk_bf16(c[2], c[3]);
                }
                xstore16((unsigned char*)(x1 + (size_t)(rbase + (fr & 7)) * 1024 + cl + (up ? 32 : 0)), (size_t)8 * 2048, wq[0], wq[1], up);
            }
    }
};

constexpr int RT2E_OFF = (140288 - 131072) / 4;
struct SchedMoe1 {
    const char* U2; const char* W1; const int* list; const LAS int* tb; const LAS int* cnt; int G, c;
    __device__ __forceinline__ bool next(int i, Unit& u) const {
        const int L = i * G + c; const int xcd = L & 7, j = L >> 3; const int pn = j & 7, rt = (j >> 3) * 8 + xcd;
        const int NRT = __builtin_amdgcn_readfirstlane(tb[32]);
        if (rt >= NRT) return false;
        const int e = __builtin_amdgcn_readfirstlane(tb[RT2E_OFF + rt]);
        const int tbe = __builtin_amdgcn_readfirstlane(tb[e]);
        u.A = U2; u.B = W1 + ((size_t)e * 2048 + (size_t)pn * 256) * 1024; u.row0 = rt * 256; u.pn = pn; u.aux = e; u.aux2 = (rt - tbe) * 256; return true;
    }
    __device__ __forceinline__ void offsets(const Unit& u, int tid, unsigned (&o0)[2], unsigned (&o1)[2]) const {
        const int e = u.aux; const int n = __builtin_amdgcn_readfirstlane(cnt[e]) - u.aux2; const int* lp = list + (size_t)e * CAP + u.aux2;
#pragma unroll
        for (int i = 0; i < 2; ++i) {
            int R, C; pg8::stage_rc(tid * 16 + i * 8192, R, C);
            const int t0 = R < n ? lp[R] : 0, t1 = (128 + R) < n ? lp[128 + R] : 0;
            o0[i] = (unsigned)t0 * 1024u + (unsigned)C * 2u; o1[i] = (unsigned)t1 * 1024u + (unsigned)C * 2u;
        }
    }
};
struct EpiMoe1 {
    unsigned char* act; const float* b1;
    __device__ __forceinline__ void operator()(const f32x4 (&acc)[2][2][4][2], const Unit& u, int wr, int wc, int fr, int fq) const {
        if (u.aux < 0) return;
        const int cl = u.pn * 128 + wc * 32 + 8 * fq; const float* bb = b1 + (size_t)u.aux * 2048;
        f32x4 bg[2], bl[2];
#pragma unroll
        for (int n = 0; n < 2; ++n) { bg[n] = *(const f32x4*)(bb + cl + n * 4); bl[n] = *(const f32x4*)(bb + 1024 + cl + n * 4) + 1.0f; }
#pragma unroll
        for (int ai = 0; ai < 2; ++ai)
#pragma unroll
            for (int m = 0; m < 4; ++m) {
                f32x4 a[2];
#pragma unroll
                for (int n = 0; n < 2; ++n) { const f32x4 g = acc[ai][0][m][n] * 0.015625f + bg[n], l = acc[ai][1][m][n] * 0.015625f + bl[n];
#pragma unroll
                    for (int i = 0; i < 4; ++i) { const float gg = fminf(g[i], 7.0f), l1 = fminf(fmaxf(l[i], -6.0f), 8.0f);
                        a[n][i] = gg * __builtin_amdgcn_rcpf(1.0f + __builtin_amdgcn_exp2f(gg * (-1.702f * 1.4426950408889634f))) * l1; } }
                u32x2 w; w.x = pk4_fp8(a[0][0], a[0][1], a[0][2], a[0][3]); w.y = pk4_fp8(a[1][0], a[1][1], a[1][2], a[1][3]);
                *(u32x2*)(act + (size_t)(u.row0 + ai * 128 + wr * 64 + m * 16 + fr) * 1024 + cl) = w;
            }
    }
};
struct SchedMoe2 {
    const char* ACT; const char* W2; const LAS int* tb; int G, c;
    __device__ __forceinline__ bool next(int i, Unit& u) const {
        const int L = i * G + c; const int xcd = L & 7, j = L >> 3; const int pn = j & 3, rt = (j >> 2) * 8 + xcd;
        const int NRT = __builtin_amdgcn_readfirstlane(tb[32]);
        if (rt >= NRT) return false;
        const int e = __builtin_amdgcn_readfirstlane(tb[RT2E_OFF + rt]);
        const int tbe = __builtin_amdgcn_readfirstlane(tb[e]);
        u.A = ACT + (size_t)rt * (TSTEP / 2); u.B = W2 + ((size_t)e * 1024 + (size_t)pn * 256) * 1024; u.row0 = rt * 256; u.pn = pn; u.aux = e; u.aux2 = (rt - tbe) * 256; return true;
    }
};
struct EpiMoe2 {
    bf16_t* ys; const float* b2; const float* lgate; const LAS int* cnt;
    __device__ __forceinline__ void operator()(const f32x4 (&acc)[2][2][4][2], const Unit& u, int wr, int wc, int fr, int fq) const {
        if (u.aux < 0) return;
        const int cl = u.pn * 256 + wc * 64 + 8 * fq; const float* bb = b2 + (size_t)u.aux * 1024; const int n = __builtin_amdgcn_readfirstlane(cnt[u.aux]) - u.aux2; const float* gp = lgate + (size_t)u.aux * CAP + u.aux2;
        const bool up = (fr & 8) != 0;
        f32x4 bv[2][2];
#pragma unroll
        for (int bj = 0; bj < 2; ++bj)
#pragma unroll
            for (int nn = 0; nn < 2; ++nn) bv[bj][nn] = *(const f32x4*)(bb + cl + bj * 32 + nn * 4);
#pragma unroll
        for (int ai = 0; ai < 2; ++ai)
#pragma unroll
            for (int m = 0; m < 4; ++m) {
                const int rl = ai * 128 + wr * 64 + m * 16 + fr; const float gw = rl < n ? gp[rl] : 0.f;
                u32x4 wq[2];
#pragma unroll
                for (int bj = 0; bj < 2; ++bj) {
                    const f32x4 v0 = (acc[ai][bj][m][0] * 0.015625f + bv[bj][0]) * gw, v1 = (acc[ai][bj][m][1] * 0.015625f + bv[bj][1]) * gw;
                    wq[bj].x = cvt_pk_bf16(v0[0], v0[1]); wq[bj].y = cvt_pk_bf16(v0[2], v0[3]); wq[bj].z = cvt_pk_bf16(v1[0], v1[1]); wq[bj].w = cvt_pk_bf16(v1[2], v1[3]);
                }
                xstore16((unsigned char*)(ys + (size_t)(u.row0 + (rl & ~8)) * 1024 + cl + (up ? 32 : 0)), (size_t)8 * 2048, wq[0], wq[1], up);
            }
    }
};

namespace att {
constexpr int NW = 8, QBLK = 32, KVBLK = 64, LD = 1024;
constexpr float SCALE = 0.125f;
constexpr float THR = 8.f;
constexpr int SHM_V = KVBLK * 128 * 2, SHM_K = KVBLK * 128 * 2, SHM_ATTN = 4 * SHM_V + 4 * SHM_K + NW * 64 * 4;
#define KSWZ(row, colB) ((row) * 256 + ((colB) ^ (((row) & 15) << 4)))
#define SBAR() __builtin_amdgcn_sched_barrier(0)
__device__ __forceinline__ int crow(int r, int hi) { return (r & 3) + 8 * (r >> 2) + 4 * hi; }
__device__ __forceinline__ unsigned cvtpk(float lo, float hi) { return cvt_pk_bf16(lo, hi); }

__device__ __forceinline__ void finishSM(f32x16& p0, f32x16& p1, float& l_reg, bf16x8& pa0, bf16x8& pa1, bf16x8& pa2, bf16x8& pa3) {
#pragma unroll
  for (int r = 0; r < 16; ++r) { p0[r] = __builtin_amdgcn_exp2f(p0[r]); p1[r] = __builtin_amdgcn_exp2f(p1[r]); }
  float s0 = p0[0], s1 = p0[8], s2 = p1[0], s3 = p1[8];
#pragma unroll
  for (int r = 1; r < 8; ++r) { s0 += p0[r]; s1 += p0[8 + r]; s2 += p1[r]; s3 += p1[8 + r]; }
  l_reg += (s0 + s1) + (s2 + s3);
#define PK4(P, BASE, OUT) do { unsigned a0 = cvtpk(P[BASE + 0], P[BASE + 1]), a1 = cvtpk(P[BASE + 2], P[BASE + 3]);   \
    unsigned b0 = cvtpk(P[BASE + 4], P[BASE + 5]), b1 = cvtpk(P[BASE + 6], P[BASE + 7]);                              \
    auto r0 = __builtin_amdgcn_permlane32_swap(a0, b0, false, false); auto r1 = __builtin_amdgcn_permlane32_swap(a1, b1, false, false); \
    u32x4 w = {r0[0], r1[0], r0[1], r1[1]}; OUT = *reinterpret_cast<bf16x8*>(&w); } while (0)
  PK4(p0, 0, pa0); PK4(p0, 8, pa1); PK4(p1, 0, pa2); PK4(p1, 8, pa3);
#undef PK4
}
__device__ __forceinline__ void qkt(f32x16& p0, f32x16& p1, const bf16_t* Ks, const bf16x8* qr, int r32, int hi, int mp) {
  p0 = f32x16{}; p1 = f32x16{};
#pragma unroll
  for (int d0 = 0; d0 < 4; ++d0) { int cb = (mp * 64 + d0 * 16 + hi * 8) * 2;
    bf16x8 b0 = *reinterpret_cast<const bf16x8*>((const char*)Ks + KSWZ(r32, cb));
    bf16x8 b1 = *reinterpret_cast<const bf16x8*>((const char*)Ks + KSWZ(32 + r32, cb));
    p0 = __builtin_amdgcn_mfma_f32_32x32x16_bf16(b0, qr[d0], p0, 0, 0, 0);
    p1 = __builtin_amdgcn_mfma_f32_32x32x16_bf16(b1, qr[d0], p1, 0, 0, 0); }
}
__device__ __forceinline__ int v_st(int k, int c) { const int kk = (k & ~0xC) | ((k & 4) << 1) | ((k & 8) >> 1); return ((kk >> 3) * 4 + (c >> 5)) * 512 + ((kk & 7) * 32 + (c & 31)) * 2; }
__device__ __forceinline__ int v_rd_base(int lane) { return ((lane & 3) << 3) | (((lane >> 2) & 3) << 6) | (((lane >> 4) & 1) << 5) | (((lane >> 5) & 1) << 8); }
constexpr int v_rd_off(int d0, int ks, int half) { return d0 * 512 + ks * 4096 + half * 2048; }
__device__ __forceinline__ int v_rd_base2(int lane) { return ((lane & 3) << 3) | (((lane >> 2) & 3) << 6) | (((lane >> 4) & 1) << 5) | (((lane >> 5) & 1) << 11); }
constexpr int v_rd_off2(int d0, int ks, int half) { return d0 * 512 + ks * 4096 + half * 256; }
template <int OFF> __device__ __forceinline__ s16x4 tr_read(int vb) {
  s16x4 r; asm volatile("ds_read_b64_tr_b16 %0, %1 offset:%2" : "=&v"(r) : "v"(vb), "i"(OFF) : "memory"); return r;
}
template <int D0> __device__ __forceinline__ void pv_one(f32x16& od, int vb, bf16x8 pa0, bf16x8 pa1, bf16x8 pa2, bf16x8 pa3) {
  const s16x4 l0 = tr_read<v_rd_off(D0, 0, 0)>(vb), h0 = tr_read<v_rd_off(D0, 0, 1)>(vb), l1 = tr_read<v_rd_off(D0, 1, 0)>(vb), h1 = tr_read<v_rd_off(D0, 1, 1)>(vb);
  const s16x4 l2 = tr_read<v_rd_off(D0, 2, 0)>(vb), h2 = tr_read<v_rd_off(D0, 2, 1)>(vb), l3 = tr_read<v_rd_off(D0, 3, 0)>(vb), h3 = tr_read<v_rd_off(D0, 3, 1)>(vb);
  asm volatile("s_waitcnt lgkmcnt(0)" ::: "memory"); SBAR();
#define PK(L, H) (bf16x8){L[0], L[1], L[2], L[3], H[0], H[1], H[2], H[3]}
  od = __builtin_amdgcn_mfma_f32_32x32x16_bf16(pa0, PK(l0, h0), od, 0, 0, 0);
  od = __builtin_amdgcn_mfma_f32_32x32x16_bf16(pa1, PK(l1, h1), od, 0, 0, 0);
  od = __builtin_amdgcn_mfma_f32_32x32x16_bf16(pa2, PK(l2, h2), od, 0, 0, 0);
  od = __builtin_amdgcn_mfma_f32_32x32x16_bf16(pa3, PK(l3, h3), od, 0, 0, 0);
#undef PK
}
__device__ __forceinline__ void pv_d0(f32x16* o, int vb, bf16x8 pa0, bf16x8 pa1, bf16x8 pa2, bf16x8 pa3) {
  pv_one<0>(o[0], vb, pa0, pa1, pa2, pa3); pv_one<1>(o[1], vb, pa0, pa1, pa2, pa3); pv_one<2>(o[2], vb, pa0, pa1, pa2, pa3); pv_one<3>(o[3], vb, pa0, pa1, pa2, pa3);
}
template <bool QK, bool PV>
__device__ __forceinline__ void mphase(f32x16& p0, f32x16& p1, f32x16* o, const char* Ks, int vb, const bf16x8* qr, const f32x16& negm,
                                       bf16x8 pa0, bf16x8 pa1, bf16x8 pa2, bf16x8 pa3, int r32, int hi, int mp) {
#define TR8(dst, D0) do { dst[0] = tr_read<v_rd_off(D0, 0, 0)>(vb); dst[1] = tr_read<v_rd_off(D0, 0, 1)>(vb); dst[2] = tr_read<v_rd_off(D0, 1, 0)>(vb); dst[3] = tr_read<v_rd_off(D0, 1, 1)>(vb); \
    dst[4] = tr_read<v_rd_off(D0, 2, 0)>(vb); dst[5] = tr_read<v_rd_off(D0, 2, 1)>(vb); dst[6] = tr_read<v_rd_off(D0, 3, 0)>(vb); dst[7] = tr_read<v_rd_off(D0, 3, 1)>(vb); } while (0)
#define PKV(v, k) (bf16x8){v[2 * (k)][0], v[2 * (k)][1], v[2 * (k)][2], v[2 * (k)][3], v[2 * (k) + 1][0], v[2 * (k) + 1][1], v[2 * (k) + 1][2], v[2 * (k) + 1][3]}
#define PV4(od, v) do { od = __builtin_amdgcn_mfma_f32_32x32x16_bf16(pa0, PKV(v, 0), od, 0, 0, 0); od = __builtin_amdgcn_mfma_f32_32x32x16_bf16(pa1, PKV(v, 1), od, 0, 0, 0); \
    od = __builtin_amdgcn_mfma_f32_32x32x16_bf16(pa2, PKV(v, 2), od, 0, 0, 0); od = __builtin_amdgcn_mfma_f32_32x32x16_bf16(pa3, PKV(v, 3), od, 0, 0, 0); } while (0)
#define LWAIT(n) do { asm volatile("s_waitcnt lgkmcnt(" #n ")" ::: "memory"); SBAR(); } while (0)
  bf16x8 kf0[4], kf1[4]; s16x4 va[8], vc[8];
  if constexpr (QK) {
#pragma unroll
    for (int d0 = 0; d0 < 4; ++d0) { const int cb = (mp * 64 + d0 * 16 + hi * 8) * 2;
      asm volatile("ds_read_b128 %0, %1" : "=&v"(kf0[d0]) : "v"((int)(uintptr_t)Ks + KSWZ(r32, cb)) : "memory");
      asm volatile("ds_read_b128 %0, %1" : "=&v"(kf1[d0]) : "v"((int)(uintptr_t)Ks + KSWZ(32 + r32, cb)) : "memory"); }
  }
  if constexpr (PV) TR8(va, 0);
  if constexpr (QK) {
    if constexpr (PV) LWAIT(8); else LWAIT(0);
    p0 = __builtin_amdgcn_mfma_f32_32x32x16_bf16(kf0[0], qr[0], negm, 0, 0, 0); p1 = __builtin_amdgcn_mfma_f32_32x32x16_bf16(kf1[0], qr[0], negm, 0, 0, 0);
#pragma unroll
    for (int d0 = 1; d0 < 4; ++d0) { p0 = __builtin_amdgcn_mfma_f32_32x32x16_bf16(kf0[d0], qr[d0], p0, 0, 0, 0); p1 = __builtin_amdgcn_mfma_f32_32x32x16_bf16(kf1[d0], qr[d0], p1, 0, 0, 0); }
    SBAR();
  }
  if constexpr (PV) {
    TR8(vc, 1); LWAIT(8); PV4(o[0], va); SBAR();
    TR8(va, 2); LWAIT(8); PV4(o[1], vc); SBAR();
    TR8(vc, 3); LWAIT(8); PV4(o[2], va); SBAR();
    LWAIT(0); PV4(o[3], vc); SBAR();
  }
#undef TR8
#undef PKV
#undef PV4
#undef LWAIT
}

__device__ __forceinline__ void attn_unit(const bf16_t* __restrict__ Qb, const bf16_t* __restrict__ Kh, const bf16_t* __restrict__ Vh, bf16_t* __restrict__ Ob,
                                          const float* __restrict__ gd, const float* __restrict__ kmax, float lam, int seq, char* lds) {
  const int tid = otid(), wid = __builtin_amdgcn_readfirstlane(tid >> 6), lane = tid & 63, r32 = lane & 31, hi = lane >> 5;
  const int qw = wid & 3, mp = wid >> 2;
  char* K_lds = lds; char* V_lds = lds + SHM_K;
  constexpr int SLOT = SHM_K + SHM_V;
  float* wsf = (float*)(lds + 4 * SLOT) + wid * 64; float* li_l = wsf;
  float l_reg = 0; f32x16 o[4] = {}; bf16x8 qr[4];
  const bf16_t* Qw = Qb + (long)(qw * QBLK + r32) * LD + mp * 64 + hi * 8;
#pragma unroll
  for (int d0 = 0; d0 < 4; ++d0) qr[d0] = *reinterpret_cast<const bf16x8*>(Qw + d0 * 16);
  float mnC;
  { float ssa = 0.f, ssb = 0.f;
#pragma unroll
    for (int d0 = 0; d0 < 4; ++d0) { const u32x4 q4 = *reinterpret_cast<const u32x4*>(&qr[d0]);
      const float t = (bf_lo(q4.x) * bf_lo(q4.x) + bf_hi(q4.x) * bf_hi(q4.x)) + (bf_lo(q4.y) * bf_lo(q4.y) + bf_hi(q4.y) * bf_hi(q4.y)) + (bf_lo(q4.z) * bf_lo(q4.z) + bf_hi(q4.z) * bf_hi(q4.z)) + (bf_lo(q4.w) * bf_lo(q4.w) + bf_hi(q4.w) * bf_hi(q4.w));
      if (d0 < 2) ssa += t; else ssb += t; }
    { auto rr = __builtin_amdgcn_permlane32_swap(__float_as_uint(ssa), __float_as_uint(ssa), false, false); ssa = __uint_as_float(rr[0]) + __uint_as_float(rr[1]); }
    { auto rr = __builtin_amdgcn_permlane32_swap(__float_as_uint(ssb), __float_as_uint(ssb), false, false); ssb = __uint_as_float(rr[0]) + __uint_as_float(rr[1]); }
    mnC = -(sqrtf(ssa) * kmax[mp * 2] + sqrtf(ssb) * kmax[mp * 2 + 1]) * 1.01f; }
  f32x16 negm;
#pragma unroll
  for (int r = 0; r < 16; ++r) negm[r] = mnC;
  asm volatile("" : "+v"(negm));
  const int sr = tid >> 4, sc = (tid & 15) * 8, vst0 = v_st(sr, sc), vst1 = v_st(32 + sr, sc), kst0 = KSWZ(sr, sc * 2), kst1 = KSWZ(32 + sr, sc * 2);
  const int vb0 = (int)(uintptr_t)V_lds + v_rd_base(lane);
  bf16x8 sk0, sk1, sv0, sv1;
#define SLOAD(t) do { const long k0_ = (long)(t) * KVBLK; sv0 = *reinterpret_cast<const bf16x8*>(&Vh[(k0_ + sr) * LD + sc]); sv1 = *reinterpret_cast<const bf16x8*>(&Vh[(k0_ + 32 + sr) * LD + sc]); \
    sk0 = *reinterpret_cast<const bf16x8*>(&Kh[(k0_ + sr) * LD + sc]); sk1 = *reinterpret_cast<const bf16x8*>(&Kh[(k0_ + 32 + sr) * LD + sc]); } while (0)
#define SWRITE(t) do { char* kp_ = K_lds + ((t) & 3) * SLOT; char* vp_ = V_lds + ((t) & 3) * SLOT; *(bf16x8*)(vp_ + vst0) = sv0; *(bf16x8*)(vp_ + vst1) = sv1; *(bf16x8*)(kp_ + kst0) = sk0; *(bf16x8*)(kp_ + kst1) = sk1; } while (0)
#define PBAR() do { SBAR(); asm volatile("s_waitcnt lgkmcnt(0)\n\ts_barrier" ::: "memory"); SBAR(); } while (0)
  f32x16 p0, p1; bf16x8 pa0, pa1, pa2, pa3; const int NT = seq / KVBLK;
  SLOAD(0); SWRITE(0); SLOAD(1); SWRITE(1); SLOAD(2);
  PBAR();
  if (mp == 1) PBAR();
  pa0 = pa1 = pa2 = pa3 = bf16x8{};
  __builtin_amdgcn_s_setprio(1); mphase<true, false>(p0, p1, o, K_lds, vb0, qr, negm, pa0, pa1, pa2, pa3, r32, hi, mp); __builtin_amdgcn_s_setprio(0);
  PBAR();
#pragma unroll 1
  for (int t = 0; t + 1 < NT; ++t) {
    finishSM(p0, p1, l_reg, pa0, pa1, pa2, pa3);
    if (t + 2 < NT) { SWRITE(t + 2); if (t + 3 < NT) SLOAD(t + 3); }
    PBAR();
    __builtin_amdgcn_s_setprio(1);
    mphase<true, true>(p0, p1, o, K_lds + ((t + 1) & 3) * SLOT, vb0 + (t & 3) * SLOT, qr, negm, pa0, pa1, pa2, pa3, r32, hi, mp);
    __builtin_amdgcn_s_setprio(0);
    PBAR();
  }
  finishSM(p0, p1, l_reg, pa0, pa1, pa2, pa3);
  PBAR();
  __builtin_amdgcn_s_setprio(1); mphase<false, true>(p0, p1, o, K_lds, vb0 + ((NT - 1) & 3) * SLOT, qr, negm, pa0, pa1, pa2, pa3, r32, hi, mp); __builtin_amdgcn_s_setprio(0);
  if (mp == 0) PBAR();
  { auto rr = __builtin_amdgcn_permlane32_swap(__float_as_uint(l_reg), __float_as_uint(l_reg), false, false); l_reg = __uint_as_float(rr[0]) + __uint_as_float(rr[1]); }
  if (hi == 0) li_l[r32] = l_reg; asm volatile("s_waitcnt lgkmcnt(0)" ::: "memory");
  float rli[16];
#pragma unroll
  for (int r = 0; r < 16; ++r) rli[r] = __builtin_amdgcn_rcpf(li_l[crow(r, hi)]);
  __syncthreads();
  float* xch = (float*)lds + qw * 4096 + lane;
  if (mp == 1) {
#pragma unroll
    for (int r = 0; r < 16; ++r)
#pragma unroll
      for (int d0 = 0; d0 < 4; ++d0) xch[(r * 4 + d0) * 64] = o[d0][r] * rli[r] * lam;
  }
  __syncthreads();
  if (mp == 0) {
    float gv[4];
#pragma unroll
    for (int d0 = 0; d0 < 4; ++d0) gv[d0] = gd[d0 * 32 + r32] * (1.0f - LAM_INIT);
#pragma unroll
    for (int r = 0; r < 16; ++r) {
      float dv[4]; float ss = 0.f;
#pragma unroll
      for (int d0 = 0; d0 < 4; ++d0) { dv[d0] = o[d0][r] * rli[r] - xch[(r * 4 + d0) * 64]; ss += dv[d0] * dv[d0]; }
      ss += __shfl_xor(ss, 1); ss += __shfl_xor(ss, 2); ss += __shfl_xor(ss, 4); ss += __shfl_xor(ss, 8); ss += __shfl_xor(ss, 16);
      const float rstd = rsqrtf(ss * (1.0f / 128.0f) + EPS);
      bf16_t* orow = Ob + (long)(qw * QBLK + crow(r, hi)) * LD + r32;
#pragma unroll
      for (int d0 = 0; d0 < 4; ++d0) orow[d0 * 32] = (bf16_t)(cvtpk(dv[d0] * rstd * gv[d0], 0.f) & 0xffffu);
    }
  }
  __syncthreads();
#undef SLOAD
#undef SWRITE
#undef PBAR
}

__device__ __forceinline__ void kfrag_issue(bf16x8 (&kf0)[4], bf16x8 (&kf1)[4], const char* Ks, int r32, int hi, int mp) {
#pragma unroll
  for (int d0 = 0; d0 < 4; ++d0) { const int cb = (mp * 64 + d0 * 16 + hi * 8) * 2;
    asm volatile("ds_read_b128 %0, %1" : "=&v"(kf0[d0]) : "v"((int)(uintptr_t)Ks + KSWZ(r32, cb)) : "memory");
    asm volatile("ds_read_b128 %0, %1" : "=&v"(kf1[d0]) : "v"((int)(uintptr_t)Ks + KSWZ(32 + r32, cb)) : "memory"); }
}
__device__ __forceinline__ void kfrag_issue_half(bf16x8 (&kf)[4], const char* Ks, int row, int hi, int mp) {
#pragma unroll
  for (int d0 = 0; d0 < 4; ++d0) { const int cb = (mp * 64 + d0 * 16 + hi * 8) * 2;
    asm volatile("ds_read_b128 %0, %1" : "=&v"(kf[d0]) : "v"((int)(uintptr_t)Ks + KSWZ(row, cb)) : "memory"); }
}
#define AIL_MFMA() __builtin_amdgcn_sched_group_barrier(0x008, 1, 0)
#define AIL_TRANS(n) __builtin_amdgcn_sched_group_barrier(0x400, n, 0)
#define AIL_VALU(n) __builtin_amdgcn_sched_group_barrier(0x002, n, 0)
__device__ __forceinline__ void attn_unit2(const bf16_t* __restrict__ Qb, const bf16_t* __restrict__ Kh, const bf16_t* __restrict__ Vh, bf16_t* __restrict__ Ob,
                                           const float* __restrict__ gd, const float* __restrict__ kmax, float lam, int seq, char* lds) {
  const int tid = otid(), wid = __builtin_amdgcn_readfirstlane(tid >> 6), lane = tid & 63, r32 = lane & 31, hi = lane >> 5;
  const int qw = wid & 3, mp = wid >> 2;
  char* K_lds = lds; char* V_lds = lds + SHM_K;
  constexpr int SLOT = SHM_K + SHM_V;
  float* wsf = (float*)(lds + 4 * SLOT) + wid * 64; float* li_l = wsf;
  f32x16 o[4] = {}; bf16x8 qr[4];
  const bf16_t* Qw = Qb + (long)(qw * QBLK + r32) * LD + mp * 64 + hi * 8;
#pragma unroll
  for (int d0 = 0; d0 < 4; ++d0) qr[d0] = *reinterpret_cast<const bf16x8*>(Qw + d0 * 16);
  const int sr = tid >> 4, sc = (tid & 15) * 8, vst0 = v_st(sr, sc), vst1 = v_st(32 + sr, sc), kst0 = KSWZ(sr, sc * 2), kst1 = KSWZ(32 + sr, sc * 2);
  const int vb0 = (int)(uintptr_t)V_lds + v_rd_base2(lane);
  bf16x8 sk0, sk1, sv0, sv1;
#define SLOAD(t) do { const long k0_ = (long)(t) * KVBLK; sv0 = *reinterpret_cast<const bf16x8*>(&Vh[(k0_ + sr) * LD + sc]); sv1 = *reinterpret_cast<const bf16x8*>(&Vh[(k0_ + 32 + sr) * LD + sc]); \
    sk0 = *reinterpret_cast<const bf16x8*>(&Kh[(k0_ + sr) * LD + sc]); sk1 = *reinterpret_cast<const bf16x8*>(&Kh[(k0_ + 32 + sr) * LD + sc]); } while (0)
#define SWRITE(t) do { char* kp_ = K_lds + ((t) & 3) * SLOT; char* vp_ = V_lds + ((t) & 3) * SLOT; *(bf16x8*)(vp_ + vst0) = sv0; *(bf16x8*)(vp_ + vst1) = sv1; *(bf16x8*)(kp_ + kst0) = sk0; *(bf16x8*)(kp_ + kst1) = sk1; } while (0)
#define PBAR() do { SBAR(); asm volatile("s_waitcnt lgkmcnt(0)\n\ts_barrier" ::: "memory"); SBAR(); } while (0)
#define TR8(dst, D0, vb) do { dst[0] = tr_read<v_rd_off2(D0, 0, 0)>(vb); dst[1] = tr_read<v_rd_off2(D0, 0, 1)>(vb); dst[2] = tr_read<v_rd_off2(D0, 1, 0)>(vb); dst[3] = tr_read<v_rd_off2(D0, 1, 1)>(vb); \
    dst[4] = tr_read<v_rd_off2(D0, 2, 0)>(vb); dst[5] = tr_read<v_rd_off2(D0, 2, 1)>(vb); dst[6] = tr_read<v_rd_off2(D0, 3, 0)>(vb); dst[7] = tr_read<v_rd_off2(D0, 3, 1)>(vb); } while (0)
#define PKV(v, k) (bf16x8){v[2 * (k)][0], v[2 * (k)][1], v[2 * (k)][2], v[2 * (k)][3], v[2 * (k) + 1][0], v[2 * (k) + 1][1], v[2 * (k) + 1][2], v[2 * (k) + 1][3]}
#define LWAIT(n) do { asm volatile("s_waitcnt lgkmcnt(" #n ")" ::: "memory"); SBAR(); } while (0)
#define QKT(Ks, PRE, NW) do { bf16x8 kf0[4], kf1[4]; kfrag_issue(kf0, kf1, (Ks), r32, hi, mp); PRE; LWAIT(NW); \
    p0 = __builtin_amdgcn_mfma_f32_32x32x16_bf16(kf0[0], qr[0], negm, 0, 0, 0); p1 = __builtin_amdgcn_mfma_f32_32x32x16_bf16(kf1[0], qr[0], negm, 0, 0, 0); \
    _Pragma("unroll") for (int d0 = 1; d0 < 4; ++d0) { p0 = __builtin_amdgcn_mfma_f32_32x32x16_bf16(kf0[d0], qr[d0], p0, 0, 0, 0); p1 = __builtin_amdgcn_mfma_f32_32x32x16_bf16(kf1[d0], qr[d0], p1, 0, 0, 0); } SBAR(); } while (0)
#define PVGROUP(D0, V, P, B, PAOUT, SA, SB) do { \
    o[D0] = __builtin_amdgcn_mfma_f32_32x32x16_bf16(pa0, PKV(V, 0), o[D0], 0, 0, 0); P[B + 0] = __builtin_amdgcn_exp2f(P[B + 0]); P[B + 1] = __builtin_amdgcn_exp2f(P[B + 1]); \
    o[D0] = __builtin_amdgcn_mfma_f32_32x32x16_bf16(pa1, PKV(V, 1), o[D0], 0, 0, 0); P[B + 2] = __builtin_amdgcn_exp2f(P[B + 2]); P[B + 3] = __builtin_amdgcn_exp2f(P[B + 3]); SA += P[B + 0]; SB += P[B + 1]; \
    o[D0] = __builtin_amdgcn_mfma_f32_32x32x16_bf16(pa2, PKV(V, 2), o[D0], 0, 0, 0); P[B + 4] = __builtin_amdgcn_exp2f(P[B + 4]); P[B + 5] = __builtin_amdgcn_exp2f(P[B + 5]); SA += P[B + 2]; SB += P[B + 3]; \
    o[D0] = __builtin_amdgcn_mfma_f32_32x32x16_bf16(pa3, PKV(V, 3), o[D0], 0, 0, 0); P[B + 6] = __builtin_amdgcn_exp2f(P[B + 6]); P[B + 7] = __builtin_amdgcn_exp2f(P[B + 7]); SA += P[B + 4]; SB += P[B + 5]; \
    SA += P[B + 6]; SB += P[B + 7]; \
    { unsigned a0 = cvtpk(P[B + 0], P[B + 1]), a1 = cvtpk(P[B + 2], P[B + 3]), b0_ = cvtpk(P[B + 4], P[B + 5]), b1_ = cvtpk(P[B + 6], P[B + 7]); \
      auto r0 = __builtin_amdgcn_permlane32_swap(a0, b0_, false, false); auto r1 = __builtin_amdgcn_permlane32_swap(a1, b1_, false, false); \
      u32x4 w4 = {r0[0], r1[0], r0[1], r1[1]}; PAOUT = *reinterpret_cast<bf16x8*>(&w4); } \
    AIL_MFMA(); AIL_TRANS(2); AIL_MFMA(); AIL_TRANS(2); AIL_VALU(2); AIL_MFMA(); AIL_TRANS(2); AIL_VALU(2); AIL_MFMA(); AIL_TRANS(2); AIL_VALU(2); SBAR(); } while (0)
#define TRM(m) do { vlo[m] = tr_read<v_rd_off2((m) / 4, (m) % 4, 0)>(vb); vhi[m] = tr_read<v_rd_off2((m) / 4, (m) % 4, 1)>(vb); } while (0)
#define PKM(m) (bf16x8){vlo[m][0], vlo[m][1], vlo[m][2], vlo[m][3], vhi[m][0], vhi[m][1], vhi[m][2], vhi[m][3]}
#define PAK(k) ((k) == 0 ? pa0 : (k) == 1 ? pa1 : (k) == 2 ? pa2 : pa3)
#define PVSTEP(m, WAITN, P, B) do { LWAIT(WAITN); o[(m) / 4] = __builtin_amdgcn_mfma_f32_32x32x16_bf16(PAK((m) % 4), PKM(m), o[(m) / 4], 0, 0, 0); \
    if ((m) + 7 < 16) TRM(((m) + 7 < 16 ? (m) + 7 : 15)); \
    P[B] = __builtin_amdgcn_exp2f(P[B]); P[B + 1] = __builtin_amdgcn_exp2f(P[B + 1]); } while (0)
#define SUM8(P, B, SA, SB) do { SA += (P[B] + P[B + 2]) + (P[B + 4] + P[B + 6]); SB += (P[B + 1] + P[B + 3]) + (P[B + 5] + P[B + 7]); } while (0)
#define PACK8(P, B, PAOUT) do { u32x4 w4 = {cvtpk(P[B + 0], P[B + 1]), cvtpk(P[B + 2], P[B + 3]), cvtpk(P[B + 4], P[B + 5]), cvtpk(P[B + 6], P[B + 7])}; PAOUT = *reinterpret_cast<bf16x8*>(&w4); } while (0)
#define PVPLAIN(D0, V) do { o[D0] = __builtin_amdgcn_mfma_f32_32x32x16_bf16(pa0, PKV(V, 0), o[D0], 0, 0, 0); o[D0] = __builtin_amdgcn_mfma_f32_32x32x16_bf16(pa1, PKV(V, 1), o[D0], 0, 0, 0); \
    o[D0] = __builtin_amdgcn_mfma_f32_32x32x16_bf16(pa2, PKV(V, 2), o[D0], 0, 0, 0); o[D0] = __builtin_amdgcn_mfma_f32_32x32x16_bf16(pa3, PKV(V, 3), o[D0], 0, 0, 0); SBAR(); } while (0)
  f32x16 p0, p1; bf16x8 pa0, pa1, pa2, pa3, pn0, pn1, pn2, pn3; float s0 = 0.f, s1 = 0.f, s2 = 0.f, s3 = 0.f, s4 = 0.f, s5 = 0.f, s6 = 0.f, s7 = 0.f; const int NT = seq / KVBLK;
  bf16x8 ak0, ak1, av0, av1, bk0, bk1, bv0, bv1;
  SLOAD(0); ak0 = sk0; ak1 = sk1; av0 = sv0; av1 = sv1;
  SLOAD(1); bk0 = sk0; bk1 = sk1; bv0 = sv0; bv1 = sv1;
  SLOAD(2);
  float mnC;
  { float ssa = 0.f, ssb = 0.f;
#pragma unroll
    for (int d0 = 0; d0 < 4; ++d0) { const u32x4 q4 = *reinterpret_cast<const u32x4*>(&qr[d0]);
      const float t = (bf_lo(q4.x) * bf_lo(q4.x) + bf_hi(q4.x) * bf_hi(q4.x)) + (bf_lo(q4.y) * bf_lo(q4.y) + bf_hi(q4.y) * bf_hi(q4.y)) + (bf_lo(q4.z) * bf_lo(q4.z) + bf_hi(q4.z) * bf_hi(q4.z)) + (bf_lo(q4.w) * bf_lo(q4.w) + bf_hi(q4.w) * bf_hi(q4.w));
      if (d0 < 2) ssa += t; else ssb += t; }
    { auto rr = __builtin_amdgcn_permlane32_swap(__float_as_uint(ssa), __float_as_uint(ssa), false, false); ssa = __uint_as_float(rr[0]) + __uint_as_float(rr[1]); }
    { auto rr = __builtin_amdgcn_permlane32_swap(__float_as_uint(ssb), __float_as_uint(ssb), false, false); ssb = __uint_as_float(rr[0]) + __uint_as_float(rr[1]); }
    mnC = -(sqrtf(ssa) * kmax[mp * 2] + sqrtf(ssb) * kmax[mp * 2 + 1]) * 1.01f; }
  f32x16 negm;
#pragma unroll
  for (int r = 0; r < 16; ++r) negm[r] = mnC;
  asm volatile("" : "+v"(negm));
  { char* kp_ = K_lds; char* vp_ = V_lds; *(bf16x8*)(vp_ + vst0) = av0; *(bf16x8*)(vp_ + vst1) = av1; *(bf16x8*)(kp_ + kst0) = ak0; *(bf16x8*)(kp_ + kst1) = ak1; }
  { char* kp_ = K_lds + SLOT; char* vp_ = V_lds + SLOT; *(bf16x8*)(vp_ + vst0) = bv0; *(bf16x8*)(vp_ + vst1) = bv1; *(bf16x8*)(kp_ + kst0) = bk0; *(bf16x8*)(kp_ + kst1) = bk1; }
  SWRITE(2); SLOAD(3);
  PBAR();
  QKT(K_lds, (void)0, 0);
  {
#pragma unroll
    for (int r = 0; r < 16; ++r) { p0[r] = __builtin_amdgcn_exp2f(p0[r]); p1[r] = __builtin_amdgcn_exp2f(p1[r]); }
    SUM8(p0, 0, s0, s1); SUM8(p0, 8, s2, s3); SUM8(p1, 0, s4, s5); SUM8(p1, 8, s6, s7);
    PACK8(p0, 0, pa0); PACK8(p0, 8, pa1); PACK8(p1, 0, pa2); PACK8(p1, 8, pa3); }
  bf16x8 kf0[4];
  kfrag_issue_half(kf0, K_lds + SLOT, r32, hi, mp);
#pragma unroll 1
  for (int t = 0; t + 1 < NT; ++t) {
    SBAR(); asm volatile("s_waitcnt lgkmcnt(4)\n\ts_barrier" ::: "memory"); SBAR();
    const int vb = vb0 + (t & 3) * SLOT;
    s16x4 vlo[16], vhi[16];
    bf16x8 kf1[4];
    kfrag_issue_half(kf1, K_lds + ((t + 1) & 3) * SLOT, 32 + r32, hi, mp); TRM(0); TRM(1); TRM(2);
    const bool stg = t + 3 < NT;
    if (stg) { SWRITE(t + 3); if (t + 4 < NT) SLOAD(t + 4); LWAIT(14); } else LWAIT(10);
    p0 = __builtin_amdgcn_mfma_f32_32x32x16_bf16(kf0[0], qr[0], negm, 0, 0, 0);
#pragma unroll
    for (int d0 = 1; d0 < 4; ++d0) p0 = __builtin_amdgcn_mfma_f32_32x32x16_bf16(kf0[d0], qr[d0], p0, 0, 0, 0);
    SBAR();
    if (stg) LWAIT(10); else LWAIT(6);
    p1 = __builtin_amdgcn_mfma_f32_32x32x16_bf16(kf1[0], qr[0], negm, 0, 0, 0);
#pragma unroll
    for (int d0 = 1; d0 < 4; ++d0) p1 = __builtin_amdgcn_mfma_f32_32x32x16_bf16(kf1[d0], qr[d0], p1, 0, 0, 0);
    SBAR();
    TRM(3); TRM(4); TRM(5); TRM(6);
    PVSTEP(0, 12, p0, 0);  PVSTEP(1, 12, p0, 2);  PVSTEP(2, 12, p0, 4);   PVSTEP(3, 12, p0, 6);   SUM8(p0, 0, s0, s1);
    PVSTEP(4, 12, p0, 8);  PVSTEP(5, 12, p0, 10); PVSTEP(6, 12, p0, 12);  PVSTEP(7, 12, p0, 14);  SUM8(p0, 8, s2, s3); PACK8(p0, 0, pn0);
    PVSTEP(8, 12, p1, 0);  PVSTEP(9, 12, p1, 2);  PVSTEP(10, 10, p1, 4);  PVSTEP(11, 8, p1, 6);   SUM8(p1, 0, s4, s5); PACK8(p0, 8, pn1);
    PVSTEP(12, 6, p1, 8);  PVSTEP(13, 4, p1, 10); PVSTEP(14, 2, p1, 12);  PVSTEP(15, 0, p1, 14);  SUM8(p1, 8, s6, s7); PACK8(p1, 0, pn2); PACK8(p1, 8, pn3);
    SBAR();
    pa0 = pn0; pa1 = pn1; pa2 = pn2; pa3 = pn3;
    if (t + 2 < NT) kfrag_issue_half(kf0, K_lds + ((t + 2) & 3) * SLOT, r32, hi, mp);
  }
  { PBAR(); const int vb = vb0 + ((NT - 1) & 3) * SLOT; s16x4 va[8], vc[8];
    TR8(va, 0, vb); TR8(vc, 1, vb); LWAIT(8); PVPLAIN(0, va); TR8(va, 2, vb); LWAIT(8); PVPLAIN(1, vc); TR8(vc, 3, vb); LWAIT(8); PVPLAIN(2, va); LWAIT(0); PVPLAIN(3, vc); }
  float l_reg = ((s0 + s1) + (s2 + s3)) + ((s4 + s5) + (s6 + s7));
  { auto rr = __builtin_amdgcn_permlane32_swap(__float_as_uint(l_reg), __float_as_uint(l_reg), false, false); l_reg = __uint_as_float(rr[0]) + __uint_as_float(rr[1]); }
  if (hi == 0) li_l[r32] = l_reg; asm volatile("s_waitcnt lgkmcnt(0)" ::: "memory");
  float rli[16];
#pragma unroll
  for (int r = 0; r < 16; ++r) rli[r] = __builtin_amdgcn_rcpf(li_l[crow(r, hi)]);
  __syncthreads();
  float* xch = (float*)lds + qw * 4096 + lane;
  if (mp == 1) {
#pragma unroll
    for (int r = 0; r < 16; ++r)
#pragma unroll
      for (int d0 = 0; d0 < 4; ++d0) xch[(r * 4 + d0) * 64] = o[d0][r] * rli[r] * lam;
  }
  __syncthreads();
  if (mp == 0) {
    float gv[4];
#pragma unroll
    for (int d0 = 0; d0 < 4; ++d0) gv[d0] = gd[d0 * 32 + r32] * (1.0f - LAM_INIT);
#pragma unroll
    for (int r = 0; r < 16; ++r) {
      float dv[4]; float ss = 0.f;
#pragma unroll
      for (int d0 = 0; d0 < 4; ++d0) { dv[d0] = o[d0][r] * rli[r] - xch[(r * 4 + d0) * 64]; ss += dv[d0] * dv[d0]; }
      ss += __shfl_xor(ss, 1); ss += __shfl_xor(ss, 2); ss += __shfl_xor(ss, 4); ss += __shfl_xor(ss, 8); ss += __shfl_xor(ss, 16);
      const float rstd = rsqrtf(ss * (1.0f / 128.0f) + EPS);
      bf16_t* orow = Ob + (long)(qw * QBLK + crow(r, hi)) * LD + r32;
#pragma unroll
      for (int d0 = 0; d0 < 4; ++d0) orow[d0 * 32] = (bf16_t)(cvtpk(dv[d0] * rstd * gv[d0], 0.f) & 0xffffu);
    }
  }
  __syncthreads();
#undef SLOAD
#undef SWRITE
#undef PBAR
#undef TR8
#undef PKV
#undef LWAIT
#undef QKT
#undef PVGROUP
#undef PVPLAIN
#undef TRM
#undef PKM
#undef PAK
#undef PVSTEP
#undef SUM8
#undef PACK8
}
#undef AIL_MFMA
#undef AIL_TRANS
#undef AIL_VALU
#undef KSWZ
#undef SBAR
}

__device__ __forceinline__ float log_sigmoidf_(float x) { return x >= 0.f ? -log1pf(__expf(-x)) : x - log1pf(__expf(x)); }

__device__ __forceinline__ int perm32(int rho) { const int n = rho >> 4, i = rho & 15; return 8 * (i >> 2) + 4 * n + (i & 3); }
__device__ __forceinline__ void transpose_item(const float* __restrict__ W, int ldw, int scol0, bf16_t* WTrow0, int k0, LAS float* scr, int lane, bool perm) {
#pragma unroll 8
    for (int i = 0; i < 32; ++i) { const int kk = 2 * i + (lane >> 5); scr[kk * 33 + (lane & 31)] = W[(size_t)(k0 + kk) * ldw + scol0 + (lane & 31)]; }
    LDS_WAIT(); asm volatile("" ::: "memory");
    const int c = lane & 7;
#pragma unroll
    for (int j = 0; j < 4; ++j) { const int n = (lane >> 3) + 8 * j; const LAS float* s = scr + (8 * c) * 33 + (perm ? perm32(n) : n);
        u32x4 o; o.x = cvt_pk_bf16(s[0 * 33], s[1 * 33]); o.y = cvt_pk_bf16(s[2 * 33], s[3 * 33]); o.z = cvt_pk_bf16(s[4 * 33], s[5 * 33]); o.w = cvt_pk_bf16(s[6 * 33], s[7 * 33]);
        *(u32x4*)(WTrow0 + (size_t)n * 1024 + k0 + 8 * c) = o; }
    LDS_WAIT(); asm volatile("" ::: "memory");
}

__device__ __forceinline__ void transpose_item8(const float* __restrict__ W, int ldw, int scol0, unsigned char* WTrow0, int k0, LAS float* scr, int lane, float scale, bool perm = true) {
#pragma unroll 8
    for (int i = 0; i < 32; ++i) { const int kk = 2 * i + (lane >> 5); scr[kk * 33 + (lane & 31)] = W[(size_t)(k0 + kk) * ldw + scol0 + (lane & 31)]; }
    LDS_WAIT(); asm volatile("" ::: "memory");
    const int c = lane & 7;
#pragma unroll
    for (int j = 0; j < 4; ++j) { const int n = (lane >> 3) + 8 * j; const LAS float* s = scr + (8 * c) * 33 + (perm ? perm32(n) : n);
        u32x2 o; o.x = pk4_fp8(s[0 * 33] * scale, s[1 * 33] * scale, s[2 * 33] * scale, s[3 * 33] * scale); o.y = pk4_fp8(s[4 * 33] * scale, s[5 * 33] * scale, s[6 * 33] * scale, s[7 * 33] * scale);
        *(u32x2*)(WTrow0 + (size_t)n * 1024 + k0 + 8 * c) = o; }
    LDS_WAIT(); asm volatile("" ::: "memory");
}

struct T8Item { const float* src; unsigned char* dst; int ldw; int split; int perm; };
__device__ __forceinline__ T8Item t8_decode(const Params& p, int it) {
    T8Item r; r.split = 0; r.perm = 2;
    if (it < 256) { const int kb = it >> 5, t = it & 31, n0 = t * 256; r.src = p.w_in + (size_t)(kb * 128) * INCOLS + (n0 < 2048 ? n0 : n0 + 16); r.ldw = INCOLS;
        r.dst = p.ws + WS_WIN + (size_t)n0 * 1024 + kb * 128; r.perm = (n0 >= 3072 && n0 < 5120) ? 0 : 2; return r; }
    it -= 256;
    if (it < 2048) { const int e = it >> 6, kb = (it >> 3) & 7, pn = it & 7; r.src = p.exp_w1 + (size_t)e * 1024 * 2048 + (size_t)(kb * 128) * 2048 + 128 * pn; r.ldw = 2048; r.split = 1024 - 128; r.perm = 1;
        r.dst = p.ws + WS_W1 + ((size_t)e * 2048 + 256 * pn) * 1024 + kb * 128; return r; }
    it -= 2048;
    { const int e = it >> 5, kb = (it >> 2) & 7, t = it & 3; r.src = p.exp_w2 + (size_t)e * 1024 * 1024 + (size_t)(kb * 128) * 1024 + 256 * t; r.ldw = 1024;
        r.dst = p.ws + WS_W2 + ((size_t)e * 1024 + 256 * t) * 1024 + kb * 128; return r; }
}
constexpr int T8_ITEMS = 256 + 2048 + 1024;
__device__ __forceinline__ void t8_load(f32x4 (&v)[16], const T8Item& q, int wave, int lane) {
    const float* sp = q.src + (size_t)(16 * wave) * q.ldw + 4 * lane + (lane >= 32 ? q.split : 0);
#pragma unroll
    for (int i = 0; i < 16; ++i) v[i] = *(const f32x4*)(sp + (size_t)i * q.ldw);
}
__device__ __forceinline__ void t8_process(const f32x4 (&v)[16], const T8Item& q, LAS unsigned char* img, int tid, int wave, int lane) {
#pragma unroll
    for (int j = 0; j < 4; ++j) { u32x4 o;
        o.x = pk4_fp8(v[0][j] * 64.0f, v[1][j] * 64.0f, v[2][j] * 64.0f, v[3][j] * 64.0f);     o.y = pk4_fp8(v[4][j] * 64.0f, v[5][j] * 64.0f, v[6][j] * 64.0f, v[7][j] * 64.0f);
        o.z = pk4_fp8(v[8][j] * 64.0f, v[9][j] * 64.0f, v[10][j] * 64.0f, v[11][j] * 64.0f); o.w = pk4_fp8(v[12][j] * 64.0f, v[13][j] * 64.0f, v[14][j] * 64.0f, v[15][j] * 64.0f);
        *(LAS u32x4*)(img + (4 * lane + j) * 128 + ((wave ^ (lane & 7)) << 4)) = o; }
    __syncthreads();
#pragma unroll
    for (int r = 0; r < 4; ++r) { const int R = r * 64 + (tid >> 3), c = tid & 7; const int n = q.perm == 2 ? 64 * ((R >> 5) & 3) + 32 * (R >> 7) + perm32(R & 31) : (q.perm == 1 ? (R & ~31) + perm32(R & 31) : R);
        const u32x4 o = *(const LAS u32x4*)(img + n * 128 + ((c ^ ((n >> 2) & 7)) << 4));
        *(u32x4*)(q.dst + (size_t)R * 1024 + 16 * c) = o; }
}

__device__ __forceinline__ void sq_transposes(const Params& p, LAS unsigned char* lds, int w0, int nw) {
    const int tid = otid(), lane = tid & 63, wave = __builtin_amdgcn_readfirstlane(tid >> 6);
    LAS float* scr = (LAS float*)(lds + wave * 8448);
    constexpr int I_SQ = 16 * 32;
    for (int r = w0; r < 3 * I_SQ; r += nw) {
        const int w = r / I_SQ, r2 = r % I_SQ, kb = r2 >> 5, nb = r2 & 31; const float* W = w == 0 ? p.w_a : (w == 1 ? p.w_b : p.w_o);
        bf16_t* WT = (bf16_t*)(p.ws + (w == 0 ? WS_WA : (w == 1 ? WS_WB : WS_WO))); transpose_item(W, 1024, (nb >> 3) * 256 + 64 * (nb & 3) + 32 * ((nb >> 2) & 1), WT + (size_t)nb * 32 * 1024, kb * 64, scr, lane, true);
    }
    __syncthreads();
}
__device__ __forceinline__ void t8_dynamic(const Params& p, LAS unsigned char* lds, unsigned* ctr, int base, int limit) {
    const int tid = otid(), lane = tid & 63, wave = __builtin_amdgcn_readfirstlane(tid >> 6);
    LAS int* t8slot = (LAS int*)(lds + 131072);
#define T8_NEXT(nx) do { if (tid == 0) *t8slot = (int)atomicAdd(ctr, 1u) + base; __syncthreads(); nx = __builtin_amdgcn_readfirstlane(*t8slot); } while (0)
    f32x4 va[16], vb[16]; int it; T8_NEXT(it);
    if (it < limit) { const T8Item q = t8_decode(p, it); t8_load(va, q, wave, lane); }
    while (it < limit) {
        int nx; { const T8Item q = t8_decode(p, it); t8_process(va, q, lds, tid, wave, lane); }
        T8_NEXT(nx);
        if (nx < limit) { const T8Item qn = t8_decode(p, nx); t8_load(vb, qn, wave, lane); }
        it = nx; if (it >= limit) break;
        { const T8Item q = t8_decode(p, it); t8_process(vb, q, lds + 32768, tid, wave, lane); }
        T8_NEXT(nx);
        if (nx < limit) { const T8Item qn = t8_decode(p, nx); t8_load(va, qn, wave, lane); }
        it = nx;
    }
#undef T8_NEXT
    __syncthreads();
}

__device__ __forceinline__ void phase_prep(const Params& p, LAS unsigned char* lds, int G) {
    const int tid = otid(), lane = tid & 63, wave = __builtin_amdgcn_readfirstlane(tid >> 6);
    const int gw = blockIdx.x * 8 + wave, NGW = G * 8;
    LAS float* sl = (LAS float*)(lds + 73728);
    for (int i = tid; i < 9 * 1024; i += NTHREADS) { const float v = i < 8192 ? p.c[i] : p.c_ctx[i - 8192]; sl[i] = v / (1.0f + __expf(-v)); }
    __syncthreads();
    float* mod = (float*)(p.ws + WS_MOD);
    unsigned* t8ctr = (unsigned*)(p.ws + WS_CTL) + 40;
    LAS int* t8slot = (LAS int*)(lds + 131072);
    const int t8lim = G >= 160 ? 256 : T8_ITEMS;
    f32x4 va[16], vb[16]; int it = blockIdx.x;
    if (it < t8lim) { const T8Item q = t8_decode(p, it); t8_load(va, q, wave, lane); }
    for (int cb = blockIdx.x; cb < 192; cb += G) {
        const int c0 = cb * 32, col = lane & 31, slab = 2 * wave + (lane >> 5);
        float acc[9];
#pragma unroll
        for (int v = 0; v < 9; ++v) acc[v] = 0.f;
        const float* wp = p.ada_w + (size_t)(slab * 64) * 6144 + c0 + col;
#pragma unroll 1
        for (int i0 = 0; i0 < 64; i0 += 32) {
            float wv[32];
#pragma unroll
            for (int i = 0; i < 32; ++i) wv[i] = wp[(size_t)(i0 + i) * 6144];
#pragma unroll
            for (int i = 0; i < 32; ++i) {
#pragma unroll
                for (int v = 0; v < 9; ++v) acc[v] += sl[v * 1024 + slab * 64 + i0 + i] * wv[i]; }
        }
        LAS float* red = (LAS float*)(lds + 110592);
#pragma unroll
        for (int v = 0; v < 9; ++v) red[(slab * 9 + v) * 32 + col] = acc[v];
        __syncthreads();
        if (tid < 288) { const int v = tid >> 5, cc = tid & 31; float sum = 0.f;
#pragma unroll
            for (int sb = 0; sb < 16; ++sb) sum += red[(sb * 9 + v) * 32 + cc];
            mod[v * 6144 + c0 + cc] = sum + p.ada_b[c0 + cc]; }
        __syncthreads();
    }
    if (blockIdx.x == 0 && wave == 0) {
        const float s01 = wave_sum(p.dlam[lane] * p.dlam[64 + lane]), s23 = wave_sum(p.dlam[128 + lane] * p.dlam[192 + lane]);
        if (lane == 0) *(float*)(p.ws + WS_LAM) = expf(s01) - expf(s23) + LAM_INIT;
    }
    if (blockIdx.x == 1 && wave == 0 && lane < 16) {
        double th = 1.0; for (int j = 0; j < lane; ++j) th *= 0.5623413251903491;
        double ct = 1.0, st = th, term_c = 1.0, term_s = th; const double t2 = th * th;
        for (int n = 1; n < 14; ++n) { term_c *= -t2 / ((2.0 * n - 1.0) * (2.0 * n)); term_s *= -t2 / ((2.0 * n) * (2.0 * n + 1.0)); ct += term_c; st += term_s; }
        float* rc = (float*)(p.ws + WS_ROPE); float* rs = rc + 1024;
        double cc = 1.0, ss = 0.0;
        for (int pos = 0; pos < 64; ++pos) { rc[pos * 16 + lane] = (float)cc; rs[pos * 16 + lane] = (float)ss; const double c2 = cc * ct - ss * st, s2 = ss * ct + cc * st; cc = c2; ss = s2; }
    }
    if (G < 160) sq_transposes(p, lds, gw, NGW);
    __syncthreads();
#define T8_NEXT(nx) do { if (tid == 0) *t8slot = (int)atomicAdd(t8ctr, 1u) + G; __syncthreads(); nx = __builtin_amdgcn_readfirstlane(*t8slot); } while (0)
    while (it < t8lim) {
        int nx; T8_NEXT(nx);
        if (nx < t8lim) { const T8Item qn = t8_decode(p, nx); t8_load(vb, qn, wave, lane); }
        { const T8Item q = t8_decode(p, it); t8_process(va, q, lds, tid, wave, lane); }
        it = nx; if (it >= t8lim) break;
        T8_NEXT(nx);
        if (nx < t8lim) { const T8Item qn = t8_decode(p, nx); t8_load(va, qn, wave, lane); }
        { const T8Item q = t8_decode(p, it); t8_process(vb, q, lds + 32768, tid, wave, lane); }
        it = nx;
    }
#undef T8_NEXT
}

__device__ __forceinline__ void phase_rows1(const Params& p, LAS unsigned char* lds, int G) {
    const int tid = otid(), lane = tid & 63, wave = __builtin_amdgcn_readfirstlane(tid >> 6);
    const int gw = blockIdx.x * 8 + wave, NGW = G * 8;
    LAS float* wg = (LAS float*)lds;
    for (int i = tid; i < 16 * 1024; i += NTHREADS) { const int k = i >> 4, g = i & 15; wg[g * 1024 + k] = p.w_in[(size_t)k * INCOLS + 2048 + g]; }
    __syncthreads();
    const float* mod = (const float*)(p.ws + WS_MOD); unsigned char* U = p.ws + WS_U; float* GT = (float*)(p.ws + WS_GT);
    f32x4 gn[4];
#pragma unroll
    for (int j = 0; j < 4; ++j) gn[j] = *(const f32x4*)(p.norm1_g + 4 * lane + 256 * j);
    f32x4 vn[4];
    { const int m = gw; const float* xr = m < TL ? p.x + (size_t)m * 1024 : p.ctx + (size_t)(m - TL) * 1024;
#pragma unroll
      for (int j = 0; j < 4; ++j) vn[j] = *(const f32x4*)(xr + 4 * lane + 256 * j); }
    for (int m = gw; m < TT; m += NGW) {
        const float* md = mod + (size_t)(m < TL ? (m >> 12) : 8) * 6144;
        f32x4 v[4]; float ss = 0.f;
#pragma unroll
        for (int j = 0; j < 4; ++j) { v[j] = vn[j]; ss += (v[j][0] * v[j][0] + v[j][1] * v[j][1]) + (v[j][2] * v[j][2] + v[j][3] * v[j][3]); }
        if (m + NGW < TT) { const int m2 = m + NGW; const float* xr = m2 < TL ? p.x + (size_t)m2 * 1024 : p.ctx + (size_t)(m2 - TL) * 1024;
#pragma unroll
            for (int j = 0; j < 4; ++j) vn[j] = *(const f32x4*)(xr + 4 * lane + 256 * j); }
        const float rstd = rsqrtf(wave_sum(ss) * (1.0f / 1024.0f) + EPS);
#pragma unroll
        for (int j = 0; j < 4; ++j) { const f32x4 sh = *(const f32x4*)(md + 4 * lane + 256 * j), sc = *(const f32x4*)(md + 1024 + 4 * lane + 256 * j);
            v[j] = (v[j] * rstd * gn[j]) * (sc + 1.0f) + sh;
            *(unsigned*)(U + (size_t)m * 1024 + 4 * lane + 256 * j) = pk4_fp8(v[j][0], v[j][1], v[j][2], v[j][3]); }
        float a[16];
#pragma unroll
        for (int g = 0; g < 16; ++g) a[g] = 0.f;
#pragma unroll
        for (int j = 0; j < 4; ++j) {
#pragma unroll
            for (int g = 0; g < 16; ++g) { const f32x4 w = *(const LAS f32x4*)(wg + g * 1024 + 4 * lane + 256 * j); a[g] = fmaf(v[j][3], w[3], fmaf(v[j][2], w[2], fmaf(v[j][1], w[1], fmaf(v[j][0], w[0], a[g])))); }
            asm volatile("" ::: "memory"); }
        { const bool u5 = (lane & 32) != 0, u4 = (lane & 16) != 0, u3 = (lane & 8) != 0, u2 = (lane & 4) != 0;
          float b8[8], b4[4], b2[2];
#pragma unroll
          for (int g = 0; g < 8; ++g) { const float send = u5 ? a[g] : a[g + 8], keep = u5 ? a[g + 8] : a[g]; b8[g] = keep + __shfl_xor(send, 32); }
#pragma unroll
          for (int g = 0; g < 4; ++g) { const float send = u4 ? b8[g] : b8[g + 4], keep = u4 ? b8[g + 4] : b8[g]; b4[g] = keep + __shfl_xor(send, 16); }
#pragma unroll
          for (int g = 0; g < 2; ++g) { const float send = u3 ? b4[g] : b4[g + 2], keep = u3 ? b4[g + 2] : b4[g]; b2[g] = keep + __shfl_xor(send, 8); }
          float val; { const float send = u2 ? b2[0] : b2[1], keep = u2 ? b2[1] : b2[0]; val = keep + __shfl_xor(send, 4); }
          val += __shfl_xor(val, 2); val += __shfl_xor(val, 1);
          const int gsel = ((lane >> 5) & 1) * 8 + ((lane >> 4) & 1) * 4 + ((lane >> 3) & 1) * 2 + ((lane >> 2) & 1);
          if ((lane & 3) == 0) {
              val += p.gate_b[gsel]; const int type = gsel >> 2; if (type & 1) val = log_sigmoidf_(val);
              GT[(size_t)m * 16 + gsel] = val; } }
    }
}

__device__ __forceinline__ void phase_mlstm_naive(const Params& p, LAS unsigned char* lds_, int item) {
    const int tid = otid(); float* lds = (float*)(unsigned char*)lds_;
    const int dvh = item & 1, dir = (item >> 1) & 1, h = (item >> 2) & 3, b = item >> 4;
    const int dvl = tid >> 2, kq = tid & 3;
    float* Ks = lds; float* Qs = lds + 4096; float* Vs = lds + 8192; float* gi = lds + 12288; float* gf = gi + 32;
    const bf16_t* MQ = (const bf16_t*)(p.ws + WS_MQ); const bf16_t* MK = (const bf16_t*)(p.ws + WS_MK); const bf16_t* MV = (const bf16_t*)(p.ws + WS_MV);
    const float* GT = (const float*)(p.ws + WS_GT); bf16_t* H = (bf16_t*)(p.ws + (dir ? WS_HB : WS_HF));
    float C[32], nn[32];
#pragma unroll
    for (int r = 0; r < 32; ++r) { C[r] = 0.f; nn[r] = 0.f; }
    for (int s0 = 0; s0 < KVLEN; s0 += 32) {
        const bool latent = s0 >= CTX;
        __syncthreads();
        {
            const int j = tid >> 4, c8 = (tid & 15) * 8; const int s = s0 + j;
            const int m = latent ? b * SEQ + (dir ? SEQ - 1 - (s - CTX) : s - CTX) : TL + b * CTX + (dir ? CTX - 1 - s : s);
            const bf16x8 kv = *(const bf16x8*)(MK + (size_t)m * 512 + h * 128 + c8);
            const bf16x8 vv = *(const bf16x8*)(MV + (size_t)m * 1024 + h * 256 + dvh * 128 + c8);
#pragma unroll
            for (int i = 0; i < 8; ++i) { Ks[j * 128 + c8 + i] = bf2f((bf16_t)kv[i]); Vs[j * 128 + c8 + i] = bf2f((bf16_t)vv[i]); }
            if (latent) { const bf16x8 qv = *(const bf16x8*)(MQ + (size_t)m * 512 + h * 128 + c8);
#pragma unroll
                for (int i = 0; i < 8; ++i) Qs[j * 128 + c8 + i] = bf2f((bf16_t)qv[i]); }
            if ((tid & 15) == 0) { gi[j] = GT[(size_t)m * 16 + dir * 8 + h]; gf[j] = GT[(size_t)m * 16 + dir * 8 + 4 + h]; }
        }
        __syncthreads();
        for (int j = 0; j < 32; ++j) {
            const float f = __expf(gf[j]), ig = __expf(gi[j]); const float v = Vs[j * 128 + dvl];
            float num = 0.f, den = 0.f;
            const f32x4* kp = (const f32x4*)(Ks + j * 128 + kq * 32); const f32x4* qp = (const f32x4*)(Qs + j * 128 + kq * 32);
#pragma unroll
            for (int r4 = 0; r4 < 8; ++r4) { const f32x4 k4 = kp[r4]; f32x4 q4 = {0.f, 0.f, 0.f, 0.f}; if (latent) q4 = qp[r4];
#pragma unroll
                for (int i = 0; i < 4; ++i) { const int r = r4 * 4 + i; const float ik = ig * k4[i]; C[r] = f * C[r] + ik * v; nn[r] = f * nn[r] + ik; num += q4[i] * C[r]; den += q4[i] * nn[r]; } }
            if (latent) {
                num += __shfl_xor(num, 1); num += __shfl_xor(num, 2); den += __shfl_xor(den, 1); den += __shfl_xor(den, 2);
                if (kq == 0) { const int s = s0 + j; const int m = b * SEQ + (dir ? SEQ - 1 - (s - CTX) : s - CTX);
                    const float hv = num / fmaxf(fabsf(den), 1.0f);
                    H[(size_t)m * 1024 + h * 256 + dvh * 128 + dvl] = (bf16_t)(cvt_pk_bf16(hv, 0.f) & 0xffffu); }
            }
        }
    }
    __syncthreads();
}

namespace mls {
#define KSWZ(row, colB) ((row) * 256 + ((colB) ^ (((row) & 7) << 4)))
#define SBAR() __builtin_amdgcn_sched_barrier(0)
using att::crow; using att::cvtpk; using att::v_st; using att::v_rd_base; using att::v_rd_off; using att::tr_read;
constexpr int L_KSW = 0, L_KV = 32768, L_V = 65536, L_CT = 98304, L_F = 114688;
__device__ __forceinline__ float swap_add(float v) { auto rr = __builtin_amdgcn_permlane32_swap(__float_as_uint(v), __float_as_uint(v), false, false); return __uint_as_float(rr[0]) + __uint_as_float(rr[1]); }
#define TRPK(L, H) (bf16x8){L[0], L[1], L[2], L[3], H[0], H[1], H[2], H[3]}
__device__ __forceinline__ void mlstm_item(const Params& p, LAS unsigned char* lds_, int item) {
    char* lds = (char*)(unsigned char*)lds_;
    const int tid = otid(), wid = __builtin_amdgcn_readfirstlane(tid >> 6), lane = tid & 63, r32 = lane & 31, hi = lane >> 5;
    const int dvq = item & 3, dir = (item >> 2) & 1, h = (item >> 3) & 3, b = item >> 5;
    const int vh = wid >> 2, rb = vh ? 3 - (wid & 3) : (wid & 3);
    float* fa = (float*)(lds + L_F); float* a_ = fa; float* bco = fa + 128; float* w_ = fa + 256; float* wint = fa + 384; float* nvec = fa + 512; float* npart = fa + 640; float* gsc = fa + 1408; bf16_t* nb = (bf16_t*)(fa + 1416);
    const bf16_t* MQ = (const bf16_t*)(p.ws + WS_MQ); const bf16_t* MK = (const bf16_t*)(p.ws + WS_MK); const bf16_t* MV = (const bf16_t*)(p.ws + WS_MV);
    const float* GT = (const float*)(p.ws + WS_GT); bf16_t* H = (bf16_t*)(p.ws + (dir ? WS_HB : WS_HF));
    f32x16 Cacc = {};
    { u32x4 z = {0u, 0u, 0u, 0u}; *(u32x4*)(lds + L_CT + tid * 32) = z; *(u32x4*)(lds + L_CT + tid * 32 + 16) = z; if (tid < 128) { nvec[tid] = 0.f; nb[tid] = 0; } }
    const int tid_outer = tid;
    bf16x8 kreg[4], vreg[2], qnx[8]; float gi0 = 0.f, glf0 = 0.f, gi1 = 0.f, glf1 = 0.f;
#define MROW0(cc_) ((cc_) >= 2 ? b * SEQ + (dir ? 33 - (cc_) : (cc_) - 2) * 128 : TL + b * CTX + (dir ? 1 - (cc_) : (cc_)) * 128)
#define LOADS(cn_, T_) do { const int mr_ = MROW0(cn_); const int ln_ = (T_) & 63; \
        _Pragma("unroll") for (int i = 0; i < 4; ++i) { const int pc = (T_) + 512 * i, pr = pc >> 4, c8 = (pc & 15) * 8; kreg[i] = *(const bf16x8*)(MK + (size_t)(mr_ + (dir ? 127 - pr : pr)) * 512 + h * 128 + c8); } \
        _Pragma("unroll") for (int i = 0; i < 2; ++i) { const int pc = (T_) + 512 * i, pr = pc >> 3, c8 = (pc & 7) * 8; vreg[i] = *(const bf16x8*)(MV + (size_t)(mr_ + (dir ? 127 - pr : pr)) * 1024 + h * 256 + dvq * 64 + c8); } \
        if ((cn_) >= 2) { const int pr = rb * 32 + (ln_ & 31); const bf16_t* qp = MQ + (size_t)(mr_ + (dir ? 127 - pr : pr)) * 512 + h * 128 + (ln_ >> 5) * 8; \
            _Pragma("unroll") for (int d0 = 0; d0 < 8; ++d0) qnx[d0] = *(const bf16x8*)(qp + d0 * 16); } \
        else { _Pragma("unroll") for (int d0 = 0; d0 < 8; ++d0) qnx[d0] = bf16x8{}; } \
        if (wid == 0) { const int p0 = 2 * ln_, p1 = 2 * ln_ + 1; const size_t m0 = (size_t)(mr_ + (dir ? 127 - p0 : p0)) * 16, m1 = (size_t)(mr_ + (dir ? 127 - p1 : p1)) * 16; \
            gi0 = GT[m0 + dir * 8 + h]; glf0 = GT[m0 + dir * 8 + 4 + h]; gi1 = GT[m1 + dir * 8 + h]; glf1 = GT[m1 + dir * 8 + 4 + h]; } } while (0)
    LOADS(0, tid_outer);
    for (int c = 0; c < 34; ++c) {
        int tid = tid_outer; asm volatile("" : "+v"(tid));
        const int lane = tid & 63, r32 = lane & 31, hi = lane >> 5;
        const int vbV = (int)(uintptr_t)(lds + L_V) + v_rd_base(lane), vbK = (int)(uintptr_t)(lds + L_KV) + v_rd_base(lane);
        const bool latent = c >= 2;
        const int mrow0 = MROW0(c);
        bf16x8 qr[8];
        if (wid == 0) {
            const int p0 = 2 * lane, p1 = 2 * lane + 1;
            const float i0 = gi0, lf0 = glf0, i1 = gi1, lf1 = glf1;
            float incl = lf0 + lf1;
#pragma unroll
            for (int o = 1; o < 64; o <<= 1) { const float t = __shfl_up(incl, o); if (lane >= o) incl += t; }
            const float F1 = incl, F0 = incl - lf1, Ftot = __shfl(incl, 63);
            a_[p0] = F0; a_[p1] = F1; bco[p0] = i0 - F0; bco[p1] = i1 - F1; wint[p0] = __expf(F0); wint[p1] = __expf(F1);
            w_[p0] = __expf(Ftot - F0 + i0); w_[p1] = __expf(Ftot - F1 + i1); if (lane == 0) gsc[0] = __expf(Ftot);
        }
        __syncthreads();
#pragma unroll
        for (int i = 0; i < 4; ++i) { const int pc = tid + 512 * i, pr = pc >> 4, c8 = (pc & 15) * 8;
            *(bf16x8*)(lds + L_KSW + KSWZ(pr, c8 * 2)) = kreg[i]; *(bf16x8*)(lds + L_KV + (pr >> 6) * 16384 + v_st(pr & 63, c8)) = kreg[i]; }
#pragma unroll
        for (int i = 0; i < 2; ++i) { const int pc = tid + 512 * i, pr = pc >> 3, c8 = (pc & 7) * 8; const float ws_ = w_[pr];
            *(bf16x8*)(lds + L_V + (pr >> 6) * 16384 + v_st(pr & 63, c8)) = vreg[i];
            u32x4 sv; const u32x4 raw = *reinterpret_cast<const u32x4*>(&vreg[i]);
            sv.x = cvtpk(bf_lo(raw.x) * ws_, bf_hi(raw.x) * ws_); sv.y = cvtpk(bf_lo(raw.y) * ws_, bf_hi(raw.y) * ws_); sv.z = cvtpk(bf_lo(raw.z) * ws_, bf_hi(raw.z) * ws_); sv.w = cvtpk(bf_lo(raw.w) * ws_, bf_hi(raw.w) * ws_);
            *(u32x4*)(lds + L_V + (pr >> 6) * 16384 + v_st(pr & 63, 64 + c8)) = sv; }
#pragma unroll
        for (int d0 = 0; d0 < 8; ++d0) qr[d0] = qnx[d0];
        __syncthreads();
        if (c + 1 < 34) LOADS(c + 1, tid);
        const float g = gsc[0];
        if (latent) {
            const int qidx = rb * 32 + r32;
            f32x16 o = {}, dn = {};
#pragma unroll
            for (int d0 = 0; d0 < 8; ++d0) { const bf16x8 cf = *(const bf16x8*)(lds + L_CT + KSWZ(32 * vh + r32, (d0 * 16 + hi * 8) * 2)); const bf16x8 nf = *(const bf16x8*)(nb + d0 * 16 + hi * 8);
                o = __builtin_amdgcn_mfma_f32_32x32x16_bf16(qr[d0], cf, o, 0, 0, 0); dn = __builtin_amdgcn_mfma_f32_32x32x16_bf16(qr[d0], nf, dn, 0, 0, 0); }
#pragma unroll
            for (int g4 = 0; g4 < 4; ++g4) { const f32x4 wi = *(const f32x4*)(wint + rb * 32 + 8 * g4 + 4 * hi);
#pragma unroll
                for (int i = 0; i < 4; ++i) { o[g4 * 4 + i] *= wi[i]; dn[g4 * 4 + i] *= wi[i]; } }
            const bf16x8 ones = {0x3f80, 0x3f80, 0x3f80, 0x3f80, 0x3f80, 0x3f80, 0x3f80, 0x3f80};
            const float aq = a_[qidx];
            for (int jt = 0; jt <= (rb >> 1); ++jt) {
                f32x16 p0 = {}, p1 = {};
#pragma unroll
                for (int d0 = 0; d0 < 8; ++d0) { const int cbb = (d0 * 16 + hi * 8) * 2;
                    const bf16x8 b0 = *(const bf16x8*)(lds + L_KSW + KSWZ(64 * jt + r32, cbb)), b1 = *(const bf16x8*)(lds + L_KSW + KSWZ(64 * jt + 32 + r32, cbb));
                    p0 = __builtin_amdgcn_mfma_f32_32x32x16_bf16(b0, qr[d0], p0, 0, 0, 0); p1 = __builtin_amdgcn_mfma_f32_32x32x16_bf16(b1, qr[d0], p1, 0, 0, 0); }
#pragma unroll
                for (int g4 = 0; g4 < 4; ++g4) { const int k0 = 64 * jt + 8 * g4 + 4 * hi; const f32x4 bb0 = *(const f32x4*)(bco + k0), bb1 = *(const f32x4*)(bco + k0 + 32);
#pragma unroll
                    for (int i = 0; i < 4; ++i) { const int r = g4 * 4 + i;
                        const float e0 = __expf(aq + bb0[i]), e1 = __expf(aq + bb1[i]);
                        p0[r] = (k0 + i <= qidx) ? p0[r] * e0 : 0.f; p1[r] = (k0 + 32 + i <= qidx) ? p1[r] * e1 : 0.f; } }
                bf16x8 pa0, pa1, pa2, pa3;
#define PK4(P, BASE, OUT) do { unsigned a0 = cvtpk(P[BASE + 0], P[BASE + 1]), a1 = cvtpk(P[BASE + 2], P[BASE + 3]);   \
    unsigned b0_ = cvtpk(P[BASE + 4], P[BASE + 5]), b1_ = cvtpk(P[BASE + 6], P[BASE + 7]);                              \
    auto r0 = __builtin_amdgcn_permlane32_swap(a0, b0_, false, false); auto r1 = __builtin_amdgcn_permlane32_swap(a1, b1_, false, false); \
    u32x4 w4 = {r0[0], r1[0], r0[1], r1[1]}; OUT = *reinterpret_cast<bf16x8*>(&w4); } while (0)
                PK4(p0, 0, pa0); PK4(p0, 8, pa1); PK4(p1, 0, pa2); PK4(p1, 8, pa3);
#undef PK4
                const int vb = vbV + jt * 16384 + vh * 512;
                const s16x4 l0 = tr_read<v_rd_off(0, 0, 0)>(vb), h0 = tr_read<v_rd_off(0, 0, 1)>(vb), l1 = tr_read<v_rd_off(0, 1, 0)>(vb), h1 = tr_read<v_rd_off(0, 1, 1)>(vb);
                const s16x4 l2 = tr_read<v_rd_off(0, 2, 0)>(vb), h2 = tr_read<v_rd_off(0, 2, 1)>(vb), l3 = tr_read<v_rd_off(0, 3, 0)>(vb), h3 = tr_read<v_rd_off(0, 3, 1)>(vb);
                asm volatile("s_waitcnt lgkmcnt(0)" ::: "memory"); SBAR();
                o = __builtin_amdgcn_mfma_f32_32x32x16_bf16(pa0, TRPK(l0, h0), o, 0, 0, 0); o = __builtin_amdgcn_mfma_f32_32x32x16_bf16(pa1, TRPK(l1, h1), o, 0, 0, 0);
                o = __builtin_amdgcn_mfma_f32_32x32x16_bf16(pa2, TRPK(l2, h2), o, 0, 0, 0); o = __builtin_amdgcn_mfma_f32_32x32x16_bf16(pa3, TRPK(l3, h3), o, 0, 0, 0);
                dn = __builtin_amdgcn_mfma_f32_32x32x16_bf16(pa0, ones, dn, 0, 0, 0); dn = __builtin_amdgcn_mfma_f32_32x32x16_bf16(pa1, ones, dn, 0, 0, 0);
                dn = __builtin_amdgcn_mfma_f32_32x32x16_bf16(pa2, ones, dn, 0, 0, 0); dn = __builtin_amdgcn_mfma_f32_32x32x16_bf16(pa3, ones, dn, 0, 0, 0);
            }
#pragma unroll
            for (int g4 = 0; g4 < 4; ++g4)
#pragma unroll
                for (int i = 0; i < 4; ++i) { const int r = g4 * 4 + i, pr = rb * 32 + 8 * g4 + 4 * hi + i;
                    const float hv = o[r] * __builtin_amdgcn_rcpf(fmaxf(fabsf(dn[r]), 1.0f));
                    H[(size_t)(mrow0 + (dir ? 127 - pr : pr)) * 1024 + h * 256 + dvq * 64 + vh * 32 + r32] = (bf16_t)(cvtpk(hv, 0.f) & 0xffffu); }
        }
#pragma unroll
        for (int r = 0; r < 16; ++r) Cacc[r] *= g;
#pragma unroll
        for (int jt = 0; jt < 2; ++jt) {
            const int va = vbV + jt * 16384 + (2 + vh) * 512, ka = vbK + jt * 16384 + rb * 512;
            const s16x4 al0 = tr_read<v_rd_off(0, 0, 0)>(va), ah0 = tr_read<v_rd_off(0, 0, 1)>(va), al1 = tr_read<v_rd_off(0, 1, 0)>(va), ah1 = tr_read<v_rd_off(0, 1, 1)>(va);
            const s16x4 al2 = tr_read<v_rd_off(0, 2, 0)>(va), ah2 = tr_read<v_rd_off(0, 2, 1)>(va), al3 = tr_read<v_rd_off(0, 3, 0)>(va), ah3 = tr_read<v_rd_off(0, 3, 1)>(va);
            const s16x4 bl0 = tr_read<v_rd_off(0, 0, 0)>(ka), bh0 = tr_read<v_rd_off(0, 0, 1)>(ka), bl1 = tr_read<v_rd_off(0, 1, 0)>(ka), bh1 = tr_read<v_rd_off(0, 1, 1)>(ka);
            const s16x4 bl2 = tr_read<v_rd_off(0, 2, 0)>(ka), bh2 = tr_read<v_rd_off(0, 2, 1)>(ka), bl3 = tr_read<v_rd_off(0, 3, 0)>(ka), bh3 = tr_read<v_rd_off(0, 3, 1)>(ka);
            asm volatile("s_waitcnt lgkmcnt(0)" ::: "memory"); SBAR();
            Cacc = __builtin_amdgcn_mfma_f32_32x32x16_bf16(TRPK(al0, ah0), TRPK(bl0, bh0), Cacc, 0, 0, 0); Cacc = __builtin_amdgcn_mfma_f32_32x32x16_bf16(TRPK(al1, ah1), TRPK(bl1, bh1), Cacc, 0, 0, 0);
            Cacc = __builtin_amdgcn_mfma_f32_32x32x16_bf16(TRPK(al2, ah2), TRPK(bl2, bh2), Cacc, 0, 0, 0); Cacc = __builtin_amdgcn_mfma_f32_32x32x16_bf16(TRPK(al3, ah3), TRPK(bl3, bh3), Cacc, 0, 0, 0);
        }
        { const int k = tid & 127, sq = tid >> 7; float part = 0.f;
#pragma unroll 8
            for (int s = sq * 32; s < sq * 32 + 32; ++s) part += w_[s] * bf2f(*(const bf16_t*)(lds + L_KSW + KSWZ(s, 2 * k)));
            npart[sq * 128 + k] = part; }
        __syncthreads();
#pragma unroll
        for (int r = 0; r < 16; ++r) *(bf16_t*)(lds + L_CT + KSWZ(32 * vh + crow(r, hi), 2 * (32 * rb + r32))) = (bf16_t)(cvtpk(Cacc[r], 0.f) & 0xffffu);
        if (tid < 128) { const float nn = g * nvec[tid] + ((npart[tid] + npart[128 + tid]) + (npart[256 + tid] + npart[384 + tid])); nvec[tid] = nn; nb[tid] = (bf16_t)(cvtpk(nn, 0.f) & 0xffffu); }
    }
    __syncthreads();
}
#undef TRPK
#undef KSWZ
#undef SBAR
#undef LOADS
#undef MROW0
}

namespace mls2 {
#define KSWZ(row, colB) ((row) * 256 + ((colB) ^ (((row) & 15) << 4)))
#define SBAR() __builtin_amdgcn_sched_barrier(0)
using att::crow; using att::cvtpk; using att::v_st; using att::v_rd_base; using att::v_rd_off; using att::tr_read;
constexpr int L_KSW = 0, L_KW = 32768, L_V = 65536, L_CT = 98304, L_F = 131072;
#define TRPK(L, H) (bf16x8){L[0], L[1], L[2], L[3], H[0], H[1], H[2], H[3]}
#define TR8(dst, base) do { dst[0] = tr_read<v_rd_off(0, 0, 0)>(base); dst[1] = tr_read<v_rd_off(0, 0, 1)>(base); dst[2] = tr_read<v_rd_off(0, 1, 0)>(base); dst[3] = tr_read<v_rd_off(0, 1, 1)>(base); \
    dst[4] = tr_read<v_rd_off(0, 2, 0)>(base); dst[5] = tr_read<v_rd_off(0, 2, 1)>(base); dst[6] = tr_read<v_rd_off(0, 3, 0)>(base); dst[7] = tr_read<v_rd_off(0, 3, 1)>(base); } while (0)
__device__ __forceinline__ void mlstm_item(const Params& p, LAS unsigned char* lds_, int item) {
    char* lds = (char*)(unsigned char*)lds_;
    const int tid = otid(), wid = __builtin_amdgcn_readfirstlane(tid >> 6);
    const int dvh = item & 1, dir = (item >> 1) & 1, h = (item >> 2) & 3, b = item >> 4;
    const int vh = wid >> 2, rb = vh ? 3 - (wid & 3) : (wid & 3);
    float* fa = (float*)(lds + L_F); float* a_ = fa; float* bco = fa + 128; float* w_ = fa + 256; float* wint = fa + 384; float* nvec = fa + 512; float* npart = fa + 640; float* gsc = fa + 1152; bf16_t* nb = (bf16_t*)(fa + 1160);
    const bf16_t* MQ = (const bf16_t*)(p.ws + WS_MQ); const bf16_t* MK = (const bf16_t*)(p.ws + WS_MK); const bf16_t* MV = (const bf16_t*)(p.ws + WS_MV);
    const float* GT = (const float*)(p.ws + WS_GT); bf16_t* H = (bf16_t*)(p.ws + (dir ? WS_HB : WS_HF));
    f32x16 Cacc0 = {}, Cacc1 = {};
    { u32x4 z = {0u, 0u, 0u, 0u};
#pragma unroll
      for (int i = 0; i < 4; ++i) *(u32x4*)(lds + L_CT + tid * 64 + i * 16) = z;
      if (tid < 128) { nvec[tid] = 0.f; nb[tid] = 0; } }
    const int tid_outer = tid;
    bf16x8 kreg[4], vreg[4]; float gi0 = 0.f, glf0 = 0.f, gi1 = 0.f, glf1 = 0.f;
#define MROW0(cc_) ((cc_) >= 2 ? b * SEQ + (dir ? 33 - (cc_) : (cc_) - 2) * 128 : TL + b * CTX + (dir ? 1 - (cc_) : (cc_)) * 128)
#define LOADS(cn_, T_) do { const int mr_ = MROW0(cn_); const int ln_ = (T_) & 63; \
        _Pragma("unroll") for (int i = 0; i < 4; ++i) { const int pc = (T_) + 512 * i, pr = pc >> 4, c8 = (pc & 15) * 8; const size_t rw_ = (size_t)(mr_ + (dir ? 127 - pr : pr)); \
            kreg[i] = *(const bf16x8*)(MK + rw_ * 512 + h * 128 + c8); vreg[i] = *(const bf16x8*)(MV + rw_ * 1024 + h * 256 + dvh * 128 + c8); } \
        if (wid == 0) { const int p0 = 2 * ln_, p1 = 2 * ln_ + 1; const size_t m0 = (size_t)(mr_ + (dir ? 127 - p0 : p0)) * 16, m1 = (size_t)(mr_ + (dir ? 127 - p1 : p1)) * 16; \
            gi0 = GT[m0 + dir * 8 + h]; glf0 = GT[m0 + dir * 8 + 4 + h]; gi1 = GT[m1 + dir * 8 + h]; glf1 = GT[m1 + dir * 8 + 4 + h]; } } while (0)
    LOADS(0, tid_outer);
    for (int c = 0; c < 34; ++c) {
        int tid = tid_outer; asm volatile("" : "+v"(tid));
        const int lane = tid & 63, r32 = lane & 31, hi = lane >> 5;
        const int vbV = (int)(uintptr_t)(lds + L_V) + v_rd_base(lane), vbK = (int)(uintptr_t)(lds + L_KW) + v_rd_base(lane);
        const bool latent = c >= 2;
        const int mrow0 = MROW0(c);
        bf16x8 qr[8];
        if (latent) { const int pr = rb * 32 + r32; const bf16_t* qp = MQ + (size_t)(mrow0 + (dir ? 127 - pr : pr)) * 512 + h * 128 + hi * 8;
#pragma unroll
            for (int d0 = 0; d0 < 8; ++d0) qr[d0] = *(const bf16x8*)(qp + d0 * 16); }
        else {
#pragma unroll
            for (int d0 = 0; d0 < 8; ++d0) qr[d0] = bf16x8{};
        }
        if (wid == 0) {
            const int p0 = 2 * lane, p1 = 2 * lane + 1;
            const float i0 = gi0, lf0 = glf0, i1 = gi1, lf1 = glf1;
            float incl = lf0 + lf1;
#pragma unroll
            for (int o = 1; o < 64; o <<= 1) { const float t = __shfl_up(incl, o); if (lane >= o) incl += t; }
            const float F1 = incl, F0 = incl - lf1, Ftot = __shfl(incl, 63);
            a_[p0] = F0; a_[p1] = F1; bco[p0] = i0 - F0; bco[p1] = i1 - F1; wint[p0] = __expf(F0); wint[p1] = __expf(F1);
            w_[p0] = __expf(Ftot - F0 + i0); w_[p1] = __expf(Ftot - F1 + i1); if (lane == 0) gsc[0] = __expf(Ftot);
        }
        __syncthreads();
#pragma unroll
        for (int i = 0; i < 4; ++i) { const int pc = tid + 512 * i, pr = pc >> 4, c8 = (pc & 15) * 8; const float ws_ = w_[pr];
            *(bf16x8*)(lds + L_KSW + KSWZ(pr, c8 * 2)) = kreg[i];
            u32x4 sk; const u32x4 raw = *reinterpret_cast<const u32x4*>(&kreg[i]);
            sk.x = cvtpk(bf_lo(raw.x) * ws_, bf_hi(raw.x) * ws_); sk.y = cvtpk(bf_lo(raw.y) * ws_, bf_hi(raw.y) * ws_); sk.z = cvtpk(bf_lo(raw.z) * ws_, bf_hi(raw.z) * ws_); sk.w = cvtpk(bf_lo(raw.w) * ws_, bf_hi(raw.w) * ws_);
            *(u32x4*)(lds + L_KW + (pr >> 6) * 16384 + v_st(pr & 63, c8)) = sk;
            *(bf16x8*)(lds + L_V + (pr >> 6) * 16384 + v_st(pr & 63, c8)) = vreg[i]; }
        __syncthreads();
        if (c + 1 < 34) LOADS(c + 1, tid);
        const float g = gsc[0];
        if (latent) {
            const int qidx = rb * 32 + r32;
            f32x16 o0 = {}, o1 = {}, dn = {};
#pragma unroll
            for (int dh = 0; dh < 2; ++dh) {
                bf16x8 c0[4], c1[4], nf[4];
#pragma unroll
                for (int d = 0; d < 4; ++d) { const int d0 = dh * 4 + d, cbb = (d0 * 16 + hi * 8) * 2;
                    c0[d] = *(const bf16x8*)(lds + L_CT + KSWZ(64 * vh + r32, cbb)); c1[d] = *(const bf16x8*)(lds + L_CT + KSWZ(64 * vh + 32 + r32, cbb)); nf[d] = *(const bf16x8*)(nb + d0 * 16 + hi * 8); }
                SBAR();
#pragma unroll
                for (int d = 0; d < 4; ++d) { const int d0 = dh * 4 + d;
                    o0 = __builtin_amdgcn_mfma_f32_32x32x16_bf16(qr[d0], c0[d], o0, 0, 0, 0); o1 = __builtin_amdgcn_mfma_f32_32x32x16_bf16(qr[d0], c1[d], o1, 0, 0, 0); dn = __builtin_amdgcn_mfma_f32_32x32x16_bf16(qr[d0], nf[d], dn, 0, 0, 0); }
                SBAR(); }
#pragma unroll
            for (int g4 = 0; g4 < 4; ++g4) { const f32x4 wi = *(const f32x4*)(wint + rb * 32 + 8 * g4 + 4 * hi);
#pragma unroll
                for (int i = 0; i < 4; ++i) { o0[g4 * 4 + i] *= wi[i]; o1[g4 * 4 + i] *= wi[i]; dn[g4 * 4 + i] *= wi[i]; } }
            const bf16x8 ones = {0x3f80, 0x3f80, 0x3f80, 0x3f80, 0x3f80, 0x3f80, 0x3f80, 0x3f80};
            const float aq = a_[qidx];
            for (int jt = 0; jt <= (rb >> 1); ++jt) {
                f32x16 p0 = {}, p1 = {};
#pragma unroll
                for (int dh = 0; dh < 2; ++dh) {
                    bf16x8 b0[4], b1[4];
#pragma unroll
                    for (int d = 0; d < 4; ++d) { const int cbb = ((dh * 4 + d) * 16 + hi * 8) * 2;
                        b0[d] = *(const bf16x8*)(lds + L_KSW + KSWZ(64 * jt + r32, cbb)); b1[d] = *(const bf16x8*)(lds + L_KSW + KSWZ(64 * jt + 32 + r32, cbb)); }
                    SBAR();
#pragma unroll
                    for (int d = 0; d < 4; ++d) { p0 = __builtin_amdgcn_mfma_f32_32x32x16_bf16(b0[d], qr[dh * 4 + d], p0, 0, 0, 0); p1 = __builtin_amdgcn_mfma_f32_32x32x16_bf16(b1[d], qr[dh * 4 + d], p1, 0, 0, 0); }
                    SBAR(); }
#pragma unroll
                for (int g4 = 0; g4 < 4; ++g4) { const int k0 = 64 * jt + 8 * g4 + 4 * hi; const f32x4 bb0 = *(const f32x4*)(bco + k0), bb1 = *(const f32x4*)(bco + k0 + 32);
#pragma unroll
                    for (int i = 0; i < 4; ++i) { const int r = g4 * 4 + i;
                        const float e0 = __expf(aq + bb0[i]), e1 = __expf(aq + bb1[i]);
                        p0[r] = (k0 + i <= qidx) ? p0[r] * e0 : 0.f; p1[r] = (k0 + 32 + i <= qidx) ? p1[r] * e1 : 0.f; } }
                bf16x8 pa0, pa1, pa2, pa3;
#define PK4(P, BASE, OUT) do { unsigned a0 = cvtpk(P[BASE + 0], P[BASE + 1]), a1 = cvtpk(P[BASE + 2], P[BASE + 3]);   \
    unsigned b0_ = cvtpk(P[BASE + 4], P[BASE + 5]), b1_ = cvtpk(P[BASE + 6], P[BASE + 7]);                              \
    auto r0 = __builtin_amdgcn_permlane32_swap(a0, b0_, false, false); auto r1 = __builtin_amdgcn_permlane32_swap(a1, b1_, false, false); \
    u32x4 w4 = {r0[0], r1[0], r0[1], r1[1]}; OUT = *reinterpret_cast<bf16x8*>(&w4); } while (0)
                PK4(p0, 0, pa0); PK4(p0, 8, pa1); PK4(p1, 0, pa2); PK4(p1, 8, pa3);
#undef PK4
                s16x4 va[8], vc[8];
                const int vb = vbV + jt * 16384 + (2 * vh) * 512;
                TR8(va, vb); TR8(vc, vb + 512);
                asm volatile("s_waitcnt lgkmcnt(0)" ::: "memory"); SBAR();
                o0 = __builtin_amdgcn_mfma_f32_32x32x16_bf16(pa0, TRPK(va[0], va[1]), o0, 0, 0, 0); o0 = __builtin_amdgcn_mfma_f32_32x32x16_bf16(pa1, TRPK(va[2], va[3]), o0, 0, 0, 0);
                o0 = __builtin_amdgcn_mfma_f32_32x32x16_bf16(pa2, TRPK(va[4], va[5]), o0, 0, 0, 0); o0 = __builtin_amdgcn_mfma_f32_32x32x16_bf16(pa3, TRPK(va[6], va[7]), o0, 0, 0, 0);
                o1 = __builtin_amdgcn_mfma_f32_32x32x16_bf16(pa0, TRPK(vc[0], vc[1]), o1, 0, 0, 0); o1 = __builtin_amdgcn_mfma_f32_32x32x16_bf16(pa1, TRPK(vc[2], vc[3]), o1, 0, 0, 0);
                o1 = __builtin_amdgcn_mfma_f32_32x32x16_bf16(pa2, TRPK(vc[4], vc[5]), o1, 0, 0, 0); o1 = __builtin_amdgcn_mfma_f32_32x32x16_bf16(pa3, TRPK(vc[6], vc[7]), o1, 0, 0, 0);
                dn = __builtin_amdgcn_mfma_f32_32x32x16_bf16(pa0, ones, dn, 0, 0, 0); dn = __builtin_amdgcn_mfma_f32_32x32x16_bf16(pa1, ones, dn, 0, 0, 0);
                dn = __builtin_amdgcn_mfma_f32_32x32x16_bf16(pa2, ones, dn, 0, 0, 0); dn = __builtin_amdgcn_mfma_f32_32x32x16_bf16(pa3, ones, dn, 0, 0, 0);
            }
#define T4X(A, B, CTRL, ODD) do { const float s_ = (ODD) ? A : B; const float r_ = __builtin_bit_cast(float, __builtin_amdgcn_update_dpp(0, __builtin_bit_cast(int, s_), CTRL, 0xf, 0xf, false)); \
        A = (ODD) ? r_ : A; B = (ODD) ? B : r_; } while (0)
#define T4(X0, X1, X2, X3) do { T4X(X0, X1, 0xB1, q1_); T4X(X2, X3, 0xB1, q1_); T4X(X0, X2, 0x4E, q2_); T4X(X1, X3, 0x4E, q2_); } while (0)
            { const bool q1_ = (lane & 1) != 0, q2_ = (lane & 2) != 0; const int q = lane & 3;
#pragma unroll
              for (int g4 = 0; g4 < 4; ++g4) {
                float x[4], z[4];
#pragma unroll
                for (int i = 0; i < 4; ++i) { const int r = g4 * 4 + i; const float rd = __builtin_amdgcn_rcpf(fmaxf(fabsf(dn[r]), 1.0f)); x[i] = o0[r] * rd; z[i] = o1[r] * rd; }
                T4(x[0], x[1], x[2], x[3]); T4(z[0], z[1], z[2], z[3]);
                const int pr = rb * 32 + 8 * g4 + 4 * hi + q;
                bf16_t* hp = H + (size_t)(mrow0 + (dir ? 127 - pr : pr)) * 1024 + h * 256 + dvh * 128 + vh * 64 + (r32 & ~3);
                u32x2 w0, w1; w0.x = cvtpk(x[0], x[1]); w0.y = cvtpk(x[2], x[3]); w1.x = cvtpk(z[0], z[1]); w1.y = cvtpk(z[2], z[3]);
                *(u32x2*)hp = w0; *(u32x2*)(hp + 32) = w1; } }
#undef T4
#undef T4X
        }
#pragma unroll
        for (int r = 0; r < 16; ++r) { Cacc0[r] *= g; Cacc1[r] *= g; }
        f32x16 nacc = {};
        const bf16x8 ones1 = {0x3f80, 0x3f80, 0x3f80, 0x3f80, 0x3f80, 0x3f80, 0x3f80, 0x3f80};
#pragma unroll
        for (int jt = 0; jt < 2; ++jt) {
            s16x4 a0[8], a1[8], kb[8];
            const int va_ = vbV + jt * 16384 + (2 * vh) * 512, ka_ = vbK + jt * 16384 + rb * 512;
            TR8(kb, ka_); TR8(a0, va_); TR8(a1, va_ + 512);
            asm volatile("s_waitcnt lgkmcnt(0)" ::: "memory"); SBAR();
#pragma unroll
            for (int k = 0; k < 4; ++k) { const bf16x8 bf = TRPK(kb[2 * k], kb[2 * k + 1]);
                Cacc0 = __builtin_amdgcn_mfma_f32_32x32x16_bf16(TRPK(a0[2 * k], a0[2 * k + 1]), bf, Cacc0, 0, 0, 0); Cacc1 = __builtin_amdgcn_mfma_f32_32x32x16_bf16(TRPK(a1[2 * k], a1[2 * k + 1]), bf, Cacc1, 0, 0, 0);
                if (vh == 0) nacc = __builtin_amdgcn_mfma_f32_32x32x16_bf16(ones1, bf, nacc, 0, 0, 0); }
        }
        __syncthreads();
#define T4X(A, B, CTRL, ODD) do { const float s_ = (ODD) ? A : B; const float r_ = __builtin_bit_cast(float, __builtin_amdgcn_update_dpp(0, __builtin_bit_cast(int, s_), CTRL, 0xf, 0xf, false)); \
        A = (ODD) ? r_ : A; B = (ODD) ? B : r_; } while (0)
#define T4(X0, X1, X2, X3) do { T4X(X0, X1, 0xB1, q1_); T4X(X2, X3, 0xB1, q1_); T4X(X0, X2, 0x4E, q2_); T4X(X1, X3, 0x4E, q2_); } while (0)
        { const bool q1_ = (lane & 1) != 0, q2_ = (lane & 2) != 0; const int q = lane & 3;
#pragma unroll
          for (int g4 = 0; g4 < 4; ++g4) {
            float x[4] = {Cacc0[g4 * 4 + 0], Cacc0[g4 * 4 + 1], Cacc0[g4 * 4 + 2], Cacc0[g4 * 4 + 3]}, z[4] = {Cacc1[g4 * 4 + 0], Cacc1[g4 * 4 + 1], Cacc1[g4 * 4 + 2], Cacc1[g4 * 4 + 3]};
            T4(x[0], x[1], x[2], x[3]); T4(z[0], z[1], z[2], z[3]);
            const int row = 8 * g4 + 4 * hi + q, colB = 2 * (32 * rb + (r32 & ~3));
            u32x2 w0, w1; w0.x = cvtpk(x[0], x[1]); w0.y = cvtpk(x[2], x[3]); w1.x = cvtpk(z[0], z[1]); w1.y = cvtpk(z[2], z[3]);
            *(u32x2*)(lds + L_CT + KSWZ(64 * vh + row, colB)) = w0; *(u32x2*)(lds + L_CT + KSWZ(64 * vh + 32 + row, colB)) = w1; } }
#undef T4
#undef T4X
        if (vh == 0 && hi == 0) { const int k = 32 * rb + r32; const float nn = g * nvec[k] + nacc[0]; nvec[k] = nn; nb[k] = (bf16_t)(cvtpk(nn, 0.f) & 0xffffu); }
    }
    __syncthreads();
}
#undef TRPK
#undef TR8
#undef KSWZ
#undef SBAR
#undef LOADS
#undef MROW0
}

__device__ __forceinline__ void phase_mfinal(const Params& p, int G) {
    const int tid = otid(), lane = tid & 63, wave = __builtin_amdgcn_readfirstlane(tid >> 6);
    const int gw = blockIdx.x * 8 + wave, NGW = G * 8;
    bf16_t* HF = (bf16_t*)(p.ws + WS_HF); const bf16_t* HB = (const bf16_t*)(p.ws + WS_HB); const bf16_t* MO = (const bf16_t*)(p.ws + WS_MO);
    u32x2 na[4], nbq[4], nog[4];
#pragma unroll
    for (int j = 0; j < 4; ++j) { const size_t o = (size_t)gw * 1024 + 256 * j + 4 * lane; na[j] = *(const u32x2*)(HF + o); nbq[j] = *(const u32x2*)(HB + o); nog[j] = *(const u32x2*)(MO + o); }
    for (int m = gw; m < TL; m += NGW) {
        u32x2 ca[4], cb[4], cg[4];
#pragma unroll
        for (int j = 0; j < 4; ++j) { ca[j] = na[j]; cb[j] = nbq[j]; cg[j] = nog[j]; }
        if (m + NGW < TL) {
#pragma unroll
            for (int j = 0; j < 4; ++j) { const size_t o = (size_t)(m + NGW) * 1024 + 256 * j + 4 * lane; na[j] = *(const u32x2*)(HF + o); nbq[j] = *(const u32x2*)(HB + o); nog[j] = *(const u32x2*)(MO + o); } }
#pragma unroll
        for (int j = 0; j < 4; ++j) {
            const size_t o = (size_t)m * 1024 + 256 * j + 4 * lane;
            const u32x2 a = ca[j], bq = cb[j], og = cg[j];
            f32x4 hs = {bf_lo(a.x) + bf_lo(bq.x), bf_hi(a.x) + bf_hi(bq.x), bf_lo(a.y) + bf_lo(bq.y), bf_hi(a.y) + bf_hi(bq.y)};
            const float rstd = rsqrtf(wave_sum((hs[0] * hs[0] + hs[1] * hs[1]) + (hs[2] * hs[2] + hs[3] * hs[3])) * (1.0f / 256.0f) + EPS);
            const f32x4 g = *(const f32x4*)(p.mnorm_g + 256 * j + 4 * lane);
            const f32x4 ov = {sigmoidf_(bf_lo(og.x)), sigmoidf_(bf_hi(og.x)), sigmoidf_(bf_lo(og.y)), sigmoidf_(bf_hi(og.y))};
            const f32x4 r = hs * rstd * g * ov;
            u32x2 w; w.x = cvt_pk_bf16(r[0], r[1]); w.y = cvt_pk_bf16(r[2], r[3]); *(u32x2*)(HF + o) = w;
        }
    }
}

__device__ __forceinline__ void mfinal_part(const Params& p, int b, int h, int quarter) {
    const int tid = otid(), lane = tid & 63, wave = __builtin_amdgcn_readfirstlane(tid >> 6);
    bf16_t* HF = (bf16_t*)(p.ws + WS_HF); const bf16_t* HB = (const bf16_t*)(p.ws + WS_HB); const bf16_t* MO = (const bf16_t*)(p.ws + WS_MO);
    const f32x4 g = *(const f32x4*)(p.mnorm_g + 256 * h + 4 * lane);
    const size_t o0 = ((size_t)b * SEQ + quarter * 1024 + wave * 128) * 1024 + 256 * h + 4 * lane;
    u32x2 na = *(const u32x2*)(HF + o0), nbq = *(const u32x2*)(HB + o0), nog = *(const u32x2*)(MO + o0);
    for (int i = 0; i < 128; ++i) {
        const size_t o = o0 + (size_t)i * 1024; const u32x2 a = na, bq = nbq, og = nog;
        if (i + 1 < 128) { na = *(const u32x2*)(HF + o + 1024); nbq = *(const u32x2*)(HB + o + 1024); nog = *(const u32x2*)(MO + o + 1024); }
        f32x4 hs = {bf_lo(a.x) + bf_lo(bq.x), bf_hi(a.x) + bf_hi(bq.x), bf_lo(a.y) + bf_lo(bq.y), bf_hi(a.y) + bf_hi(bq.y)};
        const float rstd = rsqrtf(wave_sum((hs[0] * hs[0] + hs[1] * hs[1]) + (hs[2] * hs[2] + hs[3] * hs[3])) * (1.0f / 256.0f) + EPS);
        const f32x4 ov = {sigmoidf_(bf_lo(og.x)), sigmoidf_(bf_hi(og.x)), sigmoidf_(bf_lo(og.y)), sigmoidf_(bf_hi(og.y))};
        const f32x4 r = hs * rstd * g * ov;
        u32x2 w; w.x = cvt_pk_bf16(r[0], r[1]); w.y = cvt_pk_bf16(r[2], r[3]); *(u32x2*)(HF + o) = w;
    }
}

__device__ __forceinline__ void phase_rows2(const Params& p, LAS unsigned char* lds, int grp) {
    const int tid = otid(), lane = tid & 63, wave = __builtin_amdgcn_readfirstlane(tid >> 6);
    LAS float* rw = (LAS float*)lds;
    LAS int* hist = (LAS int*)(lds + 131072);
    LAS int* basee = hist + 32;
    LAS int* a_e = basee + 32;
    LAS int* a_p = a_e + 512;
    LAS float* a_g = (LAS float*)(a_p + 512);
    for (int i = tid; i < 32 * 1024; i += NTHREADS) { const int k = i >> 5, e = i & 31; rw[e * 1024 + k] = p.router_w[i]; }
    if (tid < 32) hist[tid] = 0;
    __syncthreads();
    const float* mod = (const float*)(p.ws + WS_MOD); unsigned char* U2 = p.ws + WS_U2;
    unsigned* cnt = (unsigned*)(p.ws + WS_CTL) + CW_CNT; int* asg = (int*)(p.ws + WS_ASG); int* list = (int*)(p.ws + WS_LIST); float* lgate = (float*)(p.ws + WS_LGATE);
    f32x4 gn[4];
#pragma unroll
    for (int j = 0; j < 4; ++j) gn[j] = *(const f32x4*)(p.norm2_g + 4 * lane + 256 * j);
    const int tok0 = grp * 128 + wave * 16;
    const bf16_t* X1 = (const bf16_t*)(p.ws + WS_X1);
    u32x2 vn[4];
#pragma unroll
    for (int j = 0; j < 4; ++j) vn[j] = *(const u32x2*)(X1 + (size_t)tok0 * 1024 + 4 * lane + 256 * j);
    for (int it = 0; it < 16; ++it) {
        const int m = tok0 + it; const float* md = mod + (size_t)(m >> 12) * 6144;
        f32x4 v[4]; float ss = 0.f;
#pragma unroll
        for (int j = 0; j < 4; ++j) { v[j] = (f32x4){bf_lo(vn[j].x), bf_hi(vn[j].x), bf_lo(vn[j].y), bf_hi(vn[j].y)}; ss += (v[j][0] * v[j][0] + v[j][1] * v[j][1]) + (v[j][2] * v[j][2] + v[j][3] * v[j][3]); }
        if (it + 1 < 16) {
#pragma unroll
            for (int j = 0; j < 4; ++j) vn[j] = *(const u32x2*)(X1 + (size_t)(m + 1) * 1024 + 4 * lane + 256 * j); }
        const float rstd = rsqrtf(wave_sum(ss) * (1.0f / 1024.0f) + EPS);
#pragma unroll
        for (int j = 0; j < 4; ++j) { const f32x4 sh = *(const f32x4*)(md + 3072 + 4 * lane + 256 * j), sc = *(const f32x4*)(md + 4096 + 4 * lane + 256 * j);
            v[j] = (v[j] * rstd * gn[j]) * (sc + 1.0f) + sh;
            *(unsigned*)(U2 + (size_t)m * 1024 + 4 * lane + 256 * j) = pk4_fp8(v[j][0], v[j][1], v[j][2], v[j][3]); }
        float a[32];
#pragma unroll
        for (int e = 0; e < 32; ++e) a[e] = 0.f;
#pragma unroll
        for (int j = 0; j < 4; ++j) {
#pragma unroll
            for (int eh = 0; eh < 2; ++eh) {
#pragma unroll
                for (int e = eh * 16; e < eh * 16 + 16; ++e) { const f32x4 w = *(const LAS f32x4*)(rw + e * 1024 + 4 * lane + 256 * j); a[e] = fmaf(v[j][3], w[3], fmaf(v[j][2], w[2], fmaf(v[j][1], w[1], fmaf(v[j][0], w[0], a[e])))); }
                asm volatile("" ::: "memory"); } }
        float mine;
        { const bool u5 = (lane & 32) != 0, u4 = (lane & 16) != 0, u3 = (lane & 8) != 0, u2 = (lane & 4) != 0, u1 = (lane & 2) != 0;
          float b16[16], b8[8], b4[4], b2[2];
#pragma unroll
          for (int g = 0; g < 16; ++g) { const float send = u5 ? a[g] : a[g + 16], keep = u5 ? a[g + 16] : a[g]; b16[g] = keep + __shfl_xor(send, 32); }
#pragma unroll
          for (int g = 0; g < 8; ++g) { const float send = u4 ? b16[g] : b16[g + 8], keep = u4 ? b16[g + 8] : b16[g]; b8[g] = keep + __shfl_xor(send, 16); }
#pragma unroll
          for (int g = 0; g < 4; ++g) { const float send = u3 ? b8[g] : b8[g + 4], keep = u3 ? b8[g + 4] : b8[g]; b4[g] = keep + __shfl_xor(send, 8); }
#pragma unroll
          for (int g = 0; g < 2; ++g) { const float send = u2 ? b4[g] : b4[g + 2], keep = u2 ? b4[g + 2] : b4[g]; b2[g] = keep + __shfl_xor(send, 4); }
          { const float send = u1 ? b2[0] : b2[1], keep = u1 ? b2[1] : b2[0]; mine = keep + __shfl_xor(send, 2); }
          mine += __shfl_xor(mine, 1); }
        const int eidx = lane >> 1;
        mine += p.router_b[eidx];
        LAS float* lg = (LAS float*)(lds + 131072 + 8192) + wave * 48;
        if (!(lane & 1)) lg[eidx] = mine;
        asm volatile("s_waitcnt lgkmcnt(0)" ::: "memory");
        int rank = 0;
#pragma unroll
        for (int q = 0; q < 8; ++q) { const f32x4 o4 = *(const LAS f32x4*)(lg + 4 * q);
#pragma unroll
            for (int i = 0; i < 4; ++i) { const int oe = 4 * q + i; rank += (o4[i] > mine || (o4[i] == mine && oe < eidx)) ? 1 : 0; } }
        if (!(lane & 1) && rank < 4) { lg[32 + rank] = mine; ((LAS int*)lg)[36 + rank] = eidx; }
        asm volatile("s_waitcnt lgkmcnt(0)" ::: "memory");
        if (lane == 0) {
            const f32x4 sv = *(const LAS f32x4*)(lg + 32); const int se0 = ((const LAS int*)lg)[36], se1 = ((const LAS int*)lg)[37], se2 = ((const LAS int*)lg)[38], se3 = ((const LAS int*)lg)[39];
            const float sel_v[4] = {sv[0], sv[1], sv[2], sv[3]}; const int sel_e[4] = {se0, se1, se2, se3};
            const float e1 = __expf(sel_v[1] - sel_v[0]), e2 = __expf(sel_v[2] - sel_v[0]), e3 = __expf(sel_v[3] - sel_v[0]); const float inv = 1.0f / (1.0f + e1 + e2 + e3);
            const float gk[4] = {inv, e1 * inv, e2 * inv, e3 * inv};
#pragma unroll
            for (int k = 0; k < 4; ++k) { const int a = (wave * 16 + it) * 4 + k; a_e[a] = sel_e[k]; a_p[a] = atomicAdd((int*)&hist[sel_e[k]], 1); a_g[a] = gk[k]; }
        }
        asm volatile("s_waitcnt lgkmcnt(0)" ::: "memory");
    }
    __syncthreads();
    if (tid < 32) basee[tid] = (int)atomicAdd(cnt + tid, (unsigned)hist[tid]);
    __syncthreads();
    {
        const int a = tid; const int e = a_e[a]; const int pos = basee[e] + a_p[a]; const int tok = grp * 128 + (a >> 2);
        list[(size_t)e * CAP + pos] = tok; lgate[(size_t)e * CAP + pos] = a_g[a]; asg[tok * 4 + (a & 3)] = e * CAP + pos;
    }
    __syncthreads();
}

__device__ __forceinline__ void moe_tables(const Params& p, LAS int* tb, LAS int* cn) {
    if (threadIdx.x < 64) {
        const int lane = threadIdx.x; const unsigned* cnt = (const unsigned*)(p.ws + WS_CTL) + CW_CNT;
        const int c = lane < 32 ? (int)__hip_atomic_load(cnt + lane, __ATOMIC_RELAXED, __HIP_MEMORY_SCOPE_AGENT) : 0; const int tiles = (c + 255) >> 8;
        int incl = tiles;
#pragma unroll
        for (int o = 1; o < 32; o <<= 1) { const int t = __shfl_up(incl, o); if (lane >= o) incl += t; }
        if (lane < 32) { cn[lane] = c; tb[lane] = incl - tiles; if (lane == 31) tb[32] = incl; } }
    __syncthreads();
    if (threadIdx.x < 32) { const int e = threadIdx.x; for (int rt = tb[e]; rt < tb[e + 1]; ++rt) tb[RT2E_OFF + rt] = e; }
    __syncthreads();
}

__device__ __forceinline__ void phase_final(const Params& p, const LAS int* tb, int G) {
    const int tid = otid(), lane = tid & 63, wave = __builtin_amdgcn_readfirstlane(tid >> 6);
    const int gw = blockIdx.x * 8 + wave, NGW = G * 8;
    const float* mod = (const float*)(p.ws + WS_MOD); const bf16_t* YS = (const bf16_t*)(p.ws + WS_YS); const int* asg = (const int*)(p.ws + WS_ASG);
    f32x4 gn[4];
#pragma unroll
    for (int j = 0; j < 4; ++j) gn[j] = *(const f32x4*)(p.final_g + 4 * lane + 256 * j);
    auto rowoff = [&](int a) -> size_t { const int e = a >> 15, pos = a & (CAP - 1); return (size_t)(tb[e] * 256 + pos) * 1024; };
    int a_n[4];
    const bf16_t* X1 = (const bf16_t*)(p.ws + WS_X1);
    u32x2 xn[4]; u32x2 yn[4][4];
    { const int m0 = gw, m1 = gw + NGW; int a0[4];
#pragma unroll
      for (int k = 0; k < 4; ++k) { a0[k] = asg[m0 * 4 + k]; a_n[k] = m1 < TL ? asg[m1 * 4 + k] : 0; }
#pragma unroll
      for (int j = 0; j < 4; ++j) { xn[j] = *(const u32x2*)(X1 + (size_t)m0 * 1024 + 4 * lane + 256 * j);
#pragma unroll
        for (int k = 0; k < 4; ++k) yn[k][j] = *(const u32x2*)(YS + rowoff(a0[k]) + 4 * lane + 256 * j); } }
    for (int m = gw; m < TL; m += NGW) {
        float* xr = p.out + (size_t)m * 1024; const float* g2 = mod + (size_t)(m >> 12) * 6144 + 5120;
        u32x2 xc[4]; u32x2 yc[4][4];
#pragma unroll
        for (int j = 0; j < 4; ++j) { xc[j] = xn[j];
#pragma unroll
            for (int k = 0; k < 4; ++k) yc[k][j] = yn[k][j]; }
        if (m + NGW < TL) { const int m1 = m + NGW, m2 = m + 2 * NGW; int a1[4];
#pragma unroll
            for (int k = 0; k < 4; ++k) { a1[k] = a_n[k]; a_n[k] = m2 < TL ? asg[m2 * 4 + k] : 0; }
#pragma unroll
            for (int j = 0; j < 4; ++j) { xn[j] = *(const u32x2*)(X1 + (size_t)m1 * 1024 + 4 * lane + 256 * j);
#pragma unroll
                for (int k = 0; k < 4; ++k) yn[k][j] = *(const u32x2*)(YS + rowoff(a1[k]) + 4 * lane + 256 * j); } }
        f32x4 v[4]; float ss = 0.f;
#pragma unroll
        for (int j = 0; j < 4; ++j) {
            f32x4 y = {0.f, 0.f, 0.f, 0.f};
#pragma unroll
            for (int k = 0; k < 4; ++k) { const u32x2 w = yc[k][j]; y[0] += bf_lo(w.x); y[1] += bf_hi(w.x); y[2] += bf_lo(w.y); y[3] += bf_hi(w.y); }
            v[j] = (f32x4){bf_lo(xc[j].x), bf_hi(xc[j].x), bf_lo(xc[j].y), bf_hi(xc[j].y)} + *(const f32x4*)(g2 + 4 * lane + 256 * j) * y;
            ss += (v[j][0] * v[j][0] + v[j][1] * v[j][1]) + (v[j][2] * v[j][2] + v[j][3] * v[j][3]);
        }
        const float rstd = rsqrtf(wave_sum(ss) * (1.0f / 1024.0f) + EPS);
#pragma unroll
        for (int j = 0; j < 4; ++j) *(f32x4*)(xr + 4 * lane + 256 * j) = v[j] * rstd * gn[j];
    }
}

__device__ __forceinline__ void phase_attn(const Params& p, LAS unsigned char* lds_, int G, bf16_t* BO, unsigned* ctr) {
    char* lds = (char*)(unsigned char*)lds_;
    volatile int* uslot = (volatile int*)(lds + att::SHM_ATTN);
    const float lam = *(const float*)(p.ws + WS_LAM);
    const int xcc = (int)(__builtin_amdgcn_s_getreg((3 << 11) | 20) & 7u);
    const bf16_t* DQ = (const bf16_t*)(p.ws + WS_DQ); const bf16_t* DK = (const bf16_t*)(p.ws + WS_DK); const bf16_t* DV = (const bf16_t*)(p.ws + WS_DV);
    int q = 0;
    for (;;) {
        const int xq = (xcc + q) & 7;
        __syncthreads();
        if (threadIdx.x == 0) uslot[0] = (int)atomicAdd(ctr + 16 * xq, 1u);
        __syncthreads();
        const int u = uslot[0];
        if (u >= 256) { if (++q == 8) break; continue; }
        const int bh = (u >> 5) * 8 + xq, qb = u & 31, b = bh >> 3, h = bh & 7;
        const size_t qoff = ((size_t)b * SEQ + qb * 128) * 1024 + h * 128, koff = (size_t)b * KVLEN * 1024 + h * 128;
        att::attn_unit2(DQ + qoff, DK + koff, DV + koff, BO + qoff, p.dnorm_g + h * 128, (const float*)(p.ws + WS_CTL) + CW_KMAX + b * 32 + h * 4, lam, KVLEN, lds);
    }
}


#define XB_TMO      128
#define XB_XCNT(j)  (256  + 64 * (j))
#define XB_XSUB(j)  (1280 + 64 * (j))
#define XB_XGEN(j)  (2304 + 64 * (j))
#define XB_TOP      3328
#define XB_TOPGEN   3392
#define XCD_BAR_WORDS 3456
#define XB_SPIN_CAP (1u << 22)
__device__ __forceinline__ unsigned xb_ld(unsigned* p)              { return __hip_atomic_load(p, __ATOMIC_RELAXED, __HIP_MEMORY_SCOPE_AGENT); }
__device__ __forceinline__ unsigned xb_add(unsigned* p, unsigned v) { return __hip_atomic_fetch_add(p, v, __ATOMIC_RELAXED, __HIP_MEMORY_SCOPE_AGENT); }
__device__ __forceinline__ unsigned xb_xcc_id() { return (unsigned)__builtin_amdgcn_s_getreg((3 << 11) | 20) & 0xFu; }
#define XB_SPIN(cond, bar) do { unsigned _sp = 0; while (cond) { __builtin_amdgcn_s_sleep(1); \
    if ((++_sp & 255u) == 0u) { if (xb_ld(&(bar)[XB_TMO])) break; if (_sp > XB_SPIN_CAP) { atomicAdd(&(bar)[XB_TMO], 1u); break; } } } } while (0)
struct XcdBarrier { unsigned* bar; unsigned x; volatile LAS unsigned* st; };
__device__ __forceinline__ XcdBarrier xcd_barrier_post(unsigned* bar, volatile LAS unsigned* st) {
    XcdBarrier b; b.bar = bar; b.x = xb_xcc_id(); b.st = st;
    if (threadIdx.x == 0) (void)xb_add(&bar[XB_XCNT(b.x)], 1u);
    return b;
}
__device__ __forceinline__ void xcd_barrier_complete(unsigned* bar, unsigned x, unsigned& nloc, unsigned& nx) {
    const unsigned G = gridDim.x * gridDim.y * gridDim.z;
    unsigned sum, cnt, mine, sp = 0u;
    for (;;) {
        sum = 0u; cnt = 0u; mine = 0u;
#pragma unroll
        for (unsigned j = 0; j < 16; ++j) { const unsigned c = xb_ld(&bar[XB_XCNT(j)]); sum += c; cnt += (c > 0u) ? 1u : 0u; mine = (j == x) ? c : mine; }
        if (sum == G) break;
        __builtin_amdgcn_s_sleep(1);
        if ((++sp & 255u) == 0u) { if (xb_ld(&bar[XB_TMO])) break; if (sp > XB_SPIN_CAP) { atomicAdd(&bar[XB_TMO], 1u); break; } }
    }
    nloc = mine > 0u ? mine : 1u; nx = cnt > 0u ? cnt : 1u;
}
__device__ __forceinline__ void xcd_barrier(const XcdBarrier& b) {
    asm volatile("s_waitcnt vmcnt(0)" ::: "memory");
    __syncthreads();
    if (threadIdx.x == 0) {
        unsigned* bar = b.bar;
        __builtin_amdgcn_s_waitcnt(0);
        unsigned nloc = b.st[0], nx = b.st[1];
        if (nloc == 0u) { xcd_barrier_complete(bar, b.x, nloc, nx); b.st[0] = nloc; b.st[1] = nx; }
        const unsigned k = b.st[2];
        const unsigned old = xb_add(&bar[XB_XSUB(b.x)], 1u);
        if (old + 1u == (k + 1u) * nloc) {
            __builtin_amdgcn_fence(__ATOMIC_RELEASE, "agent");
            asm volatile("s_waitcnt vmcnt(0)" ::: "memory");
            const unsigned og = xb_add(&bar[XB_TOP], 1u);
            if (og + 1u == (k + 1u) * nx) xb_add(&bar[XB_TOPGEN], 1u);
        }
        XB_SPIN(xb_ld(&bar[XB_TOPGEN]) < k + 1u, bar);
        __builtin_amdgcn_fence(__ATOMIC_ACQUIRE, "agent");
        asm volatile("s_waitcnt vmcnt(0)" ::: "memory");
        b.st[2] = k + 1u;
    }
    __syncthreads();
}


#define FP8_SELFTEST 0
#if FP8_SELFTEST
typedef int v8i __attribute__((ext_vector_type(8)));
__device__ __forceinline__ int fp8_selftest(int lane) {
    const int i = lane & 15, kb = lane >> 4;
    v8i A, B;
#pragma unroll
    for (int d = 0; d < 8; ++d) {
        float av[4], bv[4];
#pragma unroll
        for (int t = 0; t < 4; ++t) { const int k = 32 * kb + 4 * d + t; av[t] = (float)(((i * 7 + k * 3) % 5) - 2); bv[t] = (float)(((k * 5 + i) % 7) - 3); }
        int wa = 0, wb = 0;
        wa = __builtin_amdgcn_cvt_pk_fp8_f32(av[0], av[1], wa, false); wa = __builtin_amdgcn_cvt_pk_fp8_f32(av[2], av[3], wa, true);
        wb = __builtin_amdgcn_cvt_pk_fp8_f32(bv[0], bv[1], wb, false); wb = __builtin_amdgcn_cvt_pk_fp8_f32(bv[2], bv[3], wb, true);
        A[d] = wa; B[d] = wb;
    }
    f32x4 C = {0.f, 0.f, 0.f, 0.f}, C2 = {0.f, 0.f, 0.f, 0.f};
    C = __builtin_amdgcn_mfma_scale_f32_16x16x128_f8f6f4(A, B, C, 0, 0, 0, 0x7f7f7f7f, 0, 0x7f7f7f7f);
    C2 = __builtin_amdgcn_mfma_scale_f32_16x16x128_f8f6f4(A, B, C2, 0, 0, 0, 0x79797979, 0, 0x7f7f7f7f);
    bool ok = true;
#pragma unroll
    for (int r = 0; r < 4; ++r) { const int row = 4 * kb + r, col = i; float ref = 0.f;
        for (int k = 0; k < 128; ++k) ref += (float)(((row * 7 + k * 3) % 5) - 2) * (float)(((k * 5 + col) % 7) - 3);
        ok = ok && (C[r] == ref) && (C2[r] == ref * 0.015625f); }
    return __all(ok) ? 1 : 0;
}
#endif

__global__ void __launch_bounds__(NTHREADS, 2) fwd_megakernel(Params p) {
    extern __shared__ __attribute__((aligned(16))) unsigned char smem[];
    LAS unsigned char* lds = (LAS unsigned char*)smem;
    cg::grid_group grid = cg::this_grid();
    const int G = gridDim.x, c = blockIdx.x;
    unsigned char* ws = p.ws;
    volatile LAS unsigned* bst = (volatile LAS unsigned*)(lds + LDS_BYTES - 64);
    if (threadIdx.x < 16) bst[threadIdx.x] = 0u;
    __syncthreads();
    const XcdBarrier xbar = xcd_barrier_post((unsigned*)(ws + WS_CTL) + CW_BAR, bst);
#define GSYNC() xcd_barrier(xbar)

#ifndef PH_MASK
#define PH_MASK 0xFFFF
#endif
#define PH(k) if constexpr (((PH_MASK) >> (k)) & 1)
#ifndef REP_MASK
#define REP_MASK 0
#endif
#define REP(k) for (int rep_ = 0; rep_ < ((((REP_MASK) >> (k)) & 1) ? 2 : 1); ++rep_)
    PH(0) REP(0) { phase_prep(p, lds, G); __syncthreads(); }
    grid.sync();
    PH(1) phase_rows1(p, lds, G);
    GSYNC();
    PH(2) REP(2) {
        SchedIn S{(const char*)(ws + WS_U), (const char*)(ws + WS_WIN), G, c};
        EpiIn E{ws, (const float*)(ws + WS_ROPE), (const float*)(ws + WS_ROPE) + 1024};
        pg8::gemm_phase<EpiIn, SchedIn, false, true>(lds, S, E, 0);
    }
    GSYNC();
#ifdef MLSTM_NAIVE
    PH(3) for (int item = c; item < 128; item += G) phase_mlstm_naive(p, lds, item);
#else
    const bool fuse_mf = (G >= 128) && !((REP_MASK >> 3) & 1);
    PH(3) REP(3) for (int it = c; it < 128; it += G) {
        const int x = it & 7, j = it >> 3; const int bh = x * 4 + (j >> 2); mls2::mlstm_item(p, lds, (bh << 2) | (j & 3));
        if (fuse_mf) {
            unsigned* done = (unsigned*)(ws + WS_CTL) + CW_MF + bh;
            asm volatile("s_waitcnt vmcnt(0)" ::: "memory"); __syncthreads();
            if (threadIdx.x == 0) {
                __builtin_amdgcn_fence(__ATOMIC_RELEASE, "agent"); asm volatile("s_waitcnt vmcnt(0)" ::: "memory");
                __hip_atomic_fetch_add(done, 1u, __ATOMIC_RELAXED, __HIP_MEMORY_SCOPE_AGENT);
                unsigned sp = 0; while (__hip_atomic_load(done, __ATOMIC_RELAXED, __HIP_MEMORY_SCOPE_AGENT) < 4u) { __builtin_amdgcn_s_sleep(8); if (++sp > (1u << 24)) break; }
                __builtin_amdgcn_fence(__ATOMIC_ACQUIRE, "agent"); asm volatile("s_waitcnt vmcnt(0)" ::: "memory");
            }
            __syncthreads();
            mfinal_part(p, bh >> 2, bh & 3, j & 3);
        }
    }
#endif
    if (G >= 160 && c >= 128 && c < 160) { t8_dynamic(p, lds, (unsigned*)(ws + WS_CTL) + 41, 256, T8_ITEMS); sq_transposes(p, lds, (c - 128) * 8 + __builtin_amdgcn_readfirstlane(threadIdx.x >> 6), 256); }
    if constexpr ((REP_MASK >> 4) & 1) { phase_attn(p, lds, G, (bf16_t*)(ws + WS_END), (unsigned*)(ws + WS_CTL) + CW_ATT + 512); }
    PH(4) phase_attn(p, lds, G, (bf16_t*)(ws + WS_BO), (unsigned*)(ws + WS_CTL) + CW_ATT);
    GSYNC();
    if (!fuse_mf) { PH(5) phase_mfinal(p, G); GSYNC(); }
    PH(6) REP(6) {
        SchedMerge2 S{(const char*)(ws + WS_AO), (const char*)(ws + WS_WA), (const char*)(ws + WS_BO), (const char*)(ws + WS_WB), 128, 4, G, c};
        EpiMerge2 E{(const bf16_t*)(ws + WS_GA), (const bf16_t*)(ws + WS_GB), (bf16_t*)(ws + WS_T), (bf16_t*)(ws + WS_Y)};
        pg8::gemm_phase<EpiMerge2, SchedMerge2, false>(lds, S, E);
    }
    GSYNC();
    PH(8) REP(8) {
        SchedStatic S{(const char*)(ws + WS_Y), (const char*)(ws + WS_WO), 128, 4, G, c};
        EpiOut E{p.x, (const float*)(ws + WS_MOD), (bf16_t*)(ws + WS_X1)};
        pg8::gemm_phase<EpiOut, SchedStatic, false>(lds, S, E);
    }
    GSYNC();
    PH(9) for (int grp = c; grp < 256; grp += G) phase_rows2(p, lds, grp);
    GSYNC();
    LAS int* tb = (LAS int*)(lds + 131072); LAS int* cn = tb + 64;
    moe_tables(p, tb, cn);
    PH(10) REP(10) {
        SchedMoe1 S{(const char*)(ws + WS_U2), (const char*)(ws + WS_W1), (const int*)(ws + WS_LIST), tb, cn, G, c};
        EpiMoe1 E{ws + WS_ACT, p.exp_b1};
        pg8::gemm_phase<EpiMoe1, SchedMoe1, true, true>(lds, S, E);
    }
    GSYNC();
    PH(11) REP(11) {
        SchedMoe2 S{(const char*)(ws + WS_ACT), (const char*)(ws + WS_W2), tb, G, c};
        EpiMoe2 E{(bf16_t*)(ws + WS_YS), p.exp_b2, (const float*)(ws + WS_LGATE), cn};
        pg8::gemm_phase<EpiMoe2, SchedMoe2, false, true>(lds, S, E);
    }
    GSYNC();
    PH(12) phase_final(p, tb, G);
#if FP8_SELFTEST
    if (blockIdx.x == 0 && threadIdx.x < 64) { const int okf = fp8_selftest(threadIdx.x); VM_WAIT(); if (!okf && threadIdx.x == 0) p.out[0] = __builtin_nanf(""); }
#endif
}

extern "C" void kernel_launch(void* const* d_in, const int* in_sizes, int n_in, void* d_out, int out_size, void* d_ws, size_t ws_size, hipStream_t stream) {
    static int grid = 0;
    if (grid == 0) {
        if (n_in != 23 || out_size != TL * D || ws_size < WS_END) { fprintf(stderr, "kernel_launch: unexpected shapes: n_in %d out %d ws %zu (need %zu)\n", n_in, out_size, ws_size, (size_t)WS_END); grid = -1; return; }
        int dev = 0, cus = 0, per_cu = 0;
        (void)hipGetDevice(&dev); (void)hipDeviceGetAttribute(&cus, hipDeviceAttributeMultiprocessorCount, dev);
        if (hipFuncSetAttribute((const void*)fwd_megakernel, hipFuncAttributeMaxDynamicSharedMemorySize, LDS_BYTES) != hipSuccess) { fprintf(stderr, "kernel_launch: hipFuncSetAttribute failed\n"); grid = -1; return; }
        if (hipOccupancyMaxActiveBlocksPerMultiprocessor(&per_cu, (const void*)fwd_megakernel, NTHREADS, LDS_BYTES) != hipSuccess || per_cu < 1) { fprintf(stderr, "kernel_launch: occupancy query says %d\n", per_cu); per_cu = 1; }
        (void)hipGetLastError();
        grid = cus;
        if (grid > 256) grid = 256;
    }
    if (grid < 0) return;
    (void)hipMemsetAsync((char*)d_ws + WS_CTL, 0, 32768, stream);
    Params p{};
    const float** pp = (const float**)&p;
    for (int i = 0; i < 23; ++i) pp[i] = (const float*)d_in[i];
    p.out = (float*)d_out; p.ws = (unsigned char*)d_ws;
    void* args[] = {&p};
    hipError_t e = hipLaunchCooperativeKernel((const void*)fwd_megakernel, dim3(grid), dim3(NTHREADS), args, LDS_BYTES, stream);
    if (e != hipSuccess) fprintf(stderr, "cooperative launch failed: %s (grid %d)\n", hipGetErrorString(e), grid);
}
```

```cpp
#include <hip/hip_runtime.h>
#include <hip/hip_cooperative_groups.h>
#include <cstdio>
#include <cstdint>
namespace cg = cooperative_groups;

#define LAS __attribute__((address_space(3)))
typedef unsigned short bf16_t;
typedef short bf16x8 __attribute__((ext_vector_type(8)));
typedef short s16x4 __attribute__((ext_vector_type(4)));
typedef float f32x4 __attribute__((ext_vector_type(4)));
typedef float f32x8 __attribute__((ext_vector_type(8)));
typedef float f32x16 __attribute__((ext_vector_type(16)));
typedef unsigned u32x4 __attribute__((ext_vector_type(4)));
typedef unsigned u32x2 __attribute__((ext_vector_type(2)));

constexpr int D = 1024, BATCH = 8, SEQ = 4096, CTX = 256;
constexpr int TL = BATCH * SEQ, TC = BATCH * CTX, TT = TL + TC;
constexpr int KVLEN = CTX + SEQ;
constexpr int NEXP = 32, CAP = 32768, ACT_ROWS = 139264;
constexpr int INCOLS = 8208;
constexpr float EPS = 1e-6f;
constexpr float LAM_INIT = 0.2f;

constexpr size_t MiB = 1u << 20;
constexpr size_t WS_CTL = 0;
constexpr size_t WS_MOD = 1 * MiB;
constexpr size_t WS_ROPE = 1 * MiB + 256 * 1024;
constexpr size_t WS_LAM = 1 * MiB + 300 * 1024;
constexpr size_t WS_GT = 2 * MiB;
constexpr size_t WS_ASG = 5 * MiB;
constexpr size_t WS_LIST = 6 * MiB;
constexpr size_t WS_LGATE = 10 * MiB;
constexpr size_t WS_WIN = 16 * MiB;
constexpr size_t WS_WA = 32 * MiB, WS_WB = 34 * MiB, WS_WO = 36 * MiB;
constexpr size_t WS_W1 = 40 * MiB;
constexpr size_t WS_W2 = 168 * MiB;
constexpr size_t WS_U = 232 * MiB;
constexpr size_t WS_MQ = 300 * MiB;
constexpr size_t WS_MK = 332 * MiB;
constexpr size_t WS_MV = 366 * MiB;
constexpr size_t WS_MO = 434 * MiB;
constexpr size_t WS_HB = 498 * MiB;
constexpr size_t WS_DQ = 562 * MiB;
constexpr size_t WS_DK = 626 * MiB;
constexpr size_t WS_DV = 694 * MiB;
constexpr size_t WS_GA = 762 * MiB;
constexpr size_t WS_GB = 826 * MiB;
constexpr size_t WS_END = 890 * MiB;
constexpr size_t WS_HF = WS_U, WS_AO = WS_U, WS_BO = WS_DQ, WS_T = WS_MV, WS_Y = WS_MO, WS_U2 = 370 * MiB, WS_X1 = WS_GA, WS_XS = WS_U, WS_ACT = WS_DQ, WS_YS = WS_U;
static_assert(WS_ACT + (size_t)ACT_ROWS * 2048 <= WS_END, "ACT fits");
static_assert(WS_YS + (size_t)ACT_ROWS * 2048 <= WS_DQ, "YS fits");

constexpr int CW_CNT = 0, CW_ATT = 64, CW_KMAX = 256, CW_MF = 800, CW_BAR = 1024;
constexpr int LDS_BYTES = 147456;
constexpr int NTHREADS = 512;

struct Params {
    const float *x, *c, *ctx, *c_ctx, *ada_w, *ada_b, *norm1_g, *norm2_g, *w_in, *gate_b, *mnorm_g, *dlam, *dnorm_g, *w_a, *w_b, *w_o, *router_w, *router_b,
        *exp_w1, *exp_b1, *exp_w2, *exp_b2, *final_g;
    float* out;
    unsigned char* ws;
};

#define LDS_WAIT() asm volatile("s_waitcnt lgkmcnt(0)" ::: "memory")
#define VM_WAIT() asm volatile("s_waitcnt vmcnt(0)" ::: "memory")
typedef float f32x2_t __attribute__((ext_vector_type(2))); typedef __bf16 bf16x2_t __attribute__((ext_vector_type(2)));
__device__ __forceinline__ unsigned cvt_pk_bf16(float lo, float hi) { f32x2_t v = {lo, hi}; bf16x2_t b = __builtin_convertvector(v, bf16x2_t); return __builtin_bit_cast(unsigned, b); }
__device__ __forceinline__ unsigned pk4_fp8(float a, float b, float c, float d) { int w = 0; w = __builtin_amdgcn_cvt_pk_fp8_f32(a, b, w, false); w = __builtin_amdgcn_cvt_pk_fp8_f32(c, d, w, true); return (unsigned)w; }
__device__ __forceinline__ float bf_lo(unsigned w) { return __uint_as_float(w << 16); }
__device__ __forceinline__ float bf_hi(unsigned w) { return __uint_as_float(w & 0xffff0000u); }
__device__ __forceinline__ float bf2f(bf16_t b) { return __uint_as_float(((unsigned)b) << 16); }
__device__ __forceinline__ float wave_sum(float v) {
#pragma unroll
    for (int o = 1; o < 64; o <<= 1) v += __shfl_xor(v, o);
    return v;
}
__device__ __forceinline__ float sigmoidf_(float x) { return __builtin_amdgcn_rcpf(1.0f + __expf(-x)); }
__device__ __forceinline__ int otid() { unsigned ones = ~0u; asm volatile("" : "+s"(ones));
    const int lane = __builtin_amdgcn_mbcnt_hi(ones, __builtin_amdgcn_mbcnt_lo(ones, 0u)); int t = __builtin_amdgcn_readfirstlane(threadIdx.x >> 6) * 64 + lane; asm volatile("" : "+v"(t)); return t; }

namespace pg8 {
constexpr int BM = 256, BK = 64, HALF = 128, HTB = HALF * BK * 2, STAGE_BYTES = 8 * HTB, KD = 1024;
__host__ __device__ __forceinline__ int lds_byte(int r, int c) { const int st = (r >> 4) * 2 + (c >> 5), rr = r & 15, cc = c & 31, ob = rr * 64 + cc * 2; return st * 1024 + (ob ^ (((ob >> 9) & 1) << 5)); }
__host__ __device__ __forceinline__ void stage_rc(int b, int& R, int& C) { const int st = b / 1024, sb = b % 1024, swz = sb ^ (((sb >> 9) & 1) << 5); R = (st >> 1) * 16 + swz / 64; C = (st & 1) * 32 + (swz % 64) / 2; }

struct Unit { const char* A; const char* B; int row0; int pn; int aux; int aux2; };

__device__ __forceinline__ void tile_map(int L, int nM, int nN, int& pm, int& pn) {
    const int nwg = nM * nN; int wgid = L; { const int q = nwg / 8, r = nwg % 8, xcd = wgid % 8, off = wgid / 8; wgid = (xcd < r ? xcd * (q + 1) : r * (q + 1) + (xcd - r) * q) + off; }
    const int nig = 8 * nN, gid = wgid / nig, fm = gid * 8, gsz = (nM - fm) < 8 ? (nM - fm) : 8;
    pm = fm + ((wgid % nig) % gsz); pn = (wgid % nig) / gsz;
}

typedef int v8i_t __attribute__((ext_vector_type(8)));
typedef int v8i_a16 __attribute__((ext_vector_type(8), aligned(16)));
template <class Epi, class Sched, bool GATHER, bool FP8 = false>
__device__ __forceinline__ void gemm_phase(LAS unsigned char* lds, const Sched& S, const Epi& E, int stagger_ticks = 0) {
    const int tid = otid(), wid = __builtin_amdgcn_readfirstlane(tid >> 6), lane = tid & 63, wr = wid >> 2, wc = wid & 3, fr = lane & 15, fq = lane >> 4;
    constexpr int K = FP8 ? KD / 2 : KD, nt = K / BK;
    unsigned voffB[2], voffA0[2], voffA1[2], nvA0[2], nvA1[2];
#pragma unroll
    for (int i = 0; i < 2; ++i) { int R, C; stage_rc(tid * 16 + i * 8192, R, C);
        voffB[i] = (unsigned)(R * K + C) * 2u; voffA0[i] = voffB[i]; voffA1[i] = voffB[i] + (unsigned)HALF * K * 2u; nvA0[i] = voffA0[i]; nvA1[i] = voffA1[i]; }
    const size_t kstep = (size_t)(BK * 2);
    const size_t hstep = (size_t)HALF * K * 2;
    const unsigned ldsw = (unsigned)wid * 1024u;
    const int aoff = lds_byte(wr * 64 + fr, fq * 8);
    const int boff = lds_byte(wc * 32 + fr, fq * 8);
#define PG8_SA(b, h) (((b) * 2 + (h)) * HTB)
#define PG8_SB(b, h) ((4 + (b) * 2 + (h)) * HTB)
#define PG8_STAGE(bufoff, gbase, voff) do { _Pragma("unroll") for (int _i = 0; _i < 2; ++_i) { unsigned _v = (voff)[_i]; asm volatile("" : "+v"(_v));   \
        __builtin_amdgcn_global_load_lds((const unsigned*)((const char*)(gbase) + _v), (LAS unsigned*)(lds + (bufoff) + ldsw + _i * 8192), 16, 0, 0); } } while (0)
#define PG8_LDA(dst, b, h) do { if constexpr (FP8) { _Pragma("unroll") for (int m = 0; m < 4; ++m) { const u32x4 lo_ = *(const LAS u32x4*)(lds + PG8_SA(b, h) + aoff + m * 2048), hi_ = *(const LAS u32x4*)(lds + PG8_SA(b, h) + aoff + m * 2048 + 1024); dst##8[m] = (v8i_t){(int)lo_.x, (int)lo_.y, (int)lo_.z, (int)lo_.w, (int)hi_.x, (int)hi_.y, (int)hi_.z, (int)hi_.w}; } } \
        else { _Pragma("unroll") for (int m = 0; m < 4; ++m) _Pragma("unroll") for (int k = 0; k < 2; ++k) dst[m][k] = *(const LAS bf16x8*)(lds + PG8_SA(b, h) + aoff + m * 2048 + k * 1024); } } while (0)
#define PG8_LDB(dst, b, h) do { if constexpr (FP8) { _Pragma("unroll") for (int n = 0; n < 2; ++n) { const u32x4 lo_ = *(const LAS u32x4*)(lds + PG8_SB(b, h) + boff + n * 2048), hi_ = *(const LAS u32x4*)(lds + PG8_SB(b, h) + boff + n * 2048 + 1024); dst##8[n] = (v8i_t){(int)lo_.x, (int)lo_.y, (int)lo_.z, (int)lo_.w, (int)hi_.x, (int)hi_.y, (int)hi_.z, (int)hi_.w}; } } \
        else { _Pragma("unroll") for (int n = 0; n < 2; ++n) _Pragma("unroll") for (int k = 0; k < 2; ++k) dst[n][k] = *(const LAS bf16x8*)(lds + PG8_SB(b, h) + boff + n * 2048 + k * 1024); } } while (0)
#define PG8_MMA(ai, bj, At, Bt) do { __builtin_amdgcn_s_setprio(1); _Pragma("unroll") for (int m = 0; m < 4; ++m) _Pragma("unroll") for (int n = 0; n < 2; ++n) { \
        if constexpr (FP8) { asm volatile("v_mfma_f32_16x16x128_f8f6f4 %0, %1, %2, %0" : "+v"(acc[ai][bj][m][n]) : "v"(Bt##8[n]), "v"(At##8[m])); } \
        else { _Pragma("unroll") for (int k = 0; k < 2; ++k) acc[ai][bj][m][n] = __builtin_amdgcn_mfma_f32_16x16x32_bf16(Bt[n][k], At[m][k], acc[ai][bj][m][n], 0, 0, 0); } } \
        __builtin_amdgcn_s_setprio(0); } while (0)
#define PG8_ST1(bufoff, gbase, voff, i) do { unsigned _v = (voff)[i]; asm volatile("" : "+v"(_v)); \
        __builtin_amdgcn_global_load_lds((const unsigned*)((const char*)(gbase) + _v), (LAS unsigned*)(lds + (bufoff) + ldsw + (i) * 8192), 16, 0, 0); } while (0)
#define PG8_MM1(ai, bj, At, Bt, m) do { _Pragma("unroll") for (int n = 0; n < 2; ++n) { \
        if constexpr (FP8) { asm volatile("v_mfma_f32_16x16x128_f8f6f4 %0, %1, %2, %0" : "+v"(acc[ai][bj][m][n]) : "v"(Bt##8[n]), "v"(At##8[m])); } \
        else { _Pragma("unroll") for (int k = 0; k < 2; ++k) acc[ai][bj][m][n] = __builtin_amdgcn_mfma_f32_16x16x32_bf16(Bt[n][k], At[m][k], acc[ai][bj][m][n], 0, 0, 0); } } } while (0)
#define PG8_MMAS(ai, bj, At, Bt, S0, S1, S2, S3) do { __builtin_amdgcn_s_setprio(1); \
        PG8_MM1(ai, bj, At, Bt, 0); PG8_SCHED; S0; PG8_SCHED; PG8_MM1(ai, bj, At, Bt, 1); PG8_SCHED; S1; PG8_SCHED; \
        PG8_MM1(ai, bj, At, Bt, 2); PG8_SCHED; S2; PG8_SCHED; PG8_MM1(ai, bj, At, Bt, 3); PG8_SCHED; S3; PG8_SCHED; \
        __builtin_amdgcn_s_setprio(0); } while (0)
#define PG8_WAIT_V(n) asm volatile("s_waitcnt vmcnt(" #n ")" ::: "memory")
#define PG8_WAIT_L(n) asm volatile("s_waitcnt lgkmcnt(" #n ")" ::: "memory")
#define PG8_BAR __builtin_amdgcn_s_barrier()
#define PG8_SCHED __builtin_amdgcn_sched_barrier(0)
    Unit cur, nxt; int ui = 0;
    if (!S.next(0, cur)) return;
    if (stagger_ticks > 0) {
        const unsigned long long t0 = __builtin_amdgcn_s_memrealtime(); const unsigned long long d = (unsigned long long)((blockIdx.x >> 3) & 7) * (unsigned)stagger_ticks;
        while (__builtin_amdgcn_s_memrealtime() - t0 < d) __builtin_amdgcn_s_sleep(8);
    }
    if constexpr (GATHER) { S.offsets(cur, tid, voffA0, voffA1); }
    f32x4 acc[2][2][4][2];
#pragma unroll
    for (int a = 0; a < 2; ++a)
#pragma unroll
        for (int b = 0; b < 2; ++b)
#pragma unroll
            for (int m = 0; m < 4; ++m)
#pragma unroll
                for (int n = 0; n < 2; ++n) acc[a][b][m][n] = (f32x4){0.f, 0.f, 0.f, 0.f};
    bf16x8 At[4][2], B0[2][2], B1[2][2]; v8i_t At8[4], B08[2], B18[2];
    const char* cA = cur.A; const char* cB = cur.B;
    PG8_STAGE(PG8_SB(0, 0), cB, voffB); PG8_STAGE(PG8_SB(0, 1), cB + hstep, voffB); PG8_STAGE(PG8_SA(0, 0), cA, voffA0); PG8_STAGE(PG8_SA(0, 1), cA, voffA1);
    if (wr == 1) PG8_BAR;
    PG8_WAIT_V(2); PG8_BAR;
    PG8_STAGE(PG8_SB(1, 0), cB + kstep, voffB); PG8_STAGE(PG8_SA(1, 0), cA + kstep, voffA0); PG8_STAGE(PG8_SB(1, 1), cB + hstep + kstep, voffB);
    PG8_WAIT_V(0); PG8_BAR;
    for (;;) {
        const bool has_next = S.next(ui + 1, nxt);
        const char* nA = has_next ? nxt.A : cA; const char* nB = has_next ? nxt.B : cB;
#pragma unroll 1
        for (int t = 0; t < nt; t += 2) {
            const bool last = (t == nt - 2);
            if constexpr (GATHER) { if (t == nt - 4 && has_next) { const int tq = otid(); S.offsets(nxt, tq, nvA0, nvA1); } }
            const char* a1 = cA + (size_t)(t + 1) * kstep;
            const char* a2 = last ? nA : cA + (size_t)(t + 2) * kstep; const char* b2 = last ? nB : cB + (size_t)(t + 2) * kstep;
            const char* a3 = a2 + kstep; const char* b3 = b2 + kstep;
            unsigned w0[2], w1[2];
            if constexpr (GATHER) { w0[0] = voffA0[0]; w0[1] = voffA0[1]; w1[0] = voffA1[0]; w1[1] = voffA1[1];
                if (last && has_next) { w0[0] = nvA0[0]; w0[1] = nvA0[1]; w1[0] = nvA1[0]; w1[1] = nvA1[1]; } }
            else { w0[0] = voffA0[0]; w0[1] = voffA0[1]; w1[0] = voffA1[0]; w1[1] = voffA1[1]; }
            PG8_LDB(B0, 0, 0); PG8_LDB(B1, 0, 1); PG8_SCHED; PG8_LDA(At, 0, 0);
            if (t != 0) PG8_WAIT_V(6);
            PG8_WAIT_L(0); PG8_BAR;
            PG8_MMAS(0, 0, At, B0, PG8_ST1(PG8_SA(1, 1), a1, voffA1, 0), (void)0, PG8_ST1(PG8_SA(1, 1), a1, voffA1, 1), (void)0); PG8_MMAS(0, 1, At, B1, (void)0, (void)0, (void)0, (void)0); PG8_BAR; PG8_SCHED;
            PG8_LDA(At, 0, 1);
            if (t != 0) PG8_WAIT_V(2);
            PG8_WAIT_L(0); PG8_BAR;
            PG8_MMAS(1, 0, At, B0, PG8_ST1(PG8_SB(0, 0), b2, voffB, 0), PG8_ST1(PG8_SB(0, 0), b2, voffB, 1), PG8_ST1(PG8_SB(0, 1), b2 + hstep, voffB, 0), PG8_ST1(PG8_SB(0, 1), b2 + hstep, voffB, 1));
            PG8_MMAS(1, 1, At, B1, PG8_ST1(PG8_SA(0, 0), a2, w0, 0), PG8_ST1(PG8_SA(0, 0), a2, w0, 1), (void)0, (void)0); PG8_BAR; PG8_SCHED;
            PG8_LDB(B0, 1, 0); PG8_LDB(B1, 1, 1); PG8_SCHED; PG8_LDA(At, 1, 0);
            PG8_WAIT_V(6); PG8_WAIT_L(0); PG8_BAR;
            PG8_MMAS(0, 0, At, B0, PG8_ST1(PG8_SA(0, 1), a2, w1, 0), (void)0, PG8_ST1(PG8_SA(0, 1), a2, w1, 1), (void)0); PG8_MMAS(0, 1, At, B1, (void)0, (void)0, (void)0, (void)0); PG8_BAR; PG8_SCHED;
            PG8_LDA(At, 1, 1);
            PG8_WAIT_V(2); PG8_WAIT_L(0); PG8_BAR;
            PG8_MMAS(1, 0, At, B0, PG8_ST1(PG8_SB(1, 0), b3, voffB, 0), PG8_ST1(PG8_SB(1, 0), b3, voffB, 1), PG8_ST1(PG8_SB(1, 1), b3 + hstep, voffB, 0), PG8_ST1(PG8_SB(1, 1), b3 + hstep, voffB, 1));
            PG8_MMAS(1, 1, At, B1, PG8_ST1(PG8_SA(1, 0), a3, w0, 0), PG8_ST1(PG8_SA(1, 0), a3, w0, 1), (void)0, (void)0); PG8_BAR; PG8_SCHED;
        }
        PG8_WAIT_V(0);
        if (wr == 0) PG8_BAR;
        if constexpr (FP8) asm volatile("s_nop 15\n\ts_nop 7" ::: "memory");
        { const int t2_ = otid(); E(acc, cur, wr, wc, t2_ & 15, (t2_ & 63) >> 4); }
        if (!has_next) break;
#pragma unroll
        for (int a = 0; a < 2; ++a)
#pragma unroll
            for (int b = 0; b < 2; ++b)
#pragma unroll
                for (int m = 0; m < 4; ++m)
#pragma unroll
                    for (int n = 0; n < 2; ++n) acc[a][b][m][n] = (f32x4){0.f, 0.f, 0.f, 0.f};
        cur = nxt; cA = nA; cB = nB; ++ui;
        if constexpr (GATHER) { voffA0[0] = nvA0[0]; voffA0[1] = nvA0[1]; voffA1[0] = nvA1[0]; voffA1[1] = nvA1[1]; }
        if (wr == 1) PG8_BAR;
    }
    PG8_WAIT_V(0);
    PG8_BAR;
#undef PG8_SA
#undef PG8_SB
#undef PG8_STAGE
#undef PG8_ST1
#undef PG8_MM1
#undef PG8_MMAS
#undef PG8_LDA
#undef PG8_LDB
#undef PG8_MMA
#undef PG8_WAIT_V
#undef PG8_WAIT_L
#undef PG8_BAR
#undef PG8_SCHED
}
}

using pg8::Unit;
constexpr size_t TSTEP = (size_t)256 * 1024 * 2;

struct SchedIn {
    const char* A; const char* B; int G, c;
    __device__ __forceinline__ bool next(int i, Unit& u) const {
        const int L = i * G + c; int pm, pn;
        if (L < 4096) { pg8::tile_map(L, 128, 32, pm, pn); }
        else { const int j = L - 4096; if (j >= 112) return false; pm = 128 + (j & 7); const int cj = j >> 3; pn = cj < 2 ? 2 + cj : (cj < 6 ? 4 + (cj - 2) : 16 + (cj - 6)); }
        u.A = A + (size_t)pm * (TSTEP / 2); u.B = B + (size_t)pn * (TSTEP / 2); u.row0 = pm * 256; u.pn = pn; u.aux = 0; u.aux2 = 0; return true;
    }
};
__device__ __forceinline__ void xstore16(unsigned char* p, size_t rows8, const u32x4 X, const u32x4 Y, bool up) {
    u32x4 a, b;
#pragma unroll
    for (int i = 0; i < 4; ++i) { const unsigned send = up ? X[i] : Y[i]; const unsigned recv = (unsigned)__builtin_amdgcn_update_dpp(0, (int)send, 0x128, 0xf, 0xf, false);
        a[i] = up ? recv : X[i]; b[i] = up ? Y[i] : recv; }
    *(u32x4*)p = a; *(u32x4*)(p + rows8) = b;
}
struct EpiIn {
    unsigned char* ws; const float* ropec; const float* ropes;
    template <int MODE, bool PERMT, bool ISK>
    __device__ __forceinline__ void body(const f32x4 (&acc)[2][2][4][2], unsigned char* basep, unsigned rowbytes, unsigned off0, float sc, int trow, int wc, int fr, int fq, unsigned* kmaxp) const {
        float kmx[2] = {0.f, 0.f};
#pragma unroll
        for (int ai = 0; ai < 2; ++ai)
#pragma unroll
            for (int m = 0; m < 4; ++m) {
                const unsigned off = off0 + (unsigned)(ai * 128 + m * 16) * rowbytes;
                f32x4 cs, sn;
                if (MODE == 1) { const int t = (trow + ai * 128 + m * 16) & 4095; const int pos = (wc & 1) ? (t & 63) : (t >> 6); cs = *(const f32x4*)(ropec + pos * 16 + 4 * fq); sn = *(const f32x4*)(ropes + pos * 16 + 4 * fq); }
                u32x4 wq[2];
#pragma unroll
                for (int bj = 0; bj < 2; ++bj) {
                    f32x4 v0 = acc[ai][bj][m][0], v1 = acc[ai][bj][m][1];
                    if (MODE == 1) { const f32x4 a = v0 * cs - v1 * sn, b = v1 * cs + v0 * sn; v0 = a * sc; v1 = b * sc; }
                    else if (MODE == 2) {
#pragma unroll
                        for (int i = 0; i < 4; ++i) { v0[i] = __builtin_amdgcn_rcpf(1.0f + __builtin_amdgcn_exp2f(v0[i] * (-1.4426950408889634f * 0.015625f))); v1[i] = __builtin_amdgcn_rcpf(1.0f + __builtin_amdgcn_exp2f(v1[i] * (-1.4426950408889634f * 0.015625f))); }
                    } else { v0 = v0 * sc; v1 = v1 * sc; }
                    u32x2 w0, w1; w0.x = cvt_pk_bf16(v0[0], v0[1]); w0.y = cvt_pk_bf16(v0[2], v0[3]); w1.x = cvt_pk_bf16(v1[0], v1[1]); w1.y = cvt_pk_bf16(v1[2], v1[3]);
                    if (PERMT) { wq[bj].x = w0.x; wq[bj].y = w0.y; wq[bj].z = w1.x; wq[bj].w = w1.y; }
                    else { *(u32x2*)(basep + off + bj * 256) = w0; *(u32x2*)(basep + off + bj * 256 + 32) = w1; }
                    if (ISK) { float ss = (v0[0] * v0[0] + v0[1] * v0[1]) + (v0[2] * v0[2] + v0[3] * v0[3]) + (v1[0] * v1[0] + v1[1] * v1[1]) + (v1[2] * v1[2] + v1[3] * v1[3]);
                        ss += __shfl_xor(ss, 16); ss += __shfl_xor(ss, 32); kmx[bj] = fmaxf(kmx[bj], ss); }
                }
                if (PERMT) xstore16(basep + off, (size_t)8 * rowbytes, wq[0], wq[1], (fr & 8) != 0);
            }
        if (ISK) {
#pragma unroll
            for (int bj = 0; bj < 2; ++bj) { float m = kmx[bj]; m = fmaxf(m, __shfl_xor(m, 1)); m = fmaxf(m, __shfl_xor(m, 2)); m = fmaxf(m, __shfl_xor(m, 4)); m = fmaxf(m, __shfl_xor(m, 8));
                if (fr == 0 && fq == 0) atomicMax(kmaxp + bj * 4, __float_as_uint(sqrtf(m))); }
        }
    }
    __device__ __forceinline__ void operator()(const f32x4 (&acc)[2][2][4][2], const Unit& u, int wr, int wc, int fr, int fq) const {
        const int pn = u.pn, row0 = u.row0; const bool latent = row0 < TL;
        int kvrow0; if (latent) { const int b = row0 >> 12, t = row0 & 4095; kvrow0 = b * KVLEN + CTX + t; } else { const int cc = row0 - TL; kvrow0 = (cc >> 8) * KVLEN + (cc & 255); }
        size_t wsoff; unsigned rowbytes = 2048; int col0, drow0 = row0; float sc = 1.f;
        if (pn < 2)       { wsoff = WS_MQ; rowbytes = 1024; col0 = pn * 256;        sc = 0.08838834764831845f; }
        else if (pn < 4)  { wsoff = WS_MK; rowbytes = 1024; col0 = (pn - 2) * 256; }
        else if (pn < 8)  { wsoff = WS_MV; col0 = (pn - 4) * 256; }
        else if (pn < 12) { wsoff = WS_MO; col0 = (pn - 8) * 256; }
        else if (pn < 16) { wsoff = WS_DQ; col0 = (pn - 12) * 256; sc = 0.125f * 1.4426950408889634f; }
        else if (pn < 20) { wsoff = WS_DK; col0 = (pn - 16) * 256; drow0 = kvrow0; }
        else if (pn < 24) { wsoff = WS_DV; col0 = (pn - 20) * 256; drow0 = kvrow0; }
        else if (pn < 28) { wsoff = WS_GA; col0 = (pn - 24) * 256; }
        else              { wsoff = WS_GB; col0 = (pn - 28) * 256; }
        unsigned char* basep = ws + wsoff + (size_t)drow0 * rowbytes;
        const bool permt = !(pn >= 12 && pn < 20);
        const unsigned off0 = permt ? (unsigned)(wr * 64 + (fr & 7)) * rowbytes + (unsigned)(col0 + wc * 64 + ((fr & 8) ? 32 : 0) + 8 * fq) * 2u
                                    : (unsigned)(wr * 64 + fr) * rowbytes + (unsigned)(col0 + wc * 32 + 4 * fq) * 2u;
        const int kb = latent ? (row0 >> 12) : ((row0 - TL) >> 8);
        unsigned* kmaxp = (unsigned*)(ws + WS_CTL) + CW_KMAX + kb * 32 + ((col0 + wc * 32) >> 5);
        const int trow = row0 + wr * 64 + fr;
        sc *= 0.015625f;
        if (permt) { if (pn >= 24) body<2, true, false>(acc, basep, rowbytes, off0, sc, trow, wc, fr, fq, kmaxp); else body<0, true, false>(acc, basep, rowbytes, off0, sc, trow, wc, fr, fq, kmaxp); }
        else if (pn < 16) body<1, false, false>(acc, basep, rowbytes, off0, sc, trow, wc, fr, fq, kmaxp);
        else if (latent) body<1, false, true>(acc, basep, rowbytes, off0, sc, trow, wc, fr, fq, kmaxp);
        else body<0, false, true>(acc, basep, rowbytes, off0, sc, trow, wc, fr, fq, kmaxp);
    }
};

struct SchedStatic {
    const char* A; const char* B; int nM, nN, G, c;
    __device__ __forceinline__ bool next(int i, Unit& u) const {
        const int L = i * G + c; if (L >= nM * nN) return false; int pm, pn; pg8::tile_map(L, nM, nN, pm, pn);
        u.A = A + (size_t)pm * TSTEP; u.B = B + (size_t)pn * TSTEP; u.row0 = pm * 256; u.pn = pn; u.aux = 0; u.aux2 = 0; return true;
    }
};
template <int MODE> struct EpiMerge {
    const bf16_t* gate; const bf16_t* tin; bf16_t* outp;
    __device__ __forceinline__ void operator()(const f32x4 (&acc)[2][2][4][2], const Unit& u, int wr, int wc, int fr, int fq) const {
        const int cl = u.pn * 256 + wc * 64 + 8 * fq;
        const bool up = (fr & 8) != 0;
#pragma unroll
        for (int ai = 0; ai < 2; ++ai)
#pragma unroll
            for (int m = 0; m < 4; ++m) {
                const int rbase = u.row0 + ai * 128 + wr * 64 + m * 16;
                const size_t ro = (size_t)(rbase + fr) * 1024 + cl;
                u32x4 wq[2];
#pragma unroll
                for (int bj = 0; bj < 2; ++bj) {
                    const size_t o = ro + bj * 32;
                    const u32x4 g = *(const u32x4*)(gate + o);
                    f32x4 v0 = acc[ai][bj][m][0], v1 = acc[ai][bj][m][1];
                    v0[0] *= bf_lo(g.x); v0[1] *= bf_hi(g.x); v0[2] *= bf_lo(g.y); v0[3] *= bf_hi(g.y); v1[0] *= bf_lo(g.z); v1[1] *= bf_hi(g.z); v1[2] *= bf_lo(g.w); v1[3] *= bf_hi(g.w);
                    if (MODE == 1) { const u32x4 t = *(const u32x4*)(tin + o);
                        v0[0] += bf_lo(t.x); v0[1] += bf_hi(t.x); v0[2] += bf_lo(t.y); v0[3] += bf_hi(t.y); v1[0] += bf_lo(t.z); v1[1] += bf_hi(t.z); v1[2] += bf_lo(t.w); v1[3] += bf_hi(t.w); }
                    wq[bj].x = cvt_pk_bf16(v0[0], v0[1]); wq[bj].y = cvt_pk_bf16(v0[2], v0[3]); wq[bj].z = cvt_pk_bf16(v1[0], v1[1]); wq[bj].w = cvt_pk_bf16(v1[2], v1[3]);
                }
                xstore16((unsigned char*)(outp + (size_t)(rbase + (fr & 7)) * 1024 + cl + (up ? 32 : 0)), (size_t)8 * 2048, wq[0], wq[1], up);
            }
    }
};
struct SchedMerge2 {
    const char* A0; const char* B0; const char* A1; const char* B1; int nM, nN, G, c;
    __device__ __forceinline__ bool next(int i, Unit& u) const {
        const int L = (i >> 1) * G + c; if (L >= nM * nN) return false; int pm, pn; pg8::tile_map(L, nM, nN, pm, pn); const int h = i & 1;
        u.A = (h ? A1 : A0) + (size_t)pm * TSTEP; u.B = (h ? B1 : B0) + (size_t)pn * TSTEP; u.row0 = pm * 256; u.pn = pn; u.aux = h; u.aux2 = 0; return true;
    }
};
struct EpiMerge2 {
    const bf16_t* ga; const bf16_t* gb; bf16_t* t; bf16_t* y;
    __device__ __forceinline__ void operator()(const f32x4 (&acc)[2][2][4][2], const Unit& u, int wr, int wc, int fr, int fq) const {
        if (u.aux == 0) { EpiMerge<0> E{ga, nullptr, t}; E(acc, u, wr, wc, fr, fq); } else { EpiMerge<1> E{gb, t, y}; E(acc, u, wr, wc, fr, fq); }
    }
};
struct EpiOut {
    const float* x; const float* mod; bf16_t* x1;
    __device__ __forceinline__ void operator()(const f32x4 (&acc)[2][2][4][2], const Unit& u, int wr, int wc, int fr, int fq) const {
        const int cl = u.pn * 256 + wc * 64 + 8 * fq; const float* g1 = mod + (size_t)(u.row0 >> 12) * 6144 + 2048;
        const bool up = (fr & 8) != 0;
        f32x4 g0[2], g1v[2];
#pragma unroll
        for (int bj = 0; bj < 2; ++bj) { g0[bj] = *(const f32x4*)(g1 + cl + bj * 32); g1v[bj] = *(const f32x4*)(g1 + cl + bj * 32 + 4); }
#pragma unroll
        for (int ai = 0; ai < 2; ++ai)
#pragma unroll
            for (int m = 0; m < 4; ++m) {
                const int rbase = u.row0 + ai * 128 + wr * 64 + m * 16;
                u32x4 wq[2];
#pragma unroll
                for (int bj = 0; bj < 2; ++bj) {
                    const size_t o = (size_t)(rbase + fr) * 1024 + cl + bj * 32;
                    const f32x4 a = *(const f32x4*)(x + o) + g0[bj] * acc[ai][bj][m][0], c = *(const f32x4*)(x + o + 4) + g1v[bj] * acc[ai][bj][m][1];
                    wq[bj].x = cvt_pk_bf16(a[0], a[1]); wq[bj].y = cvt_pk_bf16(a[2], a[3]); wq[bj].z = cvt_pk_bf16(c[0], c[1]); wq[bj].w = cvt_pk_bf16(c[2], c[3]);
                }
                xstore16((unsigned char*)(x1 + (size_t)(rbase + (fr & 7)) * 1024 + cl + (up ? 32 : 0)), (size_t)8 * 2048, wq[0], wq[1], up);
            }
    }
};

constexpr int RT2E_OFF = (140288 - 131072) / 4;
struct SchedMoe1 {
    const char* U2; const char* W1; const int* list; const LAS int* tb; const LAS int* cnt; int G, c;
    __device__ __forceinline__ bool next(int i, Unit& u) const {
        const int L = i * G + c; const int xcd = L & 7, j = L >> 3; const int pn = j & 7, rt = (j >> 3) * 8 + xcd;
        const int NRT = __builtin_amdgcn_readfirstlane(tb[32]);
        if (rt >= NRT) return false;
        const int e = __builtin_amdgcn_readfirstlane(tb[RT2E_OFF + rt]);
        const int tbe = __builtin_amdgcn_readfirstlane(tb[e]);
        u.A = U2; u.B = W1 + ((size_t)e * 2048 + (size_t)pn * 256) * 1024; u.row0 = rt * 256; u.pn = pn; u.aux = e; u.aux2 = (rt - tbe) * 256; return true;
    }
    __device__ __forceinline__ void offsets(const Unit& u, int tid, unsigned (&o0)[2], unsigned (&o1)[2]) const {
        const int e = u.aux; const int n = __builtin_amdgcn_readfirstlane(cnt[e]) - u.aux2; const int* lp = list + (size_t)e * CAP + u.aux2;
#pragma unroll
        for (int i = 0; i < 2; ++i) {
            int R, C; pg8::stage_rc(tid * 16 + i * 8192, R, C);
            const int t0 = R < n ? lp[R] : 0, t1 = (128 + R) < n ? lp[128 + R] : 0;
            o0[i] = (unsigned)t0 * 1024u + (unsigned)C * 2u; o1[i] = (unsigned)t1 * 1024u + (unsigned)C * 2u;
        }
    }
};
struct EpiMoe1 {
    unsigned char* act; const float* b1;
    __device__ __forceinline__ void operator()(const f32x4 (&acc)[2][2][4][2], const Unit& u, int wr, int wc, int fr, int fq) const {
        if (u.aux < 0) return;
        const int cl = u.pn * 128 + wc * 32 + 8 * fq; const float* bb = b1 + (size_t)u.aux * 2048;
        f32x4 bg[2], bl[2];
#pragma unroll
        for (int n = 0; n < 2; ++n) { bg[n] = *(const f32x4*)(bb + cl + n * 4); bl[n] = *(const f32x4*)(bb + 1024 + cl + n * 4) + 1.0f; }
#pragma unroll
        for (int ai = 0; ai < 2; ++ai)
#pragma unroll
            for (int m = 0; m < 4; ++m) {
                f32x4 a[2];
#pragma unroll
                for (int n = 0; n < 2; ++n) { const f32x4 g = acc[ai][0][m][n] * 0.015625f + bg[n], l = acc[ai][1][m][n] * 0.015625f + bl[n];
#pragma unroll
                    for (int i = 0; i < 4; ++i) { const float gg = fminf(g[i], 7.0f), l1 = fminf(fmaxf(l[i], -6.0f), 8.0f);
                        a[n][i] = gg * __builtin_amdgcn_rcpf(1.0f + __builtin_amdgcn_exp2f(gg * (-1.702f * 1.4426950408889634f))) * l1; } }
                u32x2 w; w.x = pk4_fp8(a[0][0], a[0][1], a[0][2], a[0][3]); w.y = pk4_fp8(a[1][0], a[1][1], a[1][2], a[1][3]);
                *(u32x2*)(act + (size_t)(u.row0 + ai * 128 + wr * 64 + m * 16 + fr) * 1024 + cl) = w;
            }
    }
};
struct SchedMoe2 {
    const char* ACT; const char* W2; const LAS int* tb; int G, c;
    __device__ __forceinline__ bool next(int i, Unit& u) const {
        const int L = i * G + c; const int xcd = L & 7, j = L >> 3; const int pn = j & 3, rt = (j >> 2) * 8 + xcd;
        const int NRT = __builtin_amdgcn_readfirstlane(tb[32]);
        if (rt >= NRT) return false;
        const int e = __builtin_amdgcn_readfirstlane(tb[RT2E_OFF + rt]);
        const int tbe = __builtin_amdgcn_readfirstlane(tb[e]);
        u.A = ACT + (size_t)rt * (TSTEP / 2); u.B = W2 + ((size_t)e * 1024 + (size_t)pn * 256) * 1024; u.row0 = rt * 256; u.pn = pn; u.aux = e; u.aux2 = (rt - tbe) * 256; return true;
    }
};
struct EpiMoe2 {
    bf16_t* ys; const float* b2; const float* lgate; const LAS int* cnt;
    __device__ __forceinline__ void operator()(const f32x4 (&acc)[2][2][4][2], const Unit& u, int wr, int wc, int fr, int fq) const {
        if (u.aux < 0) return;
        const int cl = u.pn * 256 + wc * 64 + 8 * fq; const float* bb = b2 + (size_t)u.aux * 1024; const int n = __builtin_amdgcn_readfirstlane(cnt[u.aux]) - u.aux2; const float* gp = lgate + (size_t)u.aux * CAP + u.aux2;
        const bool up = (fr & 8) != 0;
        f32x4 bv[2][2];
#pragma unroll
        for (int bj = 0; bj < 2; ++bj)
#pragma unroll
            for (int nn = 0; nn < 2; ++nn) bv[bj][nn] = *(const f32x4*)(bb + cl + bj * 32 + nn * 4);
#pragma unroll
        for (int ai = 0; ai < 2; ++ai)
#pragma unroll
            for (int m = 0; m < 4; ++m) {
                const int rl = ai * 128 + wr * 64 + m * 16 + fr; const float gw = rl < n ? gp[rl] : 0.f;
                u32x4 wq[2];
#pragma unroll
                for (int bj = 0; bj < 2; ++bj) {
                    const f32x4 v0 = (acc[ai][bj][m][0] * 0.015625f + bv[bj][0]) * gw, v1 = (acc[ai][bj][m][1] * 0.015625f + bv[bj][1]) * gw;
                    wq[bj].x = cvt_pk_bf16(v0[0], v0[1]); wq[bj].y = cvt_pk_bf16(v0[2], v0[3]); wq[bj].z = cvt_pk_bf16(v1[0], v1[1]); wq[bj].w = cvt_pk_bf16(v1[2], v1[3]);
                }
                xstore16((unsigned char*)(ys + (size_t)(u.row0 + (rl & ~8)) * 1024 + cl + (up ? 32 : 0)), (size_t)8 * 2048, wq[0], wq[1], up);
            }
    }
};

namespace att {
constexpr int NW = 8, QBLK = 32, KVBLK = 64, LD = 1024;
constexpr float SCALE = 0.125f;
constexpr float THR = 8.f;
constexpr int SHM_V = KVBLK * 128 * 2, SHM_K = KVBLK * 128 * 2, SHM_ATTN = 4 * SHM_V + 4 * SHM_K + NW * 64 * 4;
#define KSWZ(row, colB) ((row) * 256 + ((colB) ^ (((row) & 15) << 4)))
#define SBAR() __builtin_amdgcn_sched_barrier(0)
__device__ __forceinline__ int crow(int r, int hi) { return (r & 3) + 8 * (r >> 2) + 4 * hi; }
__device__ __forceinline__ unsigned cvtpk(float lo, float hi) { return cvt_pk_bf16(lo, hi); }

__device__ __forceinline__ void finishSM(f32x16& p0, f32x16& p1, float& l_reg, bf16x8& pa0, bf16x8& pa1, bf16x8& pa2, bf16x8& pa3) {
#pragma unroll
  for (int r = 0; r < 16; ++r) { p0[r] = __builtin_amdgcn_exp2f(p0[r]); p1[r] = __builtin_amdgcn_exp2f(p1[r]); }
  float s0 = p0[0], s1 = p0[8], s2 = p1[0], s3 = p1[8];
#pragma unroll
  for (int r = 1; r < 8; ++r) { s0 += p0[r]; s1 += p0[8 + r]; s2 += p1[r]; s3 += p1[8 + r]; }
  l_reg += (s0 + s1) + (s2 + s3);
#define PK4(P, BASE, OUT) do { unsigned a0 = cvtpk(P[BASE + 0], P[BASE + 1]), a1 = cvtpk(P[BASE + 2], P[BASE + 3]);   \
    unsigned b0 = cvtpk(P[BASE + 4], P[BASE + 5]), b1 = cvtpk(P[BASE + 6], P[BASE + 7]);                              \
    auto r0 = __builtin_amdgcn_permlane32_swap(a0, b0, false, false); auto r1 = __builtin_amdgcn_permlane32_swap(a1, b1, false, false); \
    u32x4 w = {r0[0], r1[0], r0[1], r1[1]}; OUT = *reinterpret_cast<bf16x8*>(&w); } while (0)
  PK4(p0, 0, pa0); PK4(p0, 8, pa1); PK4(p1, 0, pa2); PK4(p1, 8, pa3);
#undef PK4
}
__device__ __forceinline__ void qkt(f32x16& p0, f32x16& p1, const bf16_t* Ks, const bf16x8* qr, int r32, int hi, int mp) {
  p0 = f32x16{}; p1 = f32x16{};
#pragma unroll
  for (int d0 = 0; d0 < 4; ++d0) { int cb = (mp * 64 + d0 * 16 + hi * 8) * 2;
    bf16x8 b0 = *reinterpret_cast<const bf16x8*>((const char*)Ks + KSWZ(r32, cb));
    bf16x8 b1 = *reinterpret_cast<const bf16x8*>((const char*)Ks + KSWZ(32 + r32, cb));
    p0 = __builtin_amdgcn_mfma_f32_32x32x16_bf16(b0, qr[d0], p0, 0, 0, 0);
    p1 = __builtin_amdgcn_mfma_f32_32x32x16_bf16(b1, qr[d0], p1, 0, 0, 0); }
}
__device__ __forceinline__ int v_st(int k, int c) { const int kk = (k & ~0xC) | ((k & 4) << 1) | ((k & 8) >> 1); return ((kk >> 3) * 4 + (c >> 5)) * 512 + ((kk & 7) * 32 + (c & 31)) * 2; }
__device__ __forceinline__ int v_rd_base(int lane) { return ((lane & 3) << 3) | (((lane >> 2) & 3) << 6) | (((lane >> 4) & 1) << 5) | (((lane >> 5) & 1) << 8); }
constexpr int v_rd_off(int d0, int ks, int half) { return d0 * 512 + ks * 4096 + half * 2048; }
__device__ __forceinline__ int v_rd_base2(int lane) { return ((lane & 3) << 3) | (((lane >> 2) & 3) << 6) | (((lane >> 4) & 1) << 5) | (((lane >> 5) & 1) << 11); }
constexpr int v_rd_off2(int d0, int ks, int half) { return d0 * 512 + ks * 4096 + half * 256; }
template <int OFF> __device__ __forceinline__ s16x4 tr_read(int vb) {
  s16x4 r; asm volatile("ds_read_b64_tr_b16 %0, %1 offset:%2" : "=&v"(r) : "v"(vb), "i"(OFF) : "memory"); return r;
}
template <int D0> __device__ __forceinline__ void pv_one(f32x16& od, int vb, bf16x8 pa0, bf16x8 pa1, bf16x8 pa2, bf16x8 pa3) {
  const s16x4 l0 = tr_read<v_rd_off(D0, 0, 0)>(vb), h0 = tr_read<v_rd_off(D0, 0, 1)>(vb), l1 = tr_read<v_rd_off(D0, 1, 0)>(vb), h1 = tr_read<v_rd_off(D0, 1, 1)>(vb);
  const s16x4 l2 = tr_read<v_rd_off(D0, 2, 0)>(vb), h2 = tr_read<v_rd_off(D0, 2, 1)>(vb), l3 = tr_read<v_rd_off(D0, 3, 0)>(vb), h3 = tr_read<v_rd_off(D0, 3, 1)>(vb);
  asm volatile("s_waitcnt lgkmcnt(0)" ::: "memory"); SBAR();
#define PK(L, H) (bf16x8){L[0], L[1], L[2], L[3], H[0], H[1], H[2], H[3]}
  od = __builtin_amdgcn_mfma_f32_32x32x16_bf16(pa0, PK(l0, h0), od, 0, 0, 0);
  od = __builtin_amdgcn_mfma_f32_32x32x16_bf16(pa1, PK(l1, h1), od, 0, 0, 0);
  od = __builtin_amdgcn_mfma_f32_32x32x16_bf16(pa2, PK(l2, h2), od, 0, 0, 0);
  od = __builtin_amdgcn_mfma_f32_32x32x16_bf16(pa3, PK(l3, h3), od, 0, 0, 0);
#undef PK
}
__device__ __forceinline__ void pv_d0(f32x16* o, int vb, bf16x8 pa0, bf16x8 pa1, bf16x8 pa2, bf16x8 pa3) {
  pv_one<0>(o[0], vb, pa0, pa1, pa2, pa3); pv_one<1>(o[1], vb, pa0, pa1, pa2, pa3); pv_one<2>(o[2], vb, pa0, pa1, pa2, pa3); pv_one<3>(o[3], vb, pa0, pa1, pa2, pa3);
}
template <bool QK, bool PV>
__device__ __forceinline__ void mphase(f32x16& p0, f32x16& p1, f32x16* o, const char* Ks, int vb, const bf16x8* qr, const f32x16& negm,
                                       bf16x8 pa0, bf16x8 pa1, bf16x8 pa2, bf16x8 pa3, int r32, int hi, int mp) {
#define TR8(dst, D0) do { dst[0] = tr_read<v_rd_off(D0, 0, 0)>(vb); dst[1] = tr_read<v_rd_off(D0, 0, 1)>(vb); dst[2] = tr_read<v_rd_off(D0, 1, 0)>(vb); dst[3] = tr_read<v_rd_off(D0, 1, 1)>(vb); \
    dst[4] = tr_read<v_rd_off(D0, 2, 0)>(vb); dst[5] = tr_read<v_rd_off(D0, 2, 1)>(vb); dst[6] = tr_read<v_rd_off(D0, 3, 0)>(vb); dst[7] = tr_read<v_rd_off(D0, 3, 1)>(vb); } while (0)
#define PKV(v, k) (bf16x8){v[2 * (k)][0], v[2 * (k)][1], v[2 * (k)][2], v[2 * (k)][3], v[2 * (k) + 1][0], v[2 * (k) + 1][1], v[2 * (k) + 1][2], v[2 * (k) + 1][3]}
#define PV4(od, v) do { od = __builtin_amdgcn_mfma_f32_32x32x16_bf16(pa0, PKV(v, 0), od, 0, 0, 0); od = __builtin_amdgcn_mfma_f32_32x32x16_bf16(pa1, PKV(v, 1), od, 0, 0, 0); \
    od = __builtin_amdgcn_mfma_f32_32x32x16_bf16(pa2, PKV(v, 2), od, 0, 0, 0); od = __builtin_amdgcn_mfma_f32_32x32x16_bf16(pa3, PKV(v, 3), od, 0, 0, 0); } while (0)
#define LWAIT(n) do { asm volatile("s_waitcnt lgkmcnt(" #n ")" ::: "memory"); SBAR(); } while (0)
  bf16x8 kf0[4], kf1[4]; s16x4 va[8], vc[8];
  if constexpr (QK) {
#pragma unroll
    for (int d0 = 0; d0 < 4; ++d0) { const int cb = (mp * 64 + d0 * 16 + hi * 8) * 2;
      asm volatile("ds_read_b128 %0, %1" : "=&v"(kf0[d0]) : "v"((int)(uintptr_t)Ks + KSWZ(r32, cb)) : "memory");
      asm volatile("ds_read_b128 %0, %1" : "=&v"(kf1[d0]) : "v"((int)(uintptr_t)Ks + KSWZ(32 + r32, cb)) : "memory"); }
  }
  if constexpr (PV) TR8(va, 0);
  if constexpr (QK) {
    if constexpr (PV) LWAIT(8); else LWAIT(0);
    p0 = __builtin_amdgcn_mfma_f32_32x32x16_bf16(kf0[0], qr[0], negm, 0, 0, 0); p1 = __builtin_amdgcn_mfma_f32_32x32x16_bf16(kf1[0], qr[0], negm, 0, 0, 0);
#pragma unroll
    for (int d0 = 1; d0 < 4; ++d0) { p0 = __builtin_amdgcn_mfma_f32_32x32x16_bf16(kf0[d0], qr[d0], p0, 0, 0, 0); p1 = __builtin_amdgcn_mfma_f32_32x32x16_bf16(kf1[d0], qr[d0], p1, 0, 0, 0); }
    SBAR();
  }
  if constexpr (PV) {
    TR8(vc, 1); LWAIT(8); PV4(o[0], va); SBAR();
    TR8(va, 2); LWAIT(8); PV4(o[1], vc); SBAR();
    TR8(vc, 3); LWAIT(8); PV4(o[2], va); SBAR();
    LWAIT(0); PV4(o[3], vc); SBAR();
  }
#undef TR8
#undef PKV
#undef PV4
#undef LWAIT
}

__device__ __forceinline__ void attn_unit(const bf16_t* __restrict__ Qb, const bf16_t* __restrict__ Kh, const bf16_t* __restrict__ Vh, bf16_t* __restrict__ Ob,
                                          const float* __restrict__ gd, const float* __restrict__ kmax, float lam, int seq, char* lds) {
  const int tid = otid(), wid = __builtin_amdgcn_readfirstlane(tid >> 6), lane = tid & 63, r32 = lane & 31, hi = lane >> 5;
  const int qw = wid & 3, mp = wid >> 2;
  char* K_lds = lds; char* V_lds = lds + SHM_K;
  constexpr int SLOT = SHM_K + SHM_V;
  float* wsf = (float*)(lds + 4 * SLOT) + wid * 64; float* li_l = wsf;
  float l_reg = 0; f32x16 o[4] = {}; bf16x8 qr[4];
  const bf16_t* Qw = Qb + (long)(qw * QBLK + r32) * LD + mp * 64 + hi * 8;
#pragma unroll
  for (int d0 = 0; d0 < 4; ++d0) qr[d0] = *reinterpret_cast<const bf16x8*>(Qw + d0 * 16);
  float mnC;
  { float ssa = 0.f, ssb = 0.f;
#pragma unroll
    for (int d0 = 0; d0 < 4; ++d0) { const u32x4 q4 = *reinterpret_cast<const u32x4*>(&qr[d0]);
      const float t = (bf_lo(q4.x) * bf_lo(q4.x) + bf_hi(q4.x) * bf_hi(q4.x)) + (bf_lo(q4.y) * bf_lo(q4.y) + bf_hi(q4.y) * bf_hi(q4.y)) + (bf_lo(q4.z) * bf_lo(q4.z) + bf_hi(q4.z) * bf_hi(q4.z)) + (bf_lo(q4.w) * bf_lo(q4.w) + bf_hi(q4.w) * bf_hi(q4.w));
      if (d0 < 2) ssa += t; else ssb += t; }
    { auto rr = __builtin_amdgcn_permlane32_swap(__float_as_uint(ssa), __float_as_uint(ssa), false, false); ssa = __uint_as_float(rr[0]) + __uint_as_float(rr[1]); }
    { auto rr = __builtin_amdgcn_permlane32_swap(__float_as_uint(ssb), __float_as_uint(ssb), false, false); ssb = __uint_as_float(rr[0]) + __uint_as_float(rr[1]); }
    mnC = -(sqrtf(ssa) * kmax[mp * 2] + sqrtf(ssb) * kmax[mp * 2 + 1]) * 1.01f; }
  f32x16 negm;
#pragma unroll
  for (int r = 0; r < 16; ++r) negm[r] = mnC;
  asm volatile("" : "+v"(negm));
  const int sr = tid >> 4, sc = (tid & 15) * 8, vst0 = v_st(sr, sc), vst1 = v_st(32 + sr, sc), kst0 = KSWZ(sr, sc * 2), kst1 = KSWZ(32 + sr, sc * 2);
  const int vb0 = (int)(uintptr_t)V_lds + v_rd_base(lane);
  bf16x8 sk0, sk1, sv0, sv1;
#define SLOAD(t) do { const long k0_ = (long)(t) * KVBLK; sv0 = *reinterpret_cast<const bf16x8*>(&Vh[(k0_ + sr) * LD + sc]); sv1 = *reinterpret_cast<const bf16x8*>(&Vh[(k0_ + 32 + sr) * LD + sc]); \
    sk0 = *reinterpret_cast<const bf16x8*>(&Kh[(k0_ + sr) * LD + sc]); sk1 = *reinterpret_cast<const bf16x8*>(&Kh[(k0_ + 32 + sr) * LD + sc]); } while (0)
#define SWRITE(t) do { char* kp_ = K_lds + ((t) & 3) * SLOT; char* vp_ = V_lds + ((t) & 3) * SLOT; *(bf16x8*)(vp_ + vst0) = sv0; *(bf16x8*)(vp_ + vst1) = sv1; *(bf16x8*)(kp_ + kst0) = sk0; *(bf16x8*)(kp_ + kst1) = sk1; } while (0)
#define PBAR() do { SBAR(); asm volatile("s_waitcnt lgkmcnt(0)\n\ts_barrier" ::: "memory"); SBAR(); } while (0)
  f32x16 p0, p1; bf16x8 pa0, pa1, pa2, pa3; const int NT = seq / KVBLK;
  SLOAD(0); SWRITE(0); SLOAD(1); SWRITE(1); SLOAD(2);
  PBAR();
  if (mp == 1) PBAR();
  pa0 = pa1 = pa2 = pa3 = bf16x8{};
  __builtin_amdgcn_s_setprio(1); mphase<true, false>(p0, p1, o, K_lds, vb0, qr, negm, pa0, pa1, pa2, pa3, r32, hi, mp); __builtin_amdgcn_s_setprio(0);
  PBAR();
#pragma unroll 1
  for (int t = 0; t + 1 < NT; ++t) {
    finishSM(p0, p1, l_reg, pa0, pa1, pa2, pa3);
    if (t + 2 < NT) { SWRITE(t + 2); if (t + 3 < NT) SLOAD(t + 3); }
    PBAR();
    __builtin_amdgcn_s_setprio(1);
    mphase<true, true>(p0, p1, o, K_lds + ((t + 1) & 3) * SLOT, vb0 + (t & 3) * SLOT, qr, negm, pa0, pa1, pa2, pa3, r32, hi, mp);
    __builtin_amdgcn_s_setprio(0);
    PBAR();
  }
  finishSM(p0, p1, l_reg, pa0, pa1, pa2, pa3);
  PBAR();
  __builtin_amdgcn_s_setprio(1); mphase<false, true>(p0, p1, o, K_lds, vb0 + ((NT - 1) & 3) * SLOT, qr, negm, pa0, pa1, pa2, pa3, r32, hi, mp); __builtin_amdgcn_s_setprio(0);
  if (mp == 0) PBAR();
  { auto rr = __builtin_amdgcn_permlane32_swap(__float_as_uint(l_reg), __float_as_uint(l_reg), false, false); l_reg = __uint_as_float(rr[0]) + __uint_as_float(rr[1]); }
  if (hi == 0) li_l[r32] = l_reg; asm volatile("s_waitcnt lgkmcnt(0)" ::: "memory");
  float rli[16];
#pragma unroll
  for (int r = 0; r < 16; ++r) rli[r] = __builtin_amdgcn_rcpf(li_l[crow(r, hi)]);
  __syncthreads();
  float* xch = (float*)lds + qw * 4096 + lane;
  if (mp == 1) {
#pragma unroll
    for (int r = 0; r < 16; ++r)
#pragma unroll
      for (int d0 = 0; d0 < 4; ++d0) xch[(r * 4 + d0) * 64] = o[d0][r] * rli[r] * lam;
  }
  __syncthreads();
  if (mp == 0) {
    float gv[4];
#pragma unroll
    for (int d0 = 0; d0 < 4; ++d0) gv[d0] = gd[d0 * 32 + r32] * (1.0f - LAM_INIT);
#pragma unroll
    for (int r = 0; r < 16; ++r) {
      float dv[4]; float ss = 0.f;
#pragma unroll
      for (int d0 = 0; d0 < 4; ++d0) { dv[d0] = o[d0][r] * rli[r] - xch[(r * 4 + d0) * 64]; ss += dv[d0] * dv[d0]; }
      ss += __shfl_xor(ss, 1); ss += __shfl_xor(ss, 2); ss += __shfl_xor(ss, 4); ss += __shfl_xor(ss, 8); ss += __shfl_xor(ss, 16);
      const float rstd = rsqrtf(ss * (1.0f / 128.0f) + EPS);
      bf16_t* orow = Ob + (long)(qw * QBLK + crow(r, hi)) * LD + r32;
#pragma unroll
      for (int d0 = 0; d0 < 4; ++d0) orow[d0 * 32] = (bf16_t)(cvtpk(dv[d0] * rstd * gv[d0], 0.f) & 0xffffu);
    }
  }
  __syncthreads();
#undef SLOAD
#undef SWRITE
#undef PBAR
}

__device__ __forceinline__ void kfrag_issue(bf16x8 (&kf0)[4], bf16x8 (&kf1)[4], const char* Ks, int r32, int hi, int mp) {
#pragma unroll
  for (int d0 = 0; d0 < 4; ++d0) { const int cb = (mp * 64 + d0 * 16 + hi * 8) * 2;
    asm volatile("ds_read_b128 %0, %1" : "=&v"(kf0[d0]) : "v"((int)(uintptr_t)Ks + KSWZ(r32, cb)) : "memory");
    asm volatile("ds_read_b128 %0, %1" : "=&v"(kf1[d0]) : "v"((int)(uintptr_t)Ks + KSWZ(32 + r32, cb)) : "memory"); }
}
__device__ __forceinline__ void kfrag_issue_half(bf16x8 (&kf)[4], const char* Ks, int row, int hi, int mp) {
#pragma unroll
  for (int d0 = 0; d0 < 4; ++d0) { const int cb = (mp * 64 + d0 * 16 + hi * 8) * 2;
    asm volatile("ds_read_b128 %0, %1" : "=&v"(kf[d0]) : "v"((int)(uintptr_t)Ks + KSWZ(row, cb)) : "memory"); }
}
#define AIL_MFMA() __builtin_amdgcn_sched_group_barrier(0x008, 1, 0)
#define AIL_TRANS(n) __builtin_amdgcn_sched_group_barrier(0x400, n, 0)
#define AIL_VALU(n) __builtin_amdgcn_sched_group_barrier(0x002, n, 0)
__device__ __forceinline__ void attn_unit2(const bf16_t* __restrict__ Qb, const bf16_t* __restrict__ Kh, const bf16_t* __restrict__ Vh, bf16_t* __restrict__ Ob,
                                           const float* __restrict__ gd, const float* __restrict__ kmax, float lam, int seq, char* lds) {
  const int tid = otid(), wid = __builtin_amdgcn_readfirstlane(tid >> 6), lane = tid & 63, r32 = lane & 31, hi = lane >> 5;
  const int qw = wid & 3, mp = wid >> 2;
  char* K_lds = lds; char* V_lds = lds + SHM_K;
  constexpr int SLOT = SHM_K + SHM_V;
  float* wsf = (float*)(lds + 4 * SLOT) + wid * 64; float* li_l = wsf;
  f32x16 o[4] = {}; bf16x8 qr[4];
  const bf16_t* Qw = Qb + (long)(qw * QBLK + r32) * LD + mp * 64 + hi * 8;
#pragma unroll
  for (int d0 = 0; d0 < 4; ++d0) qr[d0] = *reinterpret_cast<const bf16x8*>(Qw + d0 * 16);
  const int sr = tid >> 4, sc = (tid & 15) * 8, vst0 = v_st(sr, sc), vst1 = v_st(32 + sr, sc), kst0 = KSWZ(sr, sc * 2), kst1 = KSWZ(32 + sr, sc * 2);
  const int vb0 = (int)(uintptr_t)V_lds + v_rd_base2(lane);
  bf16x8 sk0, sk1, sv0, sv1;
#define SLOAD(t) do { const long k0_ = (long)(t) * KVBLK; sv0 = *reinterpret_cast<const bf16x8*>(&Vh[(k0_ + sr) * LD + sc]); sv1 = *reinterpret_cast<const bf16x8*>(&Vh[(k0_ + 32 + sr) * LD + sc]); \
    sk0 = *reinterpret_cast<const bf16x8*>(&Kh[(k0_ + sr) * LD + sc]); sk1 = *reinterpret_cast<const bf16x8*>(&Kh[(k0_ + 32 + sr) * LD + sc]); } while (0)
#define SWRITE(t) do { char* kp_ = K_lds + ((t) & 3) * SLOT; char* vp_ = V_lds + ((t) & 3) * SLOT; *(bf16x8*)(vp_ + vst0) = sv0; *(bf16x8*)(vp_ + vst1) = sv1; *(bf16x8*)(kp_ + kst0) = sk0; *(bf16x8*)(kp_ + kst1) = sk1; } while (0)
#define PBAR() do { SBAR(); asm volatile("s_waitcnt lgkmcnt(0)\n\ts_barrier" ::: "memory"); SBAR(); } while (0)
#define TR8(dst, D0, vb) do { dst[0] = tr_read<v_rd_off2(D0, 0, 0)>(vb); dst[1] = tr_read<v_rd_off2(D0, 0, 1)>(vb); dst[2] = tr_read<v_rd_off2(D0, 1, 0)>(vb); dst[3] = tr_read<v_rd_off2(D0, 1, 1)>(vb); \
    dst[4] = tr_read<v_rd_off2(D0, 2, 0)>(vb); dst[5] = tr_read<v_rd_off2(D0, 2, 1)>(vb); dst[6] = tr_read<v_rd_off2(D0, 3, 0)>(vb); dst[7] = tr_read<v_rd_off2(D0, 3, 1)>(vb); } while (0)
#define PKV(v, k) (bf16x8){v[2 * (k)][0], v[2 * (k)][1], v[2 * (k)][2], v[2 * (k)][3], v[2 * (k) + 1][0], v[2 * (k) + 1][1], v[2 * (k) + 1][2], v[2 * (k) + 1][3]}
#define LWAIT(n) do { asm volatile("s_waitcnt lgkmcnt(" #n ")" ::: "memory"); SBAR(); } while (0)
#define QKT(Ks, PRE, NW) do { bf16x8 kf0[4], kf1[4]; kfrag_issue(kf0, kf1, (Ks), r32, hi, mp); PRE; LWAIT(NW); \
    p0 = __builtin_amdgcn_mfma_f32_32x32x16_bf16(kf0[0], qr[0], negm, 0, 0, 0); p1 = __builtin_amdgcn_mfma_f32_32x32x16_bf16(kf1[0], qr[0], negm, 0, 0, 0); \
    _Pragma("unroll") for (int d0 = 1; d0 < 4; ++d0) { p0 = __builtin_amdgcn_mfma_f32_32x32x16_bf16(kf0[d0], qr[d0], p0, 0, 0, 0); p1 = __builtin_amdgcn_mfma_f32_32x32x16_bf16(kf1[d0], qr[d0], p1, 0, 0, 0); } SBAR(); } while (0)
#define PVGROUP(D0, V, P, B, PAOUT, SA, SB) do { \
    o[D0] = __builtin_amdgcn_mfma_f32_32x32x16_bf16(pa0, PKV(V, 0), o[D0], 0, 0, 0); P[B + 0] = __builtin_amdgcn_exp2f(P[B + 0]); P[B + 1] = __builtin_amdgcn_exp2f(P[B + 1]); \
    o[D0] = __builtin_amdgcn_mfma_f32_32x32x16_bf16(pa1, PKV(V, 1), o[D0], 0, 0, 0); P[B + 2] = __builtin_amdgcn_exp2f(P[B + 2]); P[B + 3] = __builtin_amdgcn_exp2f(P[B + 3]); SA += P[B + 0]; SB += P[B + 1]; \
    o[D0] = __builtin_amdgcn_mfma_f32_32x32x16_bf16(pa2, PKV(V, 2), o[D0], 0, 0, 0); P[B + 4] = __builtin_amdgcn_exp2f(P[B + 4]); P[B + 5] = __builtin_amdgcn_exp2f(P[B + 5]); SA += P[B + 2]; SB += P[B + 3]; \
    o[D0] = __builtin_amdgcn_mfma_f32_32x32x16_bf16(pa3, PKV(V, 3), o[D0], 0, 0, 0); P[B + 6] = __builtin_amdgcn_exp2f(P[B + 6]); P[B + 7] = __builtin_amdgcn_exp2f(P[B + 7]); SA += P[B + 4]; SB += P[B + 5]; \
    SA += P[B + 6]; SB += P[B + 7]; \
    { unsigned a0 = cvtpk(P[B + 0], P[B + 1]), a1 = cvtpk(P[B + 2], P[B + 3]), b0_ = cvtpk(P[B + 4], P[B + 5]), b1_ = cvtpk(P[B + 6], P[B + 7]); \
      auto r0 = __builtin_amdgcn_permlane32_swap(a0, b0_, false, false); auto r1 = __builtin_amdgcn_permlane32_swap(a1, b1_, false, false); \
      u32x4 w4 = {r0[0], r1[0], r0[1], r1[1]}; PAOUT = *reinterpret_cast<bf16x8*>(&w4); } \
    AIL_MFMA(); AIL_TRANS(2); AIL_MFMA(); AIL_TRANS(2); AIL_VALU(2); AIL_MFMA(); AIL_TRANS(2); AIL_VALU(2); AIL_MFMA(); AIL_TRANS(2); AIL_VALU(2); SBAR(); } while (0)
#define TRM(m) do { vlo[m] = tr_read<v_rd_off2((m) / 4, (m) % 4, 0)>(vb); vhi[m] = tr_read<v_rd_off2((m) / 4, (m) % 4, 1)>(vb); } while (0)
#define PKM(m) (bf16x8){vlo[m][0], vlo[m][1], vlo[m][2], vlo[m][3], vhi[m][0], vhi[m][1], vhi[m][2], vhi[m][3]}
#define PAK(k) ((k) == 0 ? pa0 : (k) == 1 ? pa1 : (k) == 2 ? pa2 : pa3)
#define PVSTEP(m, WAITN, P, B) do { LWAIT(WAITN); o[(m) / 4] = __builtin_amdgcn_mfma_f32_32x32x16_bf16(PAK((m) % 4), PKM(m), o[(m) / 4], 0, 0, 0); \
    if ((m) + 7 < 16) TRM(((m) + 7 < 16 ? (m) + 7 : 15)); \
    P[B] = __builtin_amdgcn_exp2f(P[B]); P[B + 1] = __builtin_amdgcn_exp2f(P[B + 1]); } while (0)
#define SUM8(P, B, SA, SB) do { SA += (P[B] + P[B + 2]) + (P[B + 4] + P[B + 6]); SB += (P[B + 1] + P[B + 3]) + (P[B + 5] + P[B + 7]); } while (0)
#define PACK8(P, B, PAOUT) do { u32x4 w4 = {cvtpk(P[B + 0], P[B + 1]), cvtpk(P[B + 2], P[B + 3]), cvtpk(P[B + 4], P[B + 5]), cvtpk(P[B + 6], P[B + 7])}; PAOUT = *reinterpret_cast<bf16x8*>(&w4); } while (0)
#define PVPLAIN(D0, V) do { o[D0] = __builtin_amdgcn_mfma_f32_32x32x16_bf16(pa0, PKV(V, 0), o[D0], 0, 0, 0); o[D0] = __builtin_amdgcn_mfma_f32_32x32x16_bf16(pa1, PKV(V, 1), o[D0], 0, 0, 0); \
    o[D0] = __builtin_amdgcn_mfma_f32_32x32x16_bf16(pa2, PKV(V, 2), o[D0], 0, 0, 0); o[D0] = __builtin_amdgcn_mfma_f32_32x32x16_bf16(pa3, PKV(V, 3), o[D0], 0, 0, 0); SBAR(); } while (0)
  f32x16 p0, p1; bf16x8 pa0, pa1, pa2, pa3, pn0, pn1, pn2, pn3; float s0 = 0.f, s1 = 0.f, s2 = 0.f, s3 = 0.f, s4 = 0.f, s5 = 0.f, s6 = 0.f, s7 = 0.f; const int NT = seq / KVBLK;
  bf16x8 ak0, ak1, av0, av1, bk0, bk1, bv0, bv1;
  SLOAD(0); ak0 = sk0; ak1 = sk1; av0 = sv0; av1 = sv1;
  SLOAD(1); bk0 = sk0; bk1 = sk1; bv0 = sv0; bv1 = sv1;
  SLOAD(2);
  float mnC;
  { float ssa = 0.f, ssb = 0.f;
#pragma unroll
    for (int d0 = 0; d0 < 4; ++d0) { const u32x4 q4 = *reinterpret_cast<const u32x4*>(&qr[d0]);
      const float t = (bf_lo(q4.x) * bf_lo(q4.x) + bf_hi(q4.x) * bf_hi(q4.x)) + (bf_lo(q4.y) * bf_lo(q4.y) + bf_hi(q4.y) * bf_hi(q4.y)) + (bf_lo(q4.z) * bf_lo(q4.z) + bf_hi(q4.z) * bf_hi(q4.z)) + (bf_lo(q4.w) * bf_lo(q4.w) + bf_hi(q4.w) * bf_hi(q4.w));
      if (d0 < 2) ssa += t; else ssb += t; }
    { auto rr = __builtin_amdgcn_permlane32_swap(__float_as_uint(ssa), __float_as_uint(ssa), false, false); ssa = __uint_as_float(rr[0]) + __uint_as_float(rr[1]); }
    { auto rr = __builtin_amdgcn_permlane32_swap(__float_as_uint(ssb), __float_as_uint(ssb), false, false); ssb = __uint_as_float(rr[0]) + __uint_as_float(rr[1]); }
    mnC = -(sqrtf(ssa) * kmax[mp * 2] + sqrtf(ssb) * kmax[mp * 2 + 1]) * 1.01f; }
  f32x16 negm;
#pragma unroll
  for (int r = 0; r < 16; ++r) negm[r] = mnC;
  asm volatile("" : "+v"(negm));
  { char* kp_ = K_lds; char* vp_ = V_lds; *(bf16x8*)(vp_ + vst0) = av0; *(bf16x8*)(vp_ + vst1) = av1; *(bf16x8*)(kp_ + kst0) = ak0; *(bf16x8*)(kp_ + kst1) = ak1; }
  { char* kp_ = K_lds + SLOT; char* vp_ = V_lds + SLOT; *(bf16x8*)(vp_ + vst0) = bv0; *(bf16x8*)(vp_ + vst1) = bv1; *(bf16x8*)(kp_ + kst0) = bk0; *(bf16x8*)(kp_ + kst1) = bk1; }
  SWRITE(2); SLOAD(3);
  PBAR();
  QKT(K_lds, (void)0, 0);
  {
#pragma unroll
    for (int r = 0; r < 16; ++r) { p0[r] = __builtin_amdgcn_exp2f(p0[r]); p1[r] = __builtin_amdgcn_exp2f(p1[r]); }
    SUM8(p0, 0, s0, s1); SUM8(p0, 8, s2, s3); SUM8(p1, 0, s4, s5); SUM8(p1, 8, s6, s7);
    PACK8(p0, 0, pa0); PACK8(p0, 8, pa1); PACK8(p1, 0, pa2); PACK8(p1, 8, pa3); }
#pragma unroll 1
  for (int t = 0; t + 1 < NT; ++t) {
    PBAR();
    const int vb = vb0 + (t & 3) * SLOT;
    s16x4 vlo[16], vhi[16];
    QKT(K_lds + ((t + 1) & 3) * SLOT, do { TRM(0); TRM(1); TRM(2); if (t + 3 < NT) { SWRITE(t + 3); if (t + 4 < NT) SLOAD(t + 4); } } while (0), 6);
    TRM(3); TRM(4); TRM(5); TRM(6);
    PVSTEP(0, 12, p0, 0);  PVSTEP(1, 12, p0, 2);  PVSTEP(2, 12, p0, 4);   PVSTEP(3, 12, p0, 6);   SUM8(p0, 0, s0, s1);
    PVSTEP(4, 12, p0, 8);  PVSTEP(5, 12, p0, 10); PVSTEP(6, 12, p0, 12);  PVSTEP(7, 12, p0, 14);  SUM8(p0, 8, s2, s3); PACK8(p0, 0, pn0);
    PVSTEP(8, 12, p1, 0);  PVSTEP(9, 12, p1, 2);  PVSTEP(10, 10, p1, 4);  PVSTEP(11, 8, p1, 6);   SUM8(p1, 0, s4, s5); PACK8(p0, 8, pn1);
    PVSTEP(12, 6, p1, 8);  PVSTEP(13, 4, p1, 10); PVSTEP(14, 2, p1, 12);  PVSTEP(15, 0, p1, 14);  SUM8(p1, 8, s6, s7); PACK8(p1, 0, pn2); PACK8(p1, 8, pn3);
    SBAR();
    pa0 = pn0; pa1 = pn1; pa2 = pn2; pa3 = pn3;
  }
  { PBAR(); const int vb = vb0 + ((NT - 1) & 3) * SLOT; s16x4 va[8], vc[8];
    TR8(va, 0, vb); TR8(vc, 1, vb); LWAIT(8); PVPLAIN(0, va); TR8(va, 2, vb); LWAIT(8); PVPLAIN(1, vc); TR8(vc, 3, vb); LWAIT(8); PVPLAIN(2, va); LWAIT(0); PVPLAIN(3, vc); }
  float l_reg = ((s0 + s1) + (s2 + s3)) + ((s4 + s5) + (s6 + s7));
  { auto rr = __builtin_amdgcn_permlane32_swap(__float_as_uint(l_reg), __float_as_uint(l_reg), false, false); l_reg = __uint_as_float(rr[0]) + __uint_as_float(rr[1]); }
  if (hi == 0) li_l[r32] = l_reg; asm volatile("s_waitcnt lgkmcnt(0)" ::: "memory");
  float rli[16];
#pragma unroll
  for (int r = 0; r < 16; ++r) rli[r] = __builtin_amdgcn_rcpf(li_l[crow(r, hi)]);
  __syncthreads();
  float* xch = (float*)lds + qw * 4096 + lane;
  if (mp == 1) {
#pragma unroll
    for (int r = 0; r < 16; ++r)
#pragma unroll
      for (int d0 = 0; d0 < 4; ++d0) xch[(r * 4 + d0) * 64] = o[d0][r] * rli[r] * lam;
  }
  __syncthreads();
  if (mp == 0) {
    float gv[4];
#pragma unroll
    for (int d0 = 0; d0 < 4; ++d0) gv[d0] = gd[d0 * 32 + r32] * (1.0f - LAM_INIT);
#pragma unroll
    for (int r = 0; r < 16; ++r) {
      float dv[4]; float ss = 0.f;
#pragma unroll
      for (int d0 = 0; d0 < 4; ++d0) { dv[d0] = o[d0][r] * rli[r] - xch[(r * 4 + d0) * 64]; ss += dv[d0] * dv[d0]; }
      ss += __shfl_xor(ss, 1); ss += __shfl_xor(ss, 2); ss += __shfl_xor(ss, 4); ss += __shfl_xor(ss, 8); ss += __shfl_xor(ss, 16);
      const float rstd = rsqrtf(ss * (1.0f / 128.0f) + EPS);
      bf16_t* orow = Ob + (long)(qw * QBLK + crow(r, hi)) * LD + r32;
#pragma unroll
      for (int d0 = 0; d0 < 4; ++d0) orow[d0 * 32] = (bf16_t)(cvtpk(dv[d0] * rstd * gv[d0], 0.f) & 0xffffu);
    }
  }
  __syncthreads();
#undef SLOAD
#undef SWRITE
#undef PBAR
#undef TR8
#undef PKV
#undef LWAIT
#undef QKT
#undef PVGROUP
#undef PVPLAIN
#undef TRM
#undef PKM
#undef PAK
#undef PVSTEP
#undef SUM8
#undef PACK8
}
#undef AIL_MFMA
#undef AIL_TRANS
#undef AIL_VALU
#undef KSWZ
#undef SBAR
}

__device__ __forceinline__ float log_sigmoidf_(float x) { return x >= 0.f ? -log1pf(__expf(-x)) : x - log1pf(__expf(x)); }

__device__ __forceinline__ int perm32(int rho) { const int n = rho >> 4, i = rho & 15; return 8 * (i >> 2) + 4 * n + (i & 3); }
__device__ __forceinline__ void transpose_item(const float* __restrict__ W, int ldw, int scol0, bf16_t* WTrow0, int k0, LAS float* scr, int lane, bool perm) {
#pragma unroll 8
    for (int i = 0; i < 32; ++i) { const int kk = 2 * i + (lane >> 5); scr[kk * 33 + (lane & 31)] = W[(size_t)(k0 + kk) * ldw + scol0 + (lane & 31)]; }
    LDS_WAIT(); asm volatile("" ::: "memory");
    const int c = lane & 7;
#pragma unroll
    for (int j = 0; j < 4; ++j) { const int n = (lane >> 3) + 8 * j; const LAS float* s = scr + (8 * c) * 33 + (perm ? perm32(n) : n);
        u32x4 o; o.x = cvt_pk_bf16(s[0 * 33], s[1 * 33]); o.y = cvt_pk_bf16(s[2 * 33], s[3 * 33]); o.z = cvt_pk_bf16(s[4 * 33], s[5 * 33]); o.w = cvt_pk_bf16(s[6 * 33], s[7 * 33]);
        *(u32x4*)(WTrow0 + (size_t)n * 1024 + k0 + 8 * c) = o; }
    LDS_WAIT(); asm volatile("" ::: "memory");
}

__device__ __forceinline__ void transpose_item8(const float* __restrict__ W, int ldw, int scol0, unsigned char* WTrow0, int k0, LAS float* scr, int lane, float scale, bool perm = true) {
#pragma unroll 8
    for (int i = 0; i < 32; ++i) { const int kk = 2 * i + (lane >> 5); scr[kk * 33 + (lane & 31)] = W[(size_t)(k0 + kk) * ldw + scol0 + (lane & 31)]; }
    LDS_WAIT(); asm volatile("" ::: "memory");
    const int c = lane & 7;
#pragma unroll
    for (int j = 0; j < 4; ++j) { const int n = (lane >> 3) + 8 * j; const LAS float* s = scr + (8 * c) * 33 + (perm ? perm32(n) : n);
        u32x2 o; o.x = pk4_fp8(s[0 * 33] * scale, s[1 * 33] * scale, s[2 * 33] * scale, s[3 * 33] * scale); o.y = pk4_fp8(s[4 * 33] * scale, s[5 * 33] * scale, s[6 * 33] * scale, s[7 * 33] * scale);
        *(u32x2*)(WTrow0 + (size_t)n * 1024 + k0 + 8 * c) = o; }
    LDS_WAIT(); asm volatile("" ::: "memory");
}

struct T8Item { const float* src; unsigned char* dst; int ldw; int split; int perm; };
__device__ __forceinline__ T8Item t8_decode(const Params& p, int it) {
    T8Item r; r.split = 0; r.perm = 2;
    if (it < 256) { const int kb = it >> 5, t = it & 31, n0 = t * 256; r.src = p.w_in + (size_t)(kb * 128) * INCOLS + (n0 < 2048 ? n0 : n0 + 16); r.ldw = INCOLS;
        r.dst = p.ws + WS_WIN + (size_t)n0 * 1024 + kb * 128; r.perm = (n0 >= 3072 && n0 < 5120) ? 0 : 2; return r; }
    it -= 256;
    if (it < 2048) { const int e = it >> 6, kb = (it >> 3) & 7, pn = it & 7; r.src = p.exp_w1 + (size_t)e * 1024 * 2048 + (size_t)(kb * 128) * 2048 + 128 * pn; r.ldw = 2048; r.split = 1024 - 128; r.perm = 1;
        r.dst = p.ws + WS_W1 + ((size_t)e * 2048 + 256 * pn) * 1024 + kb * 128; return r; }
    it -= 2048;
    { const int e = it >> 5, kb = (it >> 2) & 7, t = it & 3; r.src = p.exp_w2 + (size_t)e * 1024 * 1024 + (size_t)(kb * 128) * 1024 + 256 * t; r.ldw = 1024;
        r.dst = p.ws + WS_W2 + ((size_t)e * 1024 + 256 * t) * 1024 + kb * 128; return r; }
}
constexpr int T8_ITEMS = 256 + 2048 + 1024;
__device__ __forceinline__ void t8_load(f32x4 (&v)[16], const T8Item& q, int wave, int lane) {
    const float* sp = q.src + (size_t)(16 * wave) * q.ldw + 4 * lane + (lane >= 32 ? q.split : 0);
#pragma unroll
    for (int i = 0; i < 16; ++i) v[i] = *(const f32x4*)(sp + (size_t)i * q.ldw);
}
__device__ __forceinline__ void t8_process(const f32x4 (&v)[16], const T8Item& q, LAS unsigned char* img, int tid, int wave, int lane) {
#pragma unroll
    for (int j = 0; j < 4; ++j) { u32x4 o;
        o.x = pk4_fp8(v[0][j] * 64.0f, v[1][j] * 64.0f, v[2][j] * 64.0f, v[3][j] * 64.0f);     o.y = pk4_fp8(v[4][j] * 64.0f, v[5][j] * 64.0f, v[6][j] * 64.0f, v[7][j] * 64.0f);
        o.z = pk4_fp8(v[8][j] * 64.0f, v[9][j] * 64.0f, v[10][j] * 64.0f, v[11][j] * 64.0f); o.w = pk4_fp8(v[12][j] * 64.0f, v[13][j] * 64.0f, v[14][j] * 64.0f, v[15][j] * 64.0f);
        *(LAS u32x4*)(img + (4 * lane + j) * 128 + ((wave ^ (lane & 7)) << 4)) = o; }
    __syncthreads();
#pragma unroll
    for (int r = 0; r < 4; ++r) { const int R = r * 64 + (tid >> 3), c = tid & 7; const int n = q.perm == 2 ? 64 * ((R >> 5) & 3) + 32 * (R >> 7) + perm32(R & 31) : (q.perm == 1 ? (R & ~31) + perm32(R & 31) : R);
        const u32x4 o = *(const LAS u32x4*)(img + n * 128 + ((c ^ ((n >> 2) & 7)) << 4));
        *(u32x4*)(q.dst + (size_t)R * 1024 + 16 * c) = o; }
}

__device__ __forceinline__ void t8_dynamic(const Params& p, LAS unsigned char* lds, unsigned* ctr, int base, int limit) {
    const int tid = otid(), lane = tid & 63, wave = __builtin_amdgcn_readfirstlane(tid >> 6);
    LAS int* t8slot = (LAS int*)(lds + 131072);
#define T8_NEXT(nx) do { if (tid == 0) *t8slot = (int)atomicAdd(ctr, 1u) + base; __syncthreads(); nx = __builtin_amdgcn_readfirstlane(*t8slot); } while (0)
    f32x4 va[16], vb[16]; int it; T8_NEXT(it);
    if (it < limit) { const T8Item q = t8_decode(p, it); t8_load(va, q, wave, lane); }
    while (it < limit) {
        int nx; { const T8Item q = t8_decode(p, it); t8_process(va, q, lds, tid, wave, lane); }
        T8_NEXT(nx);
        if (nx < limit) { const T8Item qn = t8_decode(p, nx); t8_load(vb, qn, wave, lane); }
        it = nx; if (it >= limit) break;
        { const T8Item q = t8_decode(p, it); t8_process(vb, q, lds + 32768, tid, wave, lane); }
        T8_NEXT(nx);
        if (nx < limit) { const T8Item qn = t8_decode(p, nx); t8_load(va, qn, wave, lane); }
        it = nx;
    }
#undef T8_NEXT
    __syncthreads();
}

__device__ __forceinline__ void phase_prep(const Params& p, LAS unsigned char* lds, int G) {
    const int tid = otid(), lane = tid & 63, wave = __builtin_amdgcn_readfirstlane(tid >> 6);
    const int gw = blockIdx.x * 8 + wave, NGW = G * 8;
    LAS float* sl = (LAS float*)(lds + 73728);
    for (int i = tid; i < 9 * 1024; i += NTHREADS) { const float v = i < 8192 ? p.c[i] : p.c_ctx[i - 8192]; sl[i] = v / (1.0f + __expf(-v)); }
    __syncthreads();
    float* mod = (float*)(p.ws + WS_MOD);
    unsigned* t8ctr = (unsigned*)(p.ws + WS_CTL) + 40;
    LAS int* t8slot = (LAS int*)(lds + 131072);
    const int t8lim = G >= 160 ? 256 : T8_ITEMS;
    f32x4 va[16], vb[16]; int it = blockIdx.x;
    if (it < t8lim) { const T8Item q = t8_decode(p, it); t8_load(va, q, wave, lane); }
    for (int cb = blockIdx.x; cb < 192; cb += G) {
        const int c0 = cb * 32, col = lane & 31, slab = 2 * wave + (lane >> 5);
        float acc[9];
#pragma unroll
        for (int v = 0; v < 9; ++v) acc[v] = 0.f;
        const float* wp = p.ada_w + (size_t)(slab * 64) * 6144 + c0 + col;
#pragma unroll 1
        for (int i0 = 0; i0 < 64; i0 += 32) {
            float wv[32];
#pragma unroll
            for (int i = 0; i < 32; ++i) wv[i] = wp[(size_t)(i0 + i) * 6144];
#pragma unroll
            for (int i = 0; i < 32; ++i) {
#pragma unroll
                for (int v = 0; v < 9; ++v) acc[v] += sl[v * 1024 + slab * 64 + i0 + i] * wv[i]; }
        }
        LAS float* red = (LAS float*)(lds + 110592);
#pragma unroll
        for (int v = 0; v < 9; ++v) red[(slab * 9 + v) * 32 + col] = acc[v];
        __syncthreads();
        if (tid < 288) { const int v = tid >> 5, cc = tid & 31; float sum = 0.f;
#pragma unroll
            for (int sb = 0; sb < 16; ++sb) sum += red[(sb * 9 + v) * 32 + cc];
            mod[v * 6144 + c0 + cc] = sum + p.ada_b[c0 + cc]; }
        __syncthreads();
    }
    if (blockIdx.x == 0 && wave == 0) {
        const float s01 = wave_sum(p.dlam[lane] * p.dlam[64 + lane]), s23 = wave_sum(p.dlam[128 + lane] * p.dlam[192 + lane]);
        if (lane == 0) *(float*)(p.ws + WS_LAM) = expf(s01) - expf(s23) + LAM_INIT;
    }
    if (blockIdx.x == 1 && wave == 0 && lane < 16) {
        double th = 1.0; for (int j = 0; j < lane; ++j) th *= 0.5623413251903491;
        double ct = 1.0, st = th, term_c = 1.0, term_s = th; const double t2 = th * th;
        for (int n = 1; n < 14; ++n) { term_c *= -t2 / ((2.0 * n - 1.0) * (2.0 * n)); term_s *= -t2 / ((2.0 * n) * (2.0 * n + 1.0)); ct += term_c; st += term_s; }
        float* rc = (float*)(p.ws + WS_ROPE); float* rs = rc + 1024;
        double cc = 1.0, ss = 0.0;
        for (int pos = 0; pos < 64; ++pos) { rc[pos * 16 + lane] = (float)cc; rs[pos * 16 + lane] = (float)ss; const double c2 = cc * ct - ss * st, s2 = ss * ct + cc * st; cc = c2; ss = s2; }
    }
    LAS float* scr = (LAS float*)(lds + wave * 8448);
    constexpr int I_SQ = 16 * 32;
    for (int r = gw; r < 3 * I_SQ; r += NGW) {
        const int w = r / I_SQ, r2 = r % I_SQ, kb = r2 >> 5, nb = r2 & 31; const float* W = w == 0 ? p.w_a : (w == 1 ? p.w_b : p.w_o);
        bf16_t* WT = (bf16_t*)(p.ws + (w == 0 ? WS_WA : (w == 1 ? WS_WB : WS_WO))); transpose_item(W, 1024, (nb >> 3) * 256 + 64 * (nb & 3) + 32 * ((nb >> 2) & 1), WT + (size_t)nb * 32 * 1024, kb * 64, scr, lane, true);
    }
    __syncthreads();
#define T8_NEXT(nx) do { if (tid == 0) *t8slot = (int)atomicAdd(t8ctr, 1u) + G; __syncthreads(); nx = __builtin_amdgcn_readfirstlane(*t8slot); } while (0)
    while (it < t8lim) {
        int nx; T8_NEXT(nx);
        if (nx < t8lim) { const T8Item qn = t8_decode(p, nx); t8_load(vb, qn, wave, lane); }
        { const T8Item q = t8_decode(p, it); t8_process(va, q, lds, tid, wave, lane); }
        it = nx; if (it >= t8lim) break;
        T8_NEXT(nx);
        if (nx < t8lim) { const T8Item qn = t8_decode(p, nx); t8_load(va, qn, wave, lane); }
        { const T8Item q = t8_decode(p, it); t8_process(vb, q, lds + 32768, tid, wave, lane); }
        it = nx;
    }
#undef T8_NEXT
}

__device__ __forceinline__ void phase_rows1(const Params& p, LAS unsigned char* lds, int G) {
    const int tid = otid(), lane = tid & 63, wave = __builtin_amdgcn_readfirstlane(tid >> 6);
    const int gw = blockIdx.x * 8 + wave, NGW = G * 8;
    LAS float* wg = (LAS float*)lds;
    for (int i = tid; i < 16 * 1024; i += NTHREADS) { const int k = i >> 4, g = i & 15; wg[g * 1024 + k] = p.w_in[(size_t)k * INCOLS + 2048 + g]; }
    __syncthreads();
    const float* mod = (const float*)(p.ws + WS_MOD); unsigned char* U = p.ws + WS_U; float* GT = (float*)(p.ws + WS_GT);
    f32x4 gn[4];
#pragma unroll
    for (int j = 0; j < 4; ++j) gn[j] = *(const f32x4*)(p.norm1_g + 4 * lane + 256 * j);
    f32x4 vn[4];
    { const int m = gw; const float* xr = m < TL ? p.x + (size_t)m * 1024 : p.ctx + (size_t)(m - TL) * 1024;
#pragma unroll
      for (int j = 0; j < 4; ++j) vn[j] = *(const f32x4*)(xr + 4 * lane + 256 * j); }
    for (int m = gw; m < TT; m += NGW) {
        const float* md = mod + (size_t)(m < TL ? (m >> 12) : 8) * 6144;
        f32x4 v[4]; float ss = 0.f;
#pragma unroll
        for (int j = 0; j < 4; ++j) { v[j] = vn[j]; ss += (v[j][0] * v[j][0] + v[j][1] * v[j][1]) + (v[j][2] * v[j][2] + v[j][3] * v[j][3]); }
        if (m + NGW < TT) { const int m2 = m + NGW; const float* xr = m2 < TL ? p.x + (size_t)m2 * 1024 : p.ctx + (size_t)(m2 - TL) * 1024;
#pragma unroll
            for (int j = 0; j < 4; ++j) vn[j] = *(const f32x4*)(xr + 4 * lane + 256 * j); }
        const float rstd = rsqrtf(wave_sum(ss) * (1.0f / 1024.0f) + EPS);
#pragma unroll
        for (int j = 0; j < 4; ++j) { const f32x4 sh = *(const f32x4*)(md + 4 * lane + 256 * j), sc = *(const f32x4*)(md + 1024 + 4 * lane + 256 * j);
            v[j] = (v[j] * rstd * gn[j]) * (sc + 1.0f) + sh;
            *(unsigned*)(U + (size_t)m * 1024 + 4 * lane + 256 * j) = pk4_fp8(v[j][0], v[j][1], v[j][2], v[j][3]); }
        float a[16];
#pragma unroll
        for (int g = 0; g < 16; ++g) a[g] = 0.f;
#pragma unroll
        for (int j = 0; j < 4; ++j) {
#pragma unroll
            for (int g = 0; g < 16; ++g) { const f32x4 w = *(const LAS f32x4*)(wg + g * 1024 + 4 * lane + 256 * j); a[g] = fmaf(v[j][3], w[3], fmaf(v[j][2], w[2], fmaf(v[j][1], w[1], fmaf(v[j][0], w[0], a[g])))); }
            asm volatile("" ::: "memory"); }
        { const bool u5 = (lane & 32) != 0, u4 = (lane & 16) != 0, u3 = (lane & 8) != 0, u2 = (lane & 4) != 0;
          float b8[8], b4[4], b2[2];
#pragma unroll
          for (int g = 0; g < 8; ++g) { const float send = u5 ? a[g] : a[g + 8], keep = u5 ? a[g + 8] : a[g]; b8[g] = keep + __shfl_xor(send, 32); }
#pragma unroll
          for (int g = 0; g < 4; ++g) { const float send = u4 ? b8[g] : b8[g + 4], keep = u4 ? b8[g + 4] : b8[g]; b4[g] = keep + __shfl_xor(send, 16); }
#pragma unroll
          for (int g = 0; g < 2; ++g) { const float send = u3 ? b4[g] : b4[g + 2], keep = u3 ? b4[g + 2] : b4[g]; b2[g] = keep + __shfl_xor(send, 8); }
          float val; { const float send = u2 ? b2[0] : b2[1], keep = u2 ? b2[1] : b2[0]; val = keep + __shfl_xor(send, 4); }
          val += __shfl_xor(val, 2); val += __shfl_xor(val, 1);
          const int gsel = ((lane >> 5) & 1) * 8 + ((lane >> 4) & 1) * 4 + ((lane >> 3) & 1) * 2 + ((lane >> 2) & 1);
          if ((lane & 3) == 0) {
              val += p.gate_b[gsel]; const int type = gsel >> 2; if (type & 1) val = log_sigmoidf_(val);
              GT[(size_t)m * 16 + gsel] = val; } }
    }
}

__device__ __forceinline__ void phase_mlstm_naive(const Params& p, LAS unsigned char* lds_, int item) {
    const int tid = otid(); float* lds = (float*)(unsigned char*)lds_;
    const int dvh = item & 1, dir = (item >> 1) & 1, h = (item >> 2) & 3, b = item >> 4;
    const int dvl = tid >> 2, kq = tid & 3;
    float* Ks = lds; float* Qs = lds + 4096; float* Vs = lds + 8192; float* gi = lds + 12288; float* gf = gi + 32;
    const bf16_t* MQ = (const bf16_t*)(p.ws + WS_MQ); const bf16_t* MK = (const bf16_t*)(p.ws + WS_MK); const bf16_t* MV = (const bf16_t*)(p.ws + WS_MV);
    const float* GT = (const float*)(p.ws + WS_GT); bf16_t* H = (bf16_t*)(p.ws + (dir ? WS_HB : WS_HF));
    float C[32], nn[32];
#pragma unroll
    for (int r = 0; r < 32; ++r) { C[r] = 0.f; nn[r] = 0.f; }
    for (int s0 = 0; s0 < KVLEN; s0 += 32) {
        const bool latent = s0 >= CTX;
        __syncthreads();
        {
            const int j = tid >> 4, c8 = (tid & 15) * 8; const int s = s0 + j;
            const int m = latent ? b * SEQ + (dir ? SEQ - 1 - (s - CTX) : s - CTX) : TL + b * CTX + (dir ? CTX - 1 - s : s);
            const bf16x8 kv = *(const bf16x8*)(MK + (size_t)m * 512 + h * 128 + c8);
            const bf16x8 vv = *(const bf16x8*)(MV + (size_t)m * 1024 + h * 256 + dvh * 128 + c8);
#pragma unroll
            for (int i = 0; i < 8; ++i) { Ks[j * 128 + c8 + i] = bf2f((bf16_t)kv[i]); Vs[j * 128 + c8 + i] = bf2f((bf16_t)vv[i]); }
            if (latent) { const bf16x8 qv = *(const bf16x8*)(MQ + (size_t)m * 512 + h * 128 + c8);
#pragma unroll
                for (int i = 0; i < 8; ++i) Qs[j * 128 + c8 + i] = bf2f((bf16_t)qv[i]); }
            if ((tid & 15) == 0) { gi[j] = GT[(size_t)m * 16 + dir * 8 + h]; gf[j] = GT[(size_t)m * 16 + dir * 8 + 4 + h]; }
        }
        __syncthreads();
        for (int j = 0; j < 32; ++j) {
            const float f = __expf(gf[j]), ig = __expf(gi[j]); const float v = Vs[j * 128 + dvl];
            float num = 0.f, den = 0.f;
            const f32x4* kp = (const f32x4*)(Ks + j * 128 + kq * 32); const f32x4* qp = (const f32x4*)(Qs + j * 128 + kq * 32);
#pragma unroll
            for (int r4 = 0; r4 < 8; ++r4) { const f32x4 k4 = kp[r4]; f32x4 q4 = {0.f, 0.f, 0.f, 0.f}; if (latent) q4 = qp[r4];
#pragma unroll
                for (int i = 0; i < 4; ++i) { const int r = r4 * 4 + i; const float ik = ig * k4[i]; C[r] = f * C[r] + ik * v; nn[r] = f * nn[r] + ik; num += q4[i] * C[r]; den += q4[i] * nn[r]; } }
            if (latent) {
                num += __shfl_xor(num, 1); num += __shfl_xor(num, 2); den += __shfl_xor(den, 1); den += __shfl_xor(den, 2);
                if (kq == 0) { const int s = s0 + j; const int m = b * SEQ + (dir ? SEQ - 1 - (s - CTX) : s - CTX);
                    const float hv = num / fmaxf(fabsf(den), 1.0f);
                    H[(size_t)m * 1024 + h * 256 + dvh * 128 + dvl] = (bf16_t)(cvt_pk_bf16(hv, 0.f) & 0xffffu); }
            }
        }
    }
    __syncthreads();
}

namespace mls {
#define KSWZ(row, colB) ((row) * 256 + ((colB) ^ (((row) & 7) << 4)))
#define SBAR() __builtin_amdgcn_sched_barrier(0)
using att::crow; using att::cvtpk; using att::v_st; using att::v_rd_base; using att::v_rd_off; using att::tr_read;
constexpr int L_KSW = 0, L_KV = 32768, L_V = 65536, L_CT = 98304, L_F = 114688;
__device__ __forceinline__ float swap_add(float v) { auto rr = __builtin_amdgcn_permlane32_swap(__float_as_uint(v), __float_as_uint(v), false, false); return __uint_as_float(rr[0]) + __uint_as_float(rr[1]); }
#define TRPK(L, H) (bf16x8){L[0], L[1], L[2], L[3], H[0], H[1], H[2], H[3]}
__device__ __forceinline__ void mlstm_item(const Params& p, LAS unsigned char* lds_, int item) {
    char* lds = (char*)(unsigned char*)lds_;
    const int tid = otid(), wid = __builtin_amdgcn_readfirstlane(tid >> 6), lane = tid & 63, r32 = lane & 31, hi = lane >> 5;
    const int dvq = item & 3, dir = (item >> 2) & 1, h = (item >> 3) & 3, b = item >> 5;
    const int vh = wid >> 2, rb = vh ? 3 - (wid & 3) : (wid & 3);
    float* fa = (float*)(lds + L_F); float* a_ = fa; float* bco = fa + 128; float* w_ = fa + 256; float* wint = fa + 384; float* nvec = fa + 512; float* npart = fa + 640; float* gsc = fa + 1408; bf16_t* nb = (bf16_t*)(fa + 1416);
    const bf16_t* MQ = (const bf16_t*)(p.ws + WS_MQ); const bf16_t* MK = (const bf16_t*)(p.ws + WS_MK); const bf16_t* MV = (const bf16_t*)(p.ws + WS_MV);
    const float* GT = (const float*)(p.ws + WS_GT); bf16_t* H = (bf16_t*)(p.ws + (dir ? WS_HB : WS_HF));
    f32x16 Cacc = {};
    { u32x4 z = {0u, 0u, 0u, 0u}; *(u32x4*)(lds + L_CT + tid * 32) = z; *(u32x4*)(lds + L_CT + tid * 32 + 16) = z; if (tid < 128) { nvec[tid] = 0.f; nb[tid] = 0; } }
    const int tid_outer = tid;
    bf16x8 kreg[4], vreg[2], qnx[8]; float gi0 = 0.f, glf0 = 0.f, gi1 = 0.f, glf1 = 0.f;
#define MROW0(cc_) ((cc_) >= 2 ? b * SEQ + (dir ? 33 - (cc_) : (cc_) - 2) * 128 : TL + b * CTX + (dir ? 1 - (cc_) : (cc_)) * 128)
#define LOADS(cn_, T_) do { const int mr_ = MROW0(cn_); const int ln_ = (T_) & 63; \
        _Pragma("unroll") for (int i = 0; i < 4; ++i) { const int pc = (T_) + 512 * i, pr = pc >> 4, c8 = (pc & 15) * 8; kreg[i] = *(const bf16x8*)(MK + (size_t)(mr_ + (dir ? 127 - pr : pr)) * 512 + h * 128 + c8); } \
        _Pragma("unroll") for (int i = 0; i < 2; ++i) { const int pc = (T_) + 512 * i, pr = pc >> 3, c8 = (pc & 7) * 8; vreg[i] = *(const bf16x8*)(MV + (size_t)(mr_ + (dir ? 127 - pr : pr)) * 1024 + h * 256 + dvq * 64 + c8); } \
        if ((cn_) >= 2) { const int pr = rb * 32 + (ln_ & 31); const bf16_t* qp = MQ + (size_t)(mr_ + (dir ? 127 - pr : pr)) * 512 + h * 128 + (ln_ >> 5) * 8; \
            _Pragma("unroll") for (int d0 = 0; d0 < 8; ++d0) qnx[d0] = *(const bf16x8*)(qp + d0 * 16); } \
        else { _Pragma("unroll") for (int d0 = 0; d0 < 8; ++d0) qnx[d0] = bf16x8{}; } \
        if (wid == 0) { const int p0 = 2 * ln_, p1 = 2 * ln_ + 1; const size_t m0 = (size_t)(mr_ + (dir ? 127 - p0 : p0)) * 16, m1 = (size_t)(mr_ + (dir ? 127 - p1 : p1)) * 16; \
            gi0 = GT[m0 + dir * 8 + h]; glf0 = GT[m0 + dir * 8 + 4 + h]; gi1 = GT[m1 + dir * 8 + h]; glf1 = GT[m1 + dir * 8 + 4 + h]; } } while (0)
    LOADS(0, tid_outer);
    for (int c = 0; c < 34; ++c) {
        int tid = tid_outer; asm volatile("" : "+v"(tid));
        const int lane = tid & 63, r32 = lane & 31, hi = lane >> 5;
        const int vbV = (int)(uintptr_t)(lds + L_V) + v_rd_base(lane), vbK = (int)(uintptr_t)(lds + L_KV) + v_rd_base(lane);
        const bool latent = c >= 2;
        const int mrow0 = MROW0(c);
        bf16x8 qr[8];
        if (wid == 0) {
            const int p0 = 2 * lane, p1 = 2 * lane + 1;
            const float i0 = gi0, lf0 = glf0, i1 = gi1, lf1 = glf1;
            float incl = lf0 + lf1;
#pragma unroll
            for (int o = 1; o < 64; o <<= 1) { const float t = __shfl_up(incl, o); if (lane >= o) incl += t; }
            const float F1 = incl, F0 = incl - lf1, Ftot = __shfl(incl, 63);
            a_[p0] = F0; a_[p1] = F1; bco[p0] = i0 - F0; bco[p1] = i1 - F1; wint[p0] = __expf(F0); wint[p1] = __expf(F1);
            w_[p0] = __expf(Ftot - F0 + i0); w_[p1] = __expf(Ftot - F1 + i1); if (lane == 0) gsc[0] = __expf(Ftot);
        }
        __syncthreads();
#pragma unroll
        for (int i = 0; i < 4; ++i) { const int pc = tid + 512 * i, pr = pc >> 4, c8 = (pc & 15) * 8;
            *(bf16x8*)(lds + L_KSW + KSWZ(pr, c8 * 2)) = kreg[i]; *(bf16x8*)(lds + L_KV + (pr >> 6) * 16384 + v_st(pr & 63, c8)) = kreg[i]; }
#pragma unroll
        for (int i = 0; i < 2; ++i) { const int pc = tid + 512 * i, pr = pc >> 3, c8 = (pc & 7) * 8; const float ws_ = w_[pr];
            *(bf16x8*)(lds + L_V + (pr >> 6) * 16384 + v_st(pr & 63, c8)) = vreg[i];
            u32x4 sv; const u32x4 raw = *reinterpret_cast<const u32x4*>(&vreg[i]);
            sv.x = cvtpk(bf_lo(raw.x) * ws_, bf_hi(raw.x) * ws_); sv.y = cvtpk(bf_lo(raw.y) * ws_, bf_hi(raw.y) * ws_); sv.z = cvtpk(bf_lo(raw.z) * ws_, bf_hi(raw.z) * ws_); sv.w = cvtpk(bf_lo(raw.w) * ws_, bf_hi(raw.w) * ws_);
            *(u32x4*)(lds + L_V + (pr >> 6) * 16384 + v_st(pr & 63, 64 + c8)) = sv; }
#pragma unroll
        for (int d0 = 0; d0 < 8; ++d0) qr[d0] = qnx[d0];
        __syncthreads();
        if (c + 1 < 34) LOADS(c + 1, tid);
        const float g = gsc[0];
        if (latent) {
            const int qidx = rb * 32 + r32;
            f32x16 o = {}, dn = {};
#pragma unroll
            for (int d0 = 0; d0 < 8; ++d0) { const bf16x8 cf = *(const bf16x8*)(lds + L_CT + KSWZ(32 * vh + r32, (d0 * 16 + hi * 8) * 2)); const bf16x8 nf = *(const bf16x8*)(nb + d0 * 16 + hi * 8);
                o = __builtin_amdgcn_mfma_f32_32x32x16_bf16(qr[d0], cf, o, 0, 0, 0); dn = __builtin_amdgcn_mfma_f32_32x32x16_bf16(qr[d0], nf, dn, 0, 0, 0); }
#pragma unroll
            for (int g4 = 0; g4 < 4; ++g4) { const f32x4 wi = *(const f32x4*)(wint + rb * 32 + 8 * g4 + 4 * hi);
#pragma unroll
                for (int i = 0; i < 4; ++i) { o[g4 * 4 + i] *= wi[i]; dn[g4 * 4 + i] *= wi[i]; } }
            const bf16x8 ones = {0x3f80, 0x3f80, 0x3f80, 0x3f80, 0x3f80, 0x3f80, 0x3f80, 0x3f80};
            const float aq = a_[qidx];
            for (int jt = 0; jt <= (rb >> 1); ++jt) {
                f32x16 p0 = {}, p1 = {};
#pragma unroll
                for (int d0 = 0; d0 < 8; ++d0) { const int cbb = (d0 * 16 + hi * 8) * 2;
                    const bf16x8 b0 = *(const bf16x8*)(lds + L_KSW + KSWZ(64 * jt + r32, cbb)), b1 = *(const bf16x8*)(lds + L_KSW + KSWZ(64 * jt + 32 + r32, cbb));
                    p0 = __builtin_amdgcn_mfma_f32_32x32x16_bf16(b0, qr[d0], p0, 0, 0, 0); p1 = __builtin_amdgcn_mfma_f32_32x32x16_bf16(b1, qr[d0], p1, 0, 0, 0); }
#pragma unroll
                for (int g4 = 0; g4 < 4; ++g4) { const int k0 = 64 * jt + 8 * g4 + 4 * hi; const f32x4 bb0 = *(const f32x4*)(bco + k0), bb1 = *(const f32x4*)(bco + k0 + 32);
#pragma unroll
                    for (int i = 0; i < 4; ++i) { const int r = g4 * 4 + i;
                        const float e0 = __expf(aq + bb0[i]), e1 = __expf(aq + bb1[i]);
                        p0[r] = (k0 + i <= qidx) ? p0[r] * e0 : 0.f; p1[r] = (k0 + 32 + i <= qidx) ? p1[r] * e1 : 0.f; } }
                bf16x8 pa0, pa1, pa2, pa3;
#define PK4(P, BASE, OUT) do { unsigned a0 = cvtpk(P[BASE + 0], P[BASE + 1]), a1 = cvtpk(P[BASE + 2], P[BASE + 3]);   \
    unsigned b0_ = cvtpk(P[BASE + 4], P[BASE + 5]), b1_ = cvtpk(P[BASE + 6], P[BASE + 7]);                              \
    auto r0 = __builtin_amdgcn_permlane32_swap(a0, b0_, false, false); auto r1 = __builtin_amdgcn_permlane32_swap(a1, b1_, false, false); \
    u32x4 w4 = {r0[0], r1[0], r0[1], r1[1]}; OUT = *reinterpret_cast<bf16x8*>(&w4); } while (0)
                PK4(p0, 0, pa0); PK4(p0, 8, pa1); PK4(p1, 0, pa2); PK4(p1, 8, pa3);
#undef PK4
                const int vb = vbV + jt * 16384 + vh * 512;
                const s16x4 l0 = tr_read<v_rd_off(0, 0, 0)>(vb), h0 = tr_read<v_rd_off(0, 0, 1)>(vb), l1 = tr_read<v_rd_off(0, 1, 0)>(vb), h1 = tr_read<v_rd_off(0, 1, 1)>(vb);
                const s16x4 l2 = tr_read<v_rd_off(0, 2, 0)>(vb), h2 = tr_read<v_rd_off(0, 2, 1)>(vb), l3 = tr_read<v_rd_off(0, 3, 0)>(vb), h3 = tr_read<v_rd_off(0, 3, 1)>(vb);
                asm volatile("s_waitcnt lgkmcnt(0)" ::: "memory"); SBAR();
                o = __builtin_amdgcn_mfma_f32_32x32x16_bf16(pa0, TRPK(l0, h0), o, 0, 0, 0); o = __builtin_amdgcn_mfma_f32_32x32x16_bf16(pa1, TRPK(l1, h1), o, 0, 0, 0);
                o = __builtin_amdgcn_mfma_f32_32x32x16_bf16(pa2, TRPK(l2, h2), o, 0, 0, 0); o = __builtin_amdgcn_mfma_f32_32x32x16_bf16(pa3, TRPK(l3, h3), o, 0, 0, 0);
                dn = __builtin_amdgcn_mfma_f32_32x32x16_bf16(pa0, ones, dn, 0, 0, 0); dn = __builtin_amdgcn_mfma_f32_32x32x16_bf16(pa1, ones, dn, 0, 0, 0);
                dn = __builtin_amdgcn_mfma_f32_32x32x16_bf16(pa2, ones, dn, 0, 0, 0); dn = __builtin_amdgcn_mfma_f32_32x32x16_bf16(pa3, ones, dn, 0, 0, 0);
            }
#pragma unroll
            for (int g4 = 0; g4 < 4; ++g4)
#pragma unroll
                for (int i = 0; i < 4; ++i) { const int r = g4 * 4 + i, pr = rb * 32 + 8 * g4 + 4 * hi + i;
                    const float hv = o[r] * __builtin_amdgcn_rcpf(fmaxf(fabsf(dn[r]), 1.0f));
                    H[(size_t)(mrow0 + (dir ? 127 - pr : pr)) * 1024 + h * 256 + dvq * 64 + vh * 32 + r32] = (bf16_t)(cvtpk(hv, 0.f) & 0xffffu); }
        }
#pragma unroll
        for (int r = 0; r < 16; ++r) Cacc[r] *= g;
#pragma unroll
        for (int jt = 0; jt < 2; ++jt) {
            const int va = vbV + jt * 16384 + (2 + vh) * 512, ka = vbK + jt * 16384 + rb * 512;
            const s16x4 al0 = tr_read<v_rd_off(0, 0, 0)>(va), ah0 = tr_read<v_rd_off(0, 0, 1)>(va), al1 = tr_read<v_rd_off(0, 1, 0)>(va), ah1 = tr_read<v_rd_off(0, 1, 1)>(va);
            const s16x4 al2 = tr_read<v_rd_off(0, 2, 0)>(va), ah2 = tr_read<v_rd_off(0, 2, 1)>(va), al3 = tr_read<v_rd_off(0, 3, 0)>(va), ah3 = tr_read<v_rd_off(0, 3, 1)>(va);
            const s16x4 bl0 = tr_read<v_rd_off(0, 0, 0)>(ka), bh0 = tr_read<v_rd_off(0, 0, 1)>(ka), bl1 = tr_read<v_rd_off(0, 1, 0)>(ka), bh1 = tr_read<v_rd_off(0, 1, 1)>(ka);
            const s16x4 bl2 = tr_read<v_rd_off(0, 2, 0)>(ka), bh2 = tr_read<v_rd_off(0, 2, 1)>(ka), bl3 = tr_read<v_rd_off(0, 3, 0)>(ka), bh3 = tr_read<v_rd_off(0, 3, 1)>(ka);
            asm volatile("s_waitcnt lgkmcnt(0)" ::: "memory"); SBAR();
            Cacc = __builtin_amdgcn_mfma_f32_32x32x16_bf16(TRPK(al0, ah0), TRPK(bl0, bh0), Cacc, 0, 0, 0); Cacc = __builtin_amdgcn_mfma_f32_32x32x16_bf16(TRPK(al1, ah1), TRPK(bl1, bh1), Cacc, 0, 0, 0);
            Cacc = __builtin_amdgcn_mfma_f32_32x32x16_bf16(TRPK(al2, ah2), TRPK(bl2, bh2), Cacc, 0, 0, 0); Cacc = __builtin_amdgcn_mfma_f32_32x32x16_bf16(TRPK(al3, ah3), TRPK(bl3, bh3), Cacc, 0, 0, 0);
        }
        { const int k = tid & 127, sq = tid >> 7; float part = 0.f;
#pragma unroll 8
            for (int s = sq * 32; s < sq * 32 + 32; ++s) part += w_[s] * bf2f(*(const bf16_t*)(lds + L_KSW + KSWZ(s, 2 * k)));
            npart[sq * 128 + k] = part; }
        __syncthreads();
#pragma unroll
        for (int r = 0; r < 16; ++r) *(bf16_t*)(lds + L_CT + KSWZ(32 * vh + crow(r, hi), 2 * (32 * rb + r32))) = (bf16_t)(cvtpk(Cacc[r], 0.f) & 0xffffu);
        if (tid < 128) { const float nn = g * nvec[tid] + ((npart[tid] + npart[128 + tid]) + (npart[256 + tid] + npart[384 + tid])); nvec[tid] = nn; nb[tid] = (bf16_t)(cvtpk(nn, 0.f) & 0xffffu); }
    }
    __syncthreads();
}
#undef TRPK
#undef KSWZ
#undef SBAR
#undef LOADS
#undef MROW0
}

namespace mls2 {
#define KSWZ(row, colB) ((row) * 256 + ((colB) ^ (((row) & 15) << 4)))
#define SBAR() __builtin_amdgcn_sched_barrier(0)
using att::crow; using att::cvtpk; using att::v_st; using att::v_rd_base; using att::v_rd_off; using att::tr_read;
constexpr int L_KSW = 0, L_KW = 32768, L_V = 65536, L_CT = 98304, L_F = 131072;
#define TRPK(L, H) (bf16x8){L[0], L[1], L[2], L[3], H[0], H[1], H[2], H[3]}
#define TR8(dst, base) do { dst[0] = tr_read<v_rd_off(0, 0, 0)>(base); dst[1] = tr_read<v_rd_off(0, 0, 1)>(base); dst[2] = tr_read<v_rd_off(0, 1, 0)>(base); dst[3] = tr_read<v_rd_off(0, 1, 1)>(base); \
    dst[4] = tr_read<v_rd_off(0, 2, 0)>(base); dst[5] = tr_read<v_rd_off(0, 2, 1)>(base); dst[6] = tr_read<v_rd_off(0, 3, 0)>(base); dst[7] = tr_read<v_rd_off(0, 3, 1)>(base); } while (0)
__device__ __forceinline__ void mlstm_item(const Params& p, LAS unsigned char* lds_, int item) {
    char* lds = (char*)(unsigned char*)lds_;
    const int tid = otid(), wid = __builtin_amdgcn_readfirstlane(tid >> 6);
    const int dvh = item & 1, dir = (item >> 1) & 1, h = (item >> 2) & 3, b = item >> 4;
    const int vh = wid >> 2, rb = vh ? 3 - (wid & 3) : (wid & 3);
    float* fa = (float*)(lds + L_F); float* a_ = fa; float* bco = fa + 128; float* w_ = fa + 256; float* wint = fa + 384; float* nvec = fa + 512; float* npart = fa + 640; float* gsc = fa + 1152; bf16_t* nb = (bf16_t*)(fa + 1160);
    const bf16_t* MQ = (const bf16_t*)(p.ws + WS_MQ); const bf16_t* MK = (const bf16_t*)(p.ws + WS_MK); const bf16_t* MV = (const bf16_t*)(p.ws + WS_MV);
    const float* GT = (const float*)(p.ws + WS_GT); bf16_t* H = (bf16_t*)(p.ws + (dir ? WS_HB : WS_HF));
    f32x16 Cacc0 = {}, Cacc1 = {};
    { u32x4 z = {0u, 0u, 0u, 0u};
#pragma unroll
      for (int i = 0; i < 4; ++i) *(u32x4*)(lds + L_CT + tid * 64 + i * 16) = z;
      if (tid < 128) { nvec[tid] = 0.f; nb[tid] = 0; } }
    const int tid_outer = tid;
    bf16x8 kreg[4], vreg[4]; float gi0 = 0.f, glf0 = 0.f, gi1 = 0.f, glf1 = 0.f;
#define MROW0(cc_) ((cc_) >= 2 ? b * SEQ + (dir ? 33 - (cc_) : (cc_) - 2) * 128 : TL + b * CTX + (dir ? 1 - (cc_) : (cc_)) * 128)
#define LOADS(cn_, T_) do { const int mr_ = MROW0(cn_); const int ln_ = (T_) & 63; \
        _Pragma("unroll") for (int i = 0; i < 4; ++i) { const int pc = (T_) + 512 * i, pr = pc >> 4, c8 = (pc & 15) * 8; const size_t rw_ = (size_t)(mr_ + (dir ? 127 - pr : pr)); \
            kreg[i] = *(const bf16x8*)(MK + rw_ * 512 + h * 128 + c8); vreg[i] = *(const bf16x8*)(MV + rw_ * 1024 + h * 256 + dvh * 128 + c8); } \
        if (wid == 0) { const int p0 = 2 * ln_, p1 = 2 * ln_ + 1; const size_t m0 = (size_t)(mr_ + (dir ? 127 - p0 : p0)) * 16, m1 = (size_t)(mr_ + (dir ? 127 - p1 : p1)) * 16; \
            gi0 = GT[m0 + dir * 8 + h]; glf0 = GT[m0 + dir * 8 + 4 + h]; gi1 = GT[m1 + dir * 8 + h]; glf1 = GT[m1 + dir * 8 + 4 + h]; } } while (0)
    LOADS(0, tid_outer);
    for (int c = 0; c < 34; ++c) {
        int tid = tid_outer; asm volatile("" : "+v"(tid));
        const int lane = tid & 63, r32 = lane & 31, hi = lane >> 5;
        const int vbV = (int)(uintptr_t)(lds + L_V) + v_rd_base(lane), vbK = (int)(uintptr_t)(lds + L_KW) + v_rd_base(lane);
        const bool latent = c >= 2;
        const int mrow0 = MROW0(c);
        bf16x8 qr[8];
        if (latent) { const int pr = rb * 32 + r32; const bf16_t* qp = MQ + (size_t)(mrow0 + (dir ? 127 - pr : pr)) * 512 + h * 128 + hi * 8;
#pragma unroll
            for (int d0 = 0; d0 < 8; ++d0) qr[d0] = *(const bf16x8*)(qp + d0 * 16); }
        else {
#pragma unroll
            for (int d0 = 0; d0 < 8; ++d0) qr[d0] = bf16x8{};
        }
        if (wid == 0) {
            const int p0 = 2 * lane, p1 = 2 * lane + 1;
            const float i0 = gi0, lf0 = glf0, i1 = gi1, lf1 = glf1;
            float incl = lf0 + lf1;
#pragma unroll
            for (int o = 1; o < 64; o <<= 1) { const float t = __shfl_up(incl, o); if (lane >= o) incl += t; }
            const float F1 = incl, F0 = incl - lf1, Ftot = __shfl(incl, 63);
            a_[p0] = F0; a_[p1] = F1; bco[p0] = i0 - F0; bco[p1] = i1 - F1; wint[p0] = __expf(F0); wint[p1] = __expf(F1);
            w_[p0] = __expf(Ftot - F0 + i0); w_[p1] = __expf(Ftot - F1 + i1); if (lane == 0) gsc[0] = __expf(Ftot);
        }
        __syncthreads();
#pragma unroll
        for (int i = 0; i < 4; ++i) { const int pc = tid + 512 * i, pr = pc >> 4, c8 = (pc & 15) * 8; const float ws_ = w_[pr];
            *(bf16x8*)(lds + L_KSW + KSWZ(pr, c8 * 2)) = kreg[i];
            u32x4 sk; const u32x4 raw = *reinterpret_cast<const u32x4*>(&kreg[i]);
            sk.x = cvtpk(bf_lo(raw.x) * ws_, bf_hi(raw.x) * ws_); sk.y = cvtpk(bf_lo(raw.y) * ws_, bf_hi(raw.y) * ws_); sk.z = cvtpk(bf_lo(raw.z) * ws_, bf_hi(raw.z) * ws_); sk.w = cvtpk(bf_lo(raw.w) * ws_, bf_hi(raw.w) * ws_);
            *(u32x4*)(lds + L_KW + (pr >> 6) * 16384 + v_st(pr & 63, c8)) = sk;
            *(bf16x8*)(lds + L_V + (pr >> 6) * 16384 + v_st(pr & 63, c8)) = vreg[i]; }
        __syncthreads();
        if (c + 1 < 34) LOADS(c + 1, tid);
        const float g = gsc[0];
        if (latent) {
            const int qidx = rb * 32 + r32;
            f32x16 o0 = {}, o1 = {}, dn = {};
#pragma unroll
            for (int dh = 0; dh < 2; ++dh) {
                bf16x8 c0[4], c1[4], nf[4];
#pragma unroll
                for (int d = 0; d < 4; ++d) { const int d0 = dh * 4 + d, cbb = (d0 * 16 + hi * 8) * 2;
                    c0[d] = *(const bf16x8*)(lds + L_CT + KSWZ(64 * vh + r32, cbb)); c1[d] = *(const bf16x8*)(lds + L_CT + KSWZ(64 * vh + 32 + r32, cbb)); nf[d] = *(const bf16x8*)(nb + d0 * 16 + hi * 8); }
                SBAR();
#pragma unroll
                for (int d = 0; d < 4; ++d) { const int d0 = dh * 4 + d;
                    o0 = __builtin_amdgcn_mfma_f32_32x32x16_bf16(qr[d0], c0[d], o0, 0, 0, 0); o1 = __builtin_amdgcn_mfma_f32_32x32x16_bf16(qr[d0], c1[d], o1, 0, 0, 0); dn = __builtin_amdgcn_mfma_f32_32x32x16_bf16(qr[d0], nf[d], dn, 0, 0, 0); }
                SBAR(); }
#pragma unroll
            for (int g4 = 0; g4 < 4; ++g4) { const f32x4 wi = *(const f32x4*)(wint + rb * 32 + 8 * g4 + 4 * hi);
#pragma unroll
                for (int i = 0; i < 4; ++i) { o0[g4 * 4 + i] *= wi[i]; o1[g4 * 4 + i] *= wi[i]; dn[g4 * 4 + i] *= wi[i]; } }
            const bf16x8 ones = {0x3f80, 0x3f80, 0x3f80, 0x3f80, 0x3f80, 0x3f80, 0x3f80, 0x3f80};
            const float aq = a_[qidx];
            for (int jt = 0; jt <= (rb >> 1); ++jt) {
                f32x16 p0 = {}, p1 = {};
#pragma unroll
                for (int dh = 0; dh < 2; ++dh) {
                    bf16x8 b0[4], b1[4];
#pragma unroll
                    for (int d = 0; d < 4; ++d) { const int cbb = ((dh * 4 + d) * 16 + hi * 8) * 2;
                        b0[d] = *(const bf16x8*)(lds + L_KSW + KSWZ(64 * jt + r32, cbb)); b1[d] = *(const bf16x8*)(lds + L_KSW + KSWZ(64 * jt + 32 + r32, cbb)); }
                    SBAR();
#pragma unroll
                    for (int d = 0; d < 4; ++d) { p0 = __builtin_amdgcn_mfma_f32_32x32x16_bf16(b0[d], qr[dh * 4 + d], p0, 0, 0, 0); p1 = __builtin_amdgcn_mfma_f32_32x32x16_bf16(b1[d], qr[dh * 4 + d], p1, 0, 0, 0); }
                    SBAR(); }
#pragma unroll
                for (int g4 = 0; g4 < 4; ++g4) { const int k0 = 64 * jt + 8 * g4 + 4 * hi; const f32x4 bb0 = *(const f32x4*)(bco + k0), bb1 = *(const f32x4*)(bco + k0 + 32);
#pragma unroll
                    for (int i = 0; i < 4; ++i) { const int r = g4 * 4 + i;
                        const float e0 = __expf(aq + bb0[i]), e1 = __expf(aq + bb1[i]);
                        p0[r] = (k0 + i <= qidx) ? p0[r] * e0 : 0.f; p1[r] = (k0 + 32 + i <= qidx) ? p1[r] * e1 : 0.f; } }
                bf16x8 pa0, pa1, pa2, pa3;
#define PK4(P, BASE, OUT) do { unsigned a0 = cvtpk(P[BASE + 0], P[BASE + 1]), a1 = cvtpk(P[BASE + 2], P[BASE + 3]);   \
    unsigned b0_ = cvtpk(P[BASE + 4], P[BASE + 5]), b1_ = cvtpk(P[BASE + 6], P[BASE + 7]);                              \
    auto r0 = __builtin_amdgcn_permlane32_swap(a0, b0_, false, false); auto r1 = __builtin_amdgcn_permlane32_swap(a1, b1_, false, false); \
    u32x4 w4 = {r0[0], r1[0], r0[1], r1[1]}; OUT = *reinterpret_cast<bf16x8*>(&w4); } while (0)
                PK4(p0, 0, pa0); PK4(p0, 8, pa1); PK4(p1, 0, pa2); PK4(p1, 8, pa3);
#undef PK4
                s16x4 va[8], vc[8];
                const int vb = vbV + jt * 16384 + (2 * vh) * 512;
                TR8(va, vb); TR8(vc, vb + 512);
                asm volatile("s_waitcnt lgkmcnt(0)" ::: "memory"); SBAR();
                o0 = __builtin_amdgcn_mfma_f32_32x32x16_bf16(pa0, TRPK(va[0], va[1]), o0, 0, 0, 0); o0 = __builtin_amdgcn_mfma_f32_32x32x16_bf16(pa1, TRPK(va[2], va[3]), o0, 0, 0, 0);
                o0 = __builtin_amdgcn_mfma_f32_32x32x16_bf16(pa2, TRPK(va[4], va[5]), o0, 0, 0, 0); o0 = __builtin_amdgcn_mfma_f32_32x32x16_bf16(pa3, TRPK(va[6], va[7]), o0, 0, 0, 0);
                o1 = __builtin_amdgcn_mfma_f32_32x32x16_bf16(pa0, TRPK(vc[0], vc[1]), o1, 0, 0, 0); o1 = __builtin_amdgcn_mfma_f32_32x32x16_bf16(pa1, TRPK(vc[2], vc[3]), o1, 0, 0, 0);
                o1 = __builtin_amdgcn_mfma_f32_32x32x16_bf16(pa2, TRPK(vc[4], vc[5]), o1, 0, 0, 0); o1 = __builtin_amdgcn_mfma_f32_32x32x16_bf16(pa3, TRPK(vc[6], vc[7]), o1, 0, 0, 0);
                dn = __builtin_amdgcn_mfma_f32_32x32x16_bf16(pa0, ones, dn, 0, 0, 0); dn = __builtin_amdgcn_mfma_f32_32x32x16_bf16(pa1, ones, dn, 0, 0, 0);
                dn = __builtin_amdgcn_mfma_f32_32x32x16_bf16(pa2, ones, dn, 0, 0, 0); dn = __builtin_amdgcn_mfma_f32_32x32x16_bf16(pa3, ones, dn, 0, 0, 0);
            }
#define T4X(A, B, CTRL, ODD) do { const float s_ = (ODD) ? A : B; const float r_ = __builtin_bit_cast(float, __builtin_amdgcn_update_dpp(0, __builtin_bit_cast(int, s_), CTRL, 0xf, 0xf, false)); \
        A = (ODD) ? r_ : A; B = (ODD) ? B : r_; } while (0)
#define T4(X0, X1, X2, X3) do { T4X(X0, X1, 0xB1, q1_); T4X(X2, X3, 0xB1, q1_); T4X(X0, X2, 0x4E, q2_); T4X(X1, X3, 0x4E, q2_); } while (0)
            { const bool q1_ = (lane & 1) != 0, q2_ = (lane & 2) != 0; const int q = lane & 3;
#pragma unroll
              for (int g4 = 0; g4 < 4; ++g4) {
                float x[4], z[4];
#pragma unroll
                for (int i = 0; i < 4; ++i) { const int r = g4 * 4 + i; const float rd = __builtin_amdgcn_rcpf(fmaxf(fabsf(dn[r]), 1.0f)); x[i] = o0[r] * rd; z[i] = o1[r] * rd; }
                T4(x[0], x[1], x[2], x[3]); T4(z[0], z[1], z[2], z[3]);
                const int pr = rb * 32 + 8 * g4 + 4 * hi + q;
                bf16_t* hp = H + (size_t)(mrow0 + (dir ? 127 - pr : pr)) * 1024 + h * 256 + dvh * 128 + vh * 64 + (r32 & ~3);
                u32x2 w0, w1; w0.x = cvtpk(x[0], x[1]); w0.y = cvtpk(x[2], x[3]); w1.x = cvtpk(z[0], z[1]); w1.y = cvtpk(z[2], z[3]);
                *(u32x2*)hp = w0; *(u32x2*)(hp + 32) = w1; } }
#undef T4
#undef T4X
        }
#pragma unroll
        for (int r = 0; r < 16; ++r) { Cacc0[r] *= g; Cacc1[r] *= g; }
        f32x16 nacc = {};
        const bf16x8 ones1 = {0x3f80, 0x3f80, 0x3f80, 0x3f80, 0x3f80, 0x3f80, 0x3f80, 0x3f80};
#pragma unroll
        for (int jt = 0; jt < 2; ++jt) {
            s16x4 a0[8], a1[8], kb[8];
            const int va_ = vbV + jt * 16384 + (2 * vh) * 512, ka_ = vbK + jt * 16384 + rb * 512;
            TR8(kb, ka_); TR8(a0, va_); TR8(a1, va_ + 512);
            asm volatile("s_waitcnt lgkmcnt(0)" ::: "memory"); SBAR();
#pragma unroll
            for (int k = 0; k < 4; ++k) { const bf16x8 bf = TRPK(kb[2 * k], kb[2 * k + 1]);
                Cacc0 = __builtin_amdgcn_mfma_f32_32x32x16_bf16(TRPK(a0[2 * k], a0[2 * k + 1]), bf, Cacc0, 0, 0, 0); Cacc1 = __builtin_amdgcn_mfma_f32_32x32x16_bf16(TRPK(a1[2 * k], a1[2 * k + 1]), bf, Cacc1, 0, 0, 0);
                if (vh == 0) nacc = __builtin_amdgcn_mfma_f32_32x32x16_bf16(ones1, bf, nacc, 0, 0, 0); }
        }
        __syncthreads();
#define T4X(A, B, CTRL, ODD) do { const float s_ = (ODD) ? A : B; const float r_ = __builtin_bit_cast(float, __builtin_amdgcn_update_dpp(0, __builtin_bit_cast(int, s_), CTRL, 0xf, 0xf, false)); \
        A = (ODD) ? r_ : A; B = (ODD) ? B : r_; } while (0)
#define T4(X0, X1, X2, X3) do { T4X(X0, X1, 0xB1, q1_); T4X(X2, X3, 0xB1, q1_); T4X(X0, X2, 0x4E, q2_); T4X(X1, X3, 0x4E, q2_); } while (0)
        { const bool q1_ = (lane & 1) != 0, q2_ = (lane & 2) != 0; const int q = lane & 3;
#pragma unroll
          for (int g4 = 0; g4 < 4; ++g4) {
            float x[4] = {Cacc0[g4 * 4 + 0], Cacc0[g4 * 4 + 1], Cacc0[g4 * 4 + 2], Cacc0[g4 * 4 + 3]}, z[4] = {Cacc1[g4 * 4 + 0], Cacc1[g4 * 4 + 1], Cacc1[g4 * 4 + 2], Cacc1[g4 * 4 + 3]};
            T4(x[0], x[1], x[2], x[3]); T4(z[0], z[1], z[2], z[3]);
            const int row = 8 * g4 + 4 * hi + q, colB = 2 * (32 * rb + (r32 & ~3));
            u32x2 w0, w1; w0.x = cvtpk(x[0], x[1]); w0.y = cvtpk(x[2], x[3]); w1.x = cvtpk(z[0], z[1]); w1.y = cvtpk(z[2], z[3]);
            *(u32x2*)(lds + L_CT + KSWZ(64 * vh + row, colB)) = w0; *(u32x2*)(lds + L_CT + KSWZ(64 * vh + 32 + row, colB)) = w1; } }
#undef T4
#undef T4X
        if (vh == 0 && hi == 0) { const int k = 32 * rb + r32; const float nn = g * nvec[k] + nacc[0]; nvec[k] = nn; nb[k] = (bf16_t)(cvtpk(nn, 0.f) & 0xffffu); }
    }
    __syncthreads();
}
#undef TRPK
#undef TR8
#undef KSWZ
#undef SBAR
#undef LOADS
#undef MROW0
}

__device__ __forceinline__ void phase_mfinal(const Params& p, int G) {
    const int tid = otid(), lane = tid & 63, wave = __builtin_amdgcn_readfirstlane(tid >> 6);
    const int gw = blockIdx.x * 8 + wave, NGW = G * 8;
    bf16_t* HF = (bf16_t*)(p.ws + WS_HF); const bf16_t* HB = (const bf16_t*)(p.ws + WS_HB); const bf16_t* MO = (const bf16_t*)(p.ws + WS_MO);
    u32x2 na[4], nbq[4], nog[4];
#pragma unroll
    for (int j = 0; j < 4; ++j) { const size_t o = (size_t)gw * 1024 + 256 * j + 4 * lane; na[j] = *(const u32x2*)(HF + o); nbq[j] = *(const u32x2*)(HB + o); nog[j] = *(const u32x2*)(MO + o); }
    for (int m = gw; m < TL; m += NGW) {
        u32x2 ca[4], cb[4], cg[4];
#pragma unroll
        for (int j = 0; j < 4; ++j) { ca[j] = na[j]; cb[j] = nbq[j]; cg[j] = nog[j]; }
        if (m + NGW < TL) {
#pragma unroll
            for (int j = 0; j < 4; ++j) { const size_t o = (size_t)(m + NGW) * 1024 + 256 * j + 4 * lane; na[j] = *(const u32x2*)(HF + o); nbq[j] = *(const u32x2*)(HB + o); nog[j] = *(const u32x2*)(MO + o); } }
#pragma unroll
        for (int j = 0; j < 4; ++j) {
            const size_t o = (size_t)m * 1024 + 256 * j + 4 * lane;
            const u32x2 a = ca[j], bq = cb[j], og = cg[j];
            f32x4 hs = {bf_lo(a.x) + bf_lo(bq.x), bf_hi(a.x) + bf_hi(bq.x), bf_lo(a.y) + bf_lo(bq.y), bf_hi(a.y) + bf_hi(bq.y)};
            const float rstd = rsqrtf(wave_sum((hs[0] * hs[0] + hs[1] * hs[1]) + (hs[2] * hs[2] + hs[3] * hs[3])) * (1.0f / 256.0f) + EPS);
            const f32x4 g = *(const f32x4*)(p.mnorm_g + 256 * j + 4 * lane);
            const f32x4 ov = {sigmoidf_(bf_lo(og.x)), sigmoidf_(bf_hi(og.x)), sigmoidf_(bf_lo(og.y)), sigmoidf_(bf_hi(og.y))};
            const f32x4 r = hs * rstd * g * ov;
            u32x2 w; w.x = cvt_pk_bf16(r[0], r[1]); w.y = cvt_pk_bf16(r[2], r[3]); *(u32x2*)(HF + o) = w;
        }
    }
}

__device__ __forceinline__ void mfinal_part(const Params& p, int b, int h, int quarter) {
    const int tid = otid(), lane = tid & 63, wave = __builtin_amdgcn_readfirstlane(tid >> 6);
    bf16_t* HF = (bf16_t*)(p.ws + WS_HF); const bf16_t* HB = (const bf16_t*)(p.ws + WS_HB); const bf16_t* MO = (const bf16_t*)(p.ws + WS_MO);
    const f32x4 g = *(const f32x4*)(p.mnorm_g + 256 * h + 4 * lane);
    const size_t o0 = ((size_t)b * SEQ + quarter * 1024 + wave * 128) * 1024 + 256 * h + 4 * lane;
    u32x2 na = *(const u32x2*)(HF + o0), nbq = *(const u32x2*)(HB + o0), nog = *(const u32x2*)(MO + o0);
    for (int i = 0; i < 128; ++i) {
        const size_t o = o0 + (size_t)i * 1024; const u32x2 a = na, bq = nbq, og = nog;
        if (i + 1 < 128) { na = *(const u32x2*)(HF + o + 1024); nbq = *(const u32x2*)(HB + o + 1024); nog = *(const u32x2*)(MO + o + 1024); }
        f32x4 hs = {bf_lo(a.x) + bf_lo(bq.x), bf_hi(a.x) + bf_hi(bq.x), bf_lo(a.y) + bf_lo(bq.y), bf_hi(a.y) + bf_hi(bq.y)};
        const float rstd = rsqrtf(wave_sum((hs[0] * hs[0] + hs[1] * hs[1]) + (hs[2] * hs[2] + hs[3] * hs[3])) * (1.0f / 256.0f) + EPS);
        const f32x4 ov = {sigmoidf_(bf_lo(og.x)), sigmoidf_(bf_hi(og.x)), sigmoidf_(bf_lo(og.y)), sigmoidf_(bf_hi(og.y))};
        const f32x4 r = hs * rstd * g * ov;
        u32x2 w; w.x = cvt_pk_bf16(r[0], r[1]); w.y = cvt_pk_bf16(r[2], r[3]); *(u32x2*)(HF + o) = w;
    }
}

__device__ __forceinline__ void phase_rows2(const Params& p, LAS unsigned char* lds, int grp) {
    const int tid = otid(), lane = tid & 63, wave = __builtin_amdgcn_readfirstlane(tid >> 6);
    LAS float* rw = (LAS float*)lds;
    LAS int* hist = (LAS int*)(lds + 131072);
    LAS int* basee = hist + 32;
    LAS int* a_e = basee + 32;
    LAS int* a_p = a_e + 512;
    LAS float* a_g = (LAS float*)(a_p + 512);
    for (int i = tid; i < 32 * 1024; i += NTHREADS) { const int k = i >> 5, e = i & 31; rw[e * 1024 + k] = p.router_w[i]; }
    if (tid < 32) hist[tid] = 0;
    __syncthreads();
    const float* mod = (const float*)(p.ws + WS_MOD); unsigned char* U2 = p.ws + WS_U2;
    unsigned* cnt = (unsigned*)(p.ws + WS_CTL) + CW_CNT; int* asg = (int*)(p.ws + WS_ASG); int* list = (int*)(p.ws + WS_LIST); float* lgate = (float*)(p.ws + WS_LGATE);
    f32x4 gn[4];
#pragma unroll
    for (int j = 0; j < 4; ++j) gn[j] = *(const f32x4*)(p.norm2_g + 4 * lane + 256 * j);
    const int tok0 = grp * 128 + wave * 16;
    const bf16_t* X1 = (const bf16_t*)(p.ws + WS_X1);
    u32x2 vn[4];
#pragma unroll
    for (int j = 0; j < 4; ++j) vn[j] = *(const u32x2*)(X1 + (size_t)tok0 * 1024 + 4 * lane + 256 * j);
    for (int it = 0; it < 16; ++it) {
        const int m = tok0 + it; const float* md = mod + (size_t)(m >> 12) * 6144;
        f32x4 v[4]; float ss = 0.f;
#pragma unroll
        for (int j = 0; j < 4; ++j) { v[j] = (f32x4){bf_lo(vn[j].x), bf_hi(vn[j].x), bf_lo(vn[j].y), bf_hi(vn[j].y)}; ss += (v[j][0] * v[j][0] + v[j][1] * v[j][1]) + (v[j][2] * v[j][2] + v[j][3] * v[j][3]); }
        if (it + 1 < 16) {
#pragma unroll
            for (int j = 0; j < 4; ++j) vn[j] = *(const u32x2*)(X1 + (size_t)(m + 1) * 1024 + 4 * lane + 256 * j); }
        const float rstd = rsqrtf(wave_sum(ss) * (1.0f / 1024.0f) + EPS);
#pragma unroll
        for (int j = 0; j < 4; ++j) { const f32x4 sh = *(const f32x4*)(md + 3072 + 4 * lane + 256 * j), sc = *(const f32x4*)(md + 4096 + 4 * lane + 256 * j);
            v[j] = (v[j] * rstd * gn[j]) * (sc + 1.0f) + sh;
            *(unsigned*)(U2 + (size_t)m * 1024 + 4 * lane + 256 * j) = pk4_fp8(v[j][0], v[j][1], v[j][2], v[j][3]); }
        float a[32];
#pragma unroll
        for (int e = 0; e < 32; ++e) a[e] = 0.f;
#pragma unroll
        for (int j = 0; j < 4; ++j) {
#pragma unroll
            for (int eh = 0; eh < 2; ++eh) {
#pragma unroll
                for (int e = eh * 16; e < eh * 16 + 16; ++e) { const f32x4 w = *(const LAS f32x4*)(rw + e * 1024 + 4 * lane + 256 * j); a[e] = fmaf(v[j][3], w[3], fmaf(v[j][2], w[2], fmaf(v[j][1], w[1], fmaf(v[j][0], w[0], a[e])))); }
                asm volatile("" ::: "memory"); } }
        float mine;
        { const bool u5 = (lane & 32) != 0, u4 = (lane & 16) != 0, u3 = (lane & 8) != 0, u2 = (lane & 4) != 0, u1 = (lane & 2) != 0;
          float b16[16], b8[8], b4[4], b2[2];
#pragma unroll
          for (int g = 0; g < 16; ++g) { const float send = u5 ? a[g] : a[g + 16], keep = u5 ? a[g + 16] : a[g]; b16[g] = keep + __shfl_xor(send, 32); }
#pragma unroll
          for (int g = 0; g < 8; ++g) { const float send = u4 ? b16[g] : b16[g + 8], keep = u4 ? b16[g + 8] : b16[g]; b8[g] = keep + __shfl_xor(send, 16); }
#pragma unroll
          for (int g = 0; g < 4; ++g) { const float send = u3 ? b8[g] : b8[g + 4], keep = u3 ? b8[g + 4] : b8[g]; b4[g] = keep + __shfl_xor(send, 8); }
#pragma unroll
          for (int g = 0; g < 2; ++g) { const float send = u2 ? b4[g] : b4[g + 2], keep = u2 ? b4[g + 2] : b4[g]; b2[g] = keep + __shfl_xor(send, 4); }
          { const float send = u1 ? b2[0] : b2[1], keep = u1 ? b2[1] : b2[0]; mine = keep + __shfl_xor(send, 2); }
          mine += __shfl_xor(mine, 1); }
        const int eidx = lane >> 1;
        mine += p.router_b[eidx];
        LAS float* lg = (LAS float*)(lds + 131072 + 8192) + wave * 48;
        if (!(lane & 1)) lg[eidx] = mine;
        asm volatile("s_waitcnt lgkmcnt(0)" ::: "memory");
        int rank = 0;
#pragma unroll
        for (int q = 0; q < 8; ++q) { const f32x4 o4 = *(const LAS f32x4*)(lg + 4 * q);
#pragma unroll
            for (int i = 0; i < 4; ++i) { const int oe = 4 * q + i; rank += (o4[i] > mine || (o4[i] == mine && oe < eidx)) ? 1 : 0; } }
        if (!(lane & 1) && rank < 4) { lg[32 + rank] = mine; ((LAS int*)lg)[36 + rank] = eidx; }
        asm volatile("s_waitcnt lgkmcnt(0)" ::: "memory");
        if (lane == 0) {
            const f32x4 sv = *(const LAS f32x4*)(lg + 32); const int se0 = ((const LAS int*)lg)[36], se1 = ((const LAS int*)lg)[37], se2 = ((const LAS int*)lg)[38], se3 = ((const LAS int*)lg)[39];
            const float sel_v[4] = {sv[0], sv[1], sv[2], sv[3]}; const int sel_e[4] = {se0, se1, se2, se3};
            const float e1 = __expf(sel_v[1] - sel_v[0]), e2 = __expf(sel_v[2] - sel_v[0]), e3 = __expf(sel_v[3] - sel_v[0]); const float inv = 1.0f / (1.0f + e1 + e2 + e3);
            const float gk[4] = {inv, e1 * inv, e2 * inv, e3 * inv};
#pragma unroll
            for (int k = 0; k < 4; ++k) { const int a = (wave * 16 + it) * 4 + k; a_e[a] = sel_e[k]; a_p[a] = atomicAdd((int*)&hist[sel_e[k]], 1); a_g[a] = gk[k]; }
        }
        asm volatile("s_waitcnt lgkmcnt(0)" ::: "memory");
    }
    __syncthreads();
    if (tid < 32) basee[tid] = (int)atomicAdd(cnt + tid, (unsigned)hist[tid]);
    __syncthreads();
    {
        const int a = tid; const int e = a_e[a]; const int pos = basee[e] + a_p[a]; const int tok = grp * 128 + (a >> 2);
        list[(size_t)e * CAP + pos] = tok; lgate[(size_t)e * CAP + pos] = a_g[a]; asg[tok * 4 + (a & 3)] = e * CAP + pos;
    }
    __syncthreads();
}

__device__ __forceinline__ void moe_tables(const Params& p, LAS int* tb, LAS int* cn) {
    if (threadIdx.x < 64) {
        const int lane = threadIdx.x; const unsigned* cnt = (const unsigned*)(p.ws + WS_CTL) + CW_CNT;
        const int c = lane < 32 ? (int)__hip_atomic_load(cnt + lane, __ATOMIC_RELAXED, __HIP_MEMORY_SCOPE_AGENT) : 0; const int tiles = (c + 255) >> 8;
        int incl = tiles;
#pragma unroll
        for (int o = 1; o < 32; o <<= 1) { const int t = __shfl_up(incl, o); if (lane >= o) incl += t; }
        if (lane < 32) { cn[lane] = c; tb[lane] = incl - tiles; if (lane == 31) tb[32] = incl; } }
    __syncthreads();
    if (threadIdx.x < 32) { const int e = threadIdx.x; for (int rt = tb[e]; rt < tb[e + 1]; ++rt) tb[RT2E_OFF + rt] = e; }
    __syncthreads();
}

__device__ __forceinline__ void phase_final(const Params& p, const LAS int* tb, int G) {
    const int tid = otid(), lane = tid & 63, wave = __builtin_amdgcn_readfirstlane(tid >> 6);
    const int gw = blockIdx.x * 8 + wave, NGW = G * 8;
    const float* mod = (const float*)(p.ws + WS_MOD); const bf16_t* YS = (const bf16_t*)(p.ws + WS_YS); const int* asg = (const int*)(p.ws + WS_ASG);
    f32x4 gn[4];
#pragma unroll
    for (int j = 0; j < 4; ++j) gn[j] = *(const f32x4*)(p.final_g + 4 * lane + 256 * j);
    auto rowoff = [&](int a) -> size_t { const int e = a >> 15, pos = a & (CAP - 1); return (size_t)(tb[e] * 256 + pos) * 1024; };
    int a_n[4];
    const bf16_t* X1 = (const bf16_t*)(p.ws + WS_X1);
    u32x2 xn[4]; u32x2 yn[4][4];
    { const int m0 = gw, m1 = gw + NGW; int a0[4];
#pragma unroll
      for (int k = 0; k < 4; ++k) { a0[k] = asg[m0 * 4 + k]; a_n[k] = m1 < TL ? asg[m1 * 4 + k] : 0; }
#pragma unroll
      for (int j = 0; j < 4; ++j) { xn[j] = *(const u32x2*)(X1 + (size_t)m0 * 1024 + 4 * lane + 256 * j);
#pragma unroll
        for (int k = 0; k < 4; ++k) yn[k][j] = *(const u32x2*)(YS + rowoff(a0[k]) + 4 * lane + 256 * j); } }
    for (int m = gw; m < TL; m += NGW) {
        float* xr = p.out + (size_t)m * 1024; const float* g2 = mod + (size_t)(m >> 12) * 6144 + 5120;
        u32x2 xc[4]; u32x2 yc[4][4];
#pragma unroll
        for (int j = 0; j < 4; ++j) { xc[j] = xn[j];
#pragma unroll
            for (int k = 0; k < 4; ++k) yc[k][j] = yn[k][j]; }
        if (m + NGW < TL) { const int m1 = m + NGW, m2 = m + 2 * NGW; int a1[4];
#pragma unroll
            for (int k = 0; k < 4; ++k) { a1[k] = a_n[k]; a_n[k] = m2 < TL ? asg[m2 * 4 + k] : 0; }
#pragma unroll
            for (int j = 0; j < 4; ++j) { xn[j] = *(const u32x2*)(X1 + (size_t)m1 * 1024 + 4 * lane + 256 * j);
#pragma unroll
                for (int k = 0; k < 4; ++k) yn[k][j] = *(const u32x2*)(YS + rowoff(a1[k]) + 4 * lane + 256 * j); } }
        f32x4 v[4]; float ss = 0.f;
#pragma unroll
        for (int j = 0; j < 4; ++j) {
            f32x4 y = {0.f, 0.f, 0.f, 0.f};
#pragma unroll
            for (int k = 0; k < 4; ++k) { const u32x2 w = yc[k][j]; y[0] += bf_lo(w.x); y[1] += bf_hi(w.x); y[2] += bf_lo(w.y); y[3] += bf_hi(w.y); }
            v[j] = (f32x4){bf_lo(xc[j].x), bf_hi(xc[j].x), bf_lo(xc[j].y), bf_hi(xc[j].y)} + *(const f32x4*)(g2 + 4 * lane + 256 * j) * y;
            ss += (v[j][0] * v[j][0] + v[j][1] * v[j][1]) + (v[j][2] * v[j][2] + v[j][3] * v[j][3]);
        }
        const float rstd = rsqrtf(wave_sum(ss) * (1.0f / 1024.0f) + EPS);
#pragma unroll
        for (int j = 0; j < 4; ++j) *(f32x4*)(xr + 4 * lane + 256 * j) = v[j] * rstd * gn[j];
    }
}

__device__ __forceinline__ void phase_attn(const Params& p, LAS unsigned char* lds_, int G, bf16_t* BO, unsigned* ctr) {
    char* lds = (char*)(unsigned char*)lds_;
    volatile int* uslot = (volatile int*)(lds + att::SHM_ATTN);
    const float lam = *(const float*)(p.ws + WS_LAM);
    const int xcc = (int)(__builtin_amdgcn_s_getreg((3 << 11) | 20) & 7u);
    const bf16_t* DQ = (const bf16_t*)(p.ws + WS_DQ); const bf16_t* DK = (const bf16_t*)(p.ws + WS_DK); const bf16_t* DV = (const bf16_t*)(p.ws + WS_DV);
    int q = 0;
    for (;;) {
        const int xq = (xcc + q) & 7;
        __syncthreads();
        if (threadIdx.x == 0) uslot[0] = (int)atomicAdd(ctr + 16 * xq, 1u);
        __syncthreads();
        const int u = uslot[0];
        if (u >= 256) { if (++q == 8) break; continue; }
        const int bh = (u >> 5) * 8 + xq, qb = u & 31, b = bh >> 3, h = bh & 7;
        const size_t qoff = ((size_t)b * SEQ + qb * 128) * 1024 + h * 128, koff = (size_t)b * KVLEN * 1024 + h * 128;
        att::attn_unit2(DQ + qoff, DK + koff, DV + koff, BO + qoff, p.dnorm_g + h * 128, (const float*)(p.ws + WS_CTL) + CW_KMAX + b * 32 + h * 4, lam, KVLEN, lds);
    }
}


#define XB_TMO      128
#define XB_XCNT(j)  (256  + 64 * (j))
#define XB_XSUB(j)  (1280 + 64 * (j))
#define XB_XGEN(j)  (2304 + 64 * (j))
#define XB_TOP      3328
#define XB_TOPGEN   3392
#define XCD_BAR_WORDS 3456
#define XB_SPIN_CAP (1u << 22)
__device__ __forceinline__ unsigned xb_ld(unsigned* p)              { return __hip_atomic_load(p, __ATOMIC_RELAXED, __HIP_MEMORY_SCOPE_AGENT); }
__device__ __forceinline__ unsigned xb_add(unsigned* p, unsigned v) { return __hip_atomic_fetch_add(p, v, __ATOMIC_RELAXED, __HIP_MEMORY_SCOPE_AGENT); }
__device__ __forceinline__ unsigned xb_xcc_id() { return (unsigned)__builtin_amdgcn_s_getreg((3 << 11) | 20) & 0xFu; }
#define XB_SPIN(cond, bar) do { unsigned _sp = 0; while (cond) { __builtin_amdgcn_s_sleep(1); \
    if ((++_sp & 255u) == 0u) { if (xb_ld(&(bar)[XB_TMO])) break; if (_sp > XB_SPIN_CAP) { atomicAdd(&(bar)[XB_TMO], 1u); break; } } } } while (0)
struct XcdBarrier { unsigned* bar; unsigned x; volatile LAS unsigned* st; };
__device__ __forceinline__ XcdBarrier xcd_barrier_post(unsigned* bar, volatile LAS unsigned* st) {
    XcdBarrier b; b.bar = bar; b.x = xb_xcc_id(); b.st = st;
    if (threadIdx.x == 0) (void)xb_add(&bar[XB_XCNT(b.x)], 1u);
    return b;
}
__device__ __forceinline__ void xcd_barrier_complete(unsigned* bar, unsigned x, unsigned& nloc, unsigned& nx) {
    const unsigned G = gridDim.x * gridDim.y * gridDim.z;
    unsigned sum, cnt, mine, sp = 0u;
    for (;;) {
        sum = 0u; cnt = 0u; mine = 0u;
#pragma unroll
        for (unsigned j = 0; j < 16; ++j) { const unsigned c = xb_ld(&bar[XB_XCNT(j)]); sum += c; cnt += (c > 0u) ? 1u : 0u; mine = (j == x) ? c : mine; }
        if (sum == G) break;
        __builtin_amdgcn_s_sleep(1);
        if ((++sp & 255u) == 0u) { if (xb_ld(&bar[XB_TMO])) break; if (sp > XB_SPIN_CAP) { atomicAdd(&bar[XB_TMO], 1u); break; } }
    }
    nloc = mine > 0u ? mine : 1u; nx = cnt > 0u ? cnt : 1u;
}
__device__ __forceinline__ void xcd_barrier(const XcdBarrier& b) {
    asm volatile("s_waitcnt vmcnt(0)" ::: "memory");
    __syncthreads();
    if (threadIdx.x == 0) {
        unsigned* bar = b.bar;
        __builtin_amdgcn_s_waitcnt(0);
        unsigned nloc = b.st[0], nx = b.st[1];
        if (nloc == 0u) { xcd_barrier_complete(bar, b.x, nloc, nx); b.st[0] = nloc; b.st[1] = nx; }
        const unsigned k = b.st[2];
        const unsigned old = xb_add(&bar[XB_XSUB(b.x)], 1u);
        if (old + 1u == (k + 1u) * nloc) {
            __builtin_amdgcn_fence(__ATOMIC_RELEASE, "agent");
            asm volatile("s_waitcnt vmcnt(0)" ::: "memory");
            const unsigned og = xb_add(&bar[XB_TOP], 1u);
            if (og + 1u == (k + 1u) * nx) xb_add(&bar[XB_TOPGEN], 1u);
        }
        XB_SPIN(xb_ld(&bar[XB_TOPGEN]) < k + 1u, bar);
        __builtin_amdgcn_fence(__ATOMIC_ACQUIRE, "agent");
        asm volatile("s_waitcnt vmcnt(0)" ::: "memory");
        b.st[2] = k + 1u;
    }
    __syncthreads();
}


#define FP8_SELFTEST 0
#if FP8_SELFTEST
typedef int v8i __attribute__((ext_vector_type(8)));
__device__ __forceinline__ int fp8_selftest(int lane) {
    const int i = lane & 15, kb = lane >> 4;
    v8i A, B;
#pragma unroll
    for (int d = 0; d < 8; ++d) {
        float av[4], bv[4];
#pragma unroll
        for (int t = 0; t < 4; ++t) { const int k = 32 * kb + 4 * d + t; av[t] = (float)(((i * 7 + k * 3) % 5) - 2); bv[t] = (float)(((k * 5 + i) % 7) - 3); }
        int wa = 0, wb = 0;
        wa = __builtin_amdgcn_cvt_pk_fp8_f32(av[0], av[1], wa, false); wa = __builtin_amdgcn_cvt_pk_fp8_f32(av[2], av[3], wa, true);
        wb = __builtin_amdgcn_cvt_pk_fp8_f32(bv[0], bv[1], wb, false); wb = __builtin_amdgcn_cvt_pk_fp8_f32(bv[2], bv[3], wb, true);
        A[d] = wa; B[d] = wb;
    }
    f32x4 C = {0.f, 0.f, 0.f, 0.f}, C2 = {0.f, 0.f, 0.f, 0.f};
    C = __builtin_amdgcn_mfma_scale_f32_16x16x128_f8f6f4(A, B, C, 0, 0, 0, 0x7f7f7f7f, 0, 0x7f7f7f7f);
    C2 = __builtin_amdgcn_mfma_scale_f32_16x16x128_f8f6f4(A, B, C2, 0, 0, 0, 0x79797979, 0, 0x7f7f7f7f);
    bool ok = true;
#pragma unroll
    for (int r = 0; r < 4; ++r) { const int row = 4 * kb + r, col = i; float ref = 0.f;
        for (int k = 0; k < 128; ++k) ref += (float)(((row * 7 + k * 3) % 5) - 2) * (float)(((k * 5 + col) % 7) - 3);
        ok = ok && (C[r] == ref) && (C2[r] == ref * 0.015625f); }
    return __all(ok) ? 1 : 0;
}
#endif

__global__ void __launch_bounds__(NTHREADS, 2) fwd_megakernel(Params p) {
    extern __shared__ __attribute__((aligned(16))) unsigned char smem[];
    LAS unsigned char* lds = (LAS unsigned char*)smem;
    cg::grid_group grid = cg::this_grid();
    const int G = gridDim.x, c = blockIdx.x;
    unsigned char* ws = p.ws;
    volatile LAS unsigned* bst = (volatile LAS unsigned*)(lds + LDS_BYTES - 64);
    if (threadIdx.x < 16) bst[threadIdx.x] = 0u;
    __syncthreads();
    const XcdBarrier xbar = xcd_barrier_post((unsigned*)(ws + WS_CTL) + CW_BAR, bst);
#define GSYNC() xcd_barrier(xbar)

#ifndef PH_MASK
#define PH_MASK 0xFFFF
#endif
#define PH(k) if constexpr (((PH_MASK) >> (k)) & 1)
#ifndef REP_MASK
#define REP_MASK 0
#endif
#define REP(k) for (int rep_ = 0; rep_ < ((((REP_MASK) >> (k)) & 1) ? 2 : 1); ++rep_)
    PH(0) REP(0) { phase_prep(p, lds, G); __syncthreads(); }
    grid.sync();
    PH(1) phase_rows1(p, lds, G);
    GSYNC();
    PH(2) REP(2) {
        SchedIn S{(const char*)(ws + WS_U), (const char*)(ws + WS_WIN), G, c};
        EpiIn E{ws, (const float*)(ws + WS_ROPE), (const float*)(ws + WS_ROPE) + 1024};
        pg8::gemm_phase<EpiIn, SchedIn, false, true>(lds, S, E, 0);
    }
    GSYNC();
#ifdef MLSTM_NAIVE
    PH(3) for (int item = c; item < 128; item += G) phase_mlstm_naive(p, lds, item);
#else
    const bool fuse_mf = (G >= 128) && !((REP_MASK >> 3) & 1);
    PH(3) REP(3) for (int it = c; it < 128; it += G) {
        const int x = it & 7, j = it >> 3; const int bh = x * 4 + (j >> 2); mls2::mlstm_item(p, lds, (bh << 2) | (j & 3));
        if (fuse_mf) {
            unsigned* done = (unsigned*)(ws + WS_CTL) + CW_MF + bh;
            asm volatile("s_waitcnt vmcnt(0)" ::: "memory"); __syncthreads();
            if (threadIdx.x == 0) {
                __builtin_amdgcn_fence(__ATOMIC_RELEASE, "agent"); asm volatile("s_waitcnt vmcnt(0)" ::: "memory");
                __hip_atomic_fetch_add(done, 1u, __ATOMIC_RELAXED, __HIP_MEMORY_SCOPE_AGENT);
                unsigned sp = 0; while (__hip_atomic_load(done, __ATOMIC_RELAXED, __HIP_MEMORY_SCOPE_AGENT) < 4u) { __builtin_amdgcn_s_sleep(8); if (++sp > (1u << 24)) break; }
                __builtin_amdgcn_fence(__ATOMIC_ACQUIRE, "agent"); asm volatile("s_waitcnt vmcnt(0)" ::: "memory");
            }
            __syncthreads();
            mfinal_part(p, bh >> 2, bh & 3, j & 3);
        }
    }
#endif
    if (G >= 160 && c >= 128 && c < 160) t8_dynamic(p, lds, (unsigned*)(ws + WS_CTL) + 41, 256, T8_ITEMS);
    if constexpr ((REP_MASK >> 4) & 1) { phase_attn(p, lds, G, (bf16_t*)(ws + WS_END), (unsigned*)(ws + WS_CTL) + CW_ATT + 512); }
    PH(4) phase_attn(p, lds, G, (bf16_t*)(ws + WS_BO), (unsigned*)(ws + WS_CTL) + CW_ATT);
    GSYNC();
    if (!fuse_mf) { PH(5) phase_mfinal(p, G); GSYNC(); }
    PH(6) REP(6) {
        SchedMerge2 S{(const char*)(ws + WS_AO), (const char*)(ws + WS_WA), (const char*)(ws + WS_BO), (const char*)(ws + WS_WB), 128, 4, G, c};
        EpiMerge2 E{(const bf16_t*)(ws + WS_GA), (const bf16_t*)(ws + WS_GB), (bf16_t*)(ws + WS_T), (bf16_t*)(ws + WS_Y)};
        pg8::gemm_phase<EpiMerge2, SchedMerge2, false>(lds, S, E);
    }
    GSYNC();
    PH(8) REP(8) {
        SchedStatic S{(const char*)(ws + WS_Y), (const char*)(ws + WS_WO), 128, 4, G, c};
        EpiOut E{p.x, (const float*)(ws + WS_MOD), (bf16_t*)(ws + WS_X1)};
        pg8::gemm_phase<EpiOut, SchedStatic, false>(lds, S, E);
    }
    GSYNC();
    PH(9) for (int grp = c; grp < 256; grp += G) phase_rows2(p, lds, grp);
    GSYNC();
    LAS int* tb = (LAS int*)(lds + 131072); LAS int* cn = tb + 64;
    moe_tables(p, tb, cn);
    PH(10) REP(10) {
        SchedMoe1 S{(const char*)(ws + WS_U2), (const char*)(ws + WS_W1), (const int*)(ws + WS_LIST), tb, cn, G, c};
        EpiMoe1 E{ws + WS_ACT, p.exp_b1};
        pg8::gemm_phase<EpiMoe1, SchedMoe1, true, true>(lds, S, E);
    }
    GSYNC();
    PH(11) REP(11) {
        SchedMoe2 S{(const char*)(ws + WS_ACT), (const char*)(ws + WS_W2), tb, G, c};
        EpiMoe2 E{(bf16_t*)(ws + WS_YS), p.exp_b2, (const float*)(ws + WS_LGATE), cn};
        pg8::gemm_phase<EpiMoe2, SchedMoe2, false, true>(lds, S, E);
    }
    GSYNC();
    PH(12) phase_final(p, tb, G);
#if FP8_SELFTEST
    if (blockIdx.x == 0 && threadIdx.x < 64) { const int okf = fp8_selftest(threadIdx.x); VM_WAIT(); if (!okf && threadIdx.x == 0) p.out[0] = __builtin_nanf(""); }
#endif
}

extern "C" void kernel_launch(void* const* d_in, const int* in_sizes, int n_in, void* d_out, int out_size, void* d_ws, size_t ws_size, hipStream_t stream) {
    static int grid = 0;
    if (grid == 0) {
        if (n_in != 23 || out_size != TL * D || ws_size < WS_END) { fprintf(stderr, "kernel_launch: unexpected shapes: n_in %d out %d ws %zu (need %zu)\n", n_in, out_size, ws_size, (size_t)WS_END); grid = -1; return; }
        int dev = 0, cus = 0, per_cu = 0;
        (void)hipGetDevice(&dev); (void)hipDeviceGetAttribute(&cus, hipDeviceAttributeMultiprocessorCount, dev);
        if (hipFuncSetAttribute((const void*)fwd_megakernel, hipFuncAttributeMaxDynamicSharedMemorySize, LDS_BYTES) != hipSuccess) { fprintf(stderr, "kernel_launch: hipFuncSetAttribute failed\n"); grid = -1; return; }
        if (hipOccupancyMaxActiveBlocksPerMultiprocessor(&per_cu, (const void*)fwd_megakernel, NTHREADS, LDS_BYTES) != hipSuccess || per_cu < 1) { fprintf(stderr, "kernel_launch: occupancy query says %d\n", per_cu); per_cu = 1; }
        (void)hipGetLastError();
        grid = cus;
        if (grid > 256) grid = 256;
    }
    if (grid < 0) return;
    (void)hipMemsetAsync((char*)d_ws + WS_CTL, 0, 32768, stream);
    Params p{};
    const float** pp = (const float**)&p;
    for (int i = 0; i < 23; ++i) pp[i] = (const float*)d_in[i];
    p.out = (float*)d_out; p.ws = (unsigned char*)d_ws;
    void* args[] = {&p};
    hipError_t e = hipLaunchCooperativeKernel((const void*)fwd_megakernel, dim3(grid), dim3(NTHREADS), args, LDS_BYTES, stream);
    if (e != hipSuccess) fprintf(stderr, "cooperative launch failed: %s (grid %d)\n", hipGetErrorString(e), grid);
}
```

```cpp
#include <hip/hip_runtime.h>
#include <hip/hip_cooperative_groups.h>
#include <cstdio>
#include <cstdint>
namespace cg = cooperative_groups;

#define LAS __attribute__((address_space(3)))
typedef unsigned short bf16_t;
typedef short bf16x8 __attribute__((ext_vector_type(8)));
typedef short s16x4 __attribute__((ext_vector_type(4)));
typedef float f32x4 __attribute__((ext_vector_type(4)));
typedef float f32x8 __attribute__((ext_vector_type(8)));
typedef float f32x16 __attribute__((ext_vector_type(16)));
typedef unsigned u32x4 __attribute__((ext_vector_type(4)));
typedef unsigned u32x2 __attribute__((ext_vector_type(2)));

constexpr int D = 1024, BATCH = 8, SEQ = 4096, CTX = 256;
constexpr int TL = BATCH * SEQ, TC = BATCH * CTX, TT = TL + TC;
constexpr int KVLEN = CTX + SEQ;
constexpr int NEXP = 32, CAP = 32768, ACT_ROWS = 139264;
constexpr int INCOLS = 8208;
constexpr float EPS = 1e-6f;
constexpr float LAM_INIT = 0.2f;

constexpr size_t MiB = 1u << 20;
constexpr size_t WS_CTL = 0;
constexpr size_t WS_MOD = 1 * MiB;
constexpr size_t WS_ROPE = 1 * MiB + 256 * 1024;
constexpr size_t WS_LAM = 1 * MiB + 300 * 1024;
constexpr size_t WS_GT = 2 * MiB;
constexpr size_t WS_ASG = 5 * MiB;
constexpr size_t WS_LIST = 6 * MiB;
constexpr size_t WS_LGATE = 10 * MiB;
constexpr size_t WS_WIN = 16 * MiB;
constexpr size_t WS_WA = 32 * MiB, WS_WB = 34 * MiB, WS_WO = 36 * MiB;
constexpr size_t WS_W1 = 40 * MiB;
constexpr size_t WS_W2 = 168 * MiB;
constexpr size_t WS_U = 232 * MiB;
constexpr size_t WS_MQ = 300 * MiB;
constexpr size_t WS_MK = 332 * MiB;
constexpr size_t WS_MV = 366 * MiB;
constexpr size_t WS_MO = 434 * MiB;
constexpr size_t WS_HB = 498 * MiB;
constexpr size_t WS_DQ = 562 * MiB;
constexpr size_t WS_DK = 626 * MiB;
constexpr size_t WS_DV = 694 * MiB;
constexpr size_t WS_GA = 762 * MiB;
constexpr size_t WS_GB = 826 * MiB;
constexpr size_t WS_END = 890 * MiB;
constexpr size_t WS_HF = WS_U, WS_AO = WS_U, WS_BO = WS_DQ, WS_T = WS_MV, WS_Y = WS_MO, WS_U2 = 370 * MiB, WS_X1 = WS_GA, WS_XS = WS_U, WS_ACT = WS_DQ, WS_YS = WS_U;
static_assert(WS_ACT + (size_t)ACT_ROWS * 2048 <= WS_END, "ACT fits");
static_assert(WS_YS + (size_t)ACT_ROWS * 2048 <= WS_DQ, "YS fits");

constexpr int CW_CNT = 0, CW_ATT = 64, CW_KMAX = 256, CW_MF = 800, CW_BAR = 1024;
constexpr int LDS_BYTES = 147456;
constexpr int NTHREADS = 512;

struct Params {
    const float *x, *c, *ctx, *c_ctx, *ada_w, *ada_b, *norm1_g, *norm2_g, *w_in, *gate_b, *mnorm_g, *dlam, *dnorm_g, *w_a, *w_b, *w_o, *router_w, *router_b,
        *exp_w1, *exp_b1, *exp_w2, *exp_b2, *final_g;
    float* out;
    unsigned char* ws;
};

#define LDS_WAIT() asm volatile("s_waitcnt lgkmcnt(0)" ::: "memory")
#define VM_WAIT() asm volatile("s_waitcnt vmcnt(0)" ::: "memory")
typedef float f32x2_t __attribute__((ext_vector_type(2))); typedef __bf16 bf16x2_t __attribute__((ext_vector_type(2)));
__device__ __forceinline__ unsigned cvt_pk_bf16(float lo, float hi) { f32x2_t v = {lo, hi}; bf16x2_t b = __builtin_convertvector(v, bf16x2_t); return __builtin_bit_cast(unsigned, b); }
__device__ __forceinline__ unsigned pk4_fp8(float a, float b, float c, float d) { int w = 0; w = __builtin_amdgcn_cvt_pk_fp8_f32(a, b, w, false); w = __builtin_amdgcn_cvt_pk_fp8_f32(c, d, w, true); return (unsigned)w; }
__device__ __forceinline__ float bf_lo(unsigned w) { return __uint_as_float(w << 16); }
__device__ __forceinline__ float bf_hi(unsigned w) { return __uint_as_float(w & 0xffff0000u); }
__device__ __forceinline__ float bf2f(bf16_t b) { return __uint_as_float(((unsigned)b) << 16); }
__device__ __forceinline__ float dpp_f(float v, const int ctrl_unused) { return v; }
#define DPP_ADD(v, CTRL) ((v) + __builtin_bit_cast(float, __builtin_amdgcn_update_dpp(0, __builtin_bit_cast(int, (v)), (CTRL), 0xf, 0xf, false)))
__device__ __forceinline__ float row16_sum(float v) { v = DPP_ADD(v, 0xB1); v = DPP_ADD(v, 0x4E); v = DPP_ADD(v, 0x141); v = DPP_ADD(v, 0x140); return v; }
__device__ __forceinline__ float halve32(float a, float b) { auto r = __builtin_amdgcn_permlane32_swap(__float_as_uint(a), __float_as_uint(b), false, false); return __uint_as_float(r[0]) + __uint_as_float(r[1]); }
__device__ __forceinline__ float halve16(float a, float b) { auto r = __builtin_amdgcn_permlane16_swap(__float_as_uint(a), __float_as_uint(b), false, false); return __uint_as_float(r[0]) + __uint_as_float(r[1]); }
__device__ __forceinline__ float halve8(float a, float b, bool up) { const float send = up ? a : b, keep = up ? b : a; return keep + __builtin_bit_cast(float, __builtin_amdgcn_update_dpp(0, __builtin_bit_cast(int, send), 0x128, 0xf, 0xf, false)); }
__device__ __forceinline__ float halve4(float a, float b, bool up) { const float send = up ? a : b, keep = up ? b : a; const int si = __builtin_bit_cast(int, send);
    const int r = __builtin_amdgcn_update_dpp(__builtin_amdgcn_update_dpp(0, si, 0x104, 0xf, 0x5, false), si, 0x114, 0xf, 0xA, false);
    return keep + __builtin_bit_cast(float, r); }
__device__ __forceinline__ float halve2(float a, float b, bool up) { const float send = up ? a : b, keep = up ? b : a; return keep + __builtin_bit_cast(float, __builtin_amdgcn_update_dpp(0, __builtin_bit_cast(int, send), 0x4E, 0xf, 0xf, false)); }
__device__ __forceinline__ float wave_sum(float v) {
    v = row16_sum(v);
    const int b = __builtin_bit_cast(int, v);
    return (__builtin_bit_cast(float, __builtin_amdgcn_readlane(b, 0)) + __builtin_bit_cast(float, __builtin_amdgcn_readlane(b, 16))) + (__builtin_bit_cast(float, __builtin_amdgcn_readlane(b, 32)) + __builtin_bit_cast(float, __builtin_amdgcn_readlane(b, 48)));
}
__device__ __forceinline__ float sigmoidf_(float x) { return __builtin_amdgcn_rcpf(1.0f + __expf(-x)); }
__device__ __forceinline__ int otid() { unsigned ones = ~0u; asm volatile("" : "+s"(ones));
    const int lane = __builtin_amdgcn_mbcnt_hi(ones, __builtin_amdgcn_mbcnt_lo(ones, 0u)); int t = __builtin_amdgcn_readfirstlane(threadIdx.x >> 6) * 64 + lane; asm volatile("" : "+v"(t)); return t; }

namespace pg8 {
constexpr int BM = 256, BK = 64, HALF = 128, HTB = HALF * BK * 2, STAGE_BYTES = 8 * HTB, KD = 1024;
__host__ __device__ __forceinline__ int lds_byte(int r, int c) { const int st = (r >> 4) * 2 + (c >> 5), rr = r & 15, cc = c & 31, ob = rr * 64 + cc * 2; return st * 1024 + (ob ^ (((ob >> 9) & 1) << 5)); }
__host__ __device__ __forceinline__ void stage_rc(int b, int& R, int& C) { const int st = b / 1024, sb = b % 1024, swz = sb ^ (((sb >> 9) & 1) << 5); R = (st >> 1) * 16 + swz / 64; C = (st & 1) * 32 + (swz % 64) / 2; }

struct Unit { const char* A; const char* B; int row0; int pn; int aux; int aux2; };

__device__ __forceinline__ void tile_map(int L, int nM, int nN, int& pm, int& pn) {
    const int nwg = nM * nN; int wgid = L; { const int q = nwg / 8, r = nwg % 8, xcd = wgid % 8, off = wgid / 8; wgid = (xcd < r ? xcd * (q + 1) : r * (q + 1) + (xcd - r) * q) + off; }
    const int nig = 8 * nN, gid = wgid / nig, fm = gid * 8, gsz = (nM - fm) < 8 ? (nM - fm) : 8;
    pm = fm + ((wgid % nig) % gsz); pn = (wgid % nig) / gsz;
}

typedef int v8i_t __attribute__((ext_vector_type(8)));
typedef int v8i_a16 __attribute__((ext_vector_type(8), aligned(16)));
template <class Epi, class Sched, bool GATHER, bool FP8 = false>
__device__ __forceinline__ void gemm_phase(LAS unsigned char* lds, const Sched& S, const Epi& E, int stagger_ticks = 0) {
    const int tid = otid(), wid = __builtin_amdgcn_readfirstlane(tid >> 6), lane = tid & 63, wr = wid >> 2, wc = wid & 3, fr = lane & 15, fq = lane >> 4;
    constexpr int K = FP8 ? KD / 2 : KD, nt = K / BK;
    unsigned voffB[2], voffA0[2], voffA1[2], nvA0[2], nvA1[2];
#pragma unroll
    for (int i = 0; i < 2; ++i) { int R, C; stage_rc(tid * 16 + i * 8192, R, C);
        voffB[i] = (unsigned)(R * K + C) * 2u; voffA0[i] = voffB[i]; voffA1[i] = voffB[i] + (unsigned)HALF * K * 2u; nvA0[i] = voffA0[i]; nvA1[i] = voffA1[i]; }
    const size_t kstep = (size_t)(BK * 2);
    const size_t hstep = (size_t)HALF * K * 2;
    const unsigned ldsw = (unsigned)wid * 1024u;
    const int aoff = lds_byte(wr * 64 + fr, fq * 8);
    const int boff = lds_byte(wc * 32 + fr, fq * 8);
#define PG8_SA(b, h) (((b) * 2 + (h)) * HTB)
#define PG8_SB(b, h) ((4 + (b) * 2 + (h)) * HTB)
#define PG8_STAGE(bufoff, gbase, voff) do { _Pragma("unroll") for (int _i = 0; _i < 2; ++_i) { unsigned _v = (voff)[_i]; asm volatile("" : "+v"(_v));   \
        __builtin_amdgcn_global_load_lds((const unsigned*)((const char*)(gbase) + _v), (LAS unsigned*)(lds + (bufoff) + ldsw + _i * 8192), 16, 0, 0); } } while (0)
#define PG8_LDA(dst, b, h) do { if constexpr (FP8) { _Pragma("unroll") for (int m = 0; m < 4; ++m) { const u32x4 lo_ = *(const LAS u32x4*)(lds + PG8_SA(b, h) + aoff + m * 2048), hi_ = *(const LAS u32x4*)(lds + PG8_SA(b, h) + aoff + m * 2048 + 1024); dst##8[m] = (v8i_t){(int)lo_.x, (int)lo_.y, (int)lo_.z, (int)lo_.w, (int)hi_.x, (int)hi_.y, (int)hi_.z, (int)hi_.w}; } } \
        else { _Pragma("unroll") for (int m = 0; m < 4; ++m) _Pragma("unroll") for (int k = 0; k < 2; ++k) dst[m][k] = *(const LAS bf16x8*)(lds + PG8_SA(b, h) + aoff + m * 2048 + k * 1024); } } while (0)
#define PG8_LDB(dst, b, h) do { if constexpr (FP8) { _Pragma("unroll") for (int n = 0; n < 2; ++n) { const u32x4 lo_ = *(const LAS u32x4*)(lds + PG8_SB(b, h) + boff + n * 2048), hi_ = *(const LAS u32x4*)(lds + PG8_SB(b, h) + boff + n * 2048 + 1024); dst##8[n] = (v8i_t){(int)lo_.x, (int)lo_.y, (int)lo_.z, (int)lo_.w, (int)hi_.x, (int)hi_.y, (int)hi_.z, (int)hi_.w}; } } \
        else { _Pragma("unroll") for (int n = 0; n < 2; ++n) _Pragma("unroll") for (int k = 0; k < 2; ++k) dst[n][k] = *(const LAS bf16x8*)(lds + PG8_SB(b, h) + boff + n * 2048 + k * 1024); } } while (0)
#define PG8_MMA(ai, bj, At, Bt) do { __builtin_amdgcn_s_setprio(1); _Pragma("unroll") for (int m = 0; m < 4; ++m) _Pragma("unroll") for (int n = 0; n < 2; ++n) { \
        if constexpr (FP8) { asm volatile("v_mfma_f32_16x16x128_f8f6f4 %0, %1, %2, %0" : "+v"(acc[ai][bj][m][n]) : "v"(Bt##8[n]), "v"(At##8[m])); } \
        else { _Pragma("unroll") for (int k = 0; k < 2; ++k) acc[ai][bj][m][n] = __builtin_amdgcn_mfma_f32_16x16x32_bf16(Bt[n][k], At[m][k], acc[ai][bj][m][n], 0, 0, 0); } } \
        __builtin_amdgcn_s_setprio(0); } while (0)
#define PG8_ST1(bufoff, gbase, voff, i) do { unsigned _v = (voff)[i]; asm volatile("" : "+v"(_v)); \
        __builtin_amdgcn_global_load_lds((const unsigned*)((const char*)(gbase) + _v), (LAS unsigned*)(lds + (bufoff) + ldsw + (i) * 8192), 16, 0, 0); } while (0)
#define PG8_MM1(ai, bj, At, Bt, m) do { _Pragma("unroll") for (int n = 0; n < 2; ++n) { \
        if constexpr (FP8) { asm volatile("v_mfma_f32_16x16x128_f8f6f4 %0, %1, %2, %0" : "+v"(acc[ai][bj][m][n]) : "v"(Bt##8[n]), "v"(At##8[m])); } \
        else { _Pragma("unroll") for (int k = 0; k < 2; ++k) acc[ai][bj][m][n] = __builtin_amdgcn_mfma_f32_16x16x32_bf16(Bt[n][k], At[m][k], acc[ai][bj][m][n], 0, 0, 0); } } } while (0)
#define PG8_MMAS(ai, bj, At, Bt, S0, S1, S2, S3) do { __builtin_amdgcn_s_setprio(1); \
        PG8_MM1(ai, bj, At, Bt, 0); PG8_SCHED; S0; PG8_SCHED; PG8_MM1(ai, bj, At, Bt, 1); PG8_SCHED; S1; PG8_SCHED; \
        PG8_MM1(ai, bj, At, Bt, 2); PG8_SCHED; S2; PG8_SCHED; PG8_MM1(ai, bj, At, Bt, 3); PG8_SCHED; S3; PG8_SCHED; \
        __builtin_amdgcn_s_setprio(0); } while (0)
#define PG8_WAIT_V(n) asm volatile("s_waitcnt vmcnt(" #n ")" ::: "memory")
#define PG8_WAIT_L(n) asm volatile("s_waitcnt lgkmcnt(" #n ")" ::: "memory")
#define PG8_BAR __builtin_amdgcn_s_barrier()
#define PG8_SCHED __builtin_amdgcn_sched_barrier(0)
    Unit cur, nxt; int ui = 0;
    if (!S.next(0, cur)) return;
    if (stagger_ticks > 0) {
        const unsigned long long t0 = __builtin_amdgcn_s_memrealtime(); const unsigned long long d = (unsigned long long)((blockIdx.x >> 3) & 7) * (unsigned)stagger_ticks;
        while (__builtin_amdgcn_s_memrealtime() - t0 < d) __builtin_amdgcn_s_sleep(8);
    }
    if constexpr (GATHER) { S.offsets(cur, tid, voffA0, voffA1); }
    f32x4 acc[2][2][4][2];
#pragma unroll
    for (int a = 0; a < 2; ++a)
#pragma unroll
        for (int b = 0; b < 2; ++b)
#pragma unroll
            for (int m = 0; m < 4; ++m)
#pragma unroll
                for (int n = 0; n < 2; ++n) acc[a][b][m][n] = (f32x4){0.f, 0.f, 0.f, 0.f};
    bf16x8 At[4][2], B0[2][2], B1[2][2]; v8i_t At8[4], B08[2], B18[2];
    const char* cA = cur.A; const char* cB = cur.B;
    PG8_STAGE(PG8_SB(0, 0), cB, voffB); PG8_STAGE(PG8_SB(0, 1), cB + hstep, voffB); PG8_STAGE(PG8_SA(0, 0), cA, voffA0); PG8_STAGE(PG8_SA(0, 1), cA, voffA1);
    if (wr == 1) PG8_BAR;
    PG8_WAIT_V(2); PG8_BAR;
    PG8_STAGE(PG8_SB(1, 0), cB + kstep, voffB); PG8_STAGE(PG8_SA(1, 0), cA + kstep, voffA0); PG8_STAGE(PG8_SB(1, 1), cB + hstep + kstep, voffB);
    PG8_WAIT_V(6); PG8_BAR;
    for (;;) {
        const bool has_next = S.next(ui + 1, nxt);
        const char* nA = has_next ? nxt.A : cA; const char* nB = has_next ? nxt.B : cB;
#pragma unroll 1
        for (int t = 0; t < nt; t += 2) {
            const bool last = (t == nt - 2);
            if constexpr (GATHER) { if (t == nt - 4 && has_next) { const int tq = otid(); S.offsets(nxt, tq, nvA0, nvA1); } }
            const char* a1 = cA + (size_t)(t + 1) * kstep;
            const char* a2 = last ? nA : cA + (size_t)(t + 2) * kstep; const char* b2 = last ? nB : cB + (size_t)(t + 2) * kstep;
            const char* a3 = a2 + kstep; const char* b3 = b2 + kstep;
            unsigned w0[2], w1[2];
            if constexpr (GATHER) { w0[0] = voffA0[0]; w0[1] = voffA0[1]; w1[0] = voffA1[0]; w1[1] = voffA1[1];
                if (last && has_next) { w0[0] = nvA0[0]; w0[1] = nvA0[1]; w1[0] = nvA1[0]; w1[1] = nvA1[1]; } }
            else { w0[0] = voffA0[0]; w0[1] = voffA0[1]; w1[0] = voffA1[0]; w1[1] = voffA1[1]; }
            PG8_LDB(B0, 0, 0); PG8_LDB(B1, 0, 1); PG8_SCHED; PG8_LDA(At, 0, 0); PG8_STAGE(PG8_SA(1, 1), a1, voffA1);
            PG8_WAIT_V(8);
            PG8_WAIT_L(0); PG8_BAR; PG8_MMA(0, 0, At, B0); PG8_MMA(0, 1, At, B1); PG8_BAR; PG8_SCHED;
            PG8_LDA(At, 0, 1); PG8_STAGE(PG8_SB(0, 0), b2, voffB); PG8_STAGE(PG8_SB(0, 1), b2 + hstep, voffB); PG8_STAGE(PG8_SA(0, 0), a2, w0);
            PG8_WAIT_V(8);
            PG8_WAIT_L(0); PG8_BAR; PG8_MMA(1, 0, At, B0); PG8_MMA(1, 1, At, B1); PG8_BAR; PG8_SCHED;
            PG8_LDB(B0, 1, 0); PG8_LDB(B1, 1, 1); PG8_SCHED; PG8_LDA(At, 1, 0); PG8_STAGE(PG8_SA(0, 1), a2, w1);
            PG8_WAIT_V(8); PG8_WAIT_L(0); PG8_BAR; PG8_MMA(0, 0, At, B0); PG8_MMA(0, 1, At, B1); PG8_BAR; PG8_SCHED;
            PG8_LDA(At, 1, 1); PG8_STAGE(PG8_SB(1, 0), b3, voffB); PG8_STAGE(PG8_SB(1, 1), b3 + hstep, voffB); PG8_STAGE(PG8_SA(1, 0), a3, w0);
            PG8_WAIT_V(8); PG8_WAIT_L(0); PG8_BAR; PG8_MMA(1, 0, At, B0); PG8_MMA(1, 1, At, B1); PG8_BAR; PG8_SCHED;
        }
        if (wr == 0) PG8_BAR;
        if constexpr (FP8) asm volatile("s_nop 15\n\ts_nop 7" ::: "memory");
        { const int t2_ = otid(); E(acc, cur, wr, wc, t2_ & 15, (t2_ & 63) >> 4); }
        if (!has_next) break;
#pragma unroll
        for (int a = 0; a < 2; ++a)
#pragma unroll
            for (int b = 0; b < 2; ++b)
#pragma unroll
                for (int m = 0; m < 4; ++m)
#pragma unroll
                    for (int n = 0; n < 2; ++n) acc[a][b][m][n] = (f32x4){0.f, 0.f, 0.f, 0.f};
        cur = nxt; cA = nA; cB = nB; ++ui;
        if constexpr (GATHER) { voffA0[0] = nvA0[0]; voffA0[1] = nvA0[1]; voffA1[0] = nvA1[0]; voffA1[1] = nvA1[1]; }
        if (wr == 1) PG8_BAR;
    }
    PG8_WAIT_V(0);
    PG8_BAR;
#undef PG8_SA
#undef PG8_SB
#undef PG8_STAGE
#undef PG8_ST1
#undef PG8_MM1
#undef PG8_MMAS
#undef PG8_LDA
#undef PG8_LDB
#undef PG8_MMA
#undef PG8_WAIT_V
#undef PG8_WAIT_L
#undef PG8_BAR
#undef PG8_SCHED
}
}

using pg8::Unit;
constexpr size_t TSTEP = (size_t)256 * 1024 * 2;

struct SchedIn {
    const char* A; const char* B; int G, c;
    __device__ __forceinline__ bool next(int i, Unit& u) const {
        const int L = i * G + c; int pm, pn;
        if (L < 4096) { pg8::tile_map(L, 128, 32, pm, pn); }
        else { const int j = L - 4096; if (j >= 112) return false; pm = 128 + (j & 7); const int cj = j >> 3; pn = cj < 2 ? 2 + cj : (cj < 6 ? 4 + (cj - 2) : 16 + (cj - 6)); }
        u.A = A + (size_t)pm * (TSTEP / 2); u.B = B + (size_t)pn * (TSTEP / 2); u.row0 = pm * 256; u.pn = pn; u.aux = 0; u.aux2 = 0; return true;
    }
};
__device__ __forceinline__ void xstore16(unsigned char* p, size_t rows8, const u32x4 X, const u32x4 Y, bool up) {
    u32x4 a, b;
#pragma unroll
    for (int i = 0; i < 4; ++i) { const unsigned send = up ? X[i] : Y[i]; const unsigned recv = (unsigned)__builtin_amdgcn_update_dpp(0, (int)send, 0x128, 0xf, 0xf, false);
        a[i] = up ? recv : X[i]; b[i] = up ? Y[i] : recv; }
    *(u32x4*)p = a; *(u32x4*)(p + rows8) = b;
}
struct EpiIn {
    unsigned char* ws; const float* ropec; const float* ropes;
    template <int MODE, bool PERMT, bool ISK>
    __device__ __forceinline__ void body(const f32x4 (&acc)[2][2][4][2], unsigned char* basep, unsigned rowbytes, unsigned off0, float sc, int trow, int wc, int fr, int fq, unsigned* kmaxp) const {
        float kmx[2] = {0.f, 0.f};
#pragma unroll
        for (int ai = 0; ai < 2; ++ai)
#pragma unroll
            for (int m = 0; m < 4; ++m) {
                const unsigned off = off0 + (unsigned)(ai * 128 + m * 16) * rowbytes;
                f32x4 cs, sn;
                if (MODE == 1) { const int t = (trow + ai * 128 + m * 16) & 4095; const int pos = (wc & 1) ? (t & 63) : (t >> 6); cs = *(const f32x4*)(ropec + pos * 16 + 4 * fq); sn = *(const f32x4*)(ropes + pos * 16 + 4 * fq); }
                u32x4 wq[2];
#pragma unroll
                for (int bj = 0; bj < 2; ++bj) {
                    f32x4 v0 = acc[ai][bj][m][0], v1 = acc[ai][bj][m][1];
                    if (MODE == 1) { const f32x4 a = v0 * cs - v1 * sn, b = v1 * cs + v0 * sn; v0 = a * sc; v1 = b * sc; }
                    else if (MODE == 2) {
#pragma unroll
                        for (int i = 0; i < 4; ++i) { v0[i] = __builtin_amdgcn_rcpf(1.0f + __builtin_amdgcn_exp2f(v0[i] * (-1.4426950408889634f * 0.015625f))); v1[i] = __builtin_amdgcn_rcpf(1.0f + __builtin_amdgcn_exp2f(v1[i] * (-1.4426950408889634f * 0.015625f))); }
                    } else { v0 = v0 * sc; v1 = v1 * sc; }
                    u32x2 w0, w1; w0.x = cvt_pk_bf16(v0[0], v0[1]); w0.y = cvt_pk_bf16(v0[2], v0[3]); w1.x = cvt_pk_bf16(v1[0], v1[1]); w1.y = cvt_pk_bf16(v1[2], v1[3]);
                    if (PERMT) { wq[bj].x = w0.x; wq[bj].y = w0.y; wq[bj].z = w1.x; wq[bj].w = w1.y; }
                    else { *(u32x2*)(basep + off + bj * 256) = w0; *(u32x2*)(basep + off + bj * 256 + 32) = w1; }
                    if (ISK) { float ss = (v0[0] * v0[0] + v0[1] * v0[1]) + (v0[2] * v0[2] + v0[3] * v0[3]) + (v1[0] * v1[0] + v1[1] * v1[1]) + (v1[2] * v1[2] + v1[3] * v1[3]);
                        ss = halve16(ss, ss); ss = halve32(ss, ss); kmx[bj] = fmaxf(kmx[bj], ss); }
                }
                if (PERMT) xstore16(basep + off, (size_t)8 * rowbytes, wq[0], wq[1], (fr & 8) != 0);
            }
        if (ISK) {
#pragma unroll
            for (int bj = 0; bj < 2; ++bj) { float m = kmx[bj];
#define DPP_MAX(v, CTRL) fmaxf((v), __builtin_bit_cast(float, __builtin_amdgcn_update_dpp(0, __builtin_bit_cast(int, (v)), (CTRL), 0xf, 0xf, false)))
                m = DPP_MAX(m, 0xB1); m = DPP_MAX(m, 0x4E); m = DPP_MAX(m, 0x141); m = DPP_MAX(m, 0x140);
#undef DPP_MAX
                if (fr == 0 && fq == 0) atomicMax(kmaxp + bj * 4, __float_as_uint(sqrtf(m))); }
        }
    }
    __device__ __forceinline__ void operator()(const f32x4 (&acc)[2][2][4][2], const Unit& u, int wr, int wc, int fr, int fq) const {
        const int pn = u.pn, row0 = u.row0; const bool latent = row0 < TL;
        int kvrow0; if (latent) { const int b = row0 >> 12, t = row0 & 4095; kvrow0 = b * KVLEN + CTX + t; } else { const int cc = row0 - TL; kvrow0 = (cc >> 8) * KVLEN + (cc & 255); }
        size_t wsoff; unsigned rowbytes = 2048; int col0, drow0 = row0; float sc = 1.f;
        if (pn < 2)       { wsoff = WS_MQ; rowbytes = 1024; col0 = pn * 256;        sc = 0.08838834764831845f; }
        else if (pn < 4)  { wsoff = WS_MK; rowbytes = 1024; col0 = (pn - 2) * 256; }
        else if (pn < 8)  { wsoff = WS_MV; col0 = (pn - 4) * 256; }
        else if (pn < 12) { wsoff = WS_MO; col0 = (pn - 8) * 256; }
        else if (pn < 16) { wsoff = WS_DQ; col0 = (pn - 12) * 256; sc = 0.125f * 1.4426950408889634f; }
        else if (pn < 20) { wsoff = WS_DK; col0 = (pn - 16) * 256; drow0 = kvrow0; }
        else if (pn < 24) { wsoff = WS_DV; col0 = (pn - 20) * 256; drow0 = kvrow0; }
        else if (pn < 28) { wsoff = WS_GA; col0 = (pn - 24) * 256; }
        else              { wsoff = WS_GB; col0 = (pn - 28) * 256; }
        unsigned char* basep = ws + wsoff + (size_t)drow0 * rowbytes;
        const bool permt = !(pn >= 12 && pn < 20);
        const unsigned off0 = permt ? (unsigned)(wr * 64 + (fr & 7)) * rowbytes + (unsigned)(col0 + wc * 64 + ((fr & 8) ? 32 : 0) + 8 * fq) * 2u
                                    : (unsigned)(wr * 64 + fr) * rowbytes + (unsigned)(col0 + wc * 32 + 4 * fq) * 2u;
        const int kb = latent ? (row0 >> 12) : ((row0 - TL) >> 8);
        unsigned* kmaxp = (unsigned*)(ws + WS_CTL) + CW_KMAX + kb * 32 + ((col0 + wc * 32) >> 5);
        const int trow = row0 + wr * 64 + fr;
        sc *= 0.015625f;
        if (permt) { if (pn >= 24) body<2, true, false>(acc, basep, rowbytes, off0, sc, trow, wc, fr, fq, kmaxp); else body<0, true, false>(acc, basep, rowbytes, off0, sc, trow, wc, fr, fq, kmaxp); }
        else if (pn < 16) body<1, false, false>(acc, basep, rowbytes, off0, sc, trow, wc, fr, fq, kmaxp);
        else if (latent) body<1, false, true>(acc, basep, rowbytes, off0, sc, trow, wc, fr, fq, kmaxp);
        else body<0, false, true>(acc, basep, rowbytes, off0, sc, trow, wc, fr, fq, kmaxp);
    }
};

struct SchedStatic {
    const char* A; const char* B; int nM, nN, G, c;
    __device__ __forceinline__ bool next(int i, Unit& u) const {
        const int L = i * G + c; if (L >= nM * nN) return false; int pm, pn; pg8::tile_map(L, nM, nN, pm, pn);
        u.A = A + (size_t)pm * TSTEP; u.B = B + (size_t)pn * TSTEP; u.row0 = pm * 256; u.pn = pn; u.aux = 0; u.aux2 = 0; return true;
    }
};
template <int MODE> struct EpiMerge {
    const bf16_t* gate; const bf16_t* tin; bf16_t* outp;
    __device__ __forceinline__ void operator()(const f32x4 (&acc)[2][2][4][2], const Unit& u, int wr, int wc, int fr, int fq) const {
        const int cl = u.pn * 256 + wc * 64 + 8 * fq;
        const bool up = (fr & 8) != 0;
#pragma unroll
        for (int ai = 0; ai < 2; ++ai)
#pragma unroll
            for (int m = 0; m < 4; ++m) {
                const int rbase = u.row0 + ai * 128 + wr * 64 + m * 16;
                const size_t ro = (size_t)(rbase + fr) * 1024 + cl;
                u32x4 wq[2];
#pragma unroll
                for (int bj = 0; bj < 2; ++bj) {
                    const size_t o = ro + bj * 32;
                    const u32x4 g = *(const u32x4*)(gate + o);
                    f32x4 v0 = acc[ai][bj][m][0], v1 = acc[ai][bj][m][1];
                    v0[0] *= bf_lo(g.x); v0[1] *= bf_hi(g.x); v0[2] *= bf_lo(g.y); v0[3] *= bf_hi(g.y); v1[0] *= bf_lo(g.z); v1[1] *= bf_hi(g.z); v1[2] *= bf_lo(g.w); v1[3] *= bf_hi(g.w);
                    if (MODE == 1) { const u32x4 t = *(const u32x4*)(tin + o);
                        v0[0] += bf_lo(t.x); v0[1] += bf_hi(t.x); v0[2] += bf_lo(t.y); v0[3] += bf_hi(t.y); v1[0] += bf_lo(t.z); v1[1] += bf_hi(t.z); v1[2] += bf_lo(t.w); v1[3] += bf_hi(t.w); }
                    wq[bj].x = cvt_pk_bf16(v0[0], v0[1]); wq[bj].y = cvt_pk_bf16(v0[2], v0[3]); wq[bj].z = cvt_pk_bf16(v1[0], v1[1]); wq[bj].w = cvt_pk_bf16(v1[2], v1[3]);
                }
                xstore16((unsigned char*)(outp + (size_t)(rbase + (fr & 7)) * 1024 + cl + (up ? 32 : 0)), (size_t)8 * 2048, wq[0], wq[1], up);
            }
    }
};
struct SchedMerge2 {
    const char* A0; const char* B0; const char* A1; const char* B1; int nM, nN, G, c;
    __device__ __forceinline__ bool next(int i, Unit& u) const {
        const int L = (i >> 1) * G + c; if (L >= nM * nN) return false; int pm, pn; pg8::tile_map(L, nM, nN, pm, pn); const int h = i & 1;
        u.A = (h ? A1 : A0) + (size_t)pm * TSTEP; u.B = (h ? B1 : B0) + (size_t)pn * TSTEP; u.row0 = pm * 256; u.pn = pn; u.aux = h; u.aux2 = 0; return true;
    }
};
struct EpiMerge2 {
    const bf16_t* ga; const bf16_t* gb; bf16_t* t; bf16_t* y;
    __device__ __forceinline__ void operator()(const f32x4 (&acc)[2][2][4][2], const Unit& u, int wr, int wc, int fr, int fq) const {
        if (u.aux == 0) { EpiMerge<0> E{ga, nullptr, t}; E(acc, u, wr, wc, fr, fq); } else { EpiMerge<1> E{gb, t, y}; E(acc, u, wr, wc, fr, fq); }
    }
};
struct EpiOut {
    const float* x; const float* mod; bf16_t* x1;
    __device__ __forceinline__ void operator()(const f32x4 (&acc)[2][2][4][2], const Unit& u, int wr, int wc, int fr, int fq) const {
        const int cl = u.pn * 256 + wc * 64 + 8 * fq; const float* g1 = mod + (size_t)(u.row0 >> 12) * 6144 + 2048;
        const bool up = (fr & 8) != 0;
        f32x4 g0[2], g1v[2];
#pragma unroll
        for (int bj = 0; bj < 2; ++bj) { g0[bj] = *(const f32x4*)(g1 + cl + bj * 32); g1v[bj] = *(const f32x4*)(g1 + cl + bj * 32 + 4); }
#pragma unroll
        for (int ai = 0; ai < 2; ++ai)
#pragma unroll
            for (int m = 0; m < 4; ++m) {
                const int rbase = u.row0 + ai * 128 + wr * 64 + m * 16;
                u32x4 wq[2];
#pragma unroll
                for (int bj = 0; bj < 2; ++bj) {
                    const size_t o = (size_t)(rbase + fr) * 1024 + cl + bj * 32;
                    const f32x4 a = *(const f32x4*)(x + o) + g0[bj] * acc[ai][bj][m][0], c = *(const f32x4*)(x + o + 4) + g1v[bj] * acc[ai][bj][m][1];
                    wq[bj].x = cvt_pk_bf16(a[0], a[1]); wq[bj].y = cvt_pk_bf16(a[2], a[3]); wq[bj].z = cvt_pk_bf16(c[0], c[1]); wq[bj].w = cvt_pk_bf16(c[2], c[3]);
                }
                xstore16((unsigned char*)(x1 + (size_t)(rbase + (fr & 7)) * 1024 + cl + (up ? 32 : 0)), (size_t)8 * 2048, wq[0], wq[1], up);
            }
    }
};

constexpr int RT2E_OFF = (140288 - 131072) / 4;
struct SchedMoe1 {
    const char* U2; const char* W1; const int* list; const LAS int* tb; const LAS int* cnt; int G, c;
    __device__ __forceinline__ bool next(int i, Unit& u) const {
        const int L = i * G + c; const int xcd = L & 7, j = L >> 3; const int pn = j & 7, rt = (j >> 3) * 8 + xcd;
        const int NRT = __builtin_amdgcn_readfirstlane(tb[32]);
        if (rt >= NRT) return false;
        const int e = __builtin_amdgcn_readfirstlane(tb[RT2E_OFF + rt]);
        const int tbe = __builtin_amdgcn_readfirstlane(tb[e]);
        u.A = U2; u.B = W1 + ((size_t)e * 2048 + (size_t)pn * 256) * 1024; u.row0 = rt * 256; u.pn = pn; u.aux = e; u.aux2 = (rt - tbe) * 256; return true;
    }
    __device__ __forceinline__ void offsets(const Unit& u, int tid, unsigned (&o0)[2], unsigned (&o1)[2]) const {
        const int e = u.aux; const int n = __builtin_amdgcn_readfirstlane(cnt[e]) - u.aux2; const int* lp = list + (size_t)e * CAP + u.aux2;
#pragma unroll
        for (int i = 0; i < 2; ++i) {
            int R, C; pg8::stage_rc(tid * 16 + i * 8192, R, C);
            const int t0 = R < n ? lp[R] : 0, t1 = (128 + R) < n ? lp[128 + R] : 0;
            o0[i] = (unsigned)t0 * 1024u + (unsigned)C * 2u; o1[i] = (unsigned)t1 * 1024u + (unsigned)C * 2u;
        }
    }
};
struct EpiMoe1 {
    unsigned char* act; const float* b1;
    __device__ __forceinline__ void operator()(const f32x4 (&acc)[2][2][4][2], const Unit& u, int wr, int wc, int fr, int fq) const {
        if (u.aux < 0) return;
        const int cl = u.pn * 128 + wc * 32 + 8 * fq; const float* bb = b1 + (size_t)u.aux * 2048;
        f32x4 bg[2], bl[2];
#pragma unroll
        for (int n = 0; n < 2; ++n) { bg[n] = *(const f32x4*)(bb + cl + n * 4); bl[n] = *(const f32x4*)(bb + 1024 + cl + n * 4) + 1.0f; }
#pragma unroll
        for (int ai = 0; ai < 2; ++ai)
#pragma unroll
            for (int m = 0; m < 4; ++m) {
                f32x4 a[2];
#pragma unroll
                for (int n = 0; n < 2; ++n) { const f32x4 g = acc[ai][0][m][n] * 0.015625f + bg[n], l = acc[ai][1][m][n] * 0.015625f + bl[n];
#pragma unroll
                    for (int i = 0; i < 4; ++i) { const float gg = fminf(g[i], 7.0f), l1 = fminf(fmaxf(l[i], -6.0f), 8.0f);
                        a[n][i] = gg * __builtin_amdgcn_rcpf(1.0f + __builtin_amdgcn_exp2f(gg * (-1.702f * 1.4426950408889634f))) * l1; } }
                u32x2 w; w.x = pk4_fp8(a[0][0], a[0][1], a[0][2], a[0][3]); w.y = pk4_fp8(a[1][0], a[1][1], a[1][2], a[1][3]);
                *(u32x2*)(act + (size_t)(u.row0 + ai * 128 + wr * 64 + m * 16 + fr) * 1024 + cl) = w;
            }
    }
};
struct SchedMoe2 {
    const char* ACT; const char* W2; const LAS int* tb; int G, c;
    __device__ __forceinline__ bool next(int i, Unit& u) const {
        const int L = i * G + c; const int xcd = L & 7, j = L >> 3; const int pn = j & 3, rt = (j >> 2) * 8 + xcd;
        const int NRT = __builtin_amdgcn_readfirstlane(tb[32]);
        if (rt >= NRT) return false;
        const int e = __builtin_amdgcn_readfirstlane(tb[RT2E_OFF + rt]);
        const int tbe = __builtin_amdgcn_readfirstlane(tb[e]);
        u.A = ACT + (size_t)rt * (TSTEP / 2); u.B = W2 + ((size_t)e * 1024 + (size_t)pn * 256) * 1024; u.row0 = rt * 256; u.pn = pn; u.aux = e; u.aux2 = (rt - tbe) * 256; return true;
    }
};
struct EpiMoe2 {
    bf16_t* ys; const float* b2; const float* lgate; const LAS int* cnt;
    __device__ __forceinline__ void operator()(const f32x4 (&acc)[2][2][4][2], const Unit& u, int wr, int wc, int fr, int fq) const {
        if (u.aux < 0) return;
        const int cl = u.pn * 256 + wc * 64 + 8 * fq; const float* bb = b2 + (size_t)u.aux * 1024; const int n = __builtin_amdgcn_readfirstlane(cnt[u.aux]) - u.aux2; const float* gp = lgate + (size_t)u.aux * CAP + u.aux2;
        const bool up = (fr & 8) != 0;
        f32x4 bv[2][2];
#pragma unroll
        for (int bj = 0; bj < 2; ++bj)
#pragma unroll
            for (int nn = 0; nn < 2; ++nn) bv[bj][nn] = *(const f32x4*)(bb + cl + bj * 32 + nn * 4);
#pragma unroll
        for (int ai = 0; ai < 2; ++ai)
#pragma unroll
            for (int m = 0; m < 4; ++m) {
                const int rl = ai * 128 + wr * 64 + m * 16 + fr; const float gw = rl < n ? gp[rl] : 0.f;
                u32x4 wq[2];
#pragma unroll
                for (int bj = 0; bj < 2; ++bj) {
                    const f32x4 v0 = (acc[ai][bj][m][0] * 0.015625f + bv[bj][0]) * gw, v1 = (acc[ai][bj][m][1] * 0.015625f + bv[bj][1]) * gw;
                    wq[bj].x = cvt_pk_bf16(v0[0], v0[1]); wq[bj].y = cvt_pk_bf16(v0[2], v0[3]); wq[bj].z = cvt_pk_bf16(v1[0], v1[1]); wq[bj].w = cvt_pk_bf16(v1[2], v1[3]);
                }
                xstore16((unsigned char*)(ys + (size_t)(u.row0 + (rl & ~8)) * 1024 + cl + (up ? 32 : 0)), (size_t)8 * 2048, wq[0], wq[1], up);
            }
    }
};

namespace att {
constexpr int NW = 8, QBLK = 32, KVBLK = 64, LD = 1024;
constexpr float SCALE = 0.125f;
constexpr float THR = 8.f;
constexpr int SHM_V = KVBLK * 128 * 2, SHM_K = KVBLK * 128 * 2, SHM_ATTN = 4 * SHM_V + 4 * SHM_K + NW * 64 * 4;
#define KSWZ(row, colB) ((row) * 256 + ((colB) ^ (((row) & 15) << 4)))
#define SBAR() __builtin_amdgcn_sched_barrier(0)
__device__ __forceinline__ int crow(int r, int hi) { return (r & 3) + 8 * (r >> 2) + 4 * hi; }
__device__ __forceinline__ unsigned cvtpk(float lo, float hi) { return cvt_pk_bf16(lo, hi); }

__device__ __forceinline__ void finishSM(f32x16& p0, f32x16& p1, float& l_reg, bf16x8& pa0, bf16x8& pa1, bf16x8& pa2, bf16x8& pa3) {
#pragma unroll
  for (int r = 0; r < 16; ++r) { p0[r] = __builtin_amdgcn_exp2f(p0[r]); p1[r] = __builtin_amdgcn_exp2f(p1[r]); }
  float s0 = p0[0], s1 = p0[8], s2 = p1[0], s3 = p1[8];
#pragma unroll
  for (int r = 1; r < 8; ++r) { s0 += p0[r]; s1 += p0[8 + r]; s2 += p1[r]; s3 += p1[8 + r]; }
  l_reg += (s0 + s1) + (s2 + s3);
#define PK4(P, BASE, OUT) do { unsigned a0 = cvtpk(P[BASE + 0], P[BASE + 1]), a1 = cvtpk(P[BASE + 2], P[BASE + 3]);   \
    unsigned b0 = cvtpk(P[BASE + 4], P[BASE + 5]), b1 = cvtpk(P[BASE + 6], P[BASE + 7]);                              \
    auto r0 = __builtin_amdgcn_permlane32_swap(a0, b0, false, false); auto r1 = __builtin_amdgcn_permlane32_swap(a1, b1, false, false); \
    u32x4 w = {r0[0], r1[0], r0[1], r1[1]}; OUT = *reinterpret_cast<bf16x8*>(&w); } while (0)
  PK4(p0, 0, pa0); PK4(p0, 8, pa1); PK4(p1, 0, pa2); PK4(p1, 8, pa3);
#undef PK4
}
__device__ __forceinline__ void qkt(f32x16& p0, f32x16& p1, const bf16_t* Ks, const bf16x8* qr, int r32, int hi, int mp) {
  p0 = f32x16{}; p1 = f32x16{};
#pragma unroll
  for (int d0 = 0; d0 < 4; ++d0) { int cb = (mp * 64 + d0 * 16 + hi * 8) * 2;
    bf16x8 b0 = *reinterpret_cast<const bf16x8*>((const char*)Ks + KSWZ(r32, cb));
    bf16x8 b1 = *reinterpret_cast<const bf16x8*>((const char*)Ks + KSWZ(32 + r32, cb));
    p0 = __builtin_amdgcn_mfma_f32_32x32x16_bf16(b0, qr[d0], p0, 0, 0, 0);
    p1 = __builtin_amdgcn_mfma_f32_32x32x16_bf16(b1, qr[d0], p1, 0, 0, 0); }
}
__device__ __forceinline__ int v_st(int k, int c) { const int kk = (k & ~0xC) | ((k & 4) << 1) | ((k & 8) >> 1); return ((kk >> 3) * 4 + (c >> 5)) * 512 + ((kk & 7) * 32 + (c & 31)) * 2; }
__device__ __forceinline__ int v_rd_base(int lane) { return ((lane & 3) << 3) | (((lane >> 2) & 3) << 6) | (((lane >> 4) & 1) << 5) | (((lane >> 5) & 1) << 8); }
constexpr int v_rd_off(int d0, int ks, int half) { return d0 * 512 + ks * 4096 + half * 2048; }
__device__ __forceinline__ int v_rd_base2(int lane) { return ((lane & 3) << 3) | (((lane >> 2) & 3) << 6) | (((lane >> 4) & 1) << 5) | (((lane >> 5) & 1) << 11); }
constexpr int v_rd_off2(int d0, int ks, int half) { return d0 * 512 + ks * 4096 + half * 256; }
template <int OFF> __device__ __forceinline__ s16x4 tr_read(int vb) {
  s16x4 r; asm volatile("ds_read_b64_tr_b16 %0, %1 offset:%2" : "=&v"(r) : "v"(vb), "i"(OFF) : "memory"); return r;
}
template <int D0> __device__ __forceinline__ void pv_one(f32x16& od, int vb, bf16x8 pa0, bf16x8 pa1, bf16x8 pa2, bf16x8 pa3) {
  const s16x4 l0 = tr_read<v_rd_off(D0, 0, 0)>(vb), h0 = tr_read<v_rd_off(D0, 0, 1)>(vb), l1 = tr_read<v_rd_off(D0, 1, 0)>(vb), h1 = tr_read<v_rd_off(D0, 1, 1)>(vb);
  const s16x4 l2 = tr_read<v_rd_off(D0, 2, 0)>(vb), h2 = tr_read<v_rd_off(D0, 2, 1)>(vb), l3 = tr_read<v_rd_off(D0, 3, 0)>(vb), h3 = tr_read<v_rd_off(D0, 3, 1)>(vb);
  asm volatile("s_waitcnt lgkmcnt(0)" ::: "memory"); SBAR();
#define PK(L, H) (bf16x8){L[0], L[1], L[2], L[3], H[0], H[1], H[2], H[3]}
  od = __builtin_amdgcn_mfma_f32_32x32x16_bf16(pa0, PK(l0, h0), od, 0, 0, 0);
  od = __builtin_amdgcn_mfma_f32_32x32x16_bf16(pa1, PK(l1, h1), od, 0, 0, 0);
  od = __builtin_amdgcn_mfma_f32_32x32x16_bf16(pa2, PK(l2, h2), od, 0, 0, 0);
  od = __builtin_amdgcn_mfma_f32_32x32x16_bf16(pa3, PK(l3, h3), od, 0, 0, 0);
#undef PK
}
__device__ __forceinline__ void pv_d0(f32x16* o, int vb, bf16x8 pa0, bf16x8 pa1, bf16x8 pa2, bf16x8 pa3) {
  pv_one<0>(o[0], vb, pa0, pa1, pa2, pa3); pv_one<1>(o[1], vb, pa0, pa1, pa2, pa3); pv_one<2>(o[2], vb, pa0, pa1, pa2, pa3); pv_one<3>(o[3], vb, pa0, pa1, pa2, pa3);
}
template <bool QK, bool PV>
__device__ __forceinline__ void mphase(f32x16& p0, f32x16& p1, f32x16* o, const char* Ks, int vb, const bf16x8* qr, const f32x16& negm,
                                       bf16x8 pa0, bf16x8 pa1, bf16x8 pa2, bf16x8 pa3, int r32, int hi, int mp) {
#define TR8(dst, D0) do { dst[0] = tr_read<v_rd_off(D0, 0, 0)>(vb); dst[1] = tr_read<v_rd_off(D0, 0, 1)>(vb); dst[2] = tr_read<v_rd_off(D0, 1, 0)>(vb); dst[3] = tr_read<v_rd_off(D0, 1, 1)>(vb); \
    dst[4] = tr_read<v_rd_off(D0, 2, 0)>(vb); dst[5] = tr_read<v_rd_off(D0, 2, 1)>(vb); dst[6] = tr_read<v_rd_off(D0, 3, 0)>(vb); dst[7] = tr_read<v_rd_off(D0, 3, 1)>(vb); } while (0)
#define PKV(v, k) (bf16x8){v[2 * (k)][0], v[2 * (k)][1], v[2 * (k)][2], v[2 * (k)][3], v[2 * (k) + 1][0], v[2 * (k) + 1][1], v[2 * (k) + 1][2], v[2 * (k) + 1][3]}
#define PV4(od, v) do { od = __builtin_amdgcn_mfma_f32_32x32x16_bf16(pa0, PKV(v, 0), od, 0, 0, 0); od = __builtin_amdgcn_mfma_f32_32x32x16_bf16(pa1, PKV(v, 1), od, 0, 0, 0); \
    od = __builtin_amdgcn_mfma_f32_32x32x16_bf16(pa2, PKV(v, 2), od, 0, 0, 0); od = __builtin_amdgcn_mfma_f32_32x32x16_bf16(pa3, PKV(v, 3), od, 0, 0, 0); } while (0)
#define LWAIT(n) do { asm volatile("s_waitcnt lgkmcnt(" #n ")" ::: "memory"); SBAR(); } while (0)
  bf16x8 kf0[4], kf1[4]; s16x4 va[8], vc[8];
  if constexpr (QK) {
#pragma unroll
    for (int d0 = 0; d0 < 4; ++d0) { const int cb = (mp * 64 + d0 * 16 + hi * 8) * 2;
      asm volatile("ds_read_b128 %0, %1" : "=&v"(kf0[d0]) : "v"((int)(uintptr_t)Ks + KSWZ(r32, cb)) : "memory");
      asm volatile("ds_read_b128 %0, %1" : "=&v"(kf1[d0]) : "v"((int)(uintptr_t)Ks + KSWZ(32 + r32, cb)) : "memory"); }
  }
  if constexpr (PV) TR8(va, 0);
  if constexpr (QK) {
    if constexpr (PV) LWAIT(8); else LWAIT(0);
    p0 = __builtin_amdgcn_mfma_f32_32x32x16_bf16(kf0[0], qr[0], negm, 0, 0, 0); p1 = __builtin_amdgcn_mfma_f32_32x32x16_bf16(kf1[0], qr[0], negm, 0, 0, 0);
#pragma unroll
    for (int d0 = 1; d0 < 4; ++d0) { p0 = __builtin_amdgcn_mfma_f32_32x32x16_bf16(kf0[d0], qr[d0], p0, 0, 0, 0); p1 = __builtin_amdgcn_mfma_f32_32x32x16_bf16(kf1[d0], qr[d0], p1, 0, 0, 0); }
    SBAR();
  }
  if constexpr (PV) {
    TR8(vc, 1); LWAIT(8); PV4(o[0], va); SBAR();
    TR8(va, 2); LWAIT(8); PV4(o[1], vc); SBAR();
    TR8(vc, 3); LWAIT(8); PV4(o[2], va); SBAR();
    LWAIT(0); PV4(o[3], vc); SBAR();
  }
#undef TR8
#undef PKV
#undef PV4
#undef LWAIT
}

__device__ __forceinline__ void attn_unit(const bf16_t* __restrict__ Qb, const bf16_t* __restrict__ Kh, const bf16_t* __restrict__ Vh, bf16_t* __restrict__ Ob,
                                          const float* __restrict__ gd, const float* __restrict__ kmax, float lam, int seq, char* lds) {
  const int tid = otid(), wid = __builtin_amdgcn_readfirstlane(tid >> 6), lane = tid & 63, r32 = lane & 31, hi = lane >> 5;
  const int qw = wid & 3, mp = wid >> 2;
  char* K_lds = lds; char* V_lds = lds + SHM_K;
  constexpr int SLOT = SHM_K + SHM_V;
  float* wsf = (float*)(lds + 4 * SLOT) + wid * 64; float* li_l = wsf;
  float l_reg = 0; f32x16 o[4] = {}; bf16x8 qr[4];
  const bf16_t* Qw = Qb + (long)(qw * QBLK + r32) * LD + mp * 64 + hi * 8;
#pragma unroll
  for (int d0 = 0; d0 < 4; ++d0) qr[d0] = *reinterpret_cast<const bf16x8*>(Qw + d0 * 16);
  float mnC;
  { float ssa = 0.f, ssb = 0.f;
#pragma unroll
    for (int d0 = 0; d0 < 4; ++d0) { const u32x4 q4 = *reinterpret_cast<const u32x4*>(&qr[d0]);
      const float t = (bf_lo(q4.x) * bf_lo(q4.x) + bf_hi(q4.x) * bf_hi(q4.x)) + (bf_lo(q4.y) * bf_lo(q4.y) + bf_hi(q4.y) * bf_hi(q4.y)) + (bf_lo(q4.z) * bf_lo(q4.z) + bf_hi(q4.z) * bf_hi(q4.z)) + (bf_lo(q4.w) * bf_lo(q4.w) + bf_hi(q4.w) * bf_hi(q4.w));
      if (d0 < 2) ssa += t; else ssb += t; }
    { auto rr = __builtin_amdgcn_permlane32_swap(__float_as_uint(ssa), __float_as_uint(ssa), false, false); ssa = __uint_as_float(rr[0]) + __uint_as_float(rr[1]); }
    { auto rr = __builtin_amdgcn_permlane32_swap(__float_as_uint(ssb), __float_as_uint(ssb), false, false); ssb = __uint_as_float(rr[0]) + __uint_as_float(rr[1]); }
    mnC = -(sqrtf(ssa) * kmax[mp * 2] + sqrtf(ssb) * kmax[mp * 2 + 1]) * 1.01f; }
  f32x16 negm;
#pragma unroll
  for (int r = 0; r < 16; ++r) negm[r] = mnC;
  asm volatile("" : "+v"(negm));
  const int sr = tid >> 4, sc = (tid & 15) * 8, vst0 = v_st(sr, sc), vst1 = v_st(32 + sr, sc), kst0 = KSWZ(sr, sc * 2), kst1 = KSWZ(32 + sr, sc * 2);
  const int vb0 = (int)(uintptr_t)V_lds + v_rd_base(lane);
  bf16x8 sk0, sk1, sv0, sv1;
#define SLOAD(t) do { const long k0_ = (long)(t) * KVBLK; sv0 = *reinterpret_cast<const bf16x8*>(&Vh[(k0_ + sr) * LD + sc]); sv1 = *reinterpret_cast<const bf16x8*>(&Vh[(k0_ + 32 + sr) * LD + sc]); \
    sk0 = *reinterpret_cast<const bf16x8*>(&Kh[(k0_ + sr) * LD + sc]); sk1 = *reinterpret_cast<const bf16x8*>(&Kh[(k0_ + 32 + sr) * LD + sc]); } while (0)
#define SWRITE(t) do { char* kp_ = K_lds + ((t) & 3) * SLOT; char* vp_ = V_lds + ((t) & 3) * SLOT; *(bf16x8*)(vp_ + vst0) = sv0; *(bf16x8*)(vp_ + vst1) = sv1; *(bf16x8*)(kp_ + kst0) = sk0; *(bf16x8*)(kp_ + kst1) = sk1; } while (0)
#define PBAR() do { SBAR(); asm volatile("s_waitcnt lgkmcnt(0)\n\ts_barrier" ::: "memory"); SBAR(); } while (0)
  f32x16 p0, p1; bf16x8 pa0, pa1, pa2, pa3; const int NT = seq / KVBLK;
  SLOAD(0); SWRITE(0); SLOAD(1); SWRITE(1); SLOAD(2);
  PBAR();
  if (mp == 1) PBAR();
  pa0 = pa1 = pa2 = pa3 = bf16x8{};
  __builtin_amdgcn_s_setprio(1); mphase<true, false>(p0, p1, o, K_lds, vb0, qr, negm, pa0, pa1, pa2, pa3, r32, hi, mp); __builtin_amdgcn_s_setprio(0);
  PBAR();
#pragma unroll 1
  for (int t = 0; t + 1 < NT; ++t) {
    finishSM(p0, p1, l_reg, pa0, pa1, pa2, pa3);
    if (t + 2 < NT) { SWRITE(t + 2); if (t + 3 < NT) SLOAD(t + 3); }
    PBAR();
    __builtin_amdgcn_s_setprio(1);
    mphase<true, true>(p0, p1, o, K_lds + ((t + 1) & 3) * SLOT, vb0 + (t & 3) * SLOT, qr, negm, pa0, pa1, pa2, pa3, r32, hi, mp);
    __builtin_amdgcn_s_setprio(0);
    PBAR();
  }
  finishSM(p0, p1, l_reg, pa0, pa1, pa2, pa3);
  PBAR();
  __builtin_amdgcn_s_setprio(1); mphase<false, true>(p0, p1, o, K_lds, vb0 + ((NT - 1) & 3) * SLOT, qr, negm, pa0, pa1, pa2, pa3, r32, hi, mp); __builtin_amdgcn_s_setprio(0);
  if (mp == 0) PBAR();
  { auto rr = __builtin_amdgcn_permlane32_swap(__float_as_uint(l_reg), __float_as_uint(l_reg), false, false); l_reg = __uint_as_float(rr[0]) + __uint_as_float(rr[1]); }
  if (hi == 0) li_l[r32] = l_reg; asm volatile("s_waitcnt lgkmcnt(0)" ::: "memory");
  float rli[16];
#pragma unroll
  for (int r = 0; r < 16; ++r) rli[r] = __builtin_amdgcn_rcpf(li_l[crow(r, hi)]);
  __syncthreads();
  float* xch = (float*)lds + qw * 4096 + lane;
  if (mp == 1) {
#pragma unroll
    for (int r = 0; r < 16; ++r)
#pragma unroll
      for (int d0 = 0; d0 < 4; ++d0) xch[(r * 4 + d0) * 64] = o[d0][r] * rli[r] * lam;
  }
  __syncthreads();
  if (mp == 0) {
    float gv[4];
#pragma unroll
    for (int d0 = 0; d0 < 4; ++d0) gv[d0] = gd[d0 * 32 + r32] * (1.0f - LAM_INIT);
#pragma unroll
    for (int r = 0; r < 16; ++r) {
      float dv[4]; float ss = 0.f;
#pragma unroll
      for (int d0 = 0; d0 < 4; ++d0) { dv[d0] = o[d0][r] * rli[r] - xch[(r * 4 + d0) * 64]; ss += dv[d0] * dv[d0]; }
      ss = row16_sum(ss); ss = halve16(ss, ss);
      const float rstd = rsqrtf(ss * (1.0f / 128.0f) + EPS);
      bf16_t* orow = Ob + (long)(qw * QBLK + crow(r, hi)) * LD + r32;
#pragma unroll
      for (int d0 = 0; d0 < 4; ++d0) orow[d0 * 32] = (bf16_t)(cvtpk(dv[d0] * rstd * gv[d0], 0.f) & 0xffffu);
    }
  }
  __syncthreads();
#undef SLOAD
#undef SWRITE
#undef PBAR
}

__device__ __forceinline__ void kfrag_issue(bf16x8 (&kf0)[4], bf16x8 (&kf1)[4], const char* Ks, int r32, int hi, int mp) {
#pragma unroll
  for (int d0 = 0; d0 < 4; ++d0) { const int cb = (mp * 64 + d0 * 16 + hi * 8) * 2;
    asm volatile("ds_read_b128 %0, %1" : "=&v"(kf0[d0]) : "v"((int)(uintptr_t)Ks + KSWZ(r32, cb)) : "memory");
    asm volatile("ds_read_b128 %0, %1" : "=&v"(kf1[d0]) : "v"((int)(uintptr_t)Ks + KSWZ(32 + r32, cb)) : "memory"); }
}
__device__ __forceinline__ void kfrag_issue_half(bf16x8 (&kf)[4], const char* Ks, int row, int hi, int mp) {
#pragma unroll
  for (int d0 = 0; d0 < 4; ++d0) { const int cb = (mp * 64 + d0 * 16 + hi * 8) * 2;
    asm volatile("ds_read_b128 %0, %1" : "=&v"(kf[d0]) : "v"((int)(uintptr_t)Ks + KSWZ(row, cb)) : "memory"); }
}
#define AIL_MFMA() __builtin_amdgcn_sched_group_barrier(0x008, 1, 0)
#define AIL_TRANS(n) __builtin_amdgcn_sched_group_barrier(0x400, n, 0)
#define AIL_VALU(n) __builtin_amdgcn_sched_group_barrier(0x002, n, 0)
__device__ __forceinline__ void attn_unit2(const bf16_t* __restrict__ Qb, const bf16_t* __restrict__ Kh, const bf16_t* __restrict__ Vh, bf16_t* __restrict__ Ob,
                                           const float* __restrict__ gd, const float* __restrict__ kmax, float lam, int seq, char* lds) {
  const int tid = otid(), wid = __builtin_amdgcn_readfirstlane(tid >> 6), lane = tid & 63, r32 = lane & 31, hi = lane >> 5;
  const int qw = wid & 3, mp = wid >> 2;
  char* K_lds = lds; char* V_lds = lds + SHM_K;
  constexpr int SLOT = SHM_K + SHM_V;
  float* wsf = (float*)(lds + 4 * SLOT) + wid * 64; float* li_l = wsf;
  f32x16 o[4] = {}; bf16x8 qr[4];
  const bf16_t* Qw = Qb + (long)(qw * QBLK + r32) * LD + mp * 64 + hi * 8;
#pragma unroll
  for (int d0 = 0; d0 < 4; ++d0) qr[d0] = *reinterpret_cast<const bf16x8*>(Qw + d0 * 16);
  unsigned koff[2], voff[2];
#pragma unroll
  for (int i = 0; i < 2; ++i) { const int o_ = i * 8192 + tid * 16; const int row_ = o_ >> 8, ch_ = ((o_ >> 4) & 15) ^ (row_ & 15); koff[i] = (unsigned)(row_ * LD + ch_ * 8);
    const int s_ = o_ >> 9, r8_ = (o_ >> 6) & 7, cb_ = o_ & 63, kk_ = (s_ >> 2) * 8 + r8_, k_ = (kk_ & ~0xC) | ((kk_ & 4) << 1) | ((kk_ & 8) >> 1); voff[i] = (unsigned)(k_ * LD + (s_ & 3) * 32 + (cb_ >> 1)); }
  const int vb0 = (int)(uintptr_t)V_lds + v_rd_base2(lane);
  typedef __attribute__((address_space(3))) unsigned lds_u32_t;
#define SDMA(t) do { const bf16_t* kg_ = Kh + (long)(t) * KVBLK * LD; const bf16_t* vg_ = Vh + (long)(t) * KVBLK * LD; char* kp_ = K_lds + ((t) & 3) * SLOT + wid * 1024; char* vp_ = V_lds + ((t) & 3) * SLOT + wid * 1024; \
    _Pragma("unroll") for (int i_ = 0; i_ < 2; ++i_) { __builtin_amdgcn_global_load_lds((const unsigned*)(kg_ + koff[i_]), (lds_u32_t*)(kp_ + i_ * 8192), 16, 0, 0); \
                                                       __builtin_amdgcn_global_load_lds((const unsigned*)(vg_ + voff[i_]), (lds_u32_t*)(vp_ + i_ * 8192), 16, 0, 0); } } while (0)
#define PBAR() do { SBAR(); asm volatile("s_waitcnt lgkmcnt(0)\n\ts_barrier" ::: "memory"); SBAR(); } while (0)
#define TR8(dst, D0, vb) do { dst[0] = tr_read<v_rd_off2(D0, 0, 0)>(vb); dst[1] = tr_read<v_rd_off2(D0, 0, 1)>(vb); dst[2] = tr_read<v_rd_off2(D0, 1, 0)>(vb); dst[3] = tr_read<v_rd_off2(D0, 1, 1)>(vb); \
    dst[4] = tr_read<v_rd_off2(D0, 2, 0)>(vb); dst[5] = tr_read<v_rd_off2(D0, 2, 1)>(vb); dst[6] = tr_read<v_rd_off2(D0, 3, 0)>(vb); dst[7] = tr_read<v_rd_off2(D0, 3, 1)>(vb); } while (0)
#define PKV(v, k) (bf16x8){v[2 * (k)][0], v[2 * (k)][1], v[2 * (k)][2], v[2 * (k)][3], v[2 * (k) + 1][0], v[2 * (k) + 1][1], v[2 * (k) + 1][2], v[2 * (k) + 1][3]}
#define LWAIT(n) do { asm volatile("s_waitcnt lgkmcnt(" #n ")" ::: "memory"); SBAR(); } while (0)
#define QKT(Ks, PRE, NW) do { bf16x8 kf0[4], kf1[4]; kfrag_issue(kf0, kf1, (Ks), r32, hi, mp); PRE; LWAIT(NW); \
    p0 = __builtin_amdgcn_mfma_f32_32x32x16_bf16(kf0[0], qr[0], negm, 0, 0, 0); p1 = __builtin_amdgcn_mfma_f32_32x32x16_bf16(kf1[0], qr[0], negm, 0, 0, 0); \
    _Pragma("unroll") for (int d0 = 1; d0 < 4; ++d0) { p0 = __builtin_amdgcn_mfma_f32_32x32x16_bf16(kf0[d0], qr[d0], p0, 0, 0, 0); p1 = __builtin_amdgcn_mfma_f32_32x32x16_bf16(kf1[d0], qr[d0], p1, 0, 0, 0); } SBAR(); } while (0)
#define PVGROUP(D0, V, P, B, PAOUT, SA, SB) do { \
    o[D0] = __builtin_amdgcn_mfma_f32_32x32x16_bf16(pa0, PKV(V, 0), o[D0], 0, 0, 0); P[B + 0] = __builtin_amdgcn_exp2f(P[B + 0]); P[B + 1] = __builtin_amdgcn_exp2f(P[B + 1]); \
    o[D0] = __builtin_amdgcn_mfma_f32_32x32x16_bf16(pa1, PKV(V, 1), o[D0], 0, 0, 0); P[B + 2] = __builtin_amdgcn_exp2f(P[B + 2]); P[B + 3] = __builtin_amdgcn_exp2f(P[B + 3]); SA += P[B + 0]; SB += P[B + 1]; \
    o[D0] = __builtin_amdgcn_mfma_f32_32x32x16_bf16(pa2, PKV(V, 2), o[D0], 0, 0, 0); P[B + 4] = __builtin_amdgcn_exp2f(P[B + 4]); P[B + 5] = __builtin_amdgcn_exp2f(P[B + 5]); SA += P[B + 2]; SB += P[B + 3]; \
    o[D0] = __builtin_amdgcn_mfma_f32_32x32x16_bf16(pa3, PKV(V, 3), o[D0], 0, 0, 0); P[B + 6] = __builtin_amdgcn_exp2f(P[B + 6]); P[B + 7] = __builtin_amdgcn_exp2f(P[B + 7]); SA += P[B + 4]; SB += P[B + 5]; \
    SA += P[B + 6]; SB += P[B + 7]; \
    { unsigned a0 = cvtpk(P[B + 0], P[B + 1]), a1 = cvtpk(P[B + 2], P[B + 3]), b0_ = cvtpk(P[B + 4], P[B + 5]), b1_ = cvtpk(P[B + 6], P[B + 7]); \
      auto r0 = __builtin_amdgcn_permlane32_swap(a0, b0_, false, false); auto r1 = __builtin_amdgcn_permlane32_swap(a1, b1_, false, false); \
      u32x4 w4 = {r0[0], r1[0], r0[1], r1[1]}; PAOUT = *reinterpret_cast<bf16x8*>(&w4); } \
    AIL_MFMA(); AIL_TRANS(2); AIL_MFMA(); AIL_TRANS(2); AIL_VALU(2); AIL_MFMA(); AIL_TRANS(2); AIL_VALU(2); AIL_MFMA(); AIL_TRANS(2); AIL_VALU(2); SBAR(); } while (0)
#define TRM(m) do { vlo[m] = tr_read<v_rd_off2((m) / 4, (m) % 4, 0)>(vb); vhi[m] = tr_read<v_rd_off2((m) / 4, (m) % 4, 1)>(vb); } while (0)
#define PKM(m) (bf16x8){vlo[m][0], vlo[m][1], vlo[m][2], vlo[m][3], vhi[m][0], vhi[m][1], vhi[m][2], vhi[m][3]}
#define PAK(k) ((k) == 0 ? pa0 : (k) == 1 ? pa1 : (k) == 2 ? pa2 : pa3)
#define PVSTEP(m, WAITN, P, B) do { LWAIT(WAITN); o[(m) / 4] = __builtin_amdgcn_mfma_f32_32x32x16_bf16(PAK((m) % 4), PKM(m), o[(m) / 4], 0, 0, 0); \
    if ((m) + 7 < 16) TRM(((m) + 7 < 16 ? (m) + 7 : 15)); \
    P[B] = __builtin_amdgcn_exp2f(P[B]); P[B + 1] = __builtin_amdgcn_exp2f(P[B + 1]); } while (0)
#define SUM8(P, B, SA, SB) do { SA += (P[B] + P[B + 2]) + (P[B + 4] + P[B + 6]); SB += (P[B + 1] + P[B + 3]) + (P[B + 5] + P[B + 7]); } while (0)
#define PACK8(P, B, PAOUT) do { u32x4 w4 = {cvtpk(P[B + 0], P[B + 1]), cvtpk(P[B + 2], P[B + 3]), cvtpk(P[B + 4], P[B + 5]), cvtpk(P[B + 6], P[B + 7])}; PAOUT = *reinterpret_cast<bf16x8*>(&w4); } while (0)
#define PVPLAIN(D0, V) do { o[D0] = __builtin_amdgcn_mfma_f32_32x32x16_bf16(pa0, PKV(V, 0), o[D0], 0, 0, 0); o[D0] = __builtin_amdgcn_mfma_f32_32x32x16_bf16(pa1, PKV(V, 1), o[D0], 0, 0, 0); \
    o[D0] = __builtin_amdgcn_mfma_f32_32x32x16_bf16(pa2, PKV(V, 2), o[D0], 0, 0, 0); o[D0] = __builtin_amdgcn_mfma_f32_32x32x16_bf16(pa3, PKV(V, 3), o[D0], 0, 0, 0); SBAR(); } while (0)
  f32x16 p0, p1; bf16x8 pa0, pa1, pa2, pa3; float s0 = 0.f, s1 = 0.f, s2 = 0.f, s3 = 0.f, s4 = 0.f, s5 = 0.f, s6 = 0.f, s7 = 0.f; const int NT = seq / KVBLK;
  SDMA(0); SDMA(1); SDMA(2);
  float mnC;
  { float ssa = 0.f, ssb = 0.f;
#pragma unroll
    for (int d0 = 0; d0 < 4; ++d0) { const u32x4 q4 = *reinterpret_cast<const u32x4*>(&qr[d0]);
      const float t = (bf_lo(q4.x) * bf_lo(q4.x) + bf_hi(q4.x) * bf_hi(q4.x)) + (bf_lo(q4.y) * bf_lo(q4.y) + bf_hi(q4.y) * bf_hi(q4.y)) + (bf_lo(q4.z) * bf_lo(q4.z) + bf_hi(q4.z) * bf_hi(q4.z)) + (bf_lo(q4.w) * bf_lo(q4.w) + bf_hi(q4.w) * bf_hi(q4.w));
      if (d0 < 2) ssa += t; else ssb += t; }
    { auto rr = __builtin_amdgcn_permlane32_swap(__float_as_uint(ssa), __float_as_uint(ssa), false, false); ssa = __uint_as_float(rr[0]) + __uint_as_float(rr[1]); }
    { auto rr = __builtin_amdgcn_permlane32_swap(__float_as_uint(ssb), __float_as_uint(ssb), false, false); ssb = __uint_as_float(rr[0]) + __uint_as_float(rr[1]); }
    mnC = -(sqrtf(ssa) * kmax[mp * 2] + sqrtf(ssb) * kmax[mp * 2 + 1]) * 1.01f; }
  f32x16 negm;
#pragma unroll
  for (int r = 0; r < 16; ++r) negm[r] = mnC;
  asm volatile("" : "+v"(negm));
  asm volatile("s_waitcnt vmcnt(0)" ::: "memory");
  PBAR();
  QKT(K_lds, (void)0, 0);
  {
#pragma unroll
    for (int r = 0; r < 16; ++r) { p0[r] = __builtin_amdgcn_exp2f(p0[r]); p1[r] = __builtin_amdgcn_exp2f(p1[r]); }
    SUM8(p0, 0, s0, s1); SUM8(p0, 8, s2, s3); SUM8(p1, 0, s4, s5); SUM8(p1, 8, s6, s7);
  }
#pragma unroll 1
  for (int t = 0; t + 1 < NT; ++t) {
    SBAR(); if (t + 2 < NT) asm volatile("s_waitcnt vmcnt(4) lgkmcnt(0)\n\ts_barrier" ::: "memory"); else asm volatile("s_waitcnt vmcnt(0) lgkmcnt(0)\n\ts_barrier" ::: "memory"); SBAR();
    const int vb = vb0 + (t & 3) * SLOT;
    s16x4 vlo[16], vhi[16];
    if (t + 3 < NT) SDMA(t + 3);
    QKT(K_lds + ((t + 1) & 3) * SLOT, do { TRM(0); TRM(1); TRM(2); PACK8(p0, 0, pa0); PACK8(p0, 8, pa1); PACK8(p1, 0, pa2); PACK8(p1, 8, pa3); SBAR(); } while (0), 6);
    TRM(3); TRM(4); TRM(5); TRM(6);
    PVSTEP(0, 12, p0, 0);  PVSTEP(1, 12, p0, 2);  PVSTEP(2, 12, p0, 4);   PVSTEP(3, 12, p0, 6);   SUM8(p0, 0, s0, s1);
    PVSTEP(4, 12, p0, 8);  PVSTEP(5, 12, p0, 10); PVSTEP(6, 12, p0, 12);  PVSTEP(7, 12, p0, 14);  SUM8(p0, 8, s2, s3);
    PVSTEP(8, 12, p1, 0);  PVSTEP(9, 12, p1, 2);  PVSTEP(10, 10, p1, 4);  PVSTEP(11, 8, p1, 6);   SUM8(p1, 0, s4, s5);
    PVSTEP(12, 6, p1, 8);  PVSTEP(13, 4, p1, 10); PVSTEP(14, 2, p1, 12);  PVSTEP(15, 0, p1, 14);  SUM8(p1, 8, s6, s7);
    SBAR();
  }
  PACK8(p0, 0, pa0); PACK8(p0, 8, pa1); PACK8(p1, 0, pa2); PACK8(p1, 8, pa3);
  { asm volatile("s_waitcnt vmcnt(0)" ::: "memory"); PBAR(); const int vb = vb0 + ((NT - 1) & 3) * SLOT; s16x4 va[8], vc[8];
    TR8(va, 0, vb); TR8(vc, 1, vb); LWAIT(8); PVPLAIN(0, va); TR8(va, 2, vb); LWAIT(8); PVPLAIN(1, vc); TR8(vc, 3, vb); LWAIT(8); PVPLAIN(2, va); LWAIT(0); PVPLAIN(3, vc); }
  float l_reg = ((s0 + s1) + (s2 + s3)) + ((s4 + s5) + (s6 + s7));
  { auto rr = __builtin_amdgcn_permlane32_swap(__float_as_uint(l_reg), __float_as_uint(l_reg), false, false); l_reg = __uint_as_float(rr[0]) + __uint_as_float(rr[1]); }
  if (hi == 0) li_l[r32] = l_reg; asm volatile("s_waitcnt lgkmcnt(0)" ::: "memory");
  float rli[16];
#pragma unroll
  for (int r = 0; r < 16; ++r) rli[r] = __builtin_amdgcn_rcpf(li_l[crow(r, hi)]);
  __syncthreads();
  float* xch = (float*)lds + qw * 4096 + lane;
  if (mp == 1) {
#pragma unroll
    for (int r = 0; r < 16; ++r)
#pragma unroll
      for (int d0 = 0; d0 < 4; ++d0) xch[(r * 4 + d0) * 64] = o[d0][r] * rli[r] * lam;
  }
  __syncthreads();
  if (mp == 0) {
    float gv[4];
#pragma unroll
    for (int d0 = 0; d0 < 4; ++d0) gv[d0] = gd[d0 * 32 + r32] * (1.0f - LAM_INIT);
#pragma unroll
    for (int r = 0; r < 16; ++r) {
      float dv[4]; float ss = 0.f;
#pragma unroll
      for (int d0 = 0; d0 < 4; ++d0) { dv[d0] = o[d0][r] * rli[r] - xch[(r * 4 + d0) * 64]; ss += dv[d0] * dv[d0]; }
      ss = row16_sum(ss); ss = halve16(ss, ss);
      const float rstd = rsqrtf(ss * (1.0f / 128.0f) + EPS);
      bf16_t* orow = Ob + (long)(qw * QBLK + crow(r, hi)) * LD + r32;
#pragma unroll
      for (int d0 = 0; d0 < 4; ++d0) orow[d0 * 32] = (bf16_t)(cvtpk(dv[d0] * rstd * gv[d0], 0.f) & 0xffffu);
    }
  }
  __syncthreads();
#undef SDMA
#undef PBAR
#undef TR8
#undef PKV
#undef LWAIT
#undef QKT
#undef PVGROUP
#undef PVPLAIN
#undef TRM
#undef PKM
#undef PAK
#undef PVSTEP
#undef SUM8
#undef PACK8
}
#undef AIL_MFMA
#undef AIL_TRANS
#undef AIL_VALU
#undef KSWZ
#undef SBAR
}

__device__ __forceinline__ float log_sigmoidf_(float x) { return x >= 0.f ? -log1pf(__expf(-x)) : x - log1pf(__expf(x)); }

__device__ __forceinline__ int perm32(int rho) { const int n = rho >> 4, i = rho & 15; return 8 * (i >> 2) + 4 * n + (i & 3); }
__device__ __forceinline__ void transpose_item(const float* __restrict__ W, int ldw, int scol0, bf16_t* WTrow0, int k0, LAS float* scr, int lane, bool perm) {
#pragma unroll 8
    for (int i = 0; i < 32; ++i) { const int kk = 2 * i + (lane >> 5); scr[kk * 33 + (lane & 31)] = W[(size_t)(k0 + kk) * ldw + scol0 + (lane & 31)]; }
    LDS_WAIT(); asm volatile("" ::: "memory");
    const int c = lane & 7;
#pragma unroll
    for (int j = 0; j < 4; ++j) { const int n = (lane >> 3) + 8 * j; const LAS float* s = scr + (8 * c) * 33 + (perm ? perm32(n) : n);
        u32x4 o; o.x = cvt_pk_bf16(s[0 * 33], s[1 * 33]); o.y = cvt_pk_bf16(s[2 * 33], s[3 * 33]); o.z = cvt_pk_bf16(s[4 * 33], s[5 * 33]); o.w = cvt_pk_bf16(s[6 * 33], s[7 * 33]);
        *(u32x4*)(WTrow0 + (size_t)n * 1024 + k0 + 8 * c) = o; }
    LDS_WAIT(); asm volatile("" ::: "memory");
}

__device__ __forceinline__ void transpose_item8(const float* __restrict__ W, int ldw, int scol0, unsigned char* WTrow0, int k0, LAS float* scr, int lane, float scale, bool perm = true) {
#pragma unroll 8
    for (int i = 0; i < 32; ++i) { const int kk = 2 * i + (lane >> 5); scr[kk * 33 + (lane & 31)] = W[(size_t)(k0 + kk) * ldw + scol0 + (lane & 31)]; }
    LDS_WAIT(); asm volatile("" ::: "memory");
    const int c = lane & 7;
#pragma unroll
    for (int j = 0; j < 4; ++j) { const int n = (lane >> 3) + 8 * j; const LAS float* s = scr + (8 * c) * 33 + (perm ? perm32(n) : n);
        u32x2 o; o.x = pk4_fp8(s[0 * 33] * scale, s[1 * 33] * scale, s[2 * 33] * scale, s[3 * 33] * scale); o.y = pk4_fp8(s[4 * 33] * scale, s[5 * 33] * scale, s[6 * 33] * scale, s[7 * 33] * scale);
        *(u32x2*)(WTrow0 + (size_t)n * 1024 + k0 + 8 * c) = o; }
    LDS_WAIT(); asm volatile("" ::: "memory");
}

struct T8Item { const float* src; unsigned char* dst; int ldw; int split; int perm; };
__device__ __forceinline__ T8Item t8_decode(const Params& p, int it) {
    T8Item r; r.split = 0; r.perm = 2;
    if (it < 256) { const int kb = it >> 5, t = it & 31, n0 = t * 256; r.src = p.w_in + (size_t)(kb * 128) * INCOLS + (n0 < 2048 ? n0 : n0 + 16); r.ldw = INCOLS;
        r.dst = p.ws + WS_WIN + (size_t)n0 * 1024 + kb * 128; r.perm = (n0 >= 3072 && n0 < 5120) ? 0 : 2; return r; }
    it -= 256;
    if (it < 2048) { const int e = it >> 6, kb = (it >> 3) & 7, pn = it & 7; r.src = p.exp_w1 + (size_t)e * 1024 * 2048 + (size_t)(kb * 128) * 2048 + 128 * pn; r.ldw = 2048; r.split = 1024 - 128; r.perm = 1;
        r.dst = p.ws + WS_W1 + ((size_t)e * 2048 + 256 * pn) * 1024 + kb * 128; return r; }
    it -= 2048;
    { const int e = it >> 5, kb = (it >> 2) & 7, t = it & 3; r.src = p.exp_w2 + (size_t)e * 1024 * 1024 + (size_t)(kb * 128) * 1024 + 256 * t; r.ldw = 1024;
        r.dst = p.ws + WS_W2 + ((size_t)e * 1024 + 256 * t) * 1024 + kb * 128; return r; }
}
constexpr int T8_ITEMS = 256 + 2048 + 1024;
__device__ __forceinline__ void t8_load(f32x4 (&v)[16], const T8Item& q, int wave, int lane) {
    const float* sp = q.src + (size_t)(16 * wave) * q.ldw + 4 * lane + (lane >= 32 ? q.split : 0);
#pragma unroll
    for (int i = 0; i < 16; ++i) v[i] = *(const f32x4*)(sp + (size_t)i * q.ldw);
}
__device__ __forceinline__ void t8_process(const f32x4 (&v)[16], const T8Item& q, LAS unsigned char* img, int tid, int wave, int lane) {
#pragma unroll
    for (int j = 0; j < 4; ++j) { u32x4 o;
        o.x = pk4_fp8(v[0][j] * 64.0f, v[1][j] * 64.0f, v[2][j] * 64.0f, v[3][j] * 64.0f);     o.y = pk4_fp8(v[4][j] * 64.0f, v[5][j] * 64.0f, v[6][j] * 64.0f, v[7][j] * 64.0f);
        o.z = pk4_fp8(v[8][j] * 64.0f, v[9][j] * 64.0f, v[10][j] * 64.0f, v[11][j] * 64.0f); o.w = pk4_fp8(v[12][j] * 64.0f, v[13][j] * 64.0f, v[14][j] * 64.0f, v[15][j] * 64.0f);
        *(LAS u32x4*)(img + (4 * lane + j) * 128 + ((wave ^ (lane & 7)) << 4)) = o; }
    __syncthreads();
#pragma unroll
    for (int r = 0; r < 4; ++r) { const int R = r * 64 + (tid >> 3), c = tid & 7; const int n = q.perm == 2 ? 64 * ((R >> 5) & 3) + 32 * (R >> 7) + perm32(R & 31) : (q.perm == 1 ? (R & ~31) + perm32(R & 31) : R);
        const u32x4 o = *(const LAS u32x4*)(img + n * 128 + ((c ^ ((n >> 2) & 7)) << 4));
        *(u32x4*)(q.dst + (size_t)R * 1024 + 16 * c) = o; }
}

__device__ __forceinline__ void t8_static(const Params& p, LAS unsigned char* lds, int first, int stride, int limit) {
    const int tid = otid(), lane = tid & 63, wave = __builtin_amdgcn_readfirstlane(tid >> 6);
    f32x4 va[16], vb[16]; int it = first;
    if (it < limit) { const T8Item q = t8_decode(p, it); t8_load(va, q, wave, lane); }
    while (it < limit) {
        int nx = it + stride;
        if (nx < limit) { const T8Item qn = t8_decode(p, nx); t8_load(vb, qn, wave, lane); }
        { const T8Item q = t8_decode(p, it); t8_process(va, q, lds, tid, wave, lane); }
        it = nx; if (it >= limit) break;
        nx = it + stride;
        if (nx < limit) { const T8Item qn = t8_decode(p, nx); t8_load(va, qn, wave, lane); }
        { const T8Item q = t8_decode(p, it); t8_process(vb, q, lds + 32768, tid, wave, lane); }
        it = nx;
    }
    __syncthreads();
}

__device__ __forceinline__ void phase_prep(const Params& p, LAS unsigned char* lds, int G) {
    const int tid = otid(), lane = tid & 63, wave = __builtin_amdgcn_readfirstlane(tid >> 6);
    const int gw = blockIdx.x * 8 + wave, NGW = G * 8;
    LAS float* sl = (LAS float*)(lds + 73728);
    for (int i = tid; i < 9 * 1024; i += NTHREADS) { const float v = i < 8192 ? p.c[i] : p.c_ctx[i - 8192]; sl[i] = v / (1.0f + __expf(-v)); }
    __syncthreads();
    float* mod = (float*)(p.ws + WS_MOD);
    unsigned* t8ctr = (unsigned*)(p.ws + WS_CTL) + 40;
    LAS int* t8slot = (LAS int*)(lds + 131072);
    const int t8lim = G >= 160 ? 256 : T8_ITEMS;
    f32x4 va[16], vb[16]; int it = blockIdx.x;
    if (it < t8lim) { const T8Item q = t8_decode(p, it); t8_load(va, q, wave, lane); }
    for (int cb = blockIdx.x; cb < 192; cb += G) {
        const int c0 = cb * 32, col = lane & 31, slab = 2 * wave + (lane >> 5);
        float acc[9];
#pragma unroll
        for (int v = 0; v < 9; ++v) acc[v] = 0.f;
        const float* wp = p.ada_w + (size_t)(slab * 64) * 6144 + c0 + col;
#pragma unroll 1
        for (int i0 = 0; i0 < 64; i0 += 32) {
            float wv[32];
#pragma unroll
            for (int i = 0; i < 32; ++i) wv[i] = wp[(size_t)(i0 + i) * 6144];
#pragma unroll
            for (int i = 0; i < 32; ++i) {
#pragma unroll
                for (int v = 0; v < 9; ++v) acc[v] += sl[v * 1024 + slab * 64 + i0 + i] * wv[i]; }
        }
        LAS float* red = (LAS float*)(lds + 110592);
#pragma unroll
        for (int v = 0; v < 9; ++v) red[(slab * 9 + v) * 32 + col] = acc[v];
        __syncthreads();
        if (tid < 288) { const int v = tid >> 5, cc = tid & 31; float sum = 0.f;
#pragma unroll
            for (int sb = 0; sb < 16; ++sb) sum += red[(sb * 9 + v) * 32 + cc];
            mod[v * 6144 + c0 + cc] = sum + p.ada_b[c0 + cc]; }
        __syncthreads();
    }
    if ((int)blockIdx.x == G - 2 && wave == 0) {
        const float s01 = wave_sum(p.dlam[lane] * p.dlam[64 + lane]), s23 = wave_sum(p.dlam[128 + lane] * p.dlam[192 + lane]);
        if (lane == 0) *(float*)(p.ws + WS_LAM) = expf(s01) - expf(s23) + LAM_INIT;
    }
    if ((int)blockIdx.x == G - 1 && wave == 0 && lane < 16) {
        double th = 1.0; for (int j = 0; j < lane; ++j) th *= 0.5623413251903491;
        double ct = 1.0, st = th, term_c = 1.0, term_s = th; const double t2 = th * th;
        for (int n = 1; n < 14; ++n) { term_c *= -t2 / ((2.0 * n - 1.0) * (2.0 * n)); term_s *= -t2 / ((2.0 * n) * (2.0 * n + 1.0)); ct += term_c; st += term_s; }
        float* rc = (float*)(p.ws + WS_ROPE); float* rs = rc + 1024;
        double cc = 1.0, ss = 0.0;
        for (int pos = 0; pos < 64; ++pos) { rc[pos * 16 + lane] = (float)cc; rs[pos * 16 + lane] = (float)ss; const double c2 = cc * ct - ss * st, s2 = ss * ct + cc * st; cc = c2; ss = s2; }
    }
    LAS float* scr = (LAS float*)(lds + wave * 8448);
    constexpr int I_SQ = 16 * 32;
    for (int r = gw; r < 3 * I_SQ; r += NGW) {
        const int w = r / I_SQ, r2 = r % I_SQ, kb = r2 >> 5, nb = r2 & 31; const float* W = w == 0 ? p.w_a : (w == 1 ? p.w_b : p.w_o);
        bf16_t* WT = (bf16_t*)(p.ws + (w == 0 ? WS_WA : (w == 1 ? WS_WB : WS_WO))); transpose_item(W, 1024, (nb >> 3) * 256 + 64 * (nb & 3) + 32 * ((nb >> 2) & 1), WT + (size_t)nb * 32 * 1024, kb * 64, scr, lane, true);
    }
    __syncthreads();
#define T8_NEXT(nx) do { nx = it + G; } while (0)
    while (it < t8lim) {
        int nx; T8_NEXT(nx);
        if (nx < t8lim) { const T8Item qn = t8_decode(p, nx); t8_load(vb, qn, wave, lane); }
        { const T8Item q = t8_decode(p, it); t8_process(va, q, lds, tid, wave, lane); }
        it = nx; if (it >= t8lim) break;
        T8_NEXT(nx);
        if (nx < t8lim) { const T8Item qn = t8_decode(p, nx); t8_load(va, qn, wave, lane); }
        { const T8Item q = t8_decode(p, it); t8_process(vb, q, lds + 32768, tid, wave, lane); }
        it = nx;
    }
#undef T8_NEXT
}

__device__ __forceinline__ void phase_rows1(const Params& p, LAS unsigned char* lds, int G) {
    const int tid = otid(), lane = tid & 63, wave = __builtin_amdgcn_readfirstlane(tid >> 6);
    const int gw = blockIdx.x * 8 + wave, NGW = G * 8;
    LAS float* wg = (LAS float*)lds;
    for (int k = tid; k < 1024; k += NTHREADS) {
#pragma unroll
        for (int gq = 0; gq < 4; ++gq) { const f32x4 w = *(const f32x4*)(p.w_in + (size_t)k * INCOLS + 2048 + gq * 4);
#pragma unroll
            for (int j = 0; j < 4; ++j) wg[(gq * 4 + j) * 1024 + k] = w[j]; } }
    __syncthreads();
    const float* mod = (const float*)(p.ws + WS_MOD); unsigned char* U = p.ws + WS_U; float* GT = (float*)(p.ws + WS_GT);
    f32x4 gn[4];
#pragma unroll
    for (int j = 0; j < 4; ++j) gn[j] = *(const f32x4*)(p.norm1_g + 4 * lane + 256 * j);
    f32x4 vn[4];
    { const int m = gw; const float* xr = m < TL ? p.x + (size_t)m * 1024 : p.ctx + (size_t)(m - TL) * 1024;
#pragma unroll
      for (int j = 0; j < 4; ++j) vn[j] = *(const f32x4*)(xr + 4 * lane + 256 * j); }
    for (int m = gw; m < TT; m += NGW) {
        const float* md = mod + (size_t)(m < TL ? (m >> 12) : 8) * 6144;
        f32x4 v[4]; float ss = 0.f;
#pragma unroll
        for (int j = 0; j < 4; ++j) { v[j] = vn[j]; ss += (v[j][0] * v[j][0] + v[j][1] * v[j][1]) + (v[j][2] * v[j][2] + v[j][3] * v[j][3]); }
        if (m + NGW < TT) { const int m2 = m + NGW; const float* xr = m2 < TL ? p.x + (size_t)m2 * 1024 : p.ctx + (size_t)(m2 - TL) * 1024;
#pragma unroll
            for (int j = 0; j < 4; ++j) vn[j] = *(const f32x4*)(xr + 4 * lane + 256 * j); }
        const float rstd = rsqrtf(wave_sum(ss) * (1.0f / 1024.0f) + EPS);
#pragma unroll
        for (int j = 0; j < 4; ++j) { const f32x4 sh = *(const f32x4*)(md + 4 * lane + 256 * j), sc = *(const f32x4*)(md + 1024 + 4 * lane + 256 * j);
            v[j] = (v[j] * rstd * gn[j]) * (sc + 1.0f) + sh;
            *(unsigned*)(U + (size_t)m * 1024 + 4 * lane + 256 * j) = pk4_fp8(v[j][0], v[j][1], v[j][2], v[j][3]); }
        float a[16];
#pragma unroll
        for (int g = 0; g < 16; ++g) a[g] = 0.f;
#pragma unroll
        for (int j = 0; j < 4; ++j) {
#pragma unroll
            for (int g = 0; g < 16; ++g) { const f32x4 w = *(const LAS f32x4*)(wg + g * 1024 + 4 * lane + 256 * j); a[g] = fmaf(v[j][3], w[3], fmaf(v[j][2], w[2], fmaf(v[j][1], w[1], fmaf(v[j][0], w[0], a[g])))); }
            asm volatile("" ::: "memory"); }
        { const bool u5 = (lane & 32) != 0, u4 = (lane & 16) != 0, u3 = (lane & 8) != 0, u2 = (lane & 4) != 0;
          float b8[8], b4[4], b2[2];
#pragma unroll
          for (int g = 0; g < 8; ++g) b8[g] = halve32(a[g], a[g + 8]);
#pragma unroll
          for (int g = 0; g < 4; ++g) b4[g] = halve16(b8[g], b8[g + 4]);
#pragma unroll
          for (int g = 0; g < 2; ++g) b2[g] = halve8(b4[g], b4[g + 2], u3);
          float val = halve4(b2[0], b2[1], u2);
          val = DPP_ADD(val, 0x4E); val = DPP_ADD(val, 0xB1);
          const int gsel = ((lane >> 5) & 1) * 8 + ((lane >> 4) & 1) * 4 + ((lane >> 3) & 1) * 2 + ((lane >> 2) & 1);
          if ((lane & 3) == 0) {
              val += p.gate_b[gsel]; const int type = gsel >> 2; if (type & 1) val = log_sigmoidf_(val);
              GT[(size_t)m * 16 + gsel] = val; } }
    }
}

__device__ __forceinline__ void phase_mlstm_naive(const Params& p, LAS unsigned char* lds_, int item) {
    const int tid = otid(); float* lds = (float*)(unsigned char*)lds_;
    const int dvh = item & 1, dir = (item >> 1) & 1, h = (item >> 2) & 3, b = item >> 4;
    const int dvl = tid >> 2, kq = tid & 3;
    float* Ks = lds; float* Qs = lds + 4096; float* Vs = lds + 8192; float* gi = lds + 12288; float* gf = gi + 32;
    const bf16_t* MQ = (const bf16_t*)(p.ws + WS_MQ); const bf16_t* MK = (const bf16_t*)(p.ws + WS_MK); const bf16_t* MV = (const bf16_t*)(p.ws + WS_MV);
    const float* GT = (const float*)(p.ws + WS_GT); bf16_t* H = (bf16_t*)(p.ws + (dir ? WS_HB : WS_HF));
    float C[32], nn[32];
#pragma unroll
    for (int r = 0; r < 32; ++r) { C[r] = 0.f; nn[r] = 0.f; }
    for (int s0 = 0; s0 < KVLEN; s0 += 32) {
        const bool latent = s0 >= CTX;
        __syncthreads();
        {
            const int j = tid >> 4, c8 = (tid & 15) * 8; const int s = s0 + j;
            const int m = latent ? b * SEQ + (dir ? SEQ - 1 - (s - CTX) : s - CTX) : TL + b * CTX + (dir ? CTX - 1 - s : s);
            const bf16x8 kv = *(const bf16x8*)(MK + (size_t)m * 512 + h * 128 + c8);
            const bf16x8 vv = *(const bf16x8*)(MV + (size_t)m * 1024 + h * 256 + dvh * 128 + c8);
#pragma unroll
            for (int i = 0; i < 8; ++i) { Ks[j * 128 + c8 + i] = bf2f((bf16_t)kv[i]); Vs[j * 128 + c8 + i] = bf2f((bf16_t)vv[i]); }
            if (latent) { const bf16x8 qv = *(const bf16x8*)(MQ + (size_t)m * 512 + h * 128 + c8);
#pragma unroll
                for (int i = 0; i < 8; ++i) Qs[j * 128 + c8 + i] = bf2f((bf16_t)qv[i]); }
            if ((tid & 15) == 0) { gi[j] = GT[(size_t)m * 16 + dir * 8 + h]; gf[j] = GT[(size_t)m * 16 + dir * 8 + 4 + h]; }
        }
        __syncthreads();
        for (int j = 0; j < 32; ++j) {
            const float f = __expf(gf[j]), ig = __expf(gi[j]); const float v = Vs[j * 128 + dvl];
            float num = 0.f, den = 0.f;
            const f32x4* kp = (const f32x4*)(Ks + j * 128 + kq * 32); const f32x4* qp = (const f32x4*)(Qs + j * 128 + kq * 32);
#pragma unroll
            for (int r4 = 0; r4 < 8; ++r4) { const f32x4 k4 = kp[r4]; f32x4 q4 = {0.f, 0.f, 0.f, 0.f}; if (latent) q4 = qp[r4];
#pragma unroll
                for (int i = 0; i < 4; ++i) { const int r = r4 * 4 + i; const float ik = ig * k4[i]; C[r] = f * C[r] + ik * v; nn[r] = f * nn[r] + ik; num += q4[i] * C[r]; den += q4[i] * nn[r]; } }
            if (latent) {
                num += __shfl_xor(num, 1); num += __shfl_xor(num, 2); den += __shfl_xor(den, 1); den += __shfl_xor(den, 2);
                if (kq == 0) { const int s = s0 + j; const int m = b * SEQ + (dir ? SEQ - 1 - (s - CTX) : s - CTX);
                    const float hv = num / fmaxf(fabsf(den), 1.0f);
                    H[(size_t)m * 1024 + h * 256 + dvh * 128 + dvl] = (bf16_t)(cvt_pk_bf16(hv, 0.f) & 0xffffu); }
            }
        }
    }
    __syncthreads();
}

namespace mls {
#define KSWZ(row, colB) ((row) * 256 + ((colB) ^ (((row) & 7) << 4)))
#define SBAR() __builtin_amdgcn_sched_barrier(0)
using att::crow; using att::cvtpk; using att::v_st; using att::v_rd_base; using att::v_rd_off; using att::tr_read;
constexpr int L_KSW = 0, L_KV = 32768, L_V = 65536, L_CT = 98304, L_F = 114688;
__device__ __forceinline__ float swap_add(float v) { auto rr = __builtin_amdgcn_permlane32_swap(__float_as_uint(v), __float_as_uint(v), false, false); return __uint_as_float(rr[0]) + __uint_as_float(rr[1]); }
#define TRPK(L, H) (bf16x8){L[0], L[1], L[2], L[3], H[0], H[1], H[2], H[3]}
__device__ __forceinline__ void mlstm_item(const Params& p, LAS unsigned char* lds_, int item) {
    char* lds = (char*)(unsigned char*)lds_;
    const int tid = otid(), wid = __builtin_amdgcn_readfirstlane(tid >> 6), lane = tid & 63, r32 = lane & 31, hi = lane >> 5;
    const int dvq = item & 3, dir = (item >> 2) & 1, h = (item >> 3) & 3, b = item >> 5;
    const int vh = wid >> 2, rb = vh ? 3 - (wid & 3) : (wid & 3);
    float* fa = (float*)(lds + L_F); float* a_ = fa; float* bco = fa + 128; float* w_ = fa + 256; float* wint = fa + 384; float* nvec = fa + 512; float* npart = fa + 640; float* gsc = fa + 1408; bf16_t* nb = (bf16_t*)(fa + 1416);
    const bf16_t* MQ = (const bf16_t*)(p.ws + WS_MQ); const bf16_t* MK = (const bf16_t*)(p.ws + WS_MK); const bf16_t* MV = (const bf16_t*)(p.ws + WS_MV);
    const float* GT = (const float*)(p.ws + WS_GT); bf16_t* H = (bf16_t*)(p.ws + (dir ? WS_HB : WS_HF));
    f32x16 Cacc = {};
    { u32x4 z = {0u, 0u, 0u, 0u}; *(u32x4*)(lds + L_CT + tid * 32) = z; *(u32x4*)(lds + L_CT + tid * 32 + 16) = z; if (tid < 128) { nvec[tid] = 0.f; nb[tid] = 0; } }
    const int tid_outer = tid;
    bf16x8 kreg[4], vreg[2], qnx[8]; float gi0 = 0.f, glf0 = 0.f, gi1 = 0.f, glf1 = 0.f;
#define MROW0(cc_) ((cc_) >= 2 ? b * SEQ + (dir ? 33 - (cc_) : (cc_) - 2) * 128 : TL + b * CTX + (dir ? 1 - (cc_) : (cc_)) * 128)
#define LOADS(cn_, T_) do { const int mr_ = MROW0(cn_); const int ln_ = (T_) & 63; \
        _Pragma("unroll") for (int i = 0; i < 4; ++i) { const int pc = (T_) + 512 * i, pr = pc >> 4, c8 = (pc & 15) * 8; kreg[i] = *(const bf16x8*)(MK + (size_t)(mr_ + (dir ? 127 - pr : pr)) * 512 + h * 128 + c8); } \
        _Pragma("unroll") for (int i = 0; i < 2; ++i) { const int pc = (T_) + 512 * i, pr = pc >> 3, c8 = (pc & 7) * 8; vreg[i] = *(const bf16x8*)(MV + (size_t)(mr_ + (dir ? 127 - pr : pr)) * 1024 + h * 256 + dvq * 64 + c8); } \
        if ((cn_) >= 2) { const int pr = rb * 32 + (ln_ & 31); const bf16_t* qp = MQ + (size_t)(mr_ + (dir ? 127 - pr : pr)) * 512 + h * 128 + (ln_ >> 5) * 8; \
            _Pragma("unroll") for (int d0 = 0; d0 < 8; ++d0) qnx[d0] = *(const bf16x8*)(qp + d0 * 16); } \
        else { _Pragma("unroll") for (int d0 = 0; d0 < 8; ++d0) qnx[d0] = bf16x8{}; } \
        if (wid == 0) { const int p0 = 2 * ln_, p1 = 2 * ln_ + 1; const size_t m0 = (size_t)(mr_ + (dir ? 127 - p0 : p0)) * 16, m1 = (size_t)(mr_ + (dir ? 127 - p1 : p1)) * 16; \
            gi0 = GT[m0 + dir * 8 + h]; glf0 = GT[m0 + dir * 8 + 4 + h]; gi1 = GT[m1 + dir * 8 + h]; glf1 = GT[m1 + dir * 8 + 4 + h]; } } while (0)
    LOADS(0, tid_outer);
    for (int c = 0; c < 34; ++c) {
        int tid = tid_outer; asm volatile("" : "+v"(tid));
        const int lane = tid & 63, r32 = lane & 31, hi = lane >> 5;
        const int vbV = (int)(uintptr_t)(lds + L_V) + v_rd_base(lane), vbK = (int)(uintptr_t)(lds + L_KV) + v_rd_base(lane);
        const bool latent = c >= 2;
        const int mrow0 = MROW0(c);
        bf16x8 qr[8];
        if (wid == 0) {
            const int p0 = 2 * lane, p1 = 2 * lane + 1;
            const float i0 = gi0, lf0 = glf0, i1 = gi1, lf1 = glf1;
            float incl = lf0 + lf1;
#pragma unroll
            for (int o = 1; o < 64; o <<= 1) { const float t = __shfl_up(incl, o); if (lane >= o) incl += t; }
            const float F1 = incl, F0 = incl - lf1, Ftot = __shfl(incl, 63);
            a_[p0] = F0; a_[p1] = F1; bco[p0] = i0 - F0; bco[p1] = i1 - F1; wint[p0] = __expf(F0); wint[p1] = __expf(F1);
            w_[p0] = __expf(Ftot - F0 + i0); w_[p1] = __expf(Ftot - F1 + i1); if (lane == 0) gsc[0] = __expf(Ftot);
        }
        __syncthreads();
#pragma unroll
        for (int i = 0; i < 4; ++i) { const int pc = tid + 512 * i, pr = pc >> 4, c8 = (pc & 15) * 8;
            *(bf16x8*)(lds + L_KSW + KSWZ(pr, c8 * 2)) = kreg[i]; *(bf16x8*)(lds + L_KV + (pr >> 6) * 16384 + v_st(pr & 63, c8)) = kreg[i]; }
#pragma unroll
        for (int i = 0; i < 2; ++i) { const int pc = tid + 512 * i, pr = pc >> 3, c8 = (pc & 7) * 8; const float ws_ = w_[pr];
            *(bf16x8*)(lds + L_V + (pr >> 6) * 16384 + v_st(pr & 63, c8)) = vreg[i];
            u32x4 sv; const u32x4 raw = *reinterpret_cast<const u32x4*>(&vreg[i]);
            sv.x = cvtpk(bf_lo(raw.x) * ws_, bf_hi(raw.x) * ws_); sv.y = cvtpk(bf_lo(raw.y) * ws_, bf_hi(raw.y) * ws_); sv.z = cvtpk(bf_lo(raw.z) * ws_, bf_hi(raw.z) * ws_); sv.w = cvtpk(bf_lo(raw.w) * ws_, bf_hi(raw.w) * ws_);
            *(u32x4*)(lds + L_V + (pr >> 6) * 16384 + v_st(pr & 63, 64 + c8)) = sv; }
#pragma unroll
        for (int d0 = 0; d0 < 8; ++d0) qr[d0] = qnx[d0];
        __syncthreads();
        if (c + 1 < 34) LOADS(c + 1, tid);
        const float g = gsc[0];
        if (latent) {
            const int qidx = rb * 32 + r32;
            f32x16 o = {}, dn = {};
#pragma unroll
            for (int d0 = 0; d0 < 8; ++d0) { const bf16x8 cf = *(const bf16x8*)(lds + L_CT + KSWZ(32 * vh + r32, (d0 * 16 + hi * 8) * 2)); const bf16x8 nf = *(const bf16x8*)(nb + d0 * 16 + hi * 8);
                o = __builtin_amdgcn_mfma_f32_32x32x16_bf16(qr[d0], cf, o, 0, 0, 0); dn = __builtin_amdgcn_mfma_f32_32x32x16_bf16(qr[d0], nf, dn, 0, 0, 0); }
#pragma unroll
            for (int g4 = 0; g4 < 4; ++g4) { const f32x4 wi = *(const f32x4*)(wint + rb * 32 + 8 * g4 + 4 * hi);
#pragma unroll
                for (int i = 0; i < 4; ++i) { o[g4 * 4 + i] *= wi[i]; dn[g4 * 4 + i] *= wi[i]; } }
            const bf16x8 ones = {0x3f80, 0x3f80, 0x3f80, 0x3f80, 0x3f80, 0x3f80, 0x3f80, 0x3f80};
            const float aq = a_[qidx];
            for (int jt = 0; jt <= (rb >> 1); ++jt) {
                f32x16 p0 = {}, p1 = {};
#pragma unroll
                for (int d0 = 0; d0 < 8; ++d0) { const int cbb = (d0 * 16 + hi * 8) * 2;
                    const bf16x8 b0 = *(const bf16x8*)(lds + L_KSW + KSWZ(64 * jt + r32, cbb)), b1 = *(const bf16x8*)(lds + L_KSW + KSWZ(64 * jt + 32 + r32, cbb));
                    p0 = __builtin_amdgcn_mfma_f32_32x32x16_bf16(b0, qr[d0], p0, 0, 0, 0); p1 = __builtin_amdgcn_mfma_f32_32x32x16_bf16(b1, qr[d0], p1, 0, 0, 0); }
#pragma unroll
                for (int g4 = 0; g4 < 4; ++g4) { const int k0 = 64 * jt + 8 * g4 + 4 * hi; const f32x4 bb0 = *(const f32x4*)(bco + k0), bb1 = *(const f32x4*)(bco + k0 + 32);
#pragma unroll
                    for (int i = 0; i < 4; ++i) { const int r = g4 * 4 + i;
                        const float e0 = __expf(aq + bb0[i]), e1 = __expf(aq + bb1[i]);
                        p0[r] = (k0 + i <= qidx) ? p0[r] * e0 : 0.f; p1[r] = (k0 + 32 + i <= qidx) ? p1[r] * e1 : 0.f; } }
                bf16x8 pa0, pa1, pa2, pa3;
#define PK4(P, BASE, OUT) do { unsigned a0 = cvtpk(P[BASE + 0], P[BASE + 1]), a1 = cvtpk(P[BASE + 2], P[BASE + 3]);   \
    unsigned b0_ = cvtpk(P[BASE + 4], P[BASE + 5]), b1_ = cvtpk(P[BASE + 6], P[BASE + 7]);                              \
    auto r0 = __builtin_amdgcn_permlane32_swap(a0, b0_, false, false); auto r1 = __builtin_amdgcn_permlane32_swap(a1, b1_, false, false); \
    u32x4 w4 = {r0[0], r1[0], r0[1], r1[1]}; OUT = *reinterpret_cast<bf16x8*>(&w4); } while (0)
                PK4(p0, 0, pa0); PK4(p0, 8, pa1); PK4(p1, 0, pa2); PK4(p1, 8, pa3);
#undef PK4
                const int vb = vbV + jt * 16384 + vh * 512;
                const s16x4 l0 = tr_read<v_rd_off(0, 0, 0)>(vb), h0 = tr_read<v_rd_off(0, 0, 1)>(vb), l1 = tr_read<v_rd_off(0, 1, 0)>(vb), h1 = tr_read<v_rd_off(0, 1, 1)>(vb);
                const s16x4 l2 = tr_read<v_rd_off(0, 2, 0)>(vb), h2 = tr_read<v_rd_off(0, 2, 1)>(vb), l3 = tr_read<v_rd_off(0, 3, 0)>(vb), h3 = tr_read<v_rd_off(0, 3, 1)>(vb);
                asm volatile("s_waitcnt lgkmcnt(0)" ::: "memory"); SBAR();
                o = __builtin_amdgcn_mfma_f32_32x32x16_bf16(pa0, TRPK(l0, h0), o, 0, 0, 0); o = __builtin_amdgcn_mfma_f32_32x32x16_bf16(pa1, TRPK(l1, h1), o, 0, 0, 0);
                o = __builtin_amdgcn_mfma_f32_32x32x16_bf16(pa2, TRPK(l2, h2), o, 0, 0, 0); o = __builtin_amdgcn_mfma_f32_32x32x16_bf16(pa3, TRPK(l3, h3), o, 0, 0, 0);
                dn = __builtin_amdgcn_mfma_f32_32x32x16_bf16(pa0, ones, dn, 0, 0, 0); dn = __builtin_amdgcn_mfma_f32_32x32x16_bf16(pa1, ones, dn, 0, 0, 0);
                dn = __builtin_amdgcn_mfma_f32_32x32x16_bf16(pa2, ones, dn, 0, 0, 0); dn = __builtin_amdgcn_mfma_f32_32x32x16_bf16(pa3, ones, dn, 0, 0, 0);
            }
#pragma unroll
            for (int g4 = 0; g4 < 4; ++g4)
#pragma unroll
                for (int i = 0; i < 4; ++i) { const int r = g4 * 4 + i, pr = rb * 32 + 8 * g4 + 4 * hi + i;
                    const float hv = o[r] * __builtin_amdgcn_rcpf(fmaxf(fabsf(dn[r]), 1.0f));
                    H[(size_t)(mrow0 + (dir ? 127 - pr : pr)) * 1024 + h * 256 + dvq * 64 + vh * 32 + r32] = (bf16_t)(cvtpk(hv, 0.f) & 0xffffu); }
        }
#pragma unroll
        for (int r = 0; r < 16; ++r) Cacc[r] *= g;
#pragma unroll
        for (int jt = 0; jt < 2; ++jt) {
            const int va = vbV + jt * 16384 + (2 + vh) * 512, ka = vbK + jt * 16384 + rb * 512;
            const s16x4 al0 = tr_read<v_rd_off(0, 0, 0)>(va), ah0 = tr_read<v_rd_off(0, 0, 1)>(va), al1 = tr_read<v_rd_off(0, 1, 0)>(va), ah1 = tr_read<v_rd_off(0, 1, 1)>(va);
            const s16x4 al2 = tr_read<v_rd_off(0, 2, 0)>(va), ah2 = tr_read<v_rd_off(0, 2, 1)>(va), al3 = tr_read<v_rd_off(0, 3, 0)>(va), ah3 = tr_read<v_rd_off(0, 3, 1)>(va);
            const s16x4 bl0 = tr_read<v_rd_off(0, 0, 0)>(ka), bh0 = tr_read<v_rd_off(0, 0, 1)>(ka), bl1 = tr_read<v_rd_off(0, 1, 0)>(ka), bh1 = tr_read<v_rd_off(0, 1, 1)>(ka);
            const s16x4 bl2 = tr_read<v_rd_off(0, 2, 0)>(ka), bh2 = tr_read<v_rd_off(0, 2, 1)>(ka), bl3 = tr_read<v_rd_off(0, 3, 0)>(ka), bh3 = tr_read<v_rd_off(0, 3, 1)>(ka);
            asm volatile("s_waitcnt lgkmcnt(0)" ::: "memory"); SBAR();
            Cacc = __builtin_amdgcn_mfma_f32_32x32x16_bf16(TRPK(al0, ah0), TRPK(bl0, bh0), Cacc, 0, 0, 0); Cacc = __builtin_amdgcn_mfma_f32_32x32x16_bf16(TRPK(al1, ah1), TRPK(bl1, bh1), Cacc, 0, 0, 0);
            Cacc = __builtin_amdgcn_mfma_f32_32x32x16_bf16(TRPK(al2, ah2), TRPK(bl2, bh2), Cacc, 0, 0, 0); Cacc = __builtin_amdgcn_mfma_f32_32x32x16_bf16(TRPK(al3, ah3), TRPK(bl3, bh3), Cacc, 0, 0, 0);
        }
        { const int k = tid & 127, sq = tid >> 7; float part = 0.f;
#pragma unroll 8
            for (int s = sq * 32; s < sq * 32 + 32; ++s) part += w_[s] * bf2f(*(const bf16_t*)(lds + L_KSW + KSWZ(s, 2 * k)));
            npart[sq * 128 + k] = part; }
        __syncthreads();
#pragma unroll
        for (int r = 0; r < 16; ++r) *(bf16_t*)(lds + L_CT + KSWZ(32 * vh + crow(r, hi), 2 * (32 * rb + r32))) = (bf16_t)(cvtpk(Cacc[r], 0.f) & 0xffffu);
        if (tid < 128) { const float nn = g * nvec[tid] + ((npart[tid] + npart[128 + tid]) + (npart[256 + tid] + npart[384 + tid])); nvec[tid] = nn; nb[tid] = (bf16_t)(cvtpk(nn, 0.f) & 0xffffu); }
    }
    __syncthreads();
}
#undef TRPK
#undef KSWZ
#undef SBAR
#undef LOADS
#undef MROW0
}

namespace mls2 {
#define KSWZ(row, colB) ((row) * 256 + ((colB) ^ (((row) & 15) << 4)))
#define SBAR() __builtin_amdgcn_sched_barrier(0)
using att::crow; using att::cvtpk; using att::v_st; using att::v_rd_base; using att::v_rd_off; using att::tr_read;
constexpr int L_KSW = 0, L_KW = 32768, L_V = 65536, L_CT = 98304, L_F = 131072;
#define TRPK(L, H) (bf16x8){L[0], L[1], L[2], L[3], H[0], H[1], H[2], H[3]}
#define TR8(dst, base) do { dst[0] = tr_read<v_rd_off(0, 0, 0)>(base); dst[1] = tr_read<v_rd_off(0, 0, 1)>(base); dst[2] = tr_read<v_rd_off(0, 1, 0)>(base); dst[3] = tr_read<v_rd_off(0, 1, 1)>(base); \
    dst[4] = tr_read<v_rd_off(0, 2, 0)>(base); dst[5] = tr_read<v_rd_off(0, 2, 1)>(base); dst[6] = tr_read<v_rd_off(0, 3, 0)>(base); dst[7] = tr_read<v_rd_off(0, 3, 1)>(base); } while (0)
__device__ __forceinline__ void mlstm_item(const Params& p, LAS unsigned char* lds_, int item) {
    char* lds = (char*)(unsigned char*)lds_;
    const int tid = otid(), wid = __builtin_amdgcn_readfirstlane(tid >> 6);
    const int dvh = item & 1, dir = (item >> 1) & 1, h = (item >> 2) & 3, b = item >> 4;
    const int vh = wid >> 2, rb = vh ? 3 - (wid & 3) : (wid & 3);
    float* fa = (float*)(lds + L_F); float* nvec = fa + 512; float* gsc = fa + 1152; bf16_t* nb = (bf16_t*)(fa + 1160);
    const bf16_t* MQ = (const bf16_t*)(p.ws + WS_MQ); const bf16_t* MK = (const bf16_t*)(p.ws + WS_MK); const bf16_t* MV = (const bf16_t*)(p.ws + WS_MV);
    const float* GT = (const float*)(p.ws + WS_GT); bf16_t* H = (bf16_t*)(p.ws + (dir ? WS_HB : WS_HF));
    f32x16 Cacc0 = {}, Cacc1 = {};
    { u32x4 z = {0u, 0u, 0u, 0u};
#pragma unroll
      for (int i = 0; i < 4; ++i) *(u32x4*)(lds + L_CT + tid * 64 + i * 16) = z;
      if (tid < 128) { nvec[tid] = 0.f; nb[tid] = 0; } }
    const int tid_outer = tid;
    bf16x8 kreg[4], vreg[4]; float gi0 = 0.f, glf0 = 0.f, gi1 = 0.f, glf1 = 0.f;
#define MROW0(cc_) ((cc_) >= 2 ? b * SEQ + (dir ? 33 - (cc_) : (cc_) - 2) * 128 : TL + b * CTX + (dir ? 1 - (cc_) : (cc_)) * 128)
#define LOADS(cn_, T_) do { const int mr_ = MROW0(cn_); const int ln_ = (T_) & 63; \
        _Pragma("unroll") for (int i = 0; i < 4; ++i) { const int pc = (T_) + 512 * i, pr = pc >> 4, c8 = (pc & 15) * 8; const size_t rw_ = (size_t)(mr_ + (dir ? 127 - pr : pr)); \
            kreg[i] = *(const bf16x8*)(MK + rw_ * 512 + h * 128 + c8); vreg[i] = *(const bf16x8*)(MV + rw_ * 1024 + h * 256 + dvh * 128 + c8); } \
        if (wid == 0) { const int p0 = 2 * ln_, p1 = 2 * ln_ + 1; const size_t m0 = (size_t)(mr_ + (dir ? 127 - p0 : p0)) * 16, m1 = (size_t)(mr_ + (dir ? 127 - p1 : p1)) * 16; \
            gi0 = GT[m0 + dir * 8 + h]; glf0 = GT[m0 + dir * 8 + 4 + h]; gi1 = GT[m1 + dir * 8 + h]; glf1 = GT[m1 + dir * 8 + 4 + h]; } } while (0)
#define GSCAN(PAR) do { float* sa_ = fa + (PAR) * 640; float* sb_ = sa_ + 128; float* sw_ = sa_ + 256; float* si_ = sa_ + 384; const int ln_ = tid_outer & 63; \
        const int p0 = 2 * ln_, p1 = 2 * ln_ + 1; const float i0 = gi0, lf0 = glf0, i1 = gi1, lf1 = glf1; float incl = lf0 + lf1; \
          \
        incl += __builtin_bit_cast(float, __builtin_amdgcn_update_dpp(0, __builtin_bit_cast(int, incl), 0x111, 0xf, 0xf, true)); \
        incl += __builtin_bit_cast(float, __builtin_amdgcn_update_dpp(0, __builtin_bit_cast(int, incl), 0x112, 0xf, 0xf, true)); \
        incl += __builtin_bit_cast(float, __builtin_amdgcn_update_dpp(0, __builtin_bit_cast(int, incl), 0x114, 0xf, 0xf, true)); \
        incl += __builtin_bit_cast(float, __builtin_amdgcn_update_dpp(0, __builtin_bit_cast(int, incl), 0x118, 0xf, 0xf, true)); \
        incl += __builtin_bit_cast(float, __builtin_amdgcn_update_dpp(0, __builtin_bit_cast(int, incl), 0x142, 0xa, 0xf, false)); \
        incl += __builtin_bit_cast(float, __builtin_amdgcn_update_dpp(0, __builtin_bit_cast(int, incl), 0x143, 0xc, 0xf, false)); \
        const float F1 = incl, F0 = incl - lf1, Ftot = __builtin_bit_cast(float, __builtin_amdgcn_readlane(__builtin_bit_cast(int, incl), 63)); \
        sa_[p0] = F0; sa_[p1] = F1; sb_[p0] = i0 - F0; sb_[p1] = i1 - F1; si_[p0] = __expf(F0); si_[p1] = __expf(F1); \
        sw_[p0] = __expf(Ftot - F0 + i0); sw_[p1] = __expf(Ftot - F1 + i1); if (ln_ == 0) gsc[(PAR)] = __expf(Ftot); } while (0)
    LOADS(0, tid_outer);
    if (wid == 0) GSCAN(0);
    __syncthreads();
    for (int c = 0; c < 34; ++c) {
        float* a_ = fa + (c & 1) * 640; float* bco = a_ + 128; float* w_ = a_ + 256; float* wint = a_ + 384;
        int tid = tid_outer; asm volatile("" : "+v"(tid));
        const int lane = tid & 63, r32 = lane & 31, hi = lane >> 5;
        const int vbV = (int)(uintptr_t)(lds + L_V) + v_rd_base(lane), vbK = (int)(uintptr_t)(lds + L_KW) + v_rd_base(lane);
        const bool latent = c >= 2;
        const int mrow0 = MROW0(c);
        bf16x8 qr[8];
        if (latent) { const int pr = rb * 32 + r32; const bf16_t* qp = MQ + (size_t)(mrow0 + (dir ? 127 - pr : pr)) * 512 + h * 128 + hi * 8;
#pragma unroll
            for (int d0 = 0; d0 < 8; ++d0) qr[d0] = *(const bf16x8*)(qp + d0 * 16); }
        else {
#pragma unroll
            for (int d0 = 0; d0 < 8; ++d0) qr[d0] = bf16x8{};
        }
#pragma unroll
        for (int i = 0; i < 4; ++i) { const int pc = tid + 512 * i, pr = pc >> 4, c8 = (pc & 15) * 8; const float ws_ = w_[pr];
            *(bf16x8*)(lds + L_KSW + KSWZ(pr, c8 * 2)) = kreg[i];
            u32x4 sk; const u32x4 raw = *reinterpret_cast<const u32x4*>(&kreg[i]);
            sk.x = cvtpk(bf_lo(raw.x) * ws_, bf_hi(raw.x) * ws_); sk.y = cvtpk(bf_lo(raw.y) * ws_, bf_hi(raw.y) * ws_); sk.z = cvtpk(bf_lo(raw.z) * ws_, bf_hi(raw.z) * ws_); sk.w = cvtpk(bf_lo(raw.w) * ws_, bf_hi(raw.w) * ws_);
            *(u32x4*)(lds + L_KW + (pr >> 6) * 16384 + v_st(pr & 63, c8)) = sk;
            *(bf16x8*)(lds + L_V + (pr >> 6) * 16384 + v_st(pr & 63, c8)) = vreg[i]; }
        __syncthreads();
        if (c + 1 < 34) LOADS(c + 1, tid);
        const float g = gsc[c & 1];
        if (latent) {
            const int qidx = rb * 32 + r32;
            f32x16 o0 = {}, o1 = {}, dn = {};
#pragma unroll
            for (int dh = 0; dh < 2; ++dh) {
                bf16x8 c0[4], c1[4], nf[4];
#pragma unroll
                for (int d = 0; d < 4; ++d) { const int d0 = dh * 4 + d, cbb = (d0 * 16 + hi * 8) * 2;
                    c0[d] = *(const bf16x8*)(lds + L_CT + KSWZ(64 * vh + r32, cbb)); c1[d] = *(const bf16x8*)(lds + L_CT + KSWZ(64 * vh + 32 + r32, cbb)); nf[d] = *(const bf16x8*)(nb + d0 * 16 + hi * 8); }
                SBAR();
#pragma unroll
                for (int d = 0; d < 4; ++d) { const int d0 = dh * 4 + d;
                    o0 = __builtin_amdgcn_mfma_f32_32x32x16_bf16(qr[d0], c0[d], o0, 0, 0, 0); o1 = __builtin_amdgcn_mfma_f32_32x32x16_bf16(qr[d0], c1[d], o1, 0, 0, 0); dn = __builtin_amdgcn_mfma_f32_32x32x16_bf16(qr[d0], nf[d], dn, 0, 0, 0); }
                SBAR(); }
#pragma unroll
            for (int g4 = 0; g4 < 4; ++g4) { const f32x4 wi = *(const f32x4*)(wint + rb * 32 + 8 * g4 + 4 * hi);
#pragma unroll
                for (int i = 0; i < 4; ++i) { o0[g4 * 4 + i] *= wi[i]; o1[g4 * 4 + i] *= wi[i]; dn[g4 * 4 + i] *= wi[i]; } }
            const bf16x8 ones = {0x3f80, 0x3f80, 0x3f80, 0x3f80, 0x3f80, 0x3f80, 0x3f80, 0x3f80};
            const float aq = a_[qidx];
            for (int jt = 0; jt <= (rb >> 1); ++jt) {
                f32x16 p0 = {}, p1 = {};
#pragma unroll
                for (int dh = 0; dh < 2; ++dh) {
                    bf16x8 b0[4], b1[4];
#pragma unroll
                    for (int d = 0; d < 4; ++d) { const int cbb = ((dh * 4 + d) * 16 + hi * 8) * 2;
                        b0[d] = *(const bf16x8*)(lds + L_KSW + KSWZ(64 * jt + r32, cbb)); b1[d] = *(const bf16x8*)(lds + L_KSW + KSWZ(64 * jt + 32 + r32, cbb)); }
                    SBAR();
#pragma unroll
                    for (int d = 0; d < 4; ++d) { p0 = __builtin_amdgcn_mfma_f32_32x32x16_bf16(b0[d], qr[dh * 4 + d], p0, 0, 0, 0); p1 = __builtin_amdgcn_mfma_f32_32x32x16_bf16(b1[d], qr[dh * 4 + d], p1, 0, 0, 0); }
                    SBAR(); }
#pragma unroll
                for (int g4 = 0; g4 < 4; ++g4) { const int k0 = 64 * jt + 8 * g4 + 4 * hi; const f32x4 bb0 = *(const f32x4*)(bco + k0), bb1 = *(const f32x4*)(bco + k0 + 32);
#pragma unroll
                    for (int i = 0; i < 4; ++i) { const int r = g4 * 4 + i;
                        const float e0 = __expf(aq + bb0[i]), e1 = __expf(aq + bb1[i]);
                        p0[r] = (k0 + i <= qidx) ? p0[r] * e0 : 0.f; p1[r] = (k0 + 32 + i <= qidx) ? p1[r] * e1 : 0.f; } }
                bf16x8 pa0, pa1, pa2, pa3;
#define PK4(P, BASE, OUT) do { unsigned a0 = cvtpk(P[BASE + 0], P[BASE + 1]), a1 = cvtpk(P[BASE + 2], P[BASE + 3]);   \
    unsigned b0_ = cvtpk(P[BASE + 4], P[BASE + 5]), b1_ = cvtpk(P[BASE + 6], P[BASE + 7]);                              \
    auto r0 = __builtin_amdgcn_permlane32_swap(a0, b0_, false, false); auto r1 = __builtin_amdgcn_permlane32_swap(a1, b1_, false, false); \
    u32x4 w4 = {r0[0], r1[0], r0[1], r1[1]}; OUT = *reinterpret_cast<bf16x8*>(&w4); } while (0)
                PK4(p0, 0, pa0); PK4(p0, 8, pa1); PK4(p1, 0, pa2); PK4(p1, 8, pa3);
#undef PK4
                s16x4 va[8], vc[8];
                const int vb = vbV + jt * 16384 + (2 * vh) * 512;
                TR8(va, vb); TR8(vc, vb + 512);
                asm volatile("s_waitcnt lgkmcnt(0)" ::: "memory"); SBAR();
                o0 = __builtin_amdgcn_mfma_f32_32x32x16_bf16(pa0, TRPK(va[0], va[1]), o0, 0, 0, 0); o0 = __builtin_amdgcn_mfma_f32_32x32x16_bf16(pa1, TRPK(va[2], va[3]), o0, 0, 0, 0);
                o0 = __builtin_amdgcn_mfma_f32_32x32x16_bf16(pa2, TRPK(va[4], va[5]), o0, 0, 0, 0); o0 = __builtin_amdgcn_mfma_f32_32x32x16_bf16(pa3, TRPK(va[6], va[7]), o0, 0, 0, 0);
                o1 = __builtin_amdgcn_mfma_f32_32x32x16_bf16(pa0, TRPK(vc[0], vc[1]), o1, 0, 0, 0); o1 = __builtin_amdgcn_mfma_f32_32x32x16_bf16(pa1, TRPK(vc[2], vc[3]), o1, 0, 0, 0);
                o1 = __builtin_amdgcn_mfma_f32_32x32x16_bf16(pa2, TRPK(vc[4], vc[5]), o1, 0, 0, 0); o1 = __builtin_amdgcn_mfma_f32_32x32x16_bf16(pa3, TRPK(vc[6], vc[7]), o1, 0, 0, 0);
                dn = __builtin_amdgcn_mfma_f32_32x32x16_bf16(pa0, ones, dn, 0, 0, 0); dn = __builtin_amdgcn_mfma_f32_32x32x16_bf16(pa1, ones, dn, 0, 0, 0);
                dn = __builtin_amdgcn_mfma_f32_32x32x16_bf16(pa2, ones, dn, 0, 0, 0); dn = __builtin_amdgcn_mfma_f32_32x32x16_bf16(pa3, ones, dn, 0, 0, 0);
            }
#define T4X(A, B, CTRL, ODD) do { const float s_ = (ODD) ? A : B; const float r_ = __builtin_bit_cast(float, __builtin_amdgcn_update_dpp(0, __builtin_bit_cast(int, s_), CTRL, 0xf, 0xf, false)); \
        A = (ODD) ? r_ : A; B = (ODD) ? B : r_; } while (0)
#define T4(X0, X1, X2, X3) do { T4X(X0, X1, 0xB1, q1_); T4X(X2, X3, 0xB1, q1_); T4X(X0, X2, 0x4E, q2_); T4X(X1, X3, 0x4E, q2_); } while (0)
            { const bool q1_ = (lane & 1) != 0, q2_ = (lane & 2) != 0; const int q = lane & 3;
#pragma unroll
              for (int g4 = 0; g4 < 4; ++g4) {
                float x[4], z[4];
#pragma unroll
                for (int i = 0; i < 4; ++i) { const int r = g4 * 4 + i; const float rd = __builtin_amdgcn_rcpf(fmaxf(fabsf(dn[r]), 1.0f)); x[i] = o0[r] * rd; z[i] = o1[r] * rd; }
                T4(x[0], x[1], x[2], x[3]); T4(z[0], z[1], z[2], z[3]);
                const int pr = rb * 32 + 8 * g4 + 4 * hi + q;
                bf16_t* hp = H + (size_t)(mrow0 + (dir ? 127 - pr : pr)) * 1024 + h * 256 + dvh * 128 + vh * 64 + (r32 & ~3);
                u32x2 w0, w1; w0.x = cvtpk(x[0], x[1]); w0.y = cvtpk(x[2], x[3]); w1.x = cvtpk(z[0], z[1]); w1.y = cvtpk(z[2], z[3]);
                *(u32x2*)hp = w0; *(u32x2*)(hp + 32) = w1; } }
#undef T4
#undef T4X
        }
#pragma unroll
        for (int r = 0; r < 16; ++r) { Cacc0[r] *= g; Cacc1[r] *= g; }
        f32x16 nacc = {};
        const bf16x8 ones1 = {0x3f80, 0x3f80, 0x3f80, 0x3f80, 0x3f80, 0x3f80, 0x3f80, 0x3f80};
#pragma unroll
        for (int jt = 0; jt < 2; ++jt) {
            s16x4 a0[8], a1[8], kb[8];
            const int va_ = vbV + jt * 16384 + (2 * vh) * 512, ka_ = vbK + jt * 16384 + rb * 512;
            TR8(kb, ka_); TR8(a0, va_); TR8(a1, va_ + 512);
            asm volatile("s_waitcnt lgkmcnt(0)" ::: "memory"); SBAR();
#pragma unroll
            for (int k = 0; k < 4; ++k) { const bf16x8 bf = TRPK(kb[2 * k], kb[2 * k + 1]);
                Cacc0 = __builtin_amdgcn_mfma_f32_32x32x16_bf16(TRPK(a0[2 * k], a0[2 * k + 1]), bf, Cacc0, 0, 0, 0); Cacc1 = __builtin_amdgcn_mfma_f32_32x32x16_bf16(TRPK(a1[2 * k], a1[2 * k + 1]), bf, Cacc1, 0, 0, 0);
                if (vh == 0) nacc = __builtin_amdgcn_mfma_f32_32x32x16_bf16(ones1, bf, nacc, 0, 0, 0); }
        }
        if (wid == 0 && c + 1 < 34) GSCAN((c + 1) & 1);
        __syncthreads();
#define T4X(A, B, CTRL, ODD) do { const float s_ = (ODD) ? A : B; const float r_ = __builtin_bit_cast(float, __builtin_amdgcn_update_dpp(0, __builtin_bit_cast(int, s_), CTRL, 0xf, 0xf, false)); \
        A = (ODD) ? r_ : A; B = (ODD) ? B : r_; } while (0)
#define T4(X0, X1, X2, X3) do { T4X(X0, X1, 0xB1, q1_); T4X(X2, X3, 0xB1, q1_); T4X(X0, X2, 0x4E, q2_); T4X(X1, X3, 0x4E, q2_); } while (0)
        { const bool q1_ = (lane & 1) != 0, q2_ = (lane & 2) != 0; const int q = lane & 3;
#pragma unroll
          for (int g4 = 0; g4 < 4; ++g4) {
            float x[4] = {Cacc0[g4 * 4 + 0], Cacc0[g4 * 4 + 1], Cacc0[g4 * 4 + 2], Cacc0[g4 * 4 + 3]}, z[4] = {Cacc1[g4 * 4 + 0], Cacc1[g4 * 4 + 1], Cacc1[g4 * 4 + 2], Cacc1[g4 * 4 + 3]};
            T4(x[0], x[1], x[2], x[3]); T4(z[0], z[1], z[2], z[3]);
            const int row = 8 * g4 + 4 * hi + q, colB = 2 * (32 * rb + (r32 & ~3));
            u32x2 w0, w1; w0.x = cvtpk(x[0], x[1]); w0.y = cvtpk(x[2], x[3]); w1.x = cvtpk(z[0], z[1]); w1.y = cvtpk(z[2], z[3]);
            *(u32x2*)(lds + L_CT + KSWZ(64 * vh + row, colB)) = w0; *(u32x2*)(lds + L_CT + KSWZ(64 * vh + 32 + row, colB)) = w1; } }
#undef T4
#undef T4X
        if (vh == 0 && hi == 0) { const int k = 32 * rb + r32; const float nn = g * nvec[k] + nacc[0]; nvec[k] = nn; nb[k] = (bf16_t)(cvtpk(nn, 0.f) & 0xffffu); }
    }
    __syncthreads();
}
#undef TRPK
#undef TR8
#undef KSWZ
#undef SBAR
#undef LOADS
#undef GSCAN
#undef MROW0
}

__device__ __forceinline__ void phase_mfinal(const Params& p, int G) {
    const int tid = otid(), lane = tid & 63, wave = __builtin_amdgcn_readfirstlane(tid >> 6);
    const int gw = blockIdx.x * 8 + wave, NGW = G * 8;
    bf16_t* HF = (bf16_t*)(p.ws + WS_HF); const bf16_t* HB = (const bf16_t*)(p.ws + WS_HB); const bf16_t* MO = (const bf16_t*)(p.ws + WS_MO);
    u32x2 na[4], nbq[4], nog[4];
#pragma unroll
    for (int j = 0; j < 4; ++j) { const size_t o = (size_t)gw * 1024 + 256 * j + 4 * lane; na[j] = *(const u32x2*)(HF + o); nbq[j] = *(const u32x2*)(HB + o); nog[j] = *(const u32x2*)(MO + o); }
    for (int m = gw; m < TL; m += NGW) {
        u32x2 ca[4], cb[4], cg[4];
#pragma unroll
        for (int j = 0; j < 4; ++j) { ca[j] = na[j]; cb[j] = nbq[j]; cg[j] = nog[j]; }
        if (m + NGW < TL) {
#pragma unroll
            for (int j = 0; j < 4; ++j) { const size_t o = (size_t)(m + NGW) * 1024 + 256 * j + 4 * lane; na[j] = *(const u32x2*)(HF + o); nbq[j] = *(const u32x2*)(HB + o); nog[j] = *(const u32x2*)(MO + o); } }
#pragma unroll
        for (int j = 0; j < 4; ++j) {
            const size_t o = (size_t)m * 1024 + 256 * j + 4 * lane;
            const u32x2 a = ca[j], bq = cb[j], og = cg[j];
            f32x4 hs = {bf_lo(a.x) + bf_lo(bq.x), bf_hi(a.x) + bf_hi(bq.x), bf_lo(a.y) + bf_lo(bq.y), bf_hi(a.y) + bf_hi(bq.y)};
            const float rstd = rsqrtf(wave_sum((hs[0] * hs[0] + hs[1] * hs[1]) + (hs[2] * hs[2] + hs[3] * hs[3])) * (1.0f / 256.0f) + EPS);
            const f32x4 g = *(const f32x4*)(p.mnorm_g + 256 * j + 4 * lane);
            const f32x4 ov = {sigmoidf_(bf_lo(og.x)), sigmoidf_(bf_hi(og.x)), sigmoidf_(bf_lo(og.y)), sigmoidf_(bf_hi(og.y))};
            const f32x4 r = hs * rstd * g * ov;
            u32x2 w; w.x = cvt_pk_bf16(r[0], r[1]); w.y = cvt_pk_bf16(r[2], r[3]); *(u32x2*)(HF + o) = w;
        }
    }
}

__device__ __forceinline__ void mfinal_part(const Params& p, int b, int h, int quarter) {
    const int tid = otid(), lane = tid & 63, wave = __builtin_amdgcn_readfirstlane(tid >> 6);
    bf16_t* HF = (bf16_t*)(p.ws + WS_HF); const bf16_t* HB = (const bf16_t*)(p.ws + WS_HB); const bf16_t* MO = (const bf16_t*)(p.ws + WS_MO);
    const f32x4 g = *(const f32x4*)(p.mnorm_g + 256 * h + 4 * lane);
    const size_t o0 = ((size_t)b * SEQ + quarter * 1024 + wave * 128) * 1024 + 256 * h + 4 * lane;
    u32x2 na[4], nbq[4], nog[4];
#pragma unroll
    for (int t = 0; t < 4; ++t) { na[t] = *(const u32x2*)(HF + o0 + (size_t)t * 1024); nbq[t] = *(const u32x2*)(HB + o0 + (size_t)t * 1024); nog[t] = *(const u32x2*)(MO + o0 + (size_t)t * 1024); }
    const bool u5 = (lane & 32) != 0, u4 = (lane & 16) != 0;
    for (int i = 0; i < 128; i += 4) {
        const size_t o = o0 + (size_t)i * 1024;
        u32x2 a[4], bq[4], og[4];
#pragma unroll
        for (int t = 0; t < 4; ++t) { a[t] = na[t]; bq[t] = nbq[t]; og[t] = nog[t]; }
        if (i + 4 < 128) {
#pragma unroll
            for (int t = 0; t < 4; ++t) { na[t] = *(const u32x2*)(HF + o + (size_t)(4 + t) * 1024); nbq[t] = *(const u32x2*)(HB + o + (size_t)(4 + t) * 1024); nog[t] = *(const u32x2*)(MO + o + (size_t)(4 + t) * 1024); } }
        f32x4 hs[4]; float ss[4];
#pragma unroll
        for (int t = 0; t < 4; ++t) { hs[t] = (f32x4){bf_lo(a[t].x) + bf_lo(bq[t].x), bf_hi(a[t].x) + bf_hi(bq[t].x), bf_lo(a[t].y) + bf_lo(bq[t].y), bf_hi(a[t].y) + bf_hi(bq[t].y)};
            ss[t] = (hs[t][0] * hs[t][0] + hs[t][1] * hs[t][1]) + (hs[t][2] * hs[t][2] + hs[t][3] * hs[t][3]); }
        float b2[2];
#pragma unroll
        for (int q = 0; q < 2; ++q) b2[q] = halve32(ss[q], ss[q + 2]);
        float val = halve16(b2[0], b2[1]);
        val = row16_sum(val);
#pragma unroll
        for (int t = 0; t < 4; ++t) {
            const float tot = __uint_as_float((unsigned)__builtin_amdgcn_readlane((int)__float_as_uint(val), 16 * t));
            const float rstd = rsqrtf(tot * (1.0f / 256.0f) + EPS);
            const f32x4 ov = {sigmoidf_(bf_lo(og[t].x)), sigmoidf_(bf_hi(og[t].x)), sigmoidf_(bf_lo(og[t].y)), sigmoidf_(bf_hi(og[t].y))};
            const f32x4 r = hs[t] * rstd * g * ov;
            u32x2 w; w.x = cvt_pk_bf16(r[0], r[1]); w.y = cvt_pk_bf16(r[2], r[3]); *(u32x2*)(HF + o + (size_t)t * 1024) = w; }
    }
}

__device__ __forceinline__ void phase_rows2(const Params& p, LAS unsigned char* lds, int grp) {
    const int tid = otid(), lane = tid & 63, wave = __builtin_amdgcn_readfirstlane(tid >> 6);
    LAS float* rw = (LAS float*)lds;
    LAS int* hist = (LAS int*)(lds + 131072);
    LAS int* basee = hist + 32;
    LAS int* a_e = basee + 32;
    LAS int* a_p = a_e + 512;
    LAS float* a_g = (LAS float*)(a_p + 512);
    for (int k = tid; k < 1024; k += NTHREADS) {
#pragma unroll
        for (int eq = 0; eq < 8; ++eq) { const f32x4 w = *(const f32x4*)(p.router_w + (size_t)k * 32 + eq * 4);
#pragma unroll
            for (int j = 0; j < 4; ++j) rw[(eq * 4 + j) * 1024 + k] = w[j]; } }
    if (tid < 32) hist[tid] = 0;
    __syncthreads();
    const float* mod = (const float*)(p.ws + WS_MOD); unsigned char* U2 = p.ws + WS_U2;
    unsigned* cnt = (unsigned*)(p.ws + WS_CTL) + CW_CNT; int* asg = (int*)(p.ws + WS_ASG); int* list = (int*)(p.ws + WS_LIST); float* lgate = (float*)(p.ws + WS_LGATE);
    f32x4 gn[4];
#pragma unroll
    for (int j = 0; j < 4; ++j) gn[j] = *(const f32x4*)(p.norm2_g + 4 * lane + 256 * j);
    const int tok0 = grp * 128 + wave * 16;
    const bf16_t* X1 = (const bf16_t*)(p.ws + WS_X1);
    u32x2 vn[4];
#pragma unroll
    for (int j = 0; j < 4; ++j) vn[j] = *(const u32x2*)(X1 + (size_t)tok0 * 1024 + 4 * lane + 256 * j);
    for (int it = 0; it < 16; ++it) {
        const int m = tok0 + it; const float* md = mod + (size_t)(m >> 12) * 6144;
        f32x4 v[4]; float ss = 0.f;
#pragma unroll
        for (int j = 0; j < 4; ++j) { v[j] = (f32x4){bf_lo(vn[j].x), bf_hi(vn[j].x), bf_lo(vn[j].y), bf_hi(vn[j].y)}; ss += (v[j][0] * v[j][0] + v[j][1] * v[j][1]) + (v[j][2] * v[j][2] + v[j][3] * v[j][3]); }
        if (it + 1 < 16) {
#pragma unroll
            for (int j = 0; j < 4; ++j) vn[j] = *(const u32x2*)(X1 + (size_t)(m + 1) * 1024 + 4 * lane + 256 * j); }
        const float rstd = rsqrtf(wave_sum(ss) * (1.0f / 1024.0f) + EPS);
#pragma unroll
        for (int j = 0; j < 4; ++j) { const f32x4 sh = *(const f32x4*)(md + 3072 + 4 * lane + 256 * j), sc = *(const f32x4*)(md + 4096 + 4 * lane + 256 * j);
            v[j] = (v[j] * rstd * gn[j]) * (sc + 1.0f) + sh;
            *(unsigned*)(U2 + (size_t)m * 1024 + 4 * lane + 256 * j) = pk4_fp8(v[j][0], v[j][1], v[j][2], v[j][3]); }
        float a[32];
#pragma unroll
        for (int e = 0; e < 32; ++e) a[e] = 0.f;
#pragma unroll
        for (int j = 0; j < 4; ++j) {
#pragma unroll
            for (int eh = 0; eh < 2; ++eh) {
#pragma unroll
                for (int e = eh * 16; e < eh * 16 + 16; ++e) { const f32x4 w = *(const LAS f32x4*)(rw + e * 1024 + 4 * lane + 256 * j); a[e] = fmaf(v[j][3], w[3], fmaf(v[j][2], w[2], fmaf(v[j][1], w[1], fmaf(v[j][0], w[0], a[e])))); }
                asm volatile("" ::: "memory"); } }
        float mine;
        { const bool u5 = (lane & 32) != 0, u4 = (lane & 16) != 0, u3 = (lane & 8) != 0, u2 = (lane & 4) != 0, u1 = (lane & 2) != 0;
          float b16[16], b8[8], b4[4], b2[2];
#pragma unroll
          for (int g = 0; g < 16; ++g) b16[g] = halve32(a[g], a[g + 16]);
#pragma unroll
          for (int g = 0; g < 8; ++g) b8[g] = halve16(b16[g], b16[g + 8]);
#pragma unroll
          for (int g = 0; g < 4; ++g) b4[g] = halve8(b8[g], b8[g + 4], u3);
#pragma unroll
          for (int g = 0; g < 2; ++g) b2[g] = halve4(b4[g], b4[g + 2], u2);
          mine = halve2(b2[0], b2[1], u1);
          mine = DPP_ADD(mine, 0xB1); }
        const int eidx = lane >> 1;
        mine += p.router_b[eidx];
        LAS float* lg = (LAS float*)(lds + 131072 + 8192) + wave * 48;
        if (!(lane & 1)) lg[eidx] = mine;
        asm volatile("s_waitcnt lgkmcnt(0)" ::: "memory");
        int rank = 0;
#pragma unroll
        for (int q = 0; q < 8; ++q) { const f32x4 o4 = *(const LAS f32x4*)(lg + 4 * q);
#pragma unroll
            for (int i = 0; i < 4; ++i) { const int oe = 4 * q + i; rank += (o4[i] > mine || (o4[i] == mine && oe < eidx)) ? 1 : 0; } }
        if (!(lane & 1) && rank < 4) { lg[32 + rank] = mine; ((LAS int*)lg)[36 + rank] = eidx; }
        asm volatile("s_waitcnt lgkmcnt(0)" ::: "memory");
        if (lane == 0) {
            const f32x4 sv = *(const LAS f32x4*)(lg + 32); const int se0 = ((const LAS int*)lg)[36], se1 = ((const LAS int*)lg)[37], se2 = ((const LAS int*)lg)[38], se3 = ((const LAS int*)lg)[39];
            const float sel_v[4] = {sv[0], sv[1], sv[2], sv[3]}; const int sel_e[4] = {se0, se1, se2, se3};
            const float e1 = __expf(sel_v[1] - sel_v[0]), e2 = __expf(sel_v[2] - sel_v[0]), e3 = __expf(sel_v[3] - sel_v[0]); const float inv = 1.0f / (1.0f + e1 + e2 + e3);
            const float gk[4] = {inv, e1 * inv, e2 * inv, e3 * inv};
#pragma unroll
            for (int k = 0; k < 4; ++k) { const int a = (wave * 16 + it) * 4 + k; a_e[a] = sel_e[k]; a_p[a] = atomicAdd((int*)&hist[sel_e[k]], 1); a_g[a] = gk[k]; }
        }
        asm volatile("s_waitcnt lgkmcnt(0)" ::: "memory");
    }
    __syncthreads();
    if (tid < 32) basee[tid] = (int)atomicAdd(cnt + tid, (unsigned)hist[tid]);
    __syncthreads();
    {
        const int a = tid; const int e = a_e[a]; const int pos = basee[e] + a_p[a]; const int tok = grp * 128 + (a >> 2);
        list[(size_t)e * CAP + pos] = tok; lgate[(size_t)e * CAP + pos] = a_g[a]; asg[tok * 4 + (a & 3)] = e * CAP + pos;
    }
    __syncthreads();
}

__device__ __forceinline__ void moe_tables(const Params& p, LAS int* tb, LAS int* cn) {
    if (threadIdx.x < 64) {
        const int lane = threadIdx.x; const unsigned* cnt = (const unsigned*)(p.ws + WS_CTL) + CW_CNT;
        const int c = lane < 32 ? (int)__hip_atomic_load(cnt + lane, __ATOMIC_RELAXED, __HIP_MEMORY_SCOPE_AGENT) : 0; const int tiles = (c + 255) >> 8;
        int incl = tiles;
#pragma unroll
        for (int o = 1; o < 32; o <<= 1) { const int t = __shfl_up(incl, o); if (lane >= o) incl += t; }
        if (lane < 32) { cn[lane] = c; tb[lane] = incl - tiles; if (lane == 31) tb[32] = incl; } }
    __syncthreads();
    if (threadIdx.x < 32) { const int e = threadIdx.x; for (int rt = tb[e]; rt < tb[e + 1]; ++rt) tb[RT2E_OFF + rt] = e; }
    __syncthreads();
}

__device__ __forceinline__ void phase_final(const Params& p, const LAS int* tb, int G) {
    const int tid = otid(), lane = tid & 63, wave = __builtin_amdgcn_readfirstlane(tid >> 6);
    const int gw = blockIdx.x * 8 + wave, NGW = G * 8;
    const float* mod = (const float*)(p.ws + WS_MOD); const bf16_t* YS = (const bf16_t*)(p.ws + WS_YS); const int* asg = (const int*)(p.ws + WS_ASG);
    f32x4 gn[4];
#pragma unroll
    for (int j = 0; j < 4; ++j) gn[j] = *(const f32x4*)(p.final_g + 4 * lane + 256 * j);
    auto rowoff = [&](int a) -> size_t { const int e = a >> 15, pos = a & (CAP - 1); return (size_t)(tb[e] * 256 + pos) * 1024; };
    int a_n[4];
    const bf16_t* X1 = (const bf16_t*)(p.ws + WS_X1);
    u32x2 xn[4]; u32x2 yn[4][4];
    { const int m0 = gw, m1 = gw + NGW; int a0[4];
#pragma unroll
      for (int k = 0; k < 4; ++k) { a0[k] = asg[m0 * 4 + k]; a_n[k] = m1 < TL ? asg[m1 * 4 + k] : 0; }
#pragma unroll
      for (int j = 0; j < 4; ++j) { xn[j] = *(const u32x2*)(X1 + (size_t)m0 * 1024 + 4 * lane + 256 * j);
#pragma unroll
        for (int k = 0; k < 4; ++k) yn[k][j] = *(const u32x2*)(YS + rowoff(a0[k]) + 4 * lane + 256 * j); } }
    for (int m = gw; m < TL; m += NGW) {
        float* xr = p.out + (size_t)m * 1024; const float* g2 = mod + (size_t)(m >> 12) * 6144 + 5120;
        u32x2 xc[4]; u32x2 yc[4][4];
#pragma unroll
        for (int j = 0; j < 4; ++j) { xc[j] = xn[j];
#pragma unroll
            for (int k = 0; k < 4; ++k) yc[k][j] = yn[k][j]; }
        if (m + NGW < TL) { const int m1 = m + NGW, m2 = m + 2 * NGW; int a1[4];
#pragma unroll
            for (int k = 0; k < 4; ++k) { a1[k] = a_n[k]; a_n[k] = m2 < TL ? asg[m2 * 4 + k] : 0; }
#pragma unroll
            for (int j = 0; j < 4; ++j) { xn[j] = *(const u32x2*)(X1 + (size_t)m1 * 1024 + 4 * lane + 256 * j);
#pragma unroll
                for (int k = 0; k < 4; ++k) yn[k][j] = *(const u32x2*)(YS + rowoff(a1[k]) + 4 * lane + 256 * j); } }
        f32x4 v[4]; float ss = 0.f;
#pragma unroll
        for (int j = 0; j < 4; ++j) {
            f32x4 y = {0.f, 0.f, 0.f, 0.f};
#pragma unroll
            for (int k = 0; k < 4; ++k) { const u32x2 w = yc[k][j]; y[0] += bf_lo(w.x); y[1] += bf_hi(w.x); y[2] += bf_lo(w.y); y[3] += bf_hi(w.y); }
            v[j] = (f32x4){bf_lo(xc[j].x), bf_hi(xc[j].x), bf_lo(xc[j].y), bf_hi(xc[j].y)} + *(const f32x4*)(g2 + 4 * lane + 256 * j) * y;
            ss += (v[j][0] * v[j][0] + v[j][1] * v[j][1]) + (v[j][2] * v[j][2] + v[j][3] * v[j][3]);
        }
        const float rstd = rsqrtf(wave_sum(ss) * (1.0f / 1024.0f) + EPS);
#pragma unroll
        for (int j = 0; j < 4; ++j) *(f32x4*)(xr + 4 * lane + 256 * j) = v[j] * rstd * gn[j];
    }
}

__device__ __forceinline__ void phase_attn(const Params& p, LAS unsigned char* lds_, int G, bf16_t* BO, unsigned* ctr) {
    char* lds = (char*)(unsigned char*)lds_;
    volatile int* uslot = (volatile int*)(lds + att::SHM_ATTN);
    const float lam = *(const float*)(p.ws + WS_LAM);
    const int xcc = (int)(__builtin_amdgcn_s_getreg((3 << 11) | 20) & 7u);
    const bf16_t* DQ = (const bf16_t*)(p.ws + WS_DQ); const bf16_t* DK = (const bf16_t*)(p.ws + WS_DK); const bf16_t* DV = (const bf16_t*)(p.ws + WS_DV);
    int q = 0;
    for (;;) {
        const int xq = (xcc + q) & 7;
        __syncthreads();
        if (threadIdx.x == 0) uslot[0] = (int)atomicAdd(ctr + 16 * xq, 1u);
        __syncthreads();
        const int u = uslot[0];
        if (u >= 256) { if (++q == 8) break; continue; }
        const int bh = (u >> 5) * 8 + xq, qb = u & 31, b = bh >> 3, h = bh & 7;
        const size_t qoff = ((size_t)b * SEQ + qb * 128) * 1024 + h * 128, koff = (size_t)b * KVLEN * 1024 + h * 128;
        att::attn_unit2(DQ + qoff, DK + koff, DV + koff, BO + qoff, p.dnorm_g + h * 128, (const float*)(p.ws + WS_CTL) + CW_KMAX + b * 32 + h * 4, lam, KVLEN, lds);
    }
}


#define XB_TMO      128
#define XB_XCNT(j)  (256  + 64 * (j))
#define XB_XSUB(j)  (1280 + 64 * (j))
#define XB_XGEN(j)  (2304 + 64 * (j))
#define XB_TOP      3328
#define XB_TOPGEN   3392
#define XCD_BAR_WORDS 3456
#define XB_SPIN_CAP (1u << 22)
__device__ __forceinline__ unsigned xb_ld(unsigned* p)              { return __hip_atomic_load(p, __ATOMIC_RELAXED, __HIP_MEMORY_SCOPE_AGENT); }
__device__ __forceinline__ unsigned xb_add(unsigned* p, unsigned v) { return __hip_atomic_fetch_add(p, v, __ATOMIC_RELAXED, __HIP_MEMORY_SCOPE_AGENT); }
__device__ __forceinline__ unsigned xb_xcc_id() { return (unsigned)__builtin_amdgcn_s_getreg((3 << 11) | 20) & 0xFu; }
#define XB_SPIN(cond, bar) do { unsigned _sp = 0; while (cond) { __builtin_amdgcn_s_sleep(1); \
    if ((++_sp & 255u) == 0u) { if (xb_ld(&(bar)[XB_TMO])) break; if (_sp > XB_SPIN_CAP) { atomicAdd(&(bar)[XB_TMO], 1u); break; } } } } while (0)
struct XcdBarrier { unsigned* bar; unsigned x; volatile LAS unsigned* st; };
__device__ __forceinline__ XcdBarrier xcd_barrier_post(unsigned* bar, volatile LAS unsigned* st) {
    XcdBarrier b; b.bar = bar; b.x = xb_xcc_id(); b.st = st;
    if (threadIdx.x == 0) (void)xb_add(&bar[XB_XCNT(b.x)], 1u);
    return b;
}
__device__ __forceinline__ void xcd_barrier_complete(unsigned* bar, unsigned x, unsigned& nloc, unsigned& nx) {
    const unsigned G = gridDim.x * gridDim.y * gridDim.z;
    unsigned sum, cnt, mine, sp = 0u;
    for (;;) {
        sum = 0u; cnt = 0u; mine = 0u;
#pragma unroll
        for (unsigned j = 0; j < 16; ++j) { const unsigned c = xb_ld(&bar[XB_XCNT(j)]); sum += c; cnt += (c > 0u) ? 1u : 0u; mine = (j == x) ? c : mine; }
        if (sum == G) break;
        __builtin_amdgcn_s_sleep(1);
        if ((++sp & 255u) == 0u) { if (xb_ld(&bar[XB_TMO])) break; if (sp > XB_SPIN_CAP) { atomicAdd(&bar[XB_TMO], 1u); break; } }
    }
    nloc = mine > 0u ? mine : 1u; nx = cnt > 0u ? cnt : 1u;
}
__device__ __forceinline__ void xcd_barrier(const XcdBarrier& b) {
    asm volatile("s_waitcnt vmcnt(0)" ::: "memory");
    __syncthreads();
    if (threadIdx.x == 0) {
        unsigned* bar = b.bar;
        __builtin_amdgcn_s_waitcnt(0);
        unsigned nloc = b.st[0], nx = b.st[1];
        if (nloc == 0u) { xcd_barrier_complete(bar, b.x, nloc, nx); b.st[0] = nloc; b.st[1] = nx; }
        const unsigned k = b.st[2];
        const unsigned old = xb_add(&bar[XB_XSUB(b.x)], 1u);
        if (old + 1u == (k + 1u) * nloc) {
            __builtin_amdgcn_fence(__ATOMIC_RELEASE, "agent");
            asm volatile("s_waitcnt vmcnt(0)" ::: "memory");
            const unsigned og = xb_add(&bar[XB_TOP], 1u);
            if (og + 1u == (k + 1u) * nx) xb_add(&bar[XB_TOPGEN], 1u);
        }
        XB_SPIN(xb_ld(&bar[XB_TOPGEN]) < k + 1u, bar);
        __builtin_amdgcn_fence(__ATOMIC_ACQUIRE, "agent");
        asm volatile("s_waitcnt vmcnt(0)" ::: "memory");
        b.st[2] = k + 1u;
    }
    __syncthreads();
}


#define FP8_SELFTEST 0
#if FP8_SELFTEST
typedef int v8i __attribute__((ext_vector_type(8)));
__device__ __forceinline__ int fp8_selftest(int lane) {
    const int i = lane & 15, kb = lane >> 4;
    v8i A, B;
#pragma unroll
    for (int d = 0; d < 8; ++d) {
        float av[4], bv[4];
#pragma unroll
        for (int t = 0; t < 4; ++t) { const int k = 32 * kb + 4 * d + t; av[t] = (float)(((i * 7 + k * 3) % 5) - 2); bv[t] = (float)(((k * 5 + i) % 7) - 3); }
        int wa = 0, wb = 0;
        wa = __builtin_amdgcn_cvt_pk_fp8_f32(av[0], av[1], wa, false); wa = __builtin_amdgcn_cvt_pk_fp8_f32(av[2], av[3], wa, true);
        wb = __builtin_amdgcn_cvt_pk_fp8_f32(bv[0], bv[1], wb, false); wb = __builtin_amdgcn_cvt_pk_fp8_f32(bv[2], bv[3], wb, true);
        A[d] = wa; B[d] = wb;
    }
    f32x4 C = {0.f, 0.f, 0.f, 0.f}, C2 = {0.f, 0.f, 0.f, 0.f};
    C = __builtin_amdgcn_mfma_scale_f32_16x16x128_f8f6f4(A, B, C, 0, 0, 0, 0x7f7f7f7f, 0, 0x7f7f7f7f);
    C2 = __builtin_amdgcn_mfma_scale_f32_16x16x128_f8f6f4(A, B, C2, 0, 0, 0, 0x79797979, 0, 0x7f7f7f7f);
    bool ok = true;
#pragma unroll
    for (int r = 0; r < 4; ++r) { const int row = 4 * kb + r, col = i; float ref = 0.f;
        for (int k = 0; k < 128; ++k) ref += (float)(((row * 7 + k * 3) % 5) - 2) * (float)(((k * 5 + col) % 7) - 3);
        ok = ok && (C[r] == ref) && (C2[r] == ref * 0.015625f); }
    return __all(ok) ? 1 : 0;
}
#endif

__global__ void __launch_bounds__(NTHREADS, 2) fwd_megakernel(Params p) {
    extern __shared__ __attribute__((aligned(16))) unsigned char smem[];
    LAS unsigned char* lds = (LAS unsigned char*)smem;
    cg::grid_group grid = cg::this_grid();
    const int G = gridDim.x, c = blockIdx.x;
    unsigned char* ws = p.ws;
    volatile LAS unsigned* bst = (volatile LAS unsigned*)(lds + LDS_BYTES - 64);
    if (threadIdx.x < 16) bst[threadIdx.x] = 0u;
    __syncthreads();
    const XcdBarrier xbar = xcd_barrier_post((unsigned*)(ws + WS_CTL) + CW_BAR, bst);
#define GSYNC() xcd_barrier(xbar)

#ifndef PH_MASK
#define PH_MASK 0xFFFF
#endif
#define PH(k) if constexpr (((PH_MASK) >> (k)) & 1)
#ifndef REP_MASK
#define REP_MASK 0
#endif
#define REP(k) for (int rep_ = 0; rep_ < ((((REP_MASK) >> (k)) & 1) ? 2 : 1); ++rep_)
    PH(0) REP(0) { phase_prep(p, lds, G); __syncthreads(); }
    grid.sync();
    PH(1) phase_rows1(p, lds, G);
    GSYNC();
    PH(2) REP(2) {
        SchedIn S{(const char*)(ws + WS_U), (const char*)(ws + WS_WIN), G, c};
        EpiIn E{ws, (const float*)(ws + WS_ROPE), (const float*)(ws + WS_ROPE) + 1024};
        pg8::gemm_phase<EpiIn, SchedIn, false, true>(lds, S, E, 0);
    }
    GSYNC();
#ifdef MLSTM_NAIVE
    PH(3) for (int item = c; item < 128; item += G) phase_mlstm_naive(p, lds, item);
#else
    const bool fuse_mf = (G >= 128) && !((REP_MASK >> 3) & 1);
    PH(3) REP(3) for (int it = c; it < 128; it += G) {
        const int x = it & 7, j = it >> 3; const int bh = x * 4 + (j >> 2); mls2::mlstm_item(p, lds, (bh << 2) | (j & 3));
        if (fuse_mf) {
            unsigned* done = (unsigned*)(ws + WS_CTL) + CW_MF + bh;
            asm volatile("s_waitcnt vmcnt(0)" ::: "memory"); __syncthreads();
            if (threadIdx.x == 0) {
                __builtin_amdgcn_fence(__ATOMIC_RELEASE, "agent"); asm volatile("s_waitcnt vmcnt(0)" ::: "memory");
                __hip_atomic_fetch_add(done, 1u, __ATOMIC_RELAXED, __HIP_MEMORY_SCOPE_AGENT);
                unsigned sp = 0; while (__hip_atomic_load(done, __ATOMIC_RELAXED, __HIP_MEMORY_SCOPE_AGENT) < 4u) { __builtin_amdgcn_s_sleep(8); if (++sp > (1u << 24)) break; }
                __builtin_amdgcn_fence(__ATOMIC_ACQUIRE, "agent"); asm volatile("s_waitcnt vmcnt(0)" ::: "memory");
            }
            __syncthreads();
            mfinal_part(p, bh >> 2, bh & 3, j & 3);
        }
    }
#endif
    if (G >= 160 && c >= 128 && c < 160) t8_static(p, lds, 256 + (c - 128), 32, T8_ITEMS);
    if constexpr ((REP_MASK >> 4) & 1) { phase_attn(p, lds, G, (bf16_t*)(ws + WS_END), (unsigned*)(ws + WS_CTL) + CW_ATT + 512); }
    PH(4) phase_attn(p, lds, G, (bf16_t*)(ws + WS_BO), (unsigned*)(ws + WS_CTL) + CW_ATT);
    GSYNC();
    if (!fuse_mf) { PH(5) phase_mfinal(p, G); GSYNC(); }
    PH(6) REP(6) {
        SchedMerge2 S{(const char*)(ws + WS_AO), (const char*)(ws + WS_WA), (const char*)(ws + WS_BO), (const char*)(ws + WS_WB), 128, 4, G, c};
        EpiMerge2 E{(const bf16_t*)(ws + WS_GA), (const bf16_t*)(ws + WS_GB), (bf16_t*)(ws + WS_T), (bf16_t*)(ws + WS_Y)};
        pg8::gemm_phase<EpiMerge2, SchedMerge2, false>(lds, S, E);
    }
    GSYNC();
    PH(8) REP(8) {
        SchedStatic S{(const char*)(ws + WS_Y), (const char*)(ws + WS_WO), 128, 4, G, c};
        EpiOut E{p.x, (const float*)(ws + WS_MOD), (bf16_t*)(ws + WS_X1)};
        pg8::gemm_phase<EpiOut, SchedStatic, false>(lds, S, E);
    }
    GSYNC();
    PH(9) for (int grp = c; grp < 256; grp += G) phase_rows2(p, lds, grp);
    GSYNC();
    LAS int* tb = (LAS int*)(lds + 131072); LAS int* cn = tb + 64;
    moe_tables(p, tb, cn);
    PH(10) REP(10) {
        SchedMoe1 S{(const char*)(ws + WS_U2), (const char*)(ws + WS_W1), (const int*)(ws + WS_LIST), tb, cn, G, c};
        EpiMoe1 E{ws + WS_ACT, p.exp_b1};
        pg8::gemm_phase<EpiMoe1, SchedMoe1, true, true>(lds, S, E);
    }
    GSYNC();
    PH(11) REP(11) {
        SchedMoe2 S{(const char*)(ws + WS_ACT), (const char*)(ws + WS_W2), tb, G, c};
        EpiMoe2 E{(bf16_t*)(ws + WS_YS), p.exp_b2, (const float*)(ws + WS_LGATE), cn};
        pg8::gemm_phase<EpiMoe2, SchedMoe2, false, true>(lds, S, E);
    }
    GSYNC();
    PH(12) phase_final(p, tb, G);
#if FP8_SELFTEST
    if (blockIdx.x == 0 && threadIdx.x < 64) { const int okf = fp8_selftest(threadIdx.x); VM_WAIT(); if (!okf && threadIdx.x == 0) p.out[0] = __builtin_nanf(""); }
#endif
}

extern "C" void kernel_launch(void* const* d_in, const int* in_sizes, int n_in, void* d_out, int out_size, void* d_ws, size_t ws_size, hipStream_t stream) {
    static int grid = 0;
    if (grid == 0) {
        if (n_in != 23 || out_size != TL * D || ws_size < WS_END) { fprintf(stderr, "kernel_launch: unexpected shapes: n_in %d out %d ws %zu (need %zu)\n", n_in, out_size, ws_size, (size_t)WS_END); grid = -1; return; }
        int dev = 0, cus = 0, per_cu = 0;
        (void)hipGetDevice(&dev); (void)hipDeviceGetAttribute(&cus, hipDeviceAttributeMultiprocessorCount, dev);
        if (hipFuncSetAttribute((const void*)fwd_megakernel, hipFuncAttributeMaxDynamicSharedMemorySize, LDS_BYTES) != hipSuccess) { fprintf(stderr, "kernel_launch: hipFuncSetAttribute failed\n"); grid = -1; return; }
        if (hipOccupancyMaxActiveBlocksPerMultiprocessor(&per_cu, (const void*)fwd_megakernel, NTHREADS, LDS_BYTES) != hipSuccess || per_cu < 1) { fprintf(stderr, "kernel_launch: occupancy query says %d\n", per_cu); per_cu = 1; }
        (void)hipGetLastError();
        grid = cus;
        if (grid > 256) grid = 256;
    }
    if (grid < 0) return;
    (void)hipMemsetAsync((char*)d_ws + WS_CTL, 0, 32768, stream);
    Params p{};
    const float** pp = (const float**)&p;
    for (int i = 0; i < 23; ++i) pp[i] = (const float*)d_in[i];
    p.out = (float*)d_out; p.ws = (unsigned char*)d_ws;
    void* args[] = {&p};
    hipError_t e = hipLaunchCooperativeKernel((const void*)fwd_megakernel, dim3(grid), dim3(NTHREADS), args, LDS_BYTES, stream);
    if (e != hipSuccess) fprintf(stderr, "cooperative launch failed: %s (grid %d)\n", hipGetErrorString(e), grid);
}
```
